# Optimizing an MI355X kernel written in HIP

```python
import math
import jax, jax.numpy as jnp
from jax import lax
import numpy as np

D_MODEL = 2048
BATCH = 4
SEQ = 2048
DEPTH = 1

HEAD_DIM = 64
SWA_Q_HEADS = 16
SWA_KV_HEADS = 4
SWA_GROUP = SWA_Q_HEADS // SWA_KV_HEADS
WINDOW = 128
FOX_HEADS = 16
BLOCK = 128
N_EXPERTS = 64
TOP_K = 8
N_GROUPS = 8
TOPK_GROUPS = 4
EXPERT_FF = 512
SHARED_FF = 512
ROUTED_SCALE = 2.5
MOE_BLOCK = 128
RMS_EPS = 1e-6
FORGET_BIAS_INIT = 4.0

SWA_Q_W = SWA_Q_HEADS * HEAD_DIM
SWA_KV_W = SWA_KV_HEADS * HEAD_DIM
FOX_W = FOX_HEADS * HEAD_DIM
SPLIT_SIZES = (SWA_Q_W, SWA_KV_W, SWA_KV_W, FOX_W, FOX_W, FOX_W, FOX_HEADS, D_MODEL, D_MODEL)
SPLIT_POINTS = tuple(int(v) for v in np.cumsum(SPLIT_SIZES)[:-1])
IN_WIDTH = int(sum(SPLIT_SIZES))

kernel_name = 'hybrid_swa_fox_gated_moe_block'


def rms_norm(x, g):
    xf = x.astype(jnp.float32)
    y = xf * lax.rsqrt(jnp.mean(xf * xf, axis=-1, keepdims=True) + RMS_EPS)
    return (y * g.astype(jnp.float32)).astype(x.dtype)


def alibi_slopes(n):
    return jnp.asarray([2.0 ** (-8.0 * (h + 1) / n) for h in range(n)], jnp.float32)


def sliding_window_attention(q, k, v, sinks):
    B, S = q.shape[0], q.shape[1]
    nb = S // BLOCK
    qb = q.reshape(B, nb, BLOCK, SWA_KV_HEADS, SWA_GROUP, HEAD_DIM)
    kb = k.reshape(B, nb, BLOCK, SWA_KV_HEADS, HEAD_DIM)
    vb = v.reshape(B, nb, BLOCK, SWA_KV_HEADS, HEAD_DIM)
    pad = ((0, 0), (1, 0), (0, 0), (0, 0), (0, 0))
    kk = jnp.concatenate([jnp.pad(kb, pad)[:, :-1], kb], axis=2)
    vv = jnp.concatenate([jnp.pad(vb, pad)[:, :-1], vb], axis=2)
    s = jnp.einsum('bnqhgd,bnkhd->bnhgqk', qb, kk).astype(jnp.float32) * (HEAD_DIM ** -0.5)
    qpos = jnp.arange(BLOCK)[:, None] + BLOCK
    kpos = jnp.arange(2 * BLOCK)[None, :]
    dist = qpos - kpos
    in_band = (dist >= 0) & (dist < WINDOW)
    has_prev = (jnp.arange(nb)[:, None, None] > 0) | (kpos[None] >= BLOCK)
    valid = in_band[None] & has_prev
    slopes = alibi_slopes(SWA_Q_HEADS).reshape(SWA_KV_HEADS, SWA_GROUP)
    s = s - slopes[:, :, None, None] * dist.astype(jnp.float32)
    s = jnp.where(valid[None, :, None, None], s, -jnp.inf)
    sink = sinks.astype(jnp.float32).reshape(SWA_KV_HEADS, SWA_GROUP)[:, :, None, None]
    m = jnp.maximum(jnp.max(s, axis=-1, keepdims=True), sink)
    p = jnp.exp(s - m)
    p = p / (jnp.sum(p, axis=-1, keepdims=True) + jnp.exp(sink - m))
    o = jnp.einsum('bnhgqk,bnkhd->bnqhgd', p.astype(v.dtype), vv)
    return o.reshape(B, S, SWA_Q_W)


def forgetting_attention(q, k, v, f_logit):
    B, S = q.shape[0], q.shape[1]
    c = jnp.cumsum(jax.nn.log_sigmoid(f_logit.astype(jnp.float32)), axis=1)
    c = jnp.transpose(c, (0, 2, 1))
    scale = HEAD_DIM ** -0.5
    outs = []
    for i in range(S // BLOCK):
        q0, q1 = i * BLOCK, (i + 1) * BLOCK
        s = jnp.einsum('bqhd,bkhd->bhqk', q[:, q0:q1], k[:, :q1]).astype(jnp.float32) * scale
        s = s + c[:, :, q0:q1, None] - c[:, :, None, :q1]
        causal = jnp.arange(q1)[None, :] <= (q0 + jnp.arange(BLOCK))[:, None]
        p = jax.nn.softmax(jnp.where(causal, s, -jnp.inf), axis=-1)
        outs.append(jnp.einsum('bhqk,bkhd->bqhd', p.astype(v.dtype), v[:, :q1]))
    return jnp.concatenate(outs, axis=1).reshape(B, S, FOX_W)


def swiglu(x, wg, wu, wd):
    return (jax.nn.silu(x @ wg) * (x @ wu)) @ wd


def route(u, w_router, router_bias):
    T = u.shape[0]
    scores = jax.nn.sigmoid((u @ w_router).astype(jnp.float32))
    biased = scores + router_bias.astype(jnp.float32)
    grp = biased.reshape(T, N_GROUPS, N_EXPERTS // N_GROUPS)
    grp_score = jnp.sum(lax.top_k(grp, 2)[0], axis=-1)
    _, gidx = lax.top_k(grp_score, TOPK_GROUPS)
    gmask = jnp.sum(jax.nn.one_hot(gidx, N_GROUPS, dtype=jnp.float32), axis=1) > 0
    emask = jnp.repeat(gmask, N_EXPERTS // N_GROUPS, axis=1)
    _, eidx = lax.top_k(jnp.where(emask, biased, -jnp.inf), TOP_K)
    w = jnp.take_along_axis(scores, eidx, axis=1)
    w = w / jnp.sum(w, axis=-1, keepdims=True) * ROUTED_SCALE
    return eidx, w


def routed_experts(u, eidx, gate_w, w_gate, w_up, w_down):
    T, D = u.shape
    A = T * TOP_K
    e_flat = eidx.reshape(A)
    tok_flat = (jnp.arange(A, dtype=jnp.int32) // TOP_K)
    w_flat = gate_w.reshape(A)
    order = jnp.argsort(e_flat)
    e_s, tok_s, w_s = e_flat[order], tok_flat[order], w_flat[order]
    counts = jnp.bincount(e_flat, length=N_EXPERTS)
    padded = (counts + MOE_BLOCK - 1) // MOE_BLOCK * MOE_BLOCK
    start = jnp.cumsum(counts) - counts
    pad_end = jnp.cumsum(padded)
    pad_start = pad_end - padded
    dest = jnp.arange(A) - start[e_s] + pad_start[e_s]
    n_blocks = -(-A // MOE_BLOCK) + N_EXPERTS
    P = n_blocks * MOE_BLOCK
    row_tok = jnp.zeros((P,), jnp.int32).at[dest].set(tok_s)
    row_w = jnp.zeros((P,), u.dtype).at[dest].set(w_s.astype(u.dtype))
    blk_exp = jnp.minimum(jnp.searchsorted(pad_end, jnp.arange(n_blocks) * MOE_BLOCK, side='right'), N_EXPERTS - 1)

    def run_block(args):
        toks, e = args
        return swiglu(u[toks], w_gate[e], w_up[e], w_down[e])

    y = lax.map(run_block, (row_tok.reshape(n_blocks, MOE_BLOCK), blk_exp))
    y = y.reshape(P, D) * row_w[:, None]
    return jax.ops.segment_sum(y, row_tok, num_segments=T)


def setup_inputs(seed: int = 0) -> dict:
    key = jax.random.key(seed)
    ks = jax.random.split(key, 20)
    f32 = jnp.float32

    def nrm(k, shape, scale):
        return jax.random.normal(k, shape, f32) * scale

    return {
        'x': nrm(ks[0], (BATCH, SEQ, D_MODEL), 1.0),
        'attn_norm_g': 1.0 + nrm(ks[1], (DEPTH, D_MODEL), 0.02),
        'w_in': nrm(ks[2], (DEPTH, D_MODEL, IN_WIDTH), D_MODEL ** -0.5),
        'forget_bias': FORGET_BIAS_INIT + nrm(ks[3], (DEPTH, FOX_HEADS), 0.5),
        'sinks': nrm(ks[4], (DEPTH, SWA_Q_HEADS), 0.5),
        'w_branch_swa': nrm(ks[5], (DEPTH, SWA_Q_W, D_MODEL), SWA_Q_W ** -0.5),
        'w_branch_fox': nrm(ks[6], (DEPTH, FOX_W, D_MODEL), FOX_W ** -0.5),
        'w_out': nrm(ks[7], (DEPTH, D_MODEL, D_MODEL), D_MODEL ** -0.5),
        'ffn_norm_g': 1.0 + nrm(ks[8], (DEPTH, D_MODEL), 0.02),
        'w_router': nrm(ks[9], (DEPTH, D_MODEL, N_EXPERTS), D_MODEL ** -0.5),
        'router_bias': nrm(ks[10], (DEPTH, N_EXPERTS), 0.01),
        'w_exp_gate': nrm(ks[11], (DEPTH, N_EXPERTS, D_MODEL, EXPERT_FF), D_MODEL ** -0.5),
        'w_exp_up': nrm(ks[12], (DEPTH, N_EXPERTS, D_MODEL, EXPERT_FF), D_MODEL ** -0.5),
        'w_exp_down': nrm(ks[13], (DEPTH, N_EXPERTS, EXPERT_FF, D_MODEL), EXPERT_FF ** -0.5),
        'w_sh_gate': nrm(ks[14], (DEPTH, D_MODEL, SHARED_FF), D_MODEL ** -0.5),
        'w_sh_up': nrm(ks[15], (DEPTH, D_MODEL, SHARED_FF), D_MODEL ** -0.5),
        'w_sh_down': nrm(ks[16], (DEPTH, SHARED_FF, D_MODEL), SHARED_FF ** -0.5),
        'final_norm_g': 1.0 + nrm(ks[17], (D_MODEL,), 0.02),
    }


def reference(x, attn_norm_g, w_in, forget_bias, sinks, w_branch_swa, w_branch_fox, w_out,
              ffn_norm_g, w_router, router_bias, w_exp_gate, w_exp_up, w_exp_down,
              w_sh_gate, w_sh_up, w_sh_down, final_norm_g):
    B, S, D = x.shape
    h = x
    for l in range(DEPTH):
        u = rms_norm(h, attn_norm_g[l])
        z = u @ w_in[l]
        a_q, a_k, a_v, f_q, f_k, f_v, f_g, g_swa, g_fox = jnp.split(z, SPLIT_POINTS, axis=-1)
        y_swa = sliding_window_attention(
            a_q.reshape(B, S, SWA_Q_HEADS, HEAD_DIM),
            a_k.reshape(B, S, SWA_KV_HEADS, HEAD_DIM),
            a_v.reshape(B, S, SWA_KV_HEADS, HEAD_DIM),
            sinks[l])
        y_fox = forgetting_attention(
            f_q.reshape(B, S, FOX_HEADS, HEAD_DIM),
            f_k.reshape(B, S, FOX_HEADS, HEAD_DIM),
            f_v.reshape(B, S, FOX_HEADS, HEAD_DIM),
            f_g + forget_bias[l])
        mix = (jax.nn.sigmoid(g_swa) * (y_swa @ w_branch_swa[l])
               + jax.nn.sigmoid(g_fox) * (y_fox @ w_branch_fox[l]))
        h = h + mix @ w_out[l]
        v = rms_norm(h, ffn_norm_g[l]).reshape(B * S, D)
        eidx, gate_w = route(v, w_router[l], router_bias[l])
        routed = routed_experts(v, eidx, gate_w, w_exp_gate[l], w_exp_up[l], w_exp_down[l])
        shared = swiglu(v, w_sh_gate[l], w_sh_up[l], w_sh_down[l])
        h = h + (routed + shared).reshape(B, S, D)
    return rms_norm(h, final_norm_g)
```

```cpp
#include <hip/hip_runtime.h>
#include <cstdio>
#include <cstdint>

#ifndef MK_N_LAUNCHES
#define MK_N_LAUNCHES 1
#endif

#define LAS __attribute__((address_space(3)))
#define GAS __attribute__((address_space(1)))
typedef unsigned short bf16_t;
typedef short bf16x8 __attribute__((ext_vector_type(8)));
typedef short s16x4 __attribute__((ext_vector_type(4)));
typedef float f32x2 __attribute__((ext_vector_type(2)));
typedef float f32x4 __attribute__((ext_vector_type(4)));
typedef float f32x16 __attribute__((ext_vector_type(16)));
typedef unsigned u32x2 __attribute__((ext_vector_type(2)));
typedef unsigned u32x4 __attribute__((ext_vector_type(4)));
typedef __bf16 bf16x2_t __attribute__((ext_vector_type(2)));

constexpr int T = 8192, D = 2048, SEQ = 2048, NBATCH = 4;
constexpr int NE = 64, FF = 512, TOPK = 8;
constexpr int ZP = 8704;
constexpr int ZQ = 0, ZK = 1024, ZV = 1280, ZFQ = 1536, ZFK = 2560, ZFV = 3584, ZGS = 4608, ZGF = 6656;
constexpr int NIN = 8960;
constexpr float RMS_EPS = 1e-6f;
constexpr float LOG2E = 1.4426950408889634f;
constexpr float QSCALE = 0.125f * LOG2E;
constexpr int NASSIGN = T * TOPK;
constexpr int NROWS_H = NASSIGN + T;

constexpr size_t MiB = 1u << 20;
constexpr size_t WS_CTL = 0, CTL_ZERO_BYTES = 64 * 1024;
constexpr size_t WS_FL = 1 * MiB;
constexpr size_t WS_WTS = 1 * MiB + 512 * 1024;
constexpr size_t WS_LIST = 2 * MiB;
constexpr size_t WS_WSWAT = 4 * MiB, WS_WFOXT = 8 * MiB, WS_WOUTT = 12 * MiB;
constexpr size_t WS_WINT = 20 * MiB;
constexpr size_t WS_WRG = 55 * MiB;
constexpr size_t WS_PSQ = 55 * MiB + 512 * 1024;
constexpr size_t WS_U = 56 * MiB;
constexpr size_t WS_Z = 88 * MiB;
constexpr size_t WS_YS = 224 * MiB, WS_YF = 240 * MiB;
constexpr size_t WS_T1 = 256 * MiB;
constexpr size_t WS_MIX = 320 * MiB;
constexpr size_t WS_H1 = 352 * MiB;
constexpr size_t WS_V = 416 * MiB;
constexpr size_t WS_HB = 448 * MiB;
constexpr size_t WS_WGU = 520 * MiB;
constexpr size_t WS_WD = 780 * MiB;
constexpr size_t WS_YB = 56 * MiB;
constexpr size_t WS_END = 910 * MiB;
static_assert(WS_YB + (size_t)NROWS_H * D * 2 <= WS_MIX + 32 * MiB, "YB overlay");
constexpr int CW_CNT = 64;
constexpr int CW_BAR = 4096;

constexpr int RING_BYTES = 131072;
constexpr int MISC_OFF = 139264;
constexpr int LDS_BYTES = 147456;
constexpr int NWAVES = 8, NTHREADS = 512;

__device__ __forceinline__ unsigned cvtpk(float lo, float hi) { f32x2 v = {lo, hi}; bf16x2_t b = __builtin_convertvector(v, bf16x2_t); return __builtin_bit_cast(unsigned, b); }
__device__ __forceinline__ float bf2f(bf16_t h) { return __builtin_bit_cast(float, (unsigned)h << 16); }
__device__ __forceinline__ float bflo(unsigned w) { return __builtin_bit_cast(float, w << 16); }
__device__ __forceinline__ float bfhi(unsigned w) { return __builtin_bit_cast(float, w & 0xffff0000u); }
__device__ __forceinline__ float wave_sum(float v) {
#pragma unroll
    for (int o = 1; o < 64; o <<= 1) v += __shfl_xor(v, o);
    return v;
}
__device__ __forceinline__ float wave_max(float v) {
#pragma unroll
    for (int o = 1; o < 64; o <<= 1) v = fmaxf(v, __shfl_xor(v, o));
    return v;
}
__device__ __forceinline__ float sigmoidf_(float x) { return 1.0f / (1.0f + __expf(-x)); }
#define LDS_WAIT() asm volatile("s_waitcnt lgkmcnt(0)" ::: "memory")
#define VM_WAIT() asm volatile("s_waitcnt vmcnt(0)" ::: "memory")

#define XB_TMO      128
#define XB_XCNT(j)  (256  + 64 * (j))
#define XB_XSUB(j)  (1280 + 64 * (j))
#define XB_XGEN(j)  (2304 + 64 * (j))
#define XB_TOP      3328
#define XB_TOPGEN   3392
#define XCD_BAR_WORDS 3456
#define XB_SPIN_CAP (1u << 20)
__device__ __forceinline__ unsigned xb_ld(unsigned* p)              { return __hip_atomic_load(p, __ATOMIC_RELAXED, __HIP_MEMORY_SCOPE_AGENT); }
__device__ __forceinline__ unsigned xb_add(unsigned* p, unsigned v) { return __hip_atomic_fetch_add(p, v, __ATOMIC_RELAXED, __HIP_MEMORY_SCOPE_AGENT); }
__device__ __forceinline__ unsigned xb_xcc_id() { return (unsigned)__builtin_amdgcn_s_getreg((3 << 11) | 20) & 0xFu; }
#define XB_SPIN(cond, bar) do { unsigned _sp = 0; while (cond) { __builtin_amdgcn_s_sleep(1); \
    if ((++_sp & 255u) == 0u) { if (xb_ld(&(bar)[XB_TMO])) break; if (_sp > XB_SPIN_CAP) { atomicAdd(&(bar)[XB_TMO], 1u); break; } } } } while (0)
struct XcdBarrier { unsigned* bar; unsigned x; volatile LAS unsigned* st; };
__device__ __forceinline__ XcdBarrier xcd_barrier_post(unsigned* bar, volatile LAS unsigned* st) {
    XcdBarrier b; b.bar = bar; b.x = xb_xcc_id(); b.st = st;
    if (threadIdx.x == 0) (void)xb_add(&bar[XB_XCNT(b.x)], 1u);
    return b;
}
__device__ __forceinline__ void xcd_barrier_complete(unsigned* bar, unsigned x, unsigned& nloc, unsigned& nx) {
    const unsigned G = gridDim.x * gridDim.y * gridDim.z;
    unsigned sum, cnt, mine, sp = 0u;
    for (;;) {
        sum = 0u; cnt = 0u; mine = 0u;
#pragma unroll
        for (unsigned j = 0; j < 16; ++j) { const unsigned c = xb_ld(&bar[XB_XCNT(j)]); sum += c; cnt += (c > 0u) ? 1u : 0u; mine = (j == x) ? c : mine; }
        if (sum == G) break;
        __builtin_amdgcn_s_sleep(1);
        if ((++sp & 255u) == 0u) { if (xb_ld(&bar[XB_TMO])) break; if (sp > XB_SPIN_CAP) { atomicAdd(&bar[XB_TMO], 1u); break; } }
    }
    nloc = mine > 0u ? mine : 1u; nx = cnt > 0u ? cnt : 1u;
}
__device__ __forceinline__ void xcd_barrier(const XcdBarrier& b) {
    asm volatile("s_waitcnt vmcnt(0)" ::: "memory");
    __syncthreads();
    if (threadIdx.x == 0) {
        unsigned* bar = b.bar;
        __builtin_amdgcn_s_waitcnt(0);
        unsigned nloc = b.st[0], nx = b.st[1];
        if (nloc == 0u) { xcd_barrier_complete(bar, b.x, nloc, nx); b.st[0] = nloc; b.st[1] = nx; }
        const unsigned old = xb_add(&bar[XB_XSUB(b.x)], 1u);
        const unsigned gen = old / nloc;
        if (old + 1u == (gen + 1u) * nloc) {
            __builtin_amdgcn_fence(__ATOMIC_RELEASE, "agent");
            asm volatile("s_waitcnt vmcnt(0)" ::: "memory");
            const unsigned og = xb_add(&bar[XB_TOP], 1u);
            const unsigned tg = og / nx;
            if (og + 1u == (tg + 1u) * nx) xb_add(&bar[XB_TOPGEN], 1u);
            else XB_SPIN(xb_ld(&bar[XB_TOPGEN]) == tg, bar);
            __builtin_amdgcn_fence(__ATOMIC_ACQUIRE, "agent");
            xb_add(&bar[XB_XGEN(b.x)], 1u);
            asm volatile("s_waitcnt vmcnt(0)" ::: "memory");
        } else {
            XB_SPIN(xb_ld(&bar[XB_XGEN(b.x)]) == gen, bar);
            __builtin_amdgcn_fence(__ATOMIC_ACQUIRE, "agent");
            asm volatile("s_waitcnt vmcnt(0)" ::: "memory");
        }
    }
    __syncthreads();
}

namespace pg8 {
constexpr int BM = 256, BK = 64, HALF = 128, HTB = HALF * BK * 2, STAGE_BYTES = 8 * HTB, NXCD = 8, WGM = 8;
__host__ __device__ __forceinline__ int lds_byte(int r, int c) { const int st = (r >> 4) * 2 + (c >> 5), rr = r & 15, cc = c & 31, ob = rr * 64 + cc * 2; return st * 1024 + (ob ^ (((ob >> 9) & 1) << 5)); }
__host__ __device__ __forceinline__ void stage_rc(int b, int& R, int& C) { const int st = b / 1024, sb = b % 1024, swz = sb ^ (((sb >> 9) & 1) << 5); R = (st >> 1) * 16 + swz / 64; C = (st & 1) * 32 + (swz % 64) / 2; }
__host__ __device__ __forceinline__ int perm32(int rho) { const int n = rho >> 4, i = rho & 15; return 8 * (i >> 2) + 4 * n + (i & 3); }

struct Unit { const char* A; const char* B; int pm, pn, e, rt; };

__device__ __forceinline__ void static_tile(int L, int nM, int nN, int& pm, int& pn) {
    const int nwg = nM * nN; int wgid = L;
    { const int q = nwg / NXCD, r = nwg % NXCD, xcd = wgid % NXCD, off = wgid / NXCD; wgid = (xcd < r ? xcd * (q + 1) : r * (q + 1) + (xcd - r) * q) + off; }
    const int nig = WGM * nN, gid = wgid / nig, fm = gid * WGM, gsz = (nM - fm) < WGM ? (nM - fm) : WGM;
    pm = fm + ((wgid % nig) % gsz); pn = (wgid % nig) / gsz;
}

template <class Epi, class Sched>
__device__ __forceinline__ void gemm_phase(LAS unsigned char* lds, const int K, const Sched& S, const Epi& E) {
    const int tid = threadIdx.x, wid = __builtin_amdgcn_readfirstlane(tid >> 6), lane = tid & 63, wr = wid >> 2, wc = wid & 3, fr = lane & 15, fq = lane >> 4;
    const int nt = K / BK;
    int Ri[2], Ci[2]; unsigned voffB[2];
#pragma unroll
    for (int i = 0; i < 2; ++i) { int R, C; stage_rc(tid * 16 + i * 8192, R, C); Ri[i] = R; Ci[i] = C; const int Rb = (R & ~31) + perm32(R & 31); voffB[i] = (unsigned)(Rb * K + C) * 2u; }
    const size_t kstep = (size_t)(BK * 2);
    const size_t hstep = (size_t)HALF * K * 2;
    const unsigned ldsw = (unsigned)wid * 1024u;
    const int aoff = lds_byte(wr * 64 + fr, fq * 8), boff = lds_byte(wc * 32 + fr, fq * 8);
#define PG8_SA(b, h) (((b) * 2 + (h)) * HTB)
#define PG8_SB(b, h) ((4 + (b) * 2 + (h)) * HTB)
#define PG8_STAGE(bufoff, gbase, voff) do { _Pragma("unroll") for (int _i = 0; _i < 2; ++_i) \
        __builtin_amdgcn_global_load_lds((const unsigned*)((const char*)(gbase) + (voff)[_i]), (LAS unsigned*)(lds + (bufoff) + ldsw + _i * 8192), 16, 0, 0); } while (0)
#define PG8_LDA(dst, b, h) do { _Pragma("unroll") for (int m = 0; m < 4; ++m) _Pragma("unroll") for (int k = 0; k < 2; ++k) dst[m][k] = *(const LAS bf16x8*)(lds + PG8_SA(b, h) + aoff + m * 2048 + k * 1024); } while (0)
#define PG8_LDB(dst, b, h) do { _Pragma("unroll") for (int n = 0; n < 2; ++n) _Pragma("unroll") for (int k = 0; k < 2; ++k) dst[n][k] = *(const LAS bf16x8*)(lds + PG8_SB(b, h) + boff + n * 2048 + k * 1024); } while (0)
#define PG8_MMA(ai, bj, At, Bt) do { __builtin_amdgcn_s_setprio(1); _Pragma("unroll") for (int m = 0; m < 4; ++m) _Pragma("unroll") for (int n = 0; n < 2; ++n) _Pragma("unroll") for (int k = 0; k < 2; ++k) \
        acc[ai][bj][m][n] = __builtin_amdgcn_mfma_f32_16x16x32_bf16(Bt[n][k], At[m][k], acc[ai][bj][m][n], 0, 0, 0); __builtin_amdgcn_s_setprio(0); } while (0)
#define PG8_WAIT_V(n) asm volatile("s_waitcnt vmcnt(" #n ")" ::: "memory")
#define PG8_WAIT_L(n) asm volatile("s_waitcnt lgkmcnt(" #n ")" ::: "memory")
#define PG8_BAR __builtin_amdgcn_s_barrier()
#define PG8_SCHED __builtin_amdgcn_sched_barrier(0)
    Unit cur, nxt; int ui = 0;
    if (!S.next(0, cur)) return;
    unsigned vc[2][2], vn[2][2];
    S.rowoffs(cur, vc, Ri, Ci);
    f32x4 acc[2][2][4][2];
#pragma unroll
    for (int a = 0; a < 2; ++a)
#pragma unroll
        for (int b = 0; b < 2; ++b)
#pragma unroll
            for (int m = 0; m < 4; ++m)
#pragma unroll
                for (int n = 0; n < 2; ++n) acc[a][b][m][n] = (f32x4){0.f, 0.f, 0.f, 0.f};
    bf16x8 At[4][2], B0[2][2], B1[2][2];
    const char* cA = cur.A; const char* cB = cur.B;
    PG8_STAGE(PG8_SB(0, 0), cB, voffB); PG8_STAGE(PG8_SB(0, 1), cB + hstep, voffB); PG8_STAGE(PG8_SA(0, 0), cA, vc[0]); PG8_STAGE(PG8_SA(0, 1), cA, vc[1]);
    if (wr == 1) PG8_BAR;
    PG8_WAIT_V(2); PG8_BAR;
    PG8_STAGE(PG8_SB(1, 0), cB + kstep, voffB); PG8_STAGE(PG8_SA(1, 0), cA + kstep, vc[0]); PG8_STAGE(PG8_SB(1, 1), cB + hstep + kstep, voffB);
    PG8_WAIT_V(6); PG8_BAR;
    for (;;) {
        const bool has_next = S.next(ui + 1, nxt);
        const char* nA = has_next ? nxt.A : cA; const char* nB = has_next ? nxt.B : cB;
        for (int t = 0; t < nt; t += 2) {
            const bool last = (t == nt - 2);
            const char* a1 = cA + (size_t)(t + 1) * kstep;
            const char* a2 = last ? nA : cA + (size_t)(t + 2) * kstep; const char* b2 = last ? nB : cB + (size_t)(t + 2) * kstep;
            const char* a3 = a2 + kstep; const char* b3 = b2 + kstep;
            if (last) {
                if (has_next) S.rowoffs(nxt, vn, Ri, Ci);
                else { vn[0][0] = vc[0][0]; vn[0][1] = vc[0][1]; vn[1][0] = vc[1][0]; vn[1][1] = vc[1][1]; }
            }
            unsigned v2[2][2];
            v2[0][0] = last ? vn[0][0] : vc[0][0]; v2[0][1] = last ? vn[0][1] : vc[0][1]; v2[1][0] = last ? vn[1][0] : vc[1][0]; v2[1][1] = last ? vn[1][1] : vc[1][1];
            PG8_LDB(B0, 0, 0); PG8_LDB(B1, 0, 1); PG8_SCHED; PG8_LDA(At, 0, 0); PG8_STAGE(PG8_SA(1, 1), a1, vc[1]);
            PG8_WAIT_V(8); PG8_WAIT_L(0); PG8_BAR; PG8_MMA(0, 0, At, B0); PG8_MMA(0, 1, At, B1); PG8_BAR; PG8_SCHED;
            PG8_LDA(At, 0, 1); PG8_STAGE(PG8_SB(0, 0), b2, voffB); PG8_STAGE(PG8_SB(0, 1), b2 + hstep, voffB); PG8_STAGE(PG8_SA(0, 0), a2, v2[0]);
            PG8_WAIT_V(8); PG8_WAIT_L(0); PG8_BAR; PG8_MMA(1, 0, At, B0); PG8_MMA(1, 1, At, B1); PG8_BAR; PG8_SCHED;
            PG8_LDB(B0, 1, 0); PG8_LDB(B1, 1, 1); PG8_SCHED; PG8_LDA(At, 1, 0); PG8_STAGE(PG8_SA(0, 1), a2, v2[1]);
            PG8_WAIT_V(8); PG8_WAIT_L(0); PG8_BAR; PG8_MMA(0, 0, At, B0); PG8_MMA(0, 1, At, B1); PG8_BAR; PG8_SCHED;
            PG8_LDA(At, 1, 1); PG8_STAGE(PG8_SB(1, 0), b3, voffB); PG8_STAGE(PG8_SB(1, 1), b3 + hstep, voffB); PG8_STAGE(PG8_SA(1, 0), a3, v2[0]);
            PG8_WAIT_V(8); PG8_WAIT_L(0); PG8_BAR; PG8_MMA(1, 0, At, B0); PG8_MMA(1, 1, At, B1); PG8_BAR; PG8_SCHED;
        }
        if (wr == 0) PG8_BAR;
        E(acc, cur, wr, wc, fr, fq);
        if (!has_next) break;
#pragma unroll
        for (int a = 0; a < 2; ++a)
#pragma unroll
            for (int b = 0; b < 2; ++b)
#pragma unroll
                for (int m = 0; m < 4; ++m)
#pragma unroll
                    for (int n = 0; n < 2; ++n) acc[a][b][m][n] = (f32x4){0.f, 0.f, 0.f, 0.f};
        cur = nxt; cA = nA; cB = nB; ++ui;
        vc[0][0] = vn[0][0]; vc[0][1] = vn[0][1]; vc[1][0] = vn[1][0]; vc[1][1] = vn[1][1];
        if (wr == 1) PG8_BAR;
    }
    PG8_WAIT_V(0);
    PG8_BAR;
#undef PG8_SA
#undef PG8_SB
#undef PG8_STAGE
#undef PG8_LDA
#undef PG8_LDB
#undef PG8_MMA
#undef PG8_WAIT_V
#undef PG8_WAIT_L
#undef PG8_BAR
#undef PG8_SCHED
}
}
using pg8::Unit;

struct Args { const float* in[18]; float* out; unsigned char* ws; int ph_lo, ph_hi; };
struct Frame {
    LAS unsigned char* lds; volatile LAS unsigned* MISC; unsigned* ctl; unsigned char* ws;
    int tid, lane, wave, vcu, G;
};

struct DenseSched {
    const char* A; const char* Bt; int nM, nN, K, G, c;
    __device__ __forceinline__ bool next(int i, Unit& u) const {
        const int L = i * G + c; if (L >= nM * nN) return false;
        int pm, pn; pg8::static_tile(L, nM, nN, pm, pn);
        u.pm = pm; u.pn = pn; u.e = 0; u.rt = 0; u.A = A + (size_t)pm * 256 * K * 2; u.B = Bt + (size_t)pn * 256 * K * 2; return true;
    }
    __device__ __forceinline__ void rowoffs(const Unit&, unsigned (&vo)[2][2], const int (&R)[2], const int (&C)[2]) const {
#pragma unroll
        for (int h = 0; h < 2; ++h)
#pragma unroll
            for (int i = 0; i < 2; ++i) vo[h][i] = (unsigned)((R[i] + 128 * h) * K + C[i]) * 2u;
    }
};
struct BranchSched {
    const char* A0; const char* A1; const char* B0; const char* B1; int nM, nN, K, G, c;
    __device__ __forceinline__ bool next(int i, Unit& u) const {
        const int L = (i >> 1) * G + c; if (L >= nM * nN) return false;
        int pm, pn; pg8::static_tile(L, nM, nN, pm, pn);
        const int br = i & 1;
        u.pm = pm; u.pn = pn; u.e = br; u.rt = 0; u.A = (br ? A1 : A0) + (size_t)pm * 256 * K * 2; u.B = (br ? B1 : B0) + (size_t)pn * 256 * K * 2; return true;
    }
    __device__ __forceinline__ void rowoffs(const Unit&, unsigned (&vo)[2][2], const int (&R)[2], const int (&C)[2]) const {
#pragma unroll
        for (int h = 0; h < 2; ++h)
#pragma unroll
            for (int i = 0; i < 2; ++i) vo[h][i] = (unsigned)((R[i] + 128 * h) * K + C[i]) * 2u;
    }
};
template <int MODE> struct MoeSched {
    const LAS int* tab; const int* list; const char* A; const char* Bt; int total, G, vcu;
    static constexpr int MULT = MODE == 0 ? 4 : 8, K = MODE == 0 ? 2048 : 512, NCOLS = MODE == 0 ? 1024 : 2048;
    __device__ __forceinline__ bool next(int i, Unit& u) const {
        const int L = i * G + vcu; if (L >= total) return false;
        int e, j, nrt;
        if (L < 32 * MULT) { e = 64; j = L; nrt = 32; }
        else {
            const int Lr = L - 32 * MULT; const int lane = threadIdx.x & 63;
            const int pin = tab[lane];
            const unsigned long long bal = __ballot(pin <= Lr);
            e = __builtin_popcountll(bal); e = e > 63 ? 63 : e;
            const int pex = e > 0 ? tab[e - 1] : 0; const int cnt = tab[64 + e];
            j = Lr - pex; nrt = (cnt + 255) >> 8; nrt = nrt < 1 ? 1 : nrt;
        }
        e = __builtin_amdgcn_readfirstlane(e); j = __builtin_amdgcn_readfirstlane(j); nrt = __builtin_amdgcn_readfirstlane(nrt);
        u.e = e; u.rt = j % nrt; u.pn = j / nrt; u.pm = 0;
        u.A = A; u.B = Bt + ((size_t)e * NCOLS + (size_t)u.pn * 256) * K * 2; return true;
    }
    __device__ __forceinline__ int count(int e) const { return e == 64 ? T : tab[64 + e]; }
    __device__ __forceinline__ int assign(int e, int idx) const {
        if (e == 64) return NASSIGN + idx;
        const int cnt = tab[64 + e];
        return idx < cnt ? list[e * T + idx] : -1;
    }
    __device__ __forceinline__ void rowoffs(const Unit& u, unsigned (&vo)[2][2], const int (&R)[2], const int (&C)[2]) const {
#pragma unroll
        for (int h = 0; h < 2; ++h)
#pragma unroll
            for (int i = 0; i < 2; ++i) {
                int a = assign(u.e, u.rt * 256 + R[i] + 128 * h);
                unsigned row;
                if (MODE == 0) { a = a < 0 ? 0 : a; row = a < NASSIGN ? (unsigned)(a >> 3) : (unsigned)(a - NASSIGN); }
                else row = a < 0 ? 0u : (unsigned)a;
                vo[h][i] = (row * (unsigned)K + (unsigned)C[i]) * 2u;
            }
    }
};

struct EpiZ {
    bf16_t* Z; float* FL; const float* fbias;
    __device__ __forceinline__ void operator()(const f32x4 (&acc)[2][2][4][2], const Unit& u, int wr, int wc, int fr, int fq) const {
        const int row0 = u.pm * 256 + wr * 64 + fr;
        if (u.pn == 34) {
            if (wc == 0 && fq < 2) {
                float fb[8];
#pragma unroll
                for (int j = 0; j < 8; ++j) fb[j] = fbias[8 * fq + j];
#pragma unroll
                for (int ai = 0; ai < 2; ++ai)
#pragma unroll
                    for (int m = 0; m < 4; ++m) {
                        float* o = FL + (size_t)(row0 + ai * 128 + m * 16) * 16 + 8 * fq;
#pragma unroll
                        for (int n = 0; n < 2; ++n) { f32x4 r;
#pragma unroll
                            for (int j = 0; j < 4; ++j) { const float x = acc[ai][0][m][n][j] + fb[4 * n + j]; const float ls = x >= 0.f ? -log1pf(expf(-x)) : x - log1pf(expf(x)); r[j] = ls * LOG2E; }
                            *(f32x4*)(o + 4 * n) = r; }
                    }
            }
            return;
        }
        const int mode = (u.pn < 4 || (u.pn >= 6 && u.pn < 10)) ? 1 : (u.pn >= 18 ? 2 : 0);
        const int col0 = u.pn * 256 + wc * 32 + 8 * fq;
#pragma unroll
        for (int ai = 0; ai < 2; ++ai)
#pragma unroll
            for (int m = 0; m < 4; ++m) { bf16_t* rowp = Z + (size_t)(row0 + ai * 128 + m * 16) * ZP + col0;
#pragma unroll
                for (int bj = 0; bj < 2; ++bj) { f32x4 v0 = acc[ai][bj][m][0], v1 = acc[ai][bj][m][1];
                    if (mode == 1) { v0 = v0 * QSCALE; v1 = v1 * QSCALE; }
                    else if (mode == 2) {
#pragma unroll
                        for (int j = 0; j < 4; ++j) { v0[j] = sigmoidf_(v0[j]); v1[j] = sigmoidf_(v1[j]); } }
                    u32x4 w; w.x = cvtpk(v0[0], v0[1]); w.y = cvtpk(v0[2], v0[3]); w.z = cvtpk(v1[0], v1[1]); w.w = cvtpk(v1[2], v1[3]);
                    *(u32x4*)(rowp + bj * 128) = w; } }
    }
};
struct EpiMix {
    const bf16_t* Z; float* T1; bf16_t* MIX;
    __device__ __forceinline__ void operator()(const f32x4 (&acc)[2][2][4][2], const Unit& u, int wr, int wc, int fr, int fq) const {
        const int row0 = u.pm * 256 + wr * 64 + fr, col0 = u.pn * 256 + wc * 32 + 8 * fq;
        const int gcol = (u.e ? ZGF : ZGS) + col0;
#pragma unroll
        for (int ai = 0; ai < 2; ++ai)
#pragma unroll
            for (int m = 0; m < 4; ++m) { const size_t row = (size_t)(row0 + ai * 128 + m * 16);
#pragma unroll
                for (int bj = 0; bj < 2; ++bj) {
                    const u32x4 g = *(const u32x4*)(Z + row * ZP + gcol + bj * 128);
                    f32x4 v0 = acc[ai][bj][m][0], v1 = acc[ai][bj][m][1];
                    v0[0] *= bflo(g.x); v0[1] *= bfhi(g.x); v0[2] *= bflo(g.y); v0[3] *= bfhi(g.y);
                    v1[0] *= bflo(g.z); v1[1] *= bfhi(g.z); v1[2] *= bflo(g.w); v1[3] *= bfhi(g.w);
                    float* tp = T1 + row * D + col0 + bj * 128;
                    if (u.e == 0) { *(f32x4*)tp = v0; *(f32x4*)(tp + 4) = v1; }
                    else { const f32x4 t0 = *(const f32x4*)tp, t1 = *(const f32x4*)(tp + 4); v0 = v0 + t0; v1 = v1 + t1;
                        u32x4 w; w.x = cvtpk(v0[0], v0[1]); w.y = cvtpk(v0[2], v0[3]); w.z = cvtpk(v1[0], v1[1]); w.w = cvtpk(v1[2], v1[3]);
                        *(u32x4*)(MIX + row * D + col0 + bj * 128) = w; } } }
    }
};
struct EpiOut {
    const float* X; float* H1; float* PSQ;
    __device__ __forceinline__ void operator()(const f32x4 (&acc)[2][2][4][2], const Unit& u, int wr, int wc, int fr, int fq) const {
        const int row0 = u.pm * 256 + wr * 64 + fr, col0 = u.pn * 256 + wc * 32 + 8 * fq;
#pragma unroll
        for (int ai = 0; ai < 2; ++ai)
#pragma unroll
            for (int m = 0; m < 4; ++m) { const size_t row = (size_t)(row0 + ai * 128 + m * 16); float sq = 0.f;
#pragma unroll
                for (int bj = 0; bj < 2; ++bj) {
                    const float* xp = X + row * D + col0 + bj * 128; float* hp = H1 + row * D + col0 + bj * 128;
                    const f32x4 x0 = *(const f32x4*)xp, x1 = *(const f32x4*)(xp + 4);
                    const f32x4 h0 = acc[ai][bj][m][0] + x0, h1 = acc[ai][bj][m][1] + x1;
                    *(f32x4*)hp = h0; *(f32x4*)(hp + 4) = h1;
                    sq += (h0[0] * h0[0] + h0[1] * h0[1]) + (h0[2] * h0[2] + h0[3] * h0[3]) + (h1[0] * h1[0] + h1[1] * h1[1]) + (h1[2] * h1[2] + h1[3] * h1[3]); }
                sq += __shfl_xor(sq, 16); sq += __shfl_xor(sq, 32);
                if (fq == 0) PSQ[row * 32 + u.pn * 4 + wc] = sq; }
    }
};
struct EpiSwiglu {
    const MoeSched<0>* S; bf16_t* HB;
    __device__ __forceinline__ void operator()(const f32x4 (&acc)[2][2][4][2], const Unit& u, int wr, int wc, int fr, int fq) const {
        const int ff0 = u.pn * 128 + wc * 32 + 8 * fq;
#pragma unroll
        for (int ai = 0; ai < 2; ++ai)
#pragma unroll
            for (int m = 0; m < 4; ++m) { const int a = S->assign(u.e, u.rt * 256 + ai * 128 + wr * 64 + m * 16 + fr);
                if (a >= 0) { float h[8];
#pragma unroll
                    for (int n = 0; n < 2; ++n)
#pragma unroll
                        for (int j = 0; j < 4; ++j) { const float g = acc[ai][0][m][n][j], up = acc[ai][1][m][n][j]; h[4 * n + j] = g * sigmoidf_(g) * up; }
                    u32x4 w; w.x = cvtpk(h[0], h[1]); w.y = cvtpk(h[2], h[3]); w.z = cvtpk(h[4], h[5]); w.w = cvtpk(h[6], h[7]);
                    *(u32x4*)(HB + (size_t)a * FF + ff0) = w; } }
    }
};
struct EpiDown {
    const MoeSched<1>* S; bf16_t* YB; const float* WTS;
    __device__ __forceinline__ void operator()(const f32x4 (&acc)[2][2][4][2], const Unit& u, int wr, int wc, int fr, int fq) const {
        const int col0 = u.pn * 256 + wc * 32 + 8 * fq;
#pragma unroll
        for (int ai = 0; ai < 2; ++ai)
#pragma unroll
            for (int m = 0; m < 4; ++m) { const int a = S->assign(u.e, u.rt * 256 + ai * 128 + wr * 64 + m * 16 + fr);
                if (a >= 0) { const float w8 = WTS[a];
#pragma unroll
                    for (int bj = 0; bj < 2; ++bj) { const f32x4 v0 = acc[ai][bj][m][0] * w8, v1 = acc[ai][bj][m][1] * w8;
                        u32x4 w; w.x = cvtpk(v0[0], v0[1]); w.y = cvtpk(v0[2], v0[3]); w.z = cvtpk(v1[0], v1[1]); w.w = cvtpk(v1[2], v1[3]);
                        *(u32x4*)(YB + (size_t)a * D + col0 + bj * 128) = w; } } }
    }
};

__device__ __forceinline__ void p0_transpose_item(const float* W, int ldw, int c0, int nvalid, bf16_t* dst, int K, int k0, LAS float* scr, int lane) {
    float v[64];
    const bool ok = lane < nvalid;
    const float* src = W + (size_t)k0 * ldw + c0 + lane;
#pragma unroll
    for (int k = 0; k < 64; ++k) v[k] = ok ? src[(size_t)k * ldw] : 0.f;
#pragma unroll
    for (int k = 0; k < 64; ++k) scr[k * 65 + lane] = v[k];
    LDS_WAIT(); asm volatile("" ::: "memory");
    const int c = lane & 7;
#pragma unroll
    for (int j = 0; j < 8; ++j) { const int n = (lane >> 3) + 8 * j; const LAS float* s = scr + (8 * c) * 65 + n;
        u32x4 o; o.x = cvtpk(s[0 * 65], s[1 * 65]); o.y = cvtpk(s[2 * 65], s[3 * 65]); o.z = cvtpk(s[4 * 65], s[5 * 65]); o.w = cvtpk(s[6 * 65], s[7 * 65]);
        *(u32x4*)(dst + (size_t)n * K + k0 + 8 * c) = o; }
    LDS_WAIT(); asm volatile("" ::: "memory");
}
__device__ __forceinline__ void p0_prologue(Frame& F, const Args& a) {
    LAS float* scr = (LAS float*)(F.lds + F.wave * 16640);
    const int gw = F.vcu * NWAVES + F.wave, NGW = F.G * NWAVES;
    unsigned char* ws = F.ws;
    {
        const float* g = a.in[1];
        for (int m = gw; m < T; m += NGW) {
            const f32x4* xr = (const f32x4*)(a.in[0] + (size_t)m * D) + F.lane;
            f32x4 v[8]; float s = 0.f;
#pragma unroll
            for (int j = 0; j < 8; ++j) { v[j] = xr[64 * j]; s += (v[j].x * v[j].x + v[j].y * v[j].y) + (v[j].z * v[j].z + v[j].w * v[j].w); }
            const float rinv = rsqrtf(wave_sum(s) * (1.f / D) + RMS_EPS);
            u32x2* o = (u32x2*)((bf16_t*)(ws + WS_U) + (size_t)m * D) + F.lane;
#pragma unroll
            for (int j = 0; j < 8; ++j) { const f32x4 gg = *((const f32x4*)g + F.lane + 64 * j); u32x2 w; w.x = cvtpk(v[j].x * rinv * gg.x, v[j].y * rinv * gg.y); w.y = cvtpk(v[j].z * rinv * gg.z, v[j].w * rinv * gg.w); o[64 * j] = w; }
        }
    }
    {
        const float* wr = a.in[9]; const float* g = a.in[8]; float* o = (float*)(ws + WS_WRG);
        for (int i = gw * 64 + F.lane; i < D * NE; i += NGW * 64) o[i] = wr[i] * g[i >> 6];
    }
    constexpr int I_IN = 32 * 140, I_SW = 16 * 32, I_OUT = 32 * 32, I_GU = 32 * 8, I_DN = 8 * 32, I_EXP = 2 * I_GU + I_DN;
    constexpr int NITEMS = I_IN + 2 * I_SW + I_OUT + 65 * I_EXP;
    for (int it = gw; it < NITEMS; it += NGW) {
        int r = it;
        if (r < I_IN) { const int kb = r / 140, nb = r % 140, n0 = nb * 64;
            int c0, nv; if (n0 < 4608) { c0 = n0; nv = 64; } else if (n0 < 8704) { c0 = n0 + 16; nv = 64; } else if (n0 == 8704) { c0 = 4608; nv = 16; } else { c0 = 0; nv = 0; }
            p0_transpose_item(a.in[2], 8720, c0, nv, (bf16_t*)(ws + WS_WINT) + (size_t)n0 * D, D, kb * 64, scr, F.lane); continue; }
        r -= I_IN;
        if (r < I_SW) { const int kb = r / 32, nb = r % 32; p0_transpose_item(a.in[5], D, nb * 64, 64, (bf16_t*)(ws + WS_WSWAT) + (size_t)nb * 64 * 1024, 1024, kb * 64, scr, F.lane); continue; }
        r -= I_SW;
        if (r < I_SW) { const int kb = r / 32, nb = r % 32; p0_transpose_item(a.in[6], D, nb * 64, 64, (bf16_t*)(ws + WS_WFOXT) + (size_t)nb * 64 * 1024, 1024, kb * 64, scr, F.lane); continue; }
        r -= I_SW;
        if (r < I_OUT) { const int kb = r / 32, nb = r % 32; p0_transpose_item(a.in[7], D, nb * 64, 64, (bf16_t*)(ws + WS_WOUTT) + (size_t)nb * 64 * D, D, kb * 64, scr, F.lane); continue; }
        r -= I_OUT;
        const int e = r / I_EXP; r -= e * I_EXP;
        if (r < 2 * I_GU) { const int up = r >= I_GU; r -= up * I_GU; const int kb = r / 8, nb = r % 8, n0 = nb * 64;
            const float* src = e < 64 ? (up ? a.in[12] : a.in[11]) + (size_t)e * D * FF : (up ? a.in[15] : a.in[14]);
            const int drow = 256 * (n0 >> 7) + (n0 & 127) + 128 * up;
            p0_transpose_item(src, FF, n0, 64, (bf16_t*)(ws + WS_WGU) + ((size_t)e * 1024 + drow) * D, D, kb * 64, scr, F.lane); continue; }
        r -= 2 * I_GU;
        { const int kb = r / 32, nb = r % 32;
            const float* src = e < 64 ? a.in[13] + (size_t)e * FF * D : a.in[16];
            p0_transpose_item(src, D, nb * 64, 64, (bf16_t*)(ws + WS_WD) + ((size_t)e * D + nb * 64) * FF, FF, kb * 64, scr, F.lane); }
    }
}

__device__ __forceinline__ int crow(int r, int hi) { return (r & 3) + 8 * (r >> 2) + 4 * hi; }
__device__ __forceinline__ s16x4 vtr(LAS const char* p) { typedef short v4i16_t __attribute__((ext_vector_type(4))); return __builtin_bit_cast(s16x4, __builtin_amdgcn_ds_read_tr16_b64_v4i16((LAS v4i16_t*)p)); }

__device__ __forceinline__ void attn_qk(f32x16 (&p)[2], const bf16x8 (&qf)[4], LAS const char* Kt, int r32, int hi) {
#pragma unroll
    for (int kb = 0; kb < 2; ++kb) { const int kv = 32 * kb + r32; const int sw = (kv >> 1) & 7; LAS const char* rowp = Kt + kv * 128;
        f32x16 c = {};
#pragma unroll
        for (int s = 0; s < 4; ++s) { const bf16x8 a = *(const LAS bf16x8*)(rowp + (((2 * s + hi) ^ sw) * 16)); c = __builtin_amdgcn_mfma_f32_32x32x16_bf16(a, qf[s], c, 0, 0, 0); }
        p[kb] = c; }
}
__device__ __forceinline__ void attn_softmax_pv(f32x16 (&p)[2], f32x16 (&o)[2], float& m, float& l, LAS const char* Vt, int lane) {
    float mx = p[0][0];
#pragma unroll
    for (int kb = 0; kb < 2; ++kb)
#pragma unroll
        for (int r = 0; r < 16; ++r) mx = fmaxf(mx, p[kb][r]);
    mx = fmaxf(mx, __shfl_xor(mx, 32));
    const float mn = fmaxf(m, mx);
    const float alpha = __builtin_amdgcn_exp2f(m - mn);
    float rs = 0.f;
#pragma unroll
    for (int kb = 0; kb < 2; ++kb)
#pragma unroll
        for (int r = 0; r < 16; ++r) { const float e = __builtin_amdgcn_exp2f(p[kb][r] - mn); p[kb][r] = e; rs += e; }
    rs += __shfl_xor(rs, 32);
    l = l * alpha + rs; m = mn;
#pragma unroll
    for (int db = 0; db < 2; ++db)
#pragma unroll
        for (int r = 0; r < 16; ++r) o[db][r] *= alpha;
    const int g = lane >> 4, i = lane & 15;
    LAS const char* vb = Vt + (4 * (g >> 1) + (i >> 2)) * 64 + (g & 1) * 32 + (i & 3) * 8;
#pragma unroll
    for (int kb = 0; kb < 2; ++kb)
#pragma unroll
        for (int ks = 0; ks < 2; ++ks) {
            u32x4 pw; pw.x = cvtpk(p[kb][8 * ks + 0], p[kb][8 * ks + 1]); pw.y = cvtpk(p[kb][8 * ks + 2], p[kb][8 * ks + 3]); pw.z = cvtpk(p[kb][8 * ks + 4], p[kb][8 * ks + 5]); pw.w = cvtpk(p[kb][8 * ks + 6], p[kb][8 * ks + 7]);
            const bf16x8 pb = __builtin_bit_cast(bf16x8, pw);
#pragma unroll
            for (int db = 0; db < 2; ++db) {
                const s16x4 lo = vtr(vb + db * 4096 + (32 * kb + 16 * ks) * 64), hi4 = vtr(vb + db * 4096 + (32 * kb + 16 * ks + 8) * 64);
                const bf16x8 va = (bf16x8){lo[0], lo[1], lo[2], lo[3], hi4[0], hi4[1], hi4[2], hi4[3]};
                o[db] = __builtin_amdgcn_mfma_f32_32x32x16_bf16(va, pb, o[db], 0, 0, 0); } }
}
__device__ __forceinline__ void attn_store_kv(LAS char* Kt, LAS char* Vt, const u32x4& kr, const u32x4& vr, int tid) {
    const int kv = tid >> 3, c = tid & 7;
    *(LAS u32x4*)(Kt + kv * 128 + ((c ^ ((kv >> 1) & 7)) * 16)) = kr;
    *(LAS u32x4*)(Vt + (c >> 2) * 4096 + kv * 64 + (c & 3) * 16) = vr;
}
__device__ __forceinline__ void attn_store_o(const f32x16 (&o)[2], float l, bf16_t* orow, int hi) {
    const float rl = 1.0f / l;
#pragma unroll
    for (int db = 0; db < 2; ++db)
#pragma unroll
        for (int rq = 0; rq < 4; ++rq) { u32x2 w; w.x = cvtpk(o[db][4 * rq] * rl, o[db][4 * rq + 1] * rl); w.y = cvtpk(o[db][4 * rq + 2] * rl, o[db][4 * rq + 3] * rl);
            *(u32x2*)(orow + 32 * db + 8 * rq + 4 * hi) = w; }
}

__device__ __forceinline__ void swa_unit(Frame& F, int unit, const float* sinks) {
    const bf16_t* Z = (const bf16_t*)(F.ws + WS_Z); bf16_t* YS = (bf16_t*)(F.ws + WS_YS);
    const int b = unit >> 6, kvh = (unit >> 4) & 3, nb = unit & 15;
    const int tid = F.tid, lane = F.lane, r32 = lane & 31, hi = lane >> 5, w = F.wave;
    LAS char* Kl = (LAS char*)F.lds; LAS char* Vl = (LAS char*)F.lds + 32768;
    const int t0 = nb * 128;
    {
        const int kv = tid >> 3, c = tid & 7;
#pragma unroll
        for (int tl = 0; tl < 4; ++tl) {
            if (nb > 0 || tl >= 2) {
                const size_t row = (size_t)(b * SEQ + t0 - 128 + tl * 64 + kv);
                const u32x4 kr = *(const u32x4*)(Z + row * ZP + ZK + kvh * 64 + c * 8);
                const u32x4 vr = *(const u32x4*)(Z + row * ZP + ZV + kvh * 64 + c * 8);
                attn_store_kv(Kl + tl * 8192, Vl + tl * 8192, kr, vr, tid);
            }
        }
    }
    __syncthreads();
    const int qh = kvh * 4 + (w >> 1);
    const float slope2 = exp2f(-0.5f * (float)(qh + 1)) * LOG2E;
    const float sink2 = sinks[qh] * LOG2E;
#pragma unroll 1
    for (int sb = 0; sb < 2; ++sb) {
        const int r0 = 64 * (w & 1) + 32 * sb;
        const int qrel = r0 + r32;
        const size_t qrow = (size_t)(b * SEQ + t0 + qrel);
        bf16x8 qf[4];
#pragma unroll
        for (int s = 0; s < 4; ++s) qf[s] = *(const bf16x8*)(Z + qrow * ZP + ZQ + qh * 64 + 16 * s + 8 * hi);
        f32x16 o[2]; o[0] = f32x16{}; o[1] = f32x16{};
        float m = sink2, l = 1.0f;
        const int tl0 = (r0 + 1) >> 6;
#pragma unroll 1
        for (int tt = 0; tt < 3; ++tt) {
            const int tl = tl0 + tt;
            if (nb == 0 && tl < 2) continue;
            f32x16 p[2];
            attn_qk(p, qf, Kl + tl * 8192, r32, hi);
#pragma unroll
            for (int kb = 0; kb < 2; ++kb)
#pragma unroll
                for (int r = 0; r < 16; ++r) {
                    const int krel = tl * 64 + 32 * kb + crow(r, hi) - 128;
                    const int dist = qrel - krel;
                    const float s = p[kb][r] - slope2 * (float)dist;
                    p[kb][r] = (dist >= 0 && dist < 128) ? s : -INFINITY;
                }
            attn_softmax_pv(p, o, m, l, Vl + tl * 8192, lane);
        }
        attn_store_o(o, l, YS + qrow * 1024 + qh * 64, hi);
    }
    __syncthreads();
}

__device__ __forceinline__ void fox_unit(Frame& F, int bh, int qb, LAS const float* c2) {
    const bf16_t* Z = (const bf16_t*)(F.ws + WS_Z); bf16_t* YF = (bf16_t*)(F.ws + WS_YF);
    const int b = bh >> 4, h = bh & 15;
    const int tid = F.tid, lane = F.lane, r32 = lane & 31, hi = lane >> 5, w = F.wave;
    LAS char* Kl = (LAS char*)F.lds; LAS char* Vl = (LAS char*)F.lds + 16384;
    const int q0 = qb * 256, qw = q0 + 32 * w, qabs = qw + r32;
    const size_t qrow = (size_t)(b * SEQ + qabs);
    const int NT = 4 * (qb + 1);
    const int kvr = tid >> 3, kc = tid & 7;
    const bf16_t* kbase = Z + (size_t)(b * SEQ + kvr) * ZP + ZFK + h * 64 + kc * 8;
    const bf16_t* vbase = Z + (size_t)(b * SEQ + kvr) * ZP + ZFV + h * 64 + kc * 8;
    u32x4 kr = *(const u32x4*)kbase, vr = *(const u32x4*)vbase;
    bf16x8 qf[4];
#pragma unroll
    for (int s = 0; s < 4; ++s) qf[s] = *(const bf16x8*)(Z + qrow * ZP + ZFQ + h * 64 + 16 * s + 8 * hi);
    attn_store_kv(Kl, Vl, kr, vr, tid);
    __syncthreads();
    f32x16 o[2]; o[0] = f32x16{}; o[1] = f32x16{};
    float m = -1e30f, l = 0.f;
#pragma unroll 1
    for (int t = 0; t < NT; ++t) {
        const int buf = t & 1;
        if (t + 1 < NT) { kr = *(const u32x4*)(kbase + (size_t)(t + 1) * 64 * ZP); vr = *(const u32x4*)(vbase + (size_t)(t + 1) * 64 * ZP); }
        const int k0 = t * 64;
        if (k0 <= qw + 31) {
            f32x16 p[2];
            attn_qk(p, qf, Kl + buf * 8192, r32, hi);
            const bool diag = (k0 + 63 > qw);
#pragma unroll
            for (int kb = 0; kb < 2; ++kb)
#pragma unroll
                for (int rq = 0; rq < 4; ++rq) {
                    const int kk = k0 + 32 * kb + 8 * rq + 4 * hi;
                    const f32x4 cc = *(const LAS f32x4*)(c2 + kk);
#pragma unroll
                    for (int j = 0; j < 4; ++j) { float s = p[kb][4 * rq + j] - cc[j]; if (diag && (kk + j > qabs)) s = -INFINITY; p[kb][4 * rq + j] = s; }
                }
            attn_softmax_pv(p, o, m, l, Vl + buf * 8192, lane);
        }
        if (t + 1 < NT) attn_store_kv(Kl + (buf ^ 1) * 8192, Vl + (buf ^ 1) * 8192, kr, vr, tid);
        __syncthreads();
    }
    attn_store_o(o, l, YF + qrow * 1024 + h * 64, hi);
}
__device__ __forceinline__ void p2_attention(Frame& F, const Args& a) {
    for (int u = F.vcu; u < 256; u += F.G) swa_unit(F, u, a.in[4]);
    LAS float* c2 = (LAS float*)(F.lds + 32768);
    LAS float* wtot = (LAS float*)(F.lds + 32768 + 8192);
    const float* FL = (const float*)(F.ws + WS_FL);
    for (int it = F.vcu; it < 256; it += F.G) {
        const int bh = it >> 2, s = it & 3, b = bh >> 4, h = bh & 15;
        {
            float v[4]; float run = 0.f;
#pragma unroll
            for (int j = 0; j < 4; ++j) { run += FL[(size_t)(b * SEQ + 4 * F.tid + j) * 16 + h]; v[j] = run; }
            float inc = run;
#pragma unroll
            for (int o = 1; o < 64; o <<= 1) { const float n = __shfl_up(inc, o); if (F.lane >= o) inc += n; }
            if (F.lane == 63) wtot[F.wave] = inc;
            __syncthreads();
            float base = inc - run;
            for (int ww = 0; ww < F.wave; ++ww) base += wtot[ww];
#pragma unroll
            for (int j = 0; j < 4; ++j) c2[4 * F.tid + j] = base + v[j];
            __syncthreads();
        }
        fox_unit(F, bh, s, c2);
        fox_unit(F, bh, 7 - s, c2);
        __syncthreads();
    }
}

__device__ __forceinline__ void p5_router(Frame& F, const Args& a) {
    const float* H1 = (const float*)(F.ws + WS_H1); const float* PSQ = (const float*)(F.ws + WS_PSQ); const float* WRG = (const float*)(F.ws + WS_WRG);
    bf16_t* V = (bf16_t*)(F.ws + WS_V); float* WTS = (float*)(F.ws + WS_WTS); int* LIST = (int*)(F.ws + WS_LIST);
    const float* g = a.in[8]; const float* rbias = a.in[10];
    const int lane = F.lane, w = F.wave, tid = F.tid;
    LAS float* part = (LAS float*)F.lds;
    LAS float* logit = (LAS float*)(F.lds + 65536);
    LAS float* rinvs = (LAS float*)(F.lds + 65536 + 8192);
    LAS int* lcnt = (LAS int*)(F.lds + 65536 + 8192 + 128);
    LAS int* gbase = (LAS int*)(F.lds + 65536 + 8192 + 128 + 256);
    for (int tile = F.vcu; tile < T / 32; tile += F.G) {
        const int tok0 = tile * 32;
        if (tid < 64) lcnt[tid] = 0;
#pragma unroll 1
        for (int j = 0; j < 4; ++j) {
            const int tok = tok0 + 4 * w + j;
            float sq = lane < 32 ? PSQ[(size_t)tok * 32 + lane] : 0.f;
            sq = wave_sum(sq);
            const float rinv = rsqrtf(sq * (1.f / D) + RMS_EPS);
            if (lane == 0) rinvs[4 * w + j] = rinv;
            const f32x4* hr = (const f32x4*)(H1 + (size_t)tok * D) + lane;
            u32x2* o = (u32x2*)(V + (size_t)tok * D) + lane;
#pragma unroll
            for (int jj = 0; jj < 8; ++jj) { const f32x4 hv = hr[64 * jj]; const f32x4 gg = *((const f32x4*)g + lane + 64 * jj);
                u32x2 wv; wv.x = cvtpk(hv.x * rinv * gg.x, hv.y * rinv * gg.y); wv.y = cvtpk(hv.z * rinv * gg.z, hv.w * rinv * gg.w); o[64 * jj] = wv; }
        }
        {
            f32x16 acc0 = {}, acc1 = {};
            const int tk = lane & 31, half = lane >> 5;
            const float* hp = H1 + (size_t)(tok0 + tk) * D + 256 * w + 4 * half;
            const float* wp = WRG + (size_t)(256 * w + 4 * half) * NE + tk;
#pragma unroll 4
            for (int kk = 0; kk < 32; ++kk) {
                const f32x4 av = *(const f32x4*)(hp + 8 * kk);
#pragma unroll
                for (int s = 0; s < 4; ++s) {
                    const float b0 = wp[(size_t)(8 * kk + s) * NE], b1 = wp[(size_t)(8 * kk + s) * NE + 32];
                    acc0 = __builtin_amdgcn_mfma_f32_32x32x2f32(av[s], b0, acc0, 0, 0, 0);
                    acc1 = __builtin_amdgcn_mfma_f32_32x32x2f32(av[s], b1, acc1, 0, 0, 0);
                }
            }
#pragma unroll
            for (int r = 0; r < 16; ++r) { const int tr = crow(r, half); part[(w * 32 + tr) * 64 + tk] = acc0[r]; part[(w * 32 + tr) * 64 + 32 + tk] = acc1[r]; }
        }
        __syncthreads();
#pragma unroll
        for (int q = 0; q < 4; ++q) { const int idx = tid + 512 * q; float s = 0.f;
#pragma unroll
            for (int ww = 0; ww < 8; ++ww) s += part[ww * 2048 + idx];
            logit[idx] = s * rinvs[idx >> 6]; }
        __syncthreads();
        int sel_k[4], sel_ls[4]; float sel_w[4];
        const float bias = rbias[lane];
#pragma unroll
        for (int j = 0; j < 4; ++j) {
            const int tl = 4 * w + j;
            const float score = sigmoidf_(logit[tl * 64 + lane]);
            const float biased = score + bias;
            float m1 = biased; m1 = fmaxf(m1, __shfl_xor(m1, 1)); m1 = fmaxf(m1, __shfl_xor(m1, 2)); m1 = fmaxf(m1, __shfl_xor(m1, 4));
            const unsigned long long gm = 0xFFull << (lane & 56);
            const unsigned long long b1 = __ballot(biased == m1) & gm;
            const int i1 = __builtin_ctzll(b1);
            float v2 = (lane == i1) ? -INFINITY : biased;
            float m2 = v2; m2 = fmaxf(m2, __shfl_xor(m2, 1)); m2 = fmaxf(m2, __shfl_xor(m2, 2)); m2 = fmaxf(m2, __shfl_xor(m2, 4));
            const float gs = m1 + m2; const int gi = lane >> 3;
            int rank = 0;
#pragma unroll
            for (int gg = 0; gg < 8; ++gg) { const float o = __shfl(gs, 8 * gg); rank += (o > gs || (o == gs && gg < gi)) ? 1 : 0; }
            float mv = rank < 4 ? biased : -INFINITY;
            int myk = -1;
#pragma unroll
            for (int it = 0; it < 8; ++it) { const float mx = wave_max(mv); const unsigned long long bb = __ballot(mv == mx); const int sl = __builtin_ctzll(bb); if (lane == sl) { myk = it; mv = -INFINITY; } }
            const float ssum = wave_sum(myk >= 0 ? score : 0.f);
            sel_k[j] = myk; sel_w[j] = score / ssum * 2.5f;
            sel_ls[j] = 0;
            if (myk >= 0) sel_ls[j] = __hip_atomic_fetch_add((LAS int*)&lcnt[lane], 1, __ATOMIC_RELAXED, __HIP_MEMORY_SCOPE_WORKGROUP);
        }
        __syncthreads();
        if (tid < 64) gbase[tid] = (int)atomicAdd(F.ctl + CW_CNT + tid, (unsigned)lcnt[tid]);
        __syncthreads();
#pragma unroll
        for (int j = 0; j < 4; ++j) if (sel_k[j] >= 0) { const int tok = tok0 + 4 * w + j; const int aid = tok * 8 + sel_k[j];
            LIST[(size_t)lane * T + gbase[lane] + sel_ls[j]] = aid; WTS[aid] = sel_w[j]; }
        if (tid < 32) WTS[NASSIGN + tok0 + tid] = 1.0f;
        __syncthreads();
    }
}

template <int MULT> __device__ __forceinline__ int moe_table(Frame& F, LAS int* tab) {
    if (F.tid < 64) {
        const int cnt = (int)__hip_atomic_load(F.ctl + CW_CNT + F.tid, __ATOMIC_RELAXED, __HIP_MEMORY_SCOPE_AGENT);
        int inc = ((cnt + 255) >> 8) * MULT;
#pragma unroll
        for (int o = 1; o < 64; o <<= 1) { const int n = __shfl_up(inc, o); if (F.lane >= o) inc += n; }
        tab[F.tid] = inc; tab[64 + F.tid] = cnt;
    }
    __syncthreads();
    return 32 * MULT + tab[63];
}

__device__ __forceinline__ void p8_final(Frame& F, const Args& a) {
    const float* H1 = (const float*)(F.ws + WS_H1); const bf16_t* YB = (const bf16_t*)(F.ws + WS_YB); const float* g = a.in[17];
    const int gw = F.vcu * NWAVES + F.wave, NGW = F.G * NWAVES;
    for (int tok = gw; tok < T; tok += NGW) {
        const f32x4* hr = (const f32x4*)(H1 + (size_t)tok * D) + F.lane;
        f32x4 v[8];
#pragma unroll
        for (int j = 0; j < 8; ++j) v[j] = hr[64 * j];
#pragma unroll 1
        for (int k = 0; k < 9; ++k) {
            const size_t row = k < 8 ? (size_t)tok * 8 + k : (size_t)NASSIGN + tok;
            const u32x2* yr = (const u32x2*)(YB + row * D) + F.lane;
#pragma unroll
            for (int j = 0; j < 8; ++j) { const u32x2 y = yr[64 * j]; v[j].x += bflo(y.x); v[j].y += bfhi(y.x); v[j].z += bflo(y.y); v[j].w += bfhi(y.y); }
        }
        float s = 0.f;
#pragma unroll
        for (int j = 0; j < 8; ++j) s += (v[j].x * v[j].x + v[j].y * v[j].y) + (v[j].z * v[j].z + v[j].w * v[j].w);
        const float rinv = rsqrtf(wave_sum(s) * (1.f / D) + RMS_EPS);
        f32x4* o = (f32x4*)(a.out + (size_t)tok * D) + F.lane;
#pragma unroll
        for (int j = 0; j < 8; ++j) { const f32x4 gg = *((const f32x4*)g + F.lane + 64 * j); o[64 * j] = (f32x4){v[j].x * rinv * gg.x, v[j].y * rinv * gg.y, v[j].z * rinv * gg.z, v[j].w * rinv * gg.w}; }
    }
}

constexpr int N_PHASES = 9;
__global__ void __launch_bounds__(NTHREADS, 2) fwd_kernel(Args args) {
    extern __shared__ __attribute__((aligned(16))) unsigned char lds_raw[];
    Frame F;
    F.lds = (LAS unsigned char*)lds_raw;
    F.MISC = (volatile LAS unsigned*)(F.lds + MISC_OFF);
    F.tid = threadIdx.x; F.lane = F.tid & 63; F.wave = __builtin_amdgcn_readfirstlane(F.tid >> 6);
    F.G = gridDim.x; { const int bx = blockIdx.x; F.vcu = (F.G % 8 == 0) ? (bx % 8) * (F.G / 8) + bx / 8 : bx; }
    F.ws = args.ws; F.ctl = (unsigned*)(args.ws + WS_CTL);
    for (int u = F.tid; u < (LDS_BYTES - MISC_OFF) / 4; u += NTHREADS) ((LAS unsigned*)(F.lds + MISC_OFF))[u] = 0u;
    __syncthreads();
    const int lo = args.ph_lo, hi = args.ph_hi;
    XcdBarrier bar; bar.bar = F.ctl + CW_BAR; bar.x = 0; bar.st = nullptr;
    if (hi - lo > 1) bar = xcd_barrier_post(F.ctl + CW_BAR, F.MISC + 8);
#define IN(k) (lo <= (k) && (k) < hi)
#define SEAM(k) do { if (IN(k) && IN((k) + 1)) xcd_barrier(bar); } while (0)
    unsigned char* ws = args.ws;
    LAS int* tab = (LAS int*)(F.lds + MISC_OFF + 256);

    if (IN(0)) { p0_prologue(F, args); SEAM(0); }
    if (IN(1)) {
        DenseSched S{(const char*)(ws + WS_U), (const char*)(ws + WS_WINT), T / 256, NIN / 256, D, F.G, (int)blockIdx.x};
        EpiZ E{(bf16_t*)(ws + WS_Z), (float*)(ws + WS_FL), args.in[3]};
        pg8::gemm_phase(F.lds, D, S, E);
        SEAM(1);
    }
    if (IN(2)) { p2_attention(F, args); SEAM(2); }
    if (IN(3)) {
        BranchSched S{(const char*)(ws + WS_YS), (const char*)(ws + WS_YF), (const char*)(ws + WS_WSWAT), (const char*)(ws + WS_WFOXT), T / 256, D / 256, 1024, F.G, (int)blockIdx.x};
        EpiMix E{(const bf16_t*)(ws + WS_Z), (float*)(ws + WS_T1), (bf16_t*)(ws + WS_MIX)};
        pg8::gemm_phase(F.lds, 1024, S, E);
        SEAM(3);
    }
    if (IN(4)) {
        DenseSched S{(const char*)(ws + WS_MIX), (const char*)(ws + WS_WOUTT), T / 256, D / 256, D, F.G, (int)blockIdx.x};
        EpiOut E{args.in[0], (float*)(ws + WS_H1), (float*)(ws + WS_PSQ)};
        pg8::gemm_phase(F.lds, D, S, E);
        SEAM(4);
    }
    if (IN(5)) { p5_router(F, args); SEAM(5); }
    if (IN(6)) {
        const int total = moe_table<4>(F, tab);
        MoeSched<0> S{tab, (const int*)(ws + WS_LIST), (const char*)(ws + WS_V), (const char*)(ws + WS_WGU), total, F.G, F.vcu};
        EpiSwiglu E{&S, (bf16_t*)(ws + WS_HB)};
        pg8::gemm_phase(F.lds, 2048, S, E);
        SEAM(6);
    }
    if (IN(7)) {
        const int total = moe_table<8>(F, tab);
        MoeSched<1> S{tab, (const int*)(ws + WS_LIST), (const char*)(ws + WS_HB), (const char*)(ws + WS_WD), total, F.G, F.vcu};
        EpiDown E{&S, (bf16_t*)(ws + WS_YB), (const float*)(ws + WS_WTS)};
        pg8::gemm_phase(F.lds, 512, S, E);
        SEAM(7);
    }
    if (IN(8)) { p8_final(F, args); }
#undef IN
#undef SEAM
}

extern "C" void kernel_launch(void* const* d_in, const int* in_sizes, int n_in, void* d_out, int out_size, void* d_ws, size_t ws_size, hipStream_t stream) {
    static int grid = 0;
    if (grid == 0) {
        if (n_in != 18 || out_size != T * D || ws_size < WS_END) { fprintf(stderr, "kernel_launch: unexpected shapes (n_in %d out %d ws %zu)\n", n_in, out_size, ws_size); grid = -1; return; }
        int dev = 0, cus = 0, per_cu = 0;
        if (hipGetDevice(&dev) != hipSuccess || hipDeviceGetAttribute(&cus, hipDeviceAttributeMultiprocessorCount, dev) != hipSuccess) { grid = -1; return; }
        if (hipFuncSetAttribute((const void*)fwd_kernel, hipFuncAttributeMaxDynamicSharedMemorySize, LDS_BYTES) != hipSuccess) { fprintf(stderr, "kernel_launch: hipFuncSetAttribute failed\n"); grid = -1; return; }
        if (hipOccupancyMaxActiveBlocksPerMultiprocessor(&per_cu, (const void*)fwd_kernel, NTHREADS, LDS_BYTES) != hipSuccess || per_cu < 1) { fprintf(stderr, "kernel_launch: occupancy query says %d blocks per CU\n", per_cu); (void)hipGetLastError(); grid = -1; return; }
        grid = cus;
        if (grid % 8 != 0 || grid > 256) grid = (grid / 8) * 8 > 256 ? 256 : (grid / 8) * 8;
    }
    if (grid <= 0) return;
    (void)hipMemsetAsync((char*)d_ws + WS_CTL, 0, CTL_ZERO_BYTES, stream);
    Args a{};
    for (int i = 0; i < 18; ++i) a.in[i] = (const float*)d_in[i];
    a.out = (float*)d_out; a.ws = (unsigned char*)d_ws;
#if MK_N_LAUNCHES == 1
    a.ph_lo = 0; a.ph_hi = N_PHASES;
    hipLaunchKernelGGL(fwd_kernel, dim3(grid), dim3(NTHREADS), LDS_BYTES, stream, a);
#else
    for (int p = 0; p < N_PHASES; ++p) { a.ph_lo = p; a.ph_hi = p + 1; hipLaunchKernelGGL(fwd_kernel, dim3(grid), dim3(NTHREADS), LDS_BYTES, stream, a); }
#endif
}
```

```cpp
#include <hip/hip_runtime.h>
#include <cstdio>
#include <cstdint>

#ifndef MK_N_LAUNCHES
#define MK_N_LAUNCHES 1
#endif
#define PROBE_DUP -1

#define LAS __attribute__((address_space(3)))
#define GAS __attribute__((address_space(1)))
typedef unsigned short bf16_t;
typedef short bf16x8 __attribute__((ext_vector_type(8)));
typedef short s16x4 __attribute__((ext_vector_type(4)));
typedef float f32x2 __attribute__((ext_vector_type(2)));
typedef float f32x4 __attribute__((ext_vector_type(4)));
typedef float f32x16 __attribute__((ext_vector_type(16)));
typedef unsigned u32x2 __attribute__((ext_vector_type(2)));
typedef unsigned u32x4 __attribute__((ext_vector_type(4)));
typedef __bf16 bf16x2_t __attribute__((ext_vector_type(2)));

constexpr int T = 8192, D = 2048, SEQ = 2048, NBATCH = 4;
constexpr int NE = 64, FF = 512, TOPK = 8;
constexpr int ZP = 8704;
constexpr int ZQ = 0, ZK = 1024, ZV = 1280, ZFQ = 1536, ZFK = 2560, ZFV = 3584, ZGS = 4608, ZGF = 6656;
constexpr int NIN = 8960;
constexpr float RMS_EPS = 1e-6f;
constexpr float LOG2E = 1.4426950408889634f;
constexpr float QSCALE = 0.125f * LOG2E;
constexpr int NASSIGN = T * TOPK;
constexpr int NROWS_H = NASSIGN + T;

constexpr size_t MiB = 1u << 20;
constexpr size_t WS_CTL = 0, CTL_ZERO_BYTES = 64 * 1024;
constexpr size_t WS_FL = 1 * MiB;
constexpr size_t WS_WTS = 1 * MiB + 512 * 1024;
constexpr size_t WS_LIST = 2 * MiB;
constexpr size_t WS_WSWAT = 4 * MiB, WS_WFOXT = 8 * MiB, WS_WOUTT = 12 * MiB;
constexpr size_t WS_WINT = 20 * MiB;
constexpr size_t WS_WRG = 55 * MiB;
constexpr size_t WS_PSQ = 55 * MiB + 512 * 1024;
constexpr size_t WS_U = 56 * MiB;
constexpr size_t WS_Z = 88 * MiB;
constexpr size_t WS_YS = 224 * MiB, WS_YF = 240 * MiB;
constexpr size_t WS_T1 = 256 * MiB;
constexpr size_t WS_MIX = 320 * MiB;
constexpr size_t WS_H1 = 352 * MiB;
constexpr size_t WS_V = 416 * MiB;
constexpr size_t WS_HB = 448 * MiB;
constexpr size_t WS_WGU = 520 * MiB;
constexpr size_t WS_WD = 780 * MiB;
constexpr size_t WS_YB = 56 * MiB;
constexpr size_t WS_LISTW = 910 * MiB;
constexpr size_t WS_END = 912 * MiB;
static_assert(WS_YB + (size_t)NROWS_H * D * 2 <= WS_MIX + 32 * MiB, "YB overlay");
constexpr int CW_CNT = 64;
constexpr int CW_BAR = 4096;

constexpr int RING_BYTES = 131072;
constexpr int MISC_OFF = 139264;
constexpr int LDS_BYTES = 147456;
constexpr int NWAVES = 8, NTHREADS = 512;

__device__ __forceinline__ unsigned cvtpk(float lo, float hi) { f32x2 v = {lo, hi}; bf16x2_t b = __builtin_convertvector(v, bf16x2_t); return __builtin_bit_cast(unsigned, b); }
__device__ __forceinline__ float bf2f(bf16_t h) { return __builtin_bit_cast(float, (unsigned)h << 16); }
__device__ __forceinline__ float bflo(unsigned w) { return __builtin_bit_cast(float, w << 16); }
__device__ __forceinline__ float bfhi(unsigned w) { return __builtin_bit_cast(float, w & 0xffff0000u); }
__device__ __forceinline__ float wave_sum(float v) {
#pragma unroll
    for (int o = 1; o < 64; o <<= 1) v += __shfl_xor(v, o);
    return v;
}
__device__ __forceinline__ float wave_max(float v) {
#pragma unroll
    for (int o = 1; o < 64; o <<= 1) v = fmaxf(v, __shfl_xor(v, o));
    return v;
}
__device__ __forceinline__ float sigmoidf_(float x) { return 1.0f / (1.0f + __expf(-x)); }
#define LDS_WAIT() asm volatile("s_waitcnt lgkmcnt(0)" ::: "memory")
#define VM_WAIT() asm volatile("s_waitcnt vmcnt(0)" ::: "memory")

#define XB_TMO      128
#define XB_XCNT(j)  (256  + 64 * (j))
#define XB_XSUB(j)  (1280 + 64 * (j))
#define XB_XGEN(j)  (2304 + 64 * (j))
#define XB_TOP      3328
#define XB_TOPGEN   3392
#define XCD_BAR_WORDS 3456
#define XB_SPIN_CAP (1u << 20)
__device__ __forceinline__ unsigned xb_ld(unsigned* p)              { return __hip_atomic_load(p, __ATOMIC_RELAXED, __HIP_MEMORY_SCOPE_AGENT); }
__device__ __forceinline__ unsigned xb_add(unsigned* p, unsigned v) { return __hip_atomic_fetch_add(p, v, __ATOMIC_RELAXED, __HIP_MEMORY_SCOPE_AGENT); }
__device__ __forceinline__ unsigned xb_xcc_id() { return (unsigned)__builtin_amdgcn_s_getreg((3 << 11) | 20) & 0xFu; }
#define XB_SPIN(cond, bar) do { unsigned _sp = 0; while (cond) { __builtin_amdgcn_s_sleep(1); \
    if ((++_sp & 255u) == 0u) { if (xb_ld(&(bar)[XB_TMO])) break; if (_sp > XB_SPIN_CAP) { atomicAdd(&(bar)[XB_TMO], 1u); break; } } } } while (0)
struct XcdBarrier { unsigned* bar; unsigned x; volatile LAS unsigned* st; };
__device__ __forceinline__ XcdBarrier xcd_barrier_post(unsigned* bar, volatile LAS unsigned* st) {
    XcdBarrier b; b.bar = bar; b.x = xb_xcc_id(); b.st = st;
    if (threadIdx.x == 0) (void)xb_add(&bar[XB_XCNT(b.x)], 1u);
    return b;
}
__device__ __forceinline__ void xcd_barrier_complete(unsigned* bar, unsigned x, unsigned& nloc, unsigned& nx) {
    const unsigned G = gridDim.x * gridDim.y * gridDim.z;
    unsigned sum, cnt, mine, sp = 0u;
    for (;;) {
        sum = 0u; cnt = 0u; mine = 0u;
#pragma unroll
        for (unsigned j = 0; j < 16; ++j) { const unsigned c = xb_ld(&bar[XB_XCNT(j)]); sum += c; cnt += (c > 0u) ? 1u : 0u; mine = (j == x) ? c : mine; }
        if (sum == G) break;
        __builtin_amdgcn_s_sleep(1);
        if ((++sp & 255u) == 0u) { if (xb_ld(&bar[XB_TMO])) break; if (sp > XB_SPIN_CAP) { atomicAdd(&bar[XB_TMO], 1u); break; } }
    }
    nloc = mine > 0u ? mine : 1u; nx = cnt > 0u ? cnt : 1u;
}
__device__ __forceinline__ void xcd_barrier(const XcdBarrier& b) {
    asm volatile("s_waitcnt vmcnt(0)" ::: "memory");
    __syncthreads();
    if (threadIdx.x == 0) {
        unsigned* bar = b.bar;
        __builtin_amdgcn_s_waitcnt(0);
        unsigned nloc = b.st[0], nx = b.st[1];
        if (nloc == 0u) { xcd_barrier_complete(bar, b.x, nloc, nx); b.st[0] = nloc; b.st[1] = nx; }
        const unsigned old = xb_add(&bar[XB_XSUB(b.x)], 1u);
        const unsigned gen = old / nloc;
        if (old + 1u == (gen + 1u) * nloc) {
            __builtin_amdgcn_fence(__ATOMIC_RELEASE, "agent");
            asm volatile("s_waitcnt vmcnt(0)" ::: "memory");
            const unsigned og = xb_add(&bar[XB_TOP], 1u);
            const unsigned tg = og / nx;
            if (og + 1u == (tg + 1u) * nx) xb_add(&bar[XB_TOPGEN], 1u);
            else XB_SPIN(xb_ld(&bar[XB_TOPGEN]) == tg, bar);
            __builtin_amdgcn_fence(__ATOMIC_ACQUIRE, "agent");
            xb_add(&bar[XB_XGEN(b.x)], 1u);
            asm volatile("s_waitcnt vmcnt(0)" ::: "memory");
        } else {
            XB_SPIN(xb_ld(&bar[XB_XGEN(b.x)]) == gen, bar);
            __builtin_amdgcn_fence(__ATOMIC_ACQUIRE, "agent");
            asm volatile("s_waitcnt vmcnt(0)" ::: "memory");
        }
    }
    __syncthreads();
}

namespace pg8 {
constexpr int BM = 256, BK = 64, HALF = 128, HTB = HALF * BK * 2, STAGE_BYTES = 8 * HTB, NXCD = 8, WGM = 8;
__host__ __device__ __forceinline__ int lds_byte(int r, int c) { const int st = (r >> 4) * 2 + (c >> 5), rr = r & 15, cc = c & 31, ob = rr * 64 + cc * 2; return st * 1024 + (ob ^ (((ob >> 9) & 1) << 5)); }
__host__ __device__ __forceinline__ void stage_rc(int b, int& R, int& C) { const int st = b / 1024, sb = b % 1024, swz = sb ^ (((sb >> 9) & 1) << 5); R = (st >> 1) * 16 + swz / 64; C = (st & 1) * 32 + (swz % 64) / 2; }
__host__ __device__ __forceinline__ int perm32(int rho) { const int n = rho >> 4, i = rho & 15; return 8 * (i >> 2) + 4 * n + (i & 3); }

struct Unit { const char* A; const char* B; int pm, pn, e, rt; };

__device__ __forceinline__ void static_tile(int L, int nM, int nN, int& pm, int& pn) {
    const int nwg = nM * nN; int wgid = L;
    { const int q = nwg / NXCD, r = nwg % NXCD, xcd = wgid % NXCD, off = wgid / NXCD; wgid = (xcd < r ? xcd * (q + 1) : r * (q + 1) + (xcd - r) * q) + off; }
    const int nig = WGM * nN, gid = wgid / nig, fm = gid * WGM, gsz = (nM - fm) < WGM ? (nM - fm) : WGM;
    pm = fm + ((wgid % nig) % gsz); pn = (wgid % nig) / gsz;
}

template <class Epi, class Sched>
__device__ __forceinline__ void gemm_phase(LAS unsigned char* lds, const int K, const Sched& S, const Epi& E) {
    const int tid = threadIdx.x, wid = __builtin_amdgcn_readfirstlane(tid >> 6), lane = tid & 63, wr = wid >> 2, wc = wid & 3, fr = lane & 15, fq = lane >> 4;
    const int nt = K / BK;
    int Ri[2], Ci[2]; unsigned voffB[2];
#pragma unroll
    for (int i = 0; i < 2; ++i) { int R, C; stage_rc(tid * 16 + i * 8192, R, C); Ri[i] = R; Ci[i] = C; const int Rb = (R & ~31) + perm32(R & 31); voffB[i] = (unsigned)(Rb * K + C) * 2u; }
    const size_t kstep = (size_t)(BK * 2);
    const size_t hstep = (size_t)HALF * K * 2;
    const unsigned ldsw = (unsigned)wid * 1024u;
    const int aoff = lds_byte(wr * 64 + fr, fq * 8), boff = lds_byte(wc * 32 + fr, fq * 8);
#define PG8_SA(b, h) (((b) * 2 + (h)) * HTB)
#define PG8_SB(b, h) ((4 + (b) * 2 + (h)) * HTB)
#define PG8_STAGE(bufoff, gbase, voff) do { _Pragma("unroll") for (int _i = 0; _i < 2; ++_i) \
        __builtin_amdgcn_global_load_lds((const unsigned*)((const char*)(gbase) + (voff)[_i]), (LAS unsigned*)(lds + (bufoff) + ldsw + _i * 8192), 16, 0, 0); } while (0)
#define PG8_LDA(dst, b, h) do { _Pragma("unroll") for (int m = 0; m < 4; ++m) _Pragma("unroll") for (int k = 0; k < 2; ++k) dst[m][k] = *(const LAS bf16x8*)(lds + PG8_SA(b, h) + aoff + m * 2048 + k * 1024); } while (0)
#define PG8_LDB(dst, b, h) do { _Pragma("unroll") for (int n = 0; n < 2; ++n) _Pragma("unroll") for (int k = 0; k < 2; ++k) dst[n][k] = *(const LAS bf16x8*)(lds + PG8_SB(b, h) + boff + n * 2048 + k * 1024); } while (0)
#define PG8_MMA(ai, bj, At, Bt) do { __builtin_amdgcn_s_setprio(1); _Pragma("unroll") for (int m = 0; m < 4; ++m) _Pragma("unroll") for (int n = 0; n < 2; ++n) _Pragma("unroll") for (int k = 0; k < 2; ++k) \
        acc[ai][bj][m][n] = __builtin_amdgcn_mfma_f32_16x16x32_bf16(Bt[n][k], At[m][k], acc[ai][bj][m][n], 0, 0, 0); __builtin_amdgcn_s_setprio(0); } while (0)
#define PG8_WAIT_V(n) asm volatile("s_waitcnt vmcnt(" #n ")" ::: "memory")
#define PG8_WAIT_L(n) asm volatile("s_waitcnt lgkmcnt(" #n ")" ::: "memory")
#define PG8_BAR __builtin_amdgcn_s_barrier()
#define PG8_SCHED __builtin_amdgcn_sched_barrier(0)
    Unit cur, nxt; int ui = 0;
    if (!S.next(0, cur)) return;
    unsigned vc[2][2], vn[2][2];
    int pfa = -1; float pfw = 0.f;
    S.pf_issue(cur, pfa, pfw); S.pf_commit(0, pfa, pfw);
    asm volatile("s_waitcnt vmcnt(0) lgkmcnt(0)" ::: "memory"); PG8_BAR; asm volatile("" ::: "memory");
    S.rowoffs(cur, 0, vc, Ri, Ci);
    f32x4 acc[2][2][4][2];
#pragma unroll
    for (int a = 0; a < 2; ++a)
#pragma unroll
        for (int b = 0; b < 2; ++b)
#pragma unroll
            for (int m = 0; m < 4; ++m)
#pragma unroll
                for (int n = 0; n < 2; ++n) acc[a][b][m][n] = (f32x4){0.f, 0.f, 0.f, 0.f};
    bf16x8 At[4][2], B0[2][2], B1[2][2];
    const char* cA = cur.A; const char* cB = cur.B;
    PG8_STAGE(PG8_SB(0, 0), cB, voffB); PG8_STAGE(PG8_SB(0, 1), cB + hstep, voffB); PG8_STAGE(PG8_SA(0, 0), cA, vc[0]); PG8_STAGE(PG8_SA(0, 1), cA, vc[1]);
    if (wr == 1) PG8_BAR;
    PG8_WAIT_V(2); PG8_BAR;
    PG8_STAGE(PG8_SB(1, 0), cB + kstep, voffB); PG8_STAGE(PG8_SA(1, 0), cA + kstep, vc[0]); PG8_STAGE(PG8_SB(1, 1), cB + hstep + kstep, voffB);
    PG8_WAIT_V(6); PG8_BAR;
    for (;;) {
        const bool has_next = S.next(ui + 1, nxt);
        const char* nA = has_next ? nxt.A : cA; const char* nB = has_next ? nxt.B : cB;
        if (has_next) S.pf_issue(nxt, pfa, pfw);
        for (int t = 0; t < nt; t += 2) {
            const bool last = (t == nt - 2);
            if (t == nt - 4 && has_next) S.pf_commit((ui + 1) & 1, pfa, pfw);
            const char* a1 = cA + (size_t)(t + 1) * kstep;
            const char* a2 = last ? nA : cA + (size_t)(t + 2) * kstep; const char* b2 = last ? nB : cB + (size_t)(t + 2) * kstep;
            const char* a3 = a2 + kstep; const char* b3 = b2 + kstep;
            if (last) {
                if (has_next) S.rowoffs(nxt, (ui + 1) & 1, vn, Ri, Ci);
                else { vn[0][0] = vc[0][0]; vn[0][1] = vc[0][1]; vn[1][0] = vc[1][0]; vn[1][1] = vc[1][1]; }
            }
            unsigned v2[2][2];
            v2[0][0] = last ? vn[0][0] : vc[0][0]; v2[0][1] = last ? vn[0][1] : vc[0][1]; v2[1][0] = last ? vn[1][0] : vc[1][0]; v2[1][1] = last ? vn[1][1] : vc[1][1];
            PG8_LDB(B0, 0, 0); PG8_LDB(B1, 0, 1); PG8_SCHED; PG8_LDA(At, 0, 0); PG8_STAGE(PG8_SA(1, 1), a1, vc[1]);
            PG8_WAIT_V(8); PG8_WAIT_L(0); PG8_BAR; PG8_MMA(0, 0, At, B0); PG8_MMA(0, 1, At, B1); PG8_BAR; PG8_SCHED;
            PG8_LDA(At, 0, 1); PG8_STAGE(PG8_SB(0, 0), b2, voffB); PG8_STAGE(PG8_SB(0, 1), b2 + hstep, voffB); PG8_STAGE(PG8_SA(0, 0), a2, v2[0]);
            PG8_WAIT_V(8); PG8_WAIT_L(0); PG8_BAR; PG8_MMA(1, 0, At, B0); PG8_MMA(1, 1, At, B1); PG8_BAR; PG8_SCHED;
            PG8_LDB(B0, 1, 0); PG8_LDB(B1, 1, 1); PG8_SCHED; PG8_LDA(At, 1, 0); PG8_STAGE(PG8_SA(0, 1), a2, v2[1]);
            PG8_WAIT_V(8); PG8_WAIT_L(0); PG8_BAR; PG8_MMA(0, 0, At, B0); PG8_MMA(0, 1, At, B1); PG8_BAR; PG8_SCHED;
            PG8_LDA(At, 1, 1); PG8_STAGE(PG8_SB(1, 0), b3, voffB); PG8_STAGE(PG8_SB(1, 1), b3 + hstep, voffB); PG8_STAGE(PG8_SA(1, 0), a3, v2[0]);
            PG8_WAIT_V(8); PG8_WAIT_L(0); PG8_BAR; PG8_MMA(1, 0, At, B0); PG8_MMA(1, 1, At, B1); PG8_BAR; PG8_SCHED;
        }
        if (wr == 0) PG8_BAR;
        E(acc, cur, ui & 1, wr, wc, fr, fq);
        if (!has_next) break;
#pragma unroll
        for (int a = 0; a < 2; ++a)
#pragma unroll
            for (int b = 0; b < 2; ++b)
#pragma unroll
                for (int m = 0; m < 4; ++m)
#pragma unroll
                    for (int n = 0; n < 2; ++n) acc[a][b][m][n] = (f32x4){0.f, 0.f, 0.f, 0.f};
        cur = nxt; cA = nA; cB = nB; ++ui;
        vc[0][0] = vn[0][0]; vc[0][1] = vn[0][1]; vc[1][0] = vn[1][0]; vc[1][1] = vn[1][1];
        if (wr == 1) PG8_BAR;
    }
    PG8_WAIT_V(0);
    PG8_BAR;
#undef PG8_SA
#undef PG8_SB
#undef PG8_STAGE
#undef PG8_LDA
#undef PG8_LDB
#undef PG8_MMA
#undef PG8_WAIT_V
#undef PG8_WAIT_L
#undef PG8_BAR
#undef PG8_SCHED
}
}
using pg8::Unit;

struct Args { const float* in[18]; float* out; unsigned char* ws; int ph_lo, ph_hi; };
struct Frame {
    LAS unsigned char* lds; volatile LAS unsigned* MISC; unsigned* ctl; unsigned char* ws;
    int tid, lane, wave, vcu, G;
};

struct DenseSched {
    const char* A; const char* Bt; int nM, nN, K, G, c, dup;
    __device__ __forceinline__ bool next(int i, Unit& u) const {
        int L = i * G + c; if (L >= nM * nN * dup) return false; if (L >= nM * nN) L -= nM * nN;
        int pm, pn; pg8::static_tile(L, nM, nN, pm, pn);
        u.pm = pm; u.pn = pn; u.e = 0; u.rt = 0; u.A = A + (size_t)pm * 256 * K * 2; u.B = Bt + (size_t)pn * 256 * K * 2; return true;
    }
    __device__ __forceinline__ void pf_issue(const Unit&, int&, float&) const {}
    __device__ __forceinline__ void pf_commit(int, int, float) const {}
    __device__ __forceinline__ void rowoffs(const Unit&, int, unsigned (&vo)[2][2], const int (&R)[2], const int (&C)[2]) const {
#pragma unroll
        for (int h = 0; h < 2; ++h)
#pragma unroll
            for (int i = 0; i < 2; ++i) vo[h][i] = (unsigned)((R[i] + 128 * h) * K + C[i]) * 2u;
    }
};
struct BranchSched {
    const char* A0; const char* A1; const char* B0; const char* B1; int nM, nN, K, G, c, dup;
    __device__ __forceinline__ bool next(int i, Unit& u) const {
        int L = (i >> 1) * G + c; if (L >= nM * nN * dup) return false; if (L >= nM * nN) L -= nM * nN;
        int pm, pn; pg8::static_tile(L, nM, nN, pm, pn);
        const int br = i & 1;
        u.pm = pm; u.pn = pn; u.e = br; u.rt = 0; u.A = (br ? A1 : A0) + (size_t)pm * 256 * K * 2; u.B = (br ? B1 : B0) + (size_t)pn * 256 * K * 2; return true;
    }
    __device__ __forceinline__ void pf_issue(const Unit&, int&, float&) const {}
    __device__ __forceinline__ void pf_commit(int, int, float) const {}
    __device__ __forceinline__ void rowoffs(const Unit&, int, unsigned (&vo)[2][2], const int (&R)[2], const int (&C)[2]) const {
#pragma unroll
        for (int h = 0; h < 2; ++h)
#pragma unroll
            for (int i = 0; i < 2; ++i) vo[h][i] = (unsigned)((R[i] + 128 * h) * K + C[i]) * 2u;
    }
};
template <int MODE> struct MoeSched {
    const LAS int* tab; const int* list; const float* listw; const char* A; const char* Bt; LAS int* rowA; LAS float* rowW; int total, G, vcu, dup;
    static constexpr int MULT = MODE == 0 ? 4 : 8, K = MODE == 0 ? 2048 : 512, NCOLS = MODE == 0 ? 1024 : 2048;
    __device__ __forceinline__ bool next(int i, Unit& u) const {
        int L = i * G + vcu; if (L >= total * dup) return false; if (L >= total) L -= total;
        int e, j, nrt;
        if (L < 32 * MULT) { e = 64; j = L; nrt = 32; }
        else {
            const int Lr = L - 32 * MULT; const int lane = threadIdx.x & 63;
            const int pin = tab[lane];
            const unsigned long long bal = __ballot(pin <= Lr);
            e = __builtin_popcountll(bal); e = e > 63 ? 63 : e;
            const int pex = e > 0 ? tab[e - 1] : 0; const int cnt = tab[64 + e];
            j = Lr - pex; nrt = (cnt + 255) >> 8; nrt = nrt < 1 ? 1 : nrt;
        }
        e = __builtin_amdgcn_readfirstlane(e); j = __builtin_amdgcn_readfirstlane(j); nrt = __builtin_amdgcn_readfirstlane(nrt);
        u.e = e; u.rt = j % nrt; u.pn = j / nrt; u.pm = 0;
        u.A = A; u.B = Bt + ((size_t)e * NCOLS + (size_t)u.pn * 256) * K * 2; return true;
    }
    __device__ __forceinline__ void pf_issue(const Unit& u, int& pa, float& pw) const {
        const int tid = threadIdx.x; pa = -1; pw = 0.f;
        if (tid < 256) { const int idx = u.rt * 256 + tid;
            if (u.e == 64) { pa = NASSIGN + idx; pw = 1.f; }
            else if (idx < tab[64 + u.e]) { pa = list[u.e * T + idx]; if (MODE == 1) pw = listw[u.e * T + idx]; } }
    }
    __device__ __forceinline__ void pf_commit(int s, int pa, float pw) const { const int tid = threadIdx.x; if (tid < 256) { rowA[s * 256 + tid] = pa; rowW[s * 256 + tid] = pw; } }
    __device__ __forceinline__ void rowoffs(const Unit& u, int s, unsigned (&vo)[2][2], const int (&R)[2], const int (&C)[2]) const {
#pragma unroll
        for (int h = 0; h < 2; ++h)
#pragma unroll
            for (int i = 0; i < 2; ++i) {
                int a = rowA[s * 256 + R[i] + 128 * h];
                unsigned row;
                if (MODE == 0) { a = a < 0 ? 0 : a; row = a < NASSIGN ? (unsigned)(a >> 3) : (unsigned)(a - NASSIGN); }
                else row = a < 0 ? 0u : (unsigned)a;
                vo[h][i] = (row * (unsigned)K + (unsigned)C[i]) * 2u;
            }
    }
};

struct EpiZ {
    bf16_t* Z; float* FL; const float* fbias;
    __device__ __forceinline__ void operator()(const f32x4 (&acc)[2][2][4][2], const Unit& u, int slot, int wr, int wc, int fr, int fq) const {
        const int row0 = u.pm * 256 + wr * 64 + fr;
        if (u.pn == 34) {
            if (wc == 0 && fq < 2) {
                float fb[8];
#pragma unroll
                for (int j = 0; j < 8; ++j) fb[j] = fbias[8 * fq + j];
#pragma unroll
                for (int ai = 0; ai < 2; ++ai)
#pragma unroll
                    for (int m = 0; m < 4; ++m) {
                        float* o = FL + (size_t)(row0 + ai * 128 + m * 16) * 16 + 8 * fq;
#pragma unroll
                        for (int n = 0; n < 2; ++n) { f32x4 r;
#pragma unroll
                            for (int j = 0; j < 4; ++j) { const float x = acc[ai][0][m][n][j] + fb[4 * n + j]; const float ls = x >= 0.f ? -log1pf(expf(-x)) : x - log1pf(expf(x)); r[j] = ls * LOG2E; }
                            *(f32x4*)(o + 4 * n) = r; }
                    }
            }
            return;
        }
        const int mode = (u.pn < 4 || (u.pn >= 6 && u.pn < 10)) ? 1 : (u.pn >= 18 ? 2 : 0);
        const int col0 = u.pn * 256 + wc * 32 + 8 * fq;
#pragma unroll
        for (int ai = 0; ai < 2; ++ai)
#pragma unroll
            for (int m = 0; m < 4; ++m) { bf16_t* rowp = Z + (size_t)(row0 + ai * 128 + m * 16) * ZP + col0;
#pragma unroll
                for (int bj = 0; bj < 2; ++bj) { f32x4 v0 = acc[ai][bj][m][0], v1 = acc[ai][bj][m][1];
                    if (mode == 1) { v0 = v0 * QSCALE; v1 = v1 * QSCALE; }
                    else if (mode == 2) {
#pragma unroll
                        for (int j = 0; j < 4; ++j) { v0[j] = sigmoidf_(v0[j]); v1[j] = sigmoidf_(v1[j]); } }
                    u32x4 w; w.x = cvtpk(v0[0], v0[1]); w.y = cvtpk(v0[2], v0[3]); w.z = cvtpk(v1[0], v1[1]); w.w = cvtpk(v1[2], v1[3]);
                    *(u32x4*)(rowp + bj * 128) = w; } }
    }
};
struct EpiMix {
    const bf16_t* Z; bf16_t* MIX;
    __device__ __forceinline__ void operator()(const f32x4 (&acc)[2][2][4][2], const Unit& u, int slot, int wr, int wc, int fr, int fq) const {
        const int row0 = u.pm * 256 + wr * 64 + fr, col0 = u.pn * 256 + wc * 32 + 8 * fq;
        const int gcol = (u.e ? ZGF : ZGS) + col0;
#pragma unroll
        for (int ai = 0; ai < 2; ++ai)
#pragma unroll
            for (int m = 0; m < 4; ++m) { const size_t row = (size_t)(row0 + ai * 128 + m * 16);
#pragma unroll
                for (int bj = 0; bj < 2; ++bj) {
                    const u32x4 g = *(const u32x4*)(Z + row * ZP + gcol + bj * 128);
                    f32x4 v0 = acc[ai][bj][m][0], v1 = acc[ai][bj][m][1];
                    v0[0] *= bflo(g.x); v0[1] *= bfhi(g.x); v0[2] *= bflo(g.y); v0[3] *= bfhi(g.y);
                    v1[0] *= bflo(g.z); v1[1] *= bfhi(g.z); v1[2] *= bflo(g.w); v1[3] *= bfhi(g.w);
                    u32x4* mp = (u32x4*)(MIX + row * D + col0 + bj * 128);
                    if (u.e != 0) { const u32x4 t = *mp;
                        v0[0] += bflo(t.x); v0[1] += bfhi(t.x); v0[2] += bflo(t.y); v0[3] += bfhi(t.y);
                        v1[0] += bflo(t.z); v1[1] += bfhi(t.z); v1[2] += bflo(t.w); v1[3] += bfhi(t.w); }
                    u32x4 w; w.x = cvtpk(v0[0], v0[1]); w.y = cvtpk(v0[2], v0[3]); w.z = cvtpk(v1[0], v1[1]); w.w = cvtpk(v1[2], v1[3]);
                    *mp = w; } }
    }
};
struct EpiOut {
    const float* X; float* H1; float* PSQ;
    __device__ __forceinline__ void operator()(const f32x4 (&acc)[2][2][4][2], const Unit& u, int slot, int wr, int wc, int fr, int fq) const {
        const int row0 = u.pm * 256 + wr * 64 + fr, col0 = u.pn * 256 + wc * 32 + 8 * fq;
#pragma unroll
        for (int ai = 0; ai < 2; ++ai)
#pragma unroll
            for (int m = 0; m < 4; ++m) { const size_t row = (size_t)(row0 + ai * 128 + m * 16); float sq = 0.f;
#pragma unroll
                for (int bj = 0; bj < 2; ++bj) {
                    const float* xp = X + row * D + col0 + bj * 128; float* hp = H1 + row * D + col0 + bj * 128;
                    const f32x4 x0 = *(const f32x4*)xp, x1 = *(const f32x4*)(xp + 4);
                    const f32x4 h0 = acc[ai][bj][m][0] + x0, h1 = acc[ai][bj][m][1] + x1;
                    *(f32x4*)hp = h0; *(f32x4*)(hp + 4) = h1;
                    sq += (h0[0] * h0[0] + h0[1] * h0[1]) + (h0[2] * h0[2] + h0[3] * h0[3]) + (h1[0] * h1[0] + h1[1] * h1[1]) + (h1[2] * h1[2] + h1[3] * h1[3]); }
                sq += __shfl_xor(sq, 16); sq += __shfl_xor(sq, 32);
                if (fq == 0) PSQ[row * 32 + u.pn * 4 + wc] = sq; }
    }
};
struct EpiSwiglu {
    const MoeSched<0>* S; bf16_t* HB;
    __device__ __forceinline__ void operator()(const f32x4 (&acc)[2][2][4][2], const Unit& u, int slot, int wr, int wc, int fr, int fq) const {
        const int ff0 = u.pn * 128 + wc * 32 + 8 * fq;
#pragma unroll
        for (int ai = 0; ai < 2; ++ai)
#pragma unroll
            for (int m = 0; m < 4; ++m) { const int a = S->rowA[slot * 256 + ai * 128 + wr * 64 + m * 16 + fr];
                if (a >= 0) { float h[8];
#pragma unroll
                    for (int n = 0; n < 2; ++n)
#pragma unroll
                        for (int j = 0; j < 4; ++j) { const float g = acc[ai][0][m][n][j], up = acc[ai][1][m][n][j]; h[4 * n + j] = g * sigmoidf_(g) * up; }
                    u32x4 w; w.x = cvtpk(h[0], h[1]); w.y = cvtpk(h[2], h[3]); w.z = cvtpk(h[4], h[5]); w.w = cvtpk(h[6], h[7]);
                    *(u32x4*)(HB + (size_t)a * FF + ff0) = w; } }
    }
};
struct EpiDown {
    const MoeSched<1>* S; bf16_t* YB;
    __device__ __forceinline__ void operator()(const f32x4 (&acc)[2][2][4][2], const Unit& u, int slot, int wr, int wc, int fr, int fq) const {
        const int col0 = u.pn * 256 + wc * 32 + 8 * fq;
#pragma unroll
        for (int ai = 0; ai < 2; ++ai)
#pragma unroll
            for (int m = 0; m < 4; ++m) { const int ri = slot * 256 + ai * 128 + wr * 64 + m * 16 + fr; const int a = S->rowA[ri];
                if (a >= 0) { const float w8 = S->rowW[ri];
#pragma unroll
                    for (int bj = 0; bj < 2; ++bj) { const f32x4 v0 = acc[ai][bj][m][0] * w8, v1 = acc[ai][bj][m][1] * w8;
                        u32x4 w; w.x = cvtpk(v0[0], v0[1]); w.y = cvtpk(v0[2], v0[3]); w.z = cvtpk(v1[0], v1[1]); w.w = cvtpk(v1[2], v1[3]);
                        *(u32x4*)(YB + (size_t)a * D + col0 + bj * 128) = w; } } }
    }
};

struct P0Item { const float* src; bf16_t* dst; int ldw, nvalid, K; };
__device__ __forceinline__ P0Item p0_decode(int it, const Args& a, unsigned char* ws) {
    constexpr int I_IN = 32 * 140, I_SW = 16 * 32, I_OUT = 32 * 32, I_GU = 32 * 8, I_DN = 8 * 32, I_EXP = 2 * I_GU + I_DN;
    P0Item q; int r = it;
    if (r < I_IN) { const int kb = r / 140, nb = r % 140, n0 = nb * 64;
        int c0, nv; if (n0 < 4608) { c0 = n0; nv = 64; } else if (n0 < 8704) { c0 = n0 + 16; nv = 64; } else if (n0 == 8704) { c0 = 4608; nv = 16; } else { c0 = 0; nv = 0; }
        q.src = a.in[2] + (size_t)kb * 64 * 8720 + c0; q.ldw = 8720; q.nvalid = nv; q.K = D; q.dst = (bf16_t*)(ws + WS_WINT) + (size_t)n0 * D + kb * 64; return q; }
    r -= I_IN;
    if (r < I_SW) { const int kb = r / 32, nb = r % 32; q.src = a.in[5] + (size_t)kb * 64 * D + nb * 64; q.ldw = D; q.nvalid = 64; q.K = 1024; q.dst = (bf16_t*)(ws + WS_WSWAT) + (size_t)nb * 64 * 1024 + kb * 64; return q; }
    r -= I_SW;
    if (r < I_SW) { const int kb = r / 32, nb = r % 32; q.src = a.in[6] + (size_t)kb * 64 * D + nb * 64; q.ldw = D; q.nvalid = 64; q.K = 1024; q.dst = (bf16_t*)(ws + WS_WFOXT) + (size_t)nb * 64 * 1024 + kb * 64; return q; }
    r -= I_SW;
    if (r < I_OUT) { const int kb = r / 32, nb = r % 32; q.src = a.in[7] + (size_t)kb * 64 * D + nb * 64; q.ldw = D; q.nvalid = 64; q.K = D; q.dst = (bf16_t*)(ws + WS_WOUTT) + (size_t)nb * 64 * D + kb * 64; return q; }
    r -= I_OUT;
    const int e = r / I_EXP; r -= e * I_EXP;
    if (r < 2 * I_GU) { const int up = r >= I_GU; r -= up * I_GU; const int kb = r / 8, nb = r % 8, n0 = nb * 64;
        const float* src = e < 64 ? (up ? a.in[12] : a.in[11]) + (size_t)e * D * FF : (up ? a.in[15] : a.in[14]);
        const int drow = 256 * (n0 >> 7) + (n0 & 127) + 128 * up;
        q.src = src + (size_t)kb * 64 * FF + n0; q.ldw = FF; q.nvalid = 64; q.K = D; q.dst = (bf16_t*)(ws + WS_WGU) + ((size_t)e * 1024 + drow) * D + kb * 64; return q; }
    r -= 2 * I_GU;
    { const int kb = r / 32, nb = r % 32;
        const float* src = e < 64 ? a.in[13] + (size_t)e * FF * D : a.in[16];
        q.src = src + (size_t)kb * 64 * D + nb * 64; q.ldw = D; q.nvalid = 64; q.K = FF; q.dst = (bf16_t*)(ws + WS_WD) + ((size_t)e * D + nb * 64) * FF + kb * 64; return q; }
}
__device__ __forceinline__ void p0_load(const P0Item& q, f32x4 (&v)[16], int lane) {
    const int kr = lane >> 4, nc = (lane & 15) * 4; const bool ok = nc < q.nvalid;
    const float* p = q.src + (size_t)kr * q.ldw + nc;
#pragma unroll
    for (int i = 0; i < 16; ++i) v[i] = ok ? *(const f32x4*)(p + (size_t)(4 * i) * q.ldw) : (f32x4){0.f, 0.f, 0.f, 0.f};
}
__device__ __forceinline__ void p0_process(const P0Item& q, const f32x4 (&v)[16], LAS float* scr, int lane) {
    const int kr = lane >> 4, nc = (lane & 15) * 4;
#pragma unroll
    for (int i = 0; i < 16; ++i) { LAS float* w = scr + (4 * i + kr) * 65 + nc; w[0] = v[i][0]; w[1] = v[i][1]; w[2] = v[i][2]; w[3] = v[i][3]; }
    LDS_WAIT(); asm volatile("" ::: "memory");
    const int c = lane & 7;
#pragma unroll
    for (int j = 0; j < 8; ++j) { const int n = (lane >> 3) + 8 * j; const LAS float* s = scr + (8 * c) * 65 + n;
        u32x4 o; o.x = cvtpk(s[0 * 65], s[1 * 65]); o.y = cvtpk(s[2 * 65], s[3 * 65]); o.z = cvtpk(s[4 * 65], s[5 * 65]); o.w = cvtpk(s[6 * 65], s[7 * 65]);
        *(u32x4*)(q.dst + (size_t)n * q.K + 8 * c) = o; }
    LDS_WAIT(); asm volatile("" ::: "memory");
}
__device__ __forceinline__ void p0_prologue(Frame& F, const Args& a) {
    LAS float* scr = (LAS float*)(F.lds + F.wave * 16640);
    const int gw = F.vcu * NWAVES + F.wave, NGW = F.G * NWAVES;
    unsigned char* ws = F.ws;
    {
        const float* g = a.in[1];
        for (int m = gw; m < T; m += NGW) {
            const f32x4* xr = (const f32x4*)(a.in[0] + (size_t)m * D) + F.lane;
            f32x4 v[8]; float s = 0.f;
#pragma unroll
            for (int j = 0; j < 8; ++j) { v[j] = xr[64 * j]; s += (v[j].x * v[j].x + v[j].y * v[j].y) + (v[j].z * v[j].z + v[j].w * v[j].w); }
            const float rinv = rsqrtf(wave_sum(s) * (1.f / D) + RMS_EPS);
            u32x2* o = (u32x2*)((bf16_t*)(ws + WS_U) + (size_t)m * D) + F.lane;
#pragma unroll
            for (int j = 0; j < 8; ++j) { const f32x4 gg = *((const f32x4*)g + F.lane + 64 * j); u32x2 w; w.x = cvtpk(v[j].x * rinv * gg.x, v[j].y * rinv * gg.y); w.y = cvtpk(v[j].z * rinv * gg.z, v[j].w * rinv * gg.w); o[64 * j] = w; }
        }
    }
    {
        const float* wr = a.in[9]; const float* g = a.in[8]; float* o = (float*)(ws + WS_WRG);
        for (int i = gw * 64 + F.lane; i < D * NE; i += NGW * 64) o[i] = wr[i] * g[i >> 6];
    }
    constexpr int NITEMS = 32 * 140 + 2 * 16 * 32 + 32 * 32 + 65 * (2 * 32 * 8 + 8 * 32);
    f32x4 va[16], vb[16]; P0Item qa, qb;
    int it = gw;
    if (it < NITEMS) { qa = p0_decode(it, a, ws); p0_load(qa, va, F.lane); }
    while (it < NITEMS) {
        const int it2 = it + NGW, it3 = it2 + NGW;
        if (it2 < NITEMS) { qb = p0_decode(it2, a, ws); p0_load(qb, vb, F.lane); }
        p0_process(qa, va, scr, F.lane);
        if (it3 < NITEMS) { qa = p0_decode(it3, a, ws); p0_load(qa, va, F.lane); }
        if (it2 < NITEMS) p0_process(qb, vb, scr, F.lane);
        it = it3;
    }
}

__device__ __forceinline__ int crow(int r, int hi) { return (r & 3) + 8 * (r >> 2) + 4 * hi; }
__device__ __forceinline__ s16x4 vtr(LAS const char* p) { typedef short v4i16_t __attribute__((ext_vector_type(4))); return __builtin_bit_cast(s16x4, __builtin_amdgcn_ds_read_tr16_b64_v4i16((LAS v4i16_t*)p)); }

__device__ __forceinline__ void attn_qk(f32x16 (&p)[2], const bf16x8 (&qf)[4], LAS const char* Kt, int r32, int hi) {
#pragma unroll
    for (int kb = 0; kb < 2; ++kb) { const int kv = 32 * kb + r32; const int sw = (kv >> 1) & 7; LAS const char* rowp = Kt + kv * 128;
        f32x16 c = {};
#pragma unroll
        for (int s = 0; s < 4; ++s) { const bf16x8 a = *(const LAS bf16x8*)(rowp + (((2 * s + hi) ^ sw) * 16)); c = __builtin_amdgcn_mfma_f32_32x32x16_bf16(a, qf[s], c, 0, 0, 0); }
        p[kb] = c; }
}
__device__ __forceinline__ void attn_softmax_pv(f32x16 (&p)[2], f32x16 (&o)[2], float& m, float& l, LAS const char* Vt, int lane) {
    float mx = p[0][0];
#pragma unroll
    for (int kb = 0; kb < 2; ++kb)
#pragma unroll
        for (int r = 0; r < 16; ++r) mx = fmaxf(mx, p[kb][r]);
    mx = fmaxf(mx, __shfl_xor(mx, 32));
    const float mn = fmaxf(m, mx);
    const float alpha = __builtin_amdgcn_exp2f(m - mn);
    float rs = 0.f;
#pragma unroll
    for (int kb = 0; kb < 2; ++kb)
#pragma unroll
        for (int r = 0; r < 16; ++r) { const float e = __builtin_amdgcn_exp2f(p[kb][r] - mn); p[kb][r] = e; rs += e; }
    rs += __shfl_xor(rs, 32);
    l = l * alpha + rs; m = mn;
#pragma unroll
    for (int db = 0; db < 2; ++db)
#pragma unroll
        for (int r = 0; r < 16; ++r) o[db][r] *= alpha;
    const int g = lane >> 4, i = lane & 15;
    LAS const char* vb = Vt + (4 * (g >> 1) + (i >> 2)) * 64 + (g & 1) * 32 + (i & 3) * 8;
#pragma unroll
    for (int kb = 0; kb < 2; ++kb)
#pragma unroll
        for (int ks = 0; ks < 2; ++ks) {
            u32x4 pw; pw.x = cvtpk(p[kb][8 * ks + 0], p[kb][8 * ks + 1]); pw.y = cvtpk(p[kb][8 * ks + 2], p[kb][8 * ks + 3]); pw.z = cvtpk(p[kb][8 * ks + 4], p[kb][8 * ks + 5]); pw.w = cvtpk(p[kb][8 * ks + 6], p[kb][8 * ks + 7]);
            const bf16x8 pb = __builtin_bit_cast(bf16x8, pw);
#pragma unroll
            for (int db = 0; db < 2; ++db) {
                const s16x4 lo = vtr(vb + db * 4096 + (32 * kb + 16 * ks) * 64), hi4 = vtr(vb + db * 4096 + (32 * kb + 16 * ks + 8) * 64);
                const bf16x8 va = (bf16x8){lo[0], lo[1], lo[2], lo[3], hi4[0], hi4[1], hi4[2], hi4[3]};
                o[db] = __builtin_amdgcn_mfma_f32_32x32x16_bf16(va, pb, o[db], 0, 0, 0); } }
}
__device__ __forceinline__ void attn_store_kv(LAS char* Kt, LAS char* Vt, const u32x4& kr, const u32x4& vr, int tid) {
    const int kv = tid >> 3, c = tid & 7;
    *(LAS u32x4*)(Kt + kv * 128 + ((c ^ ((kv >> 1) & 7)) * 16)) = kr;
    *(LAS u32x4*)(Vt + (c >> 2) * 4096 + kv * 64 + (c & 3) * 16) = vr;
}
__device__ __forceinline__ void attn_store_o(const f32x16 (&o)[2], float l, bf16_t* orow, int hi) {
    const float rl = 1.0f / l;
#pragma unroll
    for (int db = 0; db < 2; ++db)
#pragma unroll
        for (int rq = 0; rq < 4; ++rq) { u32x2 w; w.x = cvtpk(o[db][4 * rq] * rl, o[db][4 * rq + 1] * rl); w.y = cvtpk(o[db][4 * rq + 2] * rl, o[db][4 * rq + 3] * rl);
            *(u32x2*)(orow + 32 * db + 8 * rq + 4 * hi) = w; }
}

__device__ __forceinline__ void swa_unit(Frame& F, int unit, const float* sinks) {
    const bf16_t* Z = (const bf16_t*)(F.ws + WS_Z); bf16_t* YS = (bf16_t*)(F.ws + WS_YS);
    const int b = unit >> 6, kvh = (unit >> 4) & 3, nb = unit & 15;
    const int tid = F.tid, lane = F.lane, r32 = lane & 31, hi = lane >> 5, w = F.wave;
    LAS char* Kl = (LAS char*)F.lds; LAS char* Vl = (LAS char*)F.lds + 32768;
    const int t0 = nb * 128;
    {
        const int kv = tid >> 3, c = tid & 7;
#pragma unroll
        for (int tl = 0; tl < 4; ++tl) {
            if (nb > 0 || tl >= 2) {
                const size_t row = (size_t)(b * SEQ + t0 - 128 + tl * 64 + kv);
                const u32x4 kr = *(const u32x4*)(Z + row * ZP + ZK + kvh * 64 + c * 8);
                const u32x4 vr = *(const u32x4*)(Z + row * ZP + ZV + kvh * 64 + c * 8);
                attn_store_kv(Kl + tl * 8192, Vl + tl * 8192, kr, vr, tid);
            }
        }
    }
    __syncthreads();
    const int qh = kvh * 4 + (w >> 1);
    const float slope2 = exp2f(-0.5f * (float)(qh + 1)) * LOG2E;
    const float sink2 = sinks[qh] * LOG2E;
#pragma unroll 1
    for (int sb = 0; sb < 2; ++sb) {
        const int r0 = 64 * (w & 1) + 32 * sb;
        const int qrel = r0 + r32;
        const size_t qrow = (size_t)(b * SEQ + t0 + qrel);
        bf16x8 qf[4];
#pragma unroll
        for (int s = 0; s < 4; ++s) qf[s] = *(const bf16x8*)(Z + qrow * ZP + ZQ + qh * 64 + 16 * s + 8 * hi);
        f32x16 o[2]; o[0] = f32x16{}; o[1] = f32x16{};
        float m = sink2, l = 1.0f;
        const int tl0 = (r0 + 1) >> 6;
#pragma unroll 1
        for (int tt = 0; tt < 3; ++tt) {
            const int tl = tl0 + tt;
            if (nb == 0 && tl < 2) continue;
            f32x16 p[2];
            attn_qk(p, qf, Kl + tl * 8192, r32, hi);
#pragma unroll
            for (int kb = 0; kb < 2; ++kb)
#pragma unroll
                for (int r = 0; r < 16; ++r) {
                    const int krel = tl * 64 + 32 * kb + crow(r, hi) - 128;
                    const int dist = qrel - krel;
                    const float s = p[kb][r] - slope2 * (float)dist;
                    p[kb][r] = (dist >= 0 && dist < 128) ? s : -INFINITY;
                }
            attn_softmax_pv(p, o, m, l, Vl + tl * 8192, lane);
        }
        attn_store_o(o, l, YS + qrow * 1024 + qh * 64, hi);
    }
    __syncthreads();
}

__device__ __forceinline__ void fox_unit(Frame& F, int bh, int qb, LAS const float* c2) {
    const bf16_t* Z = (const bf16_t*)(F.ws + WS_Z); bf16_t* YF = (bf16_t*)(F.ws + WS_YF);
    const int b = bh >> 4, h = bh & 15;
    const int tid = F.tid, lane = F.lane, r32 = lane & 31, hi = lane >> 5, w = F.wave;
    LAS char* Kl = (LAS char*)F.lds; LAS char* Vl = (LAS char*)F.lds + 16384;
    const int q0 = qb * 256, qw = q0 + 32 * w, qabs = qw + r32;
    const size_t qrow = (size_t)(b * SEQ + qabs);
    const int NT = 4 * (qb + 1);
    const int kvr = tid >> 3, kc = tid & 7;
    const bf16_t* kbase = Z + (size_t)(b * SEQ + kvr) * ZP + ZFK + h * 64 + kc * 8;
    const bf16_t* vbase = Z + (size_t)(b * SEQ + kvr) * ZP + ZFV + h * 64 + kc * 8;
    u32x4 kr = *(const u32x4*)kbase, vr = *(const u32x4*)vbase;
    bf16x8 qf[4];
#pragma unroll
    for (int s = 0; s < 4; ++s) qf[s] = *(const bf16x8*)(Z + qrow * ZP + ZFQ + h * 64 + 16 * s + 8 * hi);
    attn_store_kv(Kl, Vl, kr, vr, tid);
    __syncthreads();
    f32x16 o[2]; o[0] = f32x16{}; o[1] = f32x16{};
    float m = -1e30f, l = 0.f;
#pragma unroll 1
    for (int t = 0; t < NT; ++t) {
        const int buf = t & 1;
        if (t + 1 < NT) { kr = *(const u32x4*)(kbase + (size_t)(t + 1) * 64 * ZP); vr = *(const u32x4*)(vbase + (size_t)(t + 1) * 64 * ZP); }
        const int k0 = t * 64;
        if (k0 <= qw + 31) {
            f32x16 p[2];
            attn_qk(p, qf, Kl + buf * 8192, r32, hi);
            const bool diag = (k0 + 63 > qw);
#pragma unroll
            for (int kb = 0; kb < 2; ++kb)
#pragma unroll
                for (int rq = 0; rq < 4; ++rq) {
                    const int kk = k0 + 32 * kb + 8 * rq + 4 * hi;
                    const f32x4 cc = *(const LAS f32x4*)(c2 + kk);
#pragma unroll
                    for (int j = 0; j < 4; ++j) { float s = p[kb][4 * rq + j] - cc[j]; if (diag && (kk + j > qabs)) s = -INFINITY; p[kb][4 * rq + j] = s; }
                }
            attn_softmax_pv(p, o, m, l, Vl + buf * 8192, lane);
        }
        if (t + 1 < NT) attn_store_kv(Kl + (buf ^ 1) * 8192, Vl + (buf ^ 1) * 8192, kr, vr, tid);
        __syncthreads();
    }
    attn_store_o(o, l, YF + qrow * 1024 + h * 64, hi);
}
__device__ __forceinline__ void p2_attention(Frame& F, const Args& a) {
    for (int u = F.vcu; u < 256; u += F.G) swa_unit(F, u, a.in[4]);
    LAS float* c2 = (LAS float*)(F.lds + 32768);
    LAS float* wtot = (LAS float*)(F.lds + 32768 + 8192);
    const float* FL = (const float*)(F.ws + WS_FL);
    for (int it = F.vcu; it < 256; it += F.G) {
        const int bh = it >> 2, s = it & 3, b = bh >> 4, h = bh & 15;
        {
            float v[4]; float run = 0.f;
#pragma unroll
            for (int j = 0; j < 4; ++j) { run += FL[(size_t)(b * SEQ + 4 * F.tid + j) * 16 + h]; v[j] = run; }
            float inc = run;
#pragma unroll
            for (int o = 1; o < 64; o <<= 1) { const float n = __shfl_up(inc, o); if (F.lane >= o) inc += n; }
            if (F.lane == 63) wtot[F.wave] = inc;
            __syncthreads();
            float base = inc - run;
            for (int ww = 0; ww < F.wave; ++ww) base += wtot[ww];
#pragma unroll
            for (int j = 0; j < 4; ++j) c2[4 * F.tid + j] = base + v[j];
            __syncthreads();
        }
        fox_unit(F, bh, s, c2);
        fox_unit(F, bh, 7 - s, c2);
        __syncthreads();
    }
}

__device__ __forceinline__ void p5_router(Frame& F, const Args& a, unsigned* CNT, float* LISTW, int* LIST) {
    const float* H1 = (const float*)(F.ws + WS_H1); const float* PSQ = (const float*)(F.ws + WS_PSQ); const float* WRG = (const float*)(F.ws + WS_WRG);
    bf16_t* V = (bf16_t*)(F.ws + WS_V);
    const float* g = a.in[8]; const float* rbias = a.in[10];
    const int lane = F.lane, w = F.wave, tid = F.tid;
    LAS float* part = (LAS float*)F.lds;
    LAS float* logit = (LAS float*)(F.lds + 65536);
    LAS float* rinvs = (LAS float*)(F.lds + 65536 + 8192);
    LAS int* lcnt = (LAS int*)(F.lds + 65536 + 8192 + 128);
    LAS int* gbase = (LAS int*)(F.lds + 65536 + 8192 + 128 + 256);
    for (int tile = F.vcu; tile < T / 32; tile += F.G) {
        const int tok0 = tile * 32;
        if (tid < 64) lcnt[tid] = 0;
#pragma unroll 1
        for (int j = 0; j < 4; ++j) {
            const int tok = tok0 + 4 * w + j;
            float sq = lane < 32 ? PSQ[(size_t)tok * 32 + lane] : 0.f;
            sq = wave_sum(sq);
            const float rinv = rsqrtf(sq * (1.f / D) + RMS_EPS);
            if (lane == 0) rinvs[4 * w + j] = rinv;
            const f32x4* hr = (const f32x4*)(H1 + (size_t)tok * D) + lane;
            u32x2* o = (u32x2*)(V + (size_t)tok * D) + lane;
#pragma unroll
            for (int jj = 0; jj < 8; ++jj) { const f32x4 hv = hr[64 * jj]; const f32x4 gg = *((const f32x4*)g + lane + 64 * jj);
                u32x2 wv; wv.x = cvtpk(hv.x * rinv * gg.x, hv.y * rinv * gg.y); wv.y = cvtpk(hv.z * rinv * gg.z, hv.w * rinv * gg.w); o[64 * jj] = wv; }
        }
        {
            f32x16 acc0 = {}, acc1 = {};
            const int tk = lane & 31, half = lane >> 5;
            const float* hp = H1 + (size_t)(tok0 + tk) * D + 256 * w + 4 * half;
            const float* wp = WRG + (size_t)(256 * w + 4 * half) * NE + tk;
#pragma unroll 4
            for (int kk = 0; kk < 32; ++kk) {
                const f32x4 av = *(const f32x4*)(hp + 8 * kk);
#pragma unroll
                for (int s = 0; s < 4; ++s) {
                    const float b0 = wp[(size_t)(8 * kk + s) * NE], b1 = wp[(size_t)(8 * kk + s) * NE + 32];
                    acc0 = __builtin_amdgcn_mfma_f32_32x32x2f32(av[s], b0, acc0, 0, 0, 0);
                    acc1 = __builtin_amdgcn_mfma_f32_32x32x2f32(av[s], b1, acc1, 0, 0, 0);
                }
            }
#pragma unroll
            for (int r = 0; r < 16; ++r) { const int tr = crow(r, half); part[(w * 32 + tr) * 64 + tk] = acc0[r]; part[(w * 32 + tr) * 64 + 32 + tk] = acc1[r]; }
        }
        __syncthreads();
#pragma unroll
        for (int q = 0; q < 4; ++q) { const int idx = tid + 512 * q; float s = 0.f;
#pragma unroll
            for (int ww = 0; ww < 8; ++ww) s += part[ww * 2048 + idx];
            logit[idx] = s * rinvs[idx >> 6]; }
        __syncthreads();
        int sel_k[4], sel_ls[4]; float sel_w[4];
        const float bias = rbias[lane];
#pragma unroll
        for (int j = 0; j < 4; ++j) {
            const int tl = 4 * w + j;
            const float score = sigmoidf_(logit[tl * 64 + lane]);
            const float biased = score + bias;
            float m1 = biased; m1 = fmaxf(m1, __shfl_xor(m1, 1)); m1 = fmaxf(m1, __shfl_xor(m1, 2)); m1 = fmaxf(m1, __shfl_xor(m1, 4));
            const unsigned long long gm = 0xFFull << (lane & 56);
            const unsigned long long b1 = __ballot(biased == m1) & gm;
            const int i1 = __builtin_ctzll(b1);
            float v2 = (lane == i1) ? -INFINITY : biased;
            float m2 = v2; m2 = fmaxf(m2, __shfl_xor(m2, 1)); m2 = fmaxf(m2, __shfl_xor(m2, 2)); m2 = fmaxf(m2, __shfl_xor(m2, 4));
            const float gs = m1 + m2; const int gi = lane >> 3;
            int rank = 0;
#pragma unroll
            for (int gg = 0; gg < 8; ++gg) { const float o = __shfl(gs, 8 * gg); rank += (o > gs || (o == gs && gg < gi)) ? 1 : 0; }
            float mv = rank < 4 ? biased : -INFINITY;
            int myk = -1;
#pragma unroll
            for (int it = 0; it < 8; ++it) { const float mx = wave_max(mv); const unsigned long long bb = __ballot(mv == mx); const int sl = __builtin_ctzll(bb); if (lane == sl) { myk = it; mv = -INFINITY; } }
            const float ssum = wave_sum(myk >= 0 ? score : 0.f);
            sel_k[j] = myk; sel_w[j] = score / ssum * 2.5f;
            sel_ls[j] = 0;
            if (myk >= 0) sel_ls[j] = __hip_atomic_fetch_add((LAS int*)&lcnt[lane], 1, __ATOMIC_RELAXED, __HIP_MEMORY_SCOPE_WORKGROUP);
        }
        __syncthreads();
        if (tid < 64) gbase[tid] = (int)atomicAdd(CNT + tid, (unsigned)lcnt[tid]);
        __syncthreads();
#pragma unroll
        for (int j = 0; j < 4; ++j) if (sel_k[j] >= 0) { const int tok = tok0 + 4 * w + j; const int aid = tok * 8 + sel_k[j];
            const size_t li = (size_t)lane * T + gbase[lane] + sel_ls[j]; LIST[li] = aid; LISTW[li] = sel_w[j]; }
        __syncthreads();
    }
}

template <int MULT> __device__ __forceinline__ int moe_table(Frame& F, LAS int* tab) {
    if (F.tid < 64) {
        const int cnt = (int)__hip_atomic_load(F.ctl + CW_CNT + F.tid, __ATOMIC_RELAXED, __HIP_MEMORY_SCOPE_AGENT);
        int inc = ((cnt + 255) >> 8) * MULT;
#pragma unroll
        for (int o = 1; o < 64; o <<= 1) { const int n = __shfl_up(inc, o); if (F.lane >= o) inc += n; }
        tab[F.tid] = inc; tab[64 + F.tid] = cnt;
    }
    __syncthreads();
    return 32 * MULT + tab[63];
}

__device__ __forceinline__ void p8_final(Frame& F, const Args& a) {
    const float* H1 = (const float*)(F.ws + WS_H1); const bf16_t* YB = (const bf16_t*)(F.ws + WS_YB); const float* g = a.in[17];
    const int gw = F.vcu * NWAVES + F.wave, NGW = F.G * NWAVES;
    for (int tok = gw; tok < T; tok += NGW) {
        const f32x4* hr = (const f32x4*)(H1 + (size_t)tok * D) + F.lane;
        f32x4 v[8];
#pragma unroll
        for (int j = 0; j < 8; ++j) v[j] = hr[64 * j];
#pragma unroll 1
        for (int k = 0; k < 9; ++k) {
            const size_t row = k < 8 ? (size_t)tok * 8 + k : (size_t)NASSIGN + tok;
            const u32x2* yr = (const u32x2*)(YB + row * D) + F.lane;
#pragma unroll
            for (int j = 0; j < 8; ++j) { const u32x2 y = yr[64 * j]; v[j].x += bflo(y.x); v[j].y += bfhi(y.x); v[j].z += bflo(y.y); v[j].w += bfhi(y.y); }
        }
        float s = 0.f;
#pragma unroll
        for (int j = 0; j < 8; ++j) s += (v[j].x * v[j].x + v[j].y * v[j].y) + (v[j].z * v[j].z + v[j].w * v[j].w);
        const float rinv = rsqrtf(wave_sum(s) * (1.f / D) + RMS_EPS);
        f32x4* o = (f32x4*)(a.out + (size_t)tok * D) + F.lane;
#pragma unroll
        for (int j = 0; j < 8; ++j) { const f32x4 gg = *((const f32x4*)g + F.lane + 64 * j); o[64 * j] = (f32x4){v[j].x * rinv * gg.x, v[j].y * rinv * gg.y, v[j].z * rinv * gg.z, v[j].w * rinv * gg.w}; }
    }
}

constexpr int N_PHASES = 9;
__global__ void __launch_bounds__(NTHREADS, 2) fwd_kernel(Args args) {
    extern __shared__ __attribute__((aligned(16))) unsigned char lds_raw[];
    Frame F;
    F.lds = (LAS unsigned char*)lds_raw;
    F.MISC = (volatile LAS unsigned*)(F.lds + MISC_OFF);
    F.tid = threadIdx.x; F.lane = F.tid & 63; F.wave = __builtin_amdgcn_readfirstlane(F.tid >> 6);
    F.G = gridDim.x; { const int bx = blockIdx.x; F.vcu = (F.G % 8 == 0) ? (bx % 8) * (F.G / 8) + bx / 8 : bx; }
    F.ws = args.ws; F.ctl = (unsigned*)(args.ws + WS_CTL);
    for (int u = F.tid; u < (LDS_BYTES - MISC_OFF) / 4; u += NTHREADS) ((LAS unsigned*)(F.lds + MISC_OFF))[u] = 0u;
    __syncthreads();
    const int lo = args.ph_lo, hi = args.ph_hi;
    XcdBarrier bar; bar.bar = F.ctl + CW_BAR; bar.x = 0; bar.st = nullptr;
    if (hi - lo > 1) bar = xcd_barrier_post(F.ctl + CW_BAR, F.MISC + 8);
#define IN(k) (lo <= (k) && (k) < hi)
#define SEAM(k) do { if (IN(k) && IN((k) + 1)) xcd_barrier(bar); } while (0)
    unsigned char* ws = args.ws;
    LAS int* tab = (LAS int*)(F.lds + MISC_OFF + 256);

#define REPS(k) for (int rep_ = 0; rep_ < (PROBE_DUP == (k) ? 2 : 1); ++rep_)
#define REPBAR(k) do { if (PROBE_DUP == (k) && rep_ == 0) xcd_barrier(bar); } while (0)
    if (IN(0)) { REPS(0) { p0_prologue(F, args); REPBAR(0); } SEAM(0); }
    if (IN(1)) {
        DenseSched S{(const char*)(ws + WS_U), (const char*)(ws + WS_WINT), T / 256, NIN / 256, D, F.G, (int)blockIdx.x, PROBE_DUP == 1 ? 2 : 1};
        EpiZ E{(bf16_t*)(ws + WS_Z), (float*)(ws + WS_FL), args.in[3]};
        pg8::gemm_phase(F.lds, D, S, E);
        SEAM(1);
    }
    if (IN(2)) { REPS(2) { p2_attention(F, args); REPBAR(2); } SEAM(2); }
    if (IN(3)) {
        BranchSched S{(const char*)(ws + WS_YS), (const char*)(ws + WS_YF), (const char*)(ws + WS_WSWAT), (const char*)(ws + WS_WFOXT), T / 256, D / 256, 1024, F.G, (int)blockIdx.x, PROBE_DUP == 3 ? 2 : 1};
        EpiMix E{(const bf16_t*)(ws + WS_Z), (bf16_t*)(ws + WS_MIX)};
        pg8::gemm_phase(F.lds, 1024, S, E);
        SEAM(3);
    }
    if (IN(4)) {
        DenseSched S{(const char*)(ws + WS_MIX), (const char*)(ws + WS_WOUTT), T / 256, D / 256, D, F.G, (int)blockIdx.x, PROBE_DUP == 4 ? 2 : 1};
        EpiOut E{args.in[0], (float*)(ws + WS_H1), (float*)(ws + WS_PSQ)};
        pg8::gemm_phase(F.lds, D, S, E);
        SEAM(4);
    }
    if (IN(5)) {
        if (PROBE_DUP == 5) { p5_router(F, args, F.ctl + 256, (float*)(ws + WS_T1), (int*)(ws + WS_T1 + 2 * MiB)); xcd_barrier(bar); }
        p5_router(F, args, F.ctl + CW_CNT, (float*)(ws + WS_LISTW), (int*)(ws + WS_LIST));
        if (PROBE_DUP == 9) { for (int q = 0; q < 16; ++q) xcd_barrier(bar); }
        SEAM(5); }
    if (IN(6)) {
        const int total = moe_table<4>(F, tab);
        MoeSched<0> S{tab, (const int*)(ws + WS_LIST), (const float*)(ws + WS_LISTW), (const char*)(ws + WS_V), (const char*)(ws + WS_WGU), (LAS int*)(F.lds + MISC_OFF + 1024), (LAS float*)(F.lds + MISC_OFF + 3072), total, F.G, F.vcu, PROBE_DUP == 6 ? 2 : 1};
        EpiSwiglu E{&S, (bf16_t*)(ws + WS_HB)};
        pg8::gemm_phase(F.lds, 2048, S, E);
        SEAM(6);
    }
    if (IN(7)) {
        const int total = moe_table<8>(F, tab);
        MoeSched<1> S{tab, (const int*)(ws + WS_LIST), (const float*)(ws + WS_LISTW), (const char*)(ws + WS_HB), (const char*)(ws + WS_WD), (LAS int*)(F.lds + MISC_OFF + 1024), (LAS float*)(F.lds + MISC_OFF + 3072), total, F.G, F.vcu, PROBE_DUP == 7 ? 2 : 1};
        EpiDown E{&S, (bf16_t*)(ws + WS_YB)};
        pg8::gemm_phase(F.lds, 512, S, E);
        SEAM(7);
    }
    if (IN(8)) { REPS(8) { p8_final(F, args); REPBAR(8); } }
#undef IN
#undef SEAM
}

extern "C" void kernel_launch(void* const* d_in, const int* in_sizes, int n_in, void* d_out, int out_size, void* d_ws, size_t ws_size, hipStream_t stream) {
    static int grid = 0;
    if (grid == 0) {
        if (n_in != 18 || out_size != T * D || ws_size < WS_END) { fprintf(stderr, "kernel_launch: unexpected shapes (n_in %d out %d ws %zu)\n", n_in, out_size, ws_size); grid = -1; return; }
        int dev = 0, cus = 0, per_cu = 0;
        if (hipGetDevice(&dev) != hipSuccess || hipDeviceGetAttribute(&cus, hipDeviceAttributeMultiprocessorCount, dev) != hipSuccess) { grid = -1; return; }
        if (hipFuncSetAttribute((const void*)fwd_kernel, hipFuncAttributeMaxDynamicSharedMemorySize, LDS_BYTES) != hipSuccess) { fprintf(stderr, "kernel_launch: hipFuncSetAttribute failed\n"); grid = -1; return; }
        if (hipOccupancyMaxActiveBlocksPerMultiprocessor(&per_cu, (const void*)fwd_kernel, NTHREADS, LDS_BYTES) != hipSuccess || per_cu < 1) { fprintf(stderr, "kernel_launch: occupancy query says %d blocks per CU\n", per_cu); (void)hipGetLastError(); grid = -1; return; }
        grid = cus;
        if (grid % 8 != 0 || grid > 256) grid = (grid / 8) * 8 > 256 ? 256 : (grid / 8) * 8;
    }
    if (grid <= 0) return;
    (void)hipMemsetAsync((char*)d_ws + WS_CTL, 0, CTL_ZERO_BYTES, stream);
    Args a{};
    for (int i = 0; i < 18; ++i) a.in[i] = (const float*)d_in[i];
    a.out = (float*)d_out; a.ws = (unsigned char*)d_ws;
#if MK_N_LAUNCHES == 1
    a.ph_lo = 0; a.ph_hi = N_PHASES;
    hipLaunchKernelGGL(fwd_kernel, dim3(grid), dim3(NTHREADS), LDS_BYTES, stream, a);
#else
    for (int p = 0; p < N_PHASES; ++p) { a.ph_lo = p; a.ph_hi = p + 1; hipLaunchKernelGGL(fwd_kernel, dim3(grid), dim3(NTHREADS), LDS_BYTES, stream, a); }
#endif
}
```

```cpp
#include <hip/hip_runtime.h>
#include <cstdio>
#include <cstdint>

#ifndef MK_N_LAUNCHES
#define MK_N_LAUNCHES 1
#endif
#define PROBE_DUP 7

#define LAS __attribute__((address_space(3)))
#define GAS __attribute__((address_space(1)))
typedef unsigned short bf16_t;
typedef short bf16x8 __attribute__((ext_vector_type(8)));
typedef short s16x4 __attribute__((ext_vector_type(4)));
typedef float f32x2 __attribute__((ext_vector_type(2)));
typedef float f32x4 __attribute__((ext_vector_type(4)));
typedef float f32x16 __attribute__((ext_vector_type(16)));
typedef unsigned u32x2 __attribute__((ext_vector_type(2)));
typedef unsigned u32x4 __attribute__((ext_vector_type(4)));
typedef __bf16 bf16x2_t __attribute__((ext_vector_type(2)));

constexpr int T = 8192, D = 2048, SEQ = 2048, NBATCH = 4;
constexpr int NE = 64, FF = 512, TOPK = 8;
constexpr int ZP = 8704;
constexpr int ZQ = 0, ZK = 1024, ZV = 1280, ZFQ = 1536, ZFK = 2560, ZFV = 3584, ZGS = 4608, ZGF = 6656;
constexpr int NIN = 8960;
constexpr float RMS_EPS = 1e-6f;
constexpr float LOG2E = 1.4426950408889634f;
constexpr float QSCALE = 0.125f * LOG2E;
constexpr int NASSIGN = T * TOPK;
constexpr int NROWS_H = NASSIGN + T;

constexpr size_t MiB = 1u << 20;
constexpr size_t WS_CTL = 0, CTL_ZERO_BYTES = 64 * 1024;
constexpr size_t WS_FL = 1 * MiB;
constexpr size_t WS_WTS = 1 * MiB + 512 * 1024;
constexpr size_t WS_LIST = 2 * MiB;
constexpr size_t WS_WSWAT = 4 * MiB, WS_WFOXT = 8 * MiB, WS_WOUTT = 12 * MiB;
constexpr size_t WS_WINT = 20 * MiB;
constexpr size_t WS_WRG = 55 * MiB;
constexpr size_t WS_PSQ = 55 * MiB + 512 * 1024;
constexpr size_t WS_U = 56 * MiB;
constexpr size_t WS_Z = 88 * MiB;
constexpr size_t WS_YS = 224 * MiB, WS_YF = 240 * MiB;
constexpr size_t WS_T1 = 256 * MiB;
constexpr size_t WS_MIX = 320 * MiB;
constexpr size_t WS_H1 = 352 * MiB;
constexpr size_t WS_V = 416 * MiB;
constexpr size_t WS_HB = 448 * MiB;
constexpr size_t WS_WGU = 520 * MiB;
constexpr size_t WS_WD = 780 * MiB;
constexpr size_t WS_YB = 56 * MiB;
constexpr size_t WS_LISTW = 910 * MiB;
constexpr size_t WS_END = 912 * MiB;
static_assert(WS_YB + (size_t)NROWS_H * D * 2 <= WS_MIX + 32 * MiB, "YB overlay");
constexpr int CW_CNT = 64;
constexpr int CW_BAR = 4096;

constexpr int RING_BYTES = 131072;
constexpr int MISC_OFF = 139264;
constexpr int LDS_BYTES = 147456;
constexpr int NWAVES = 8, NTHREADS = 512;

__device__ __forceinline__ unsigned cvtpk(float lo, float hi) { f32x2 v = {lo, hi}; bf16x2_t b = __builtin_convertvector(v, bf16x2_t); return __builtin_bit_cast(unsigned, b); }
__device__ __forceinline__ float bf2f(bf16_t h) { return __builtin_bit_cast(float, (unsigned)h << 16); }
__device__ __forceinline__ float bflo(unsigned w) { return __builtin_bit_cast(float, w << 16); }
__device__ __forceinline__ float bfhi(unsigned w) { return __builtin_bit_cast(float, w & 0xffff0000u); }
__device__ __forceinline__ float wave_sum(float v) {
#pragma unroll
    for (int o = 1; o < 64; o <<= 1) v += __shfl_xor(v, o);
    return v;
}
__device__ __forceinline__ float wave_max(float v) {
#pragma unroll
    for (int o = 1; o < 64; o <<= 1) v = fmaxf(v, __shfl_xor(v, o));
    return v;
}
__device__ __forceinline__ float sigmoidf_(float x) { return 1.0f / (1.0f + __expf(-x)); }
#define LDS_WAIT() asm volatile("s_waitcnt lgkmcnt(0)" ::: "memory")
#define VM_WAIT() asm volatile("s_waitcnt vmcnt(0)" ::: "memory")

#define XB_TMO      128
#define XB_XCNT(j)  (256  + 64 * (j))
#define XB_XSUB(j)  (1280 + 64 * (j))
#define XB_XGEN(j)  (2304 + 64 * (j))
#define XB_TOP      3328
#define XB_TOPGEN   3392
#define XCD_BAR_WORDS 3456
#define XB_SPIN_CAP (1u << 20)
__device__ __forceinline__ unsigned xb_ld(unsigned* p)              { return __hip_atomic_load(p, __ATOMIC_RELAXED, __HIP_MEMORY_SCOPE_AGENT); }
__device__ __forceinline__ unsigned xb_add(unsigned* p, unsigned v) { return __hip_atomic_fetch_add(p, v, __ATOMIC_RELAXED, __HIP_MEMORY_SCOPE_AGENT); }
__device__ __forceinline__ unsigned xb_xcc_id() { return (unsigned)__builtin_amdgcn_s_getreg((3 << 11) | 20) & 0xFu; }
#define XB_SPIN(cond, bar) do { unsigned _sp = 0; while (cond) { __builtin_amdgcn_s_sleep(1); \
    if ((++_sp & 255u) == 0u) { if (xb_ld(&(bar)[XB_TMO])) break; if (_sp > XB_SPIN_CAP) { atomicAdd(&(bar)[XB_TMO], 1u); break; } } } } while (0)
struct XcdBarrier { unsigned* bar; unsigned x; volatile LAS unsigned* st; };
__device__ __forceinline__ XcdBarrier xcd_barrier_post(unsigned* bar, volatile LAS unsigned* st) {
    XcdBarrier b; b.bar = bar; b.x = xb_xcc_id(); b.st = st;
    if (threadIdx.x == 0) (void)xb_add(&bar[XB_XCNT(b.x)], 1u);
    return b;
}
__device__ __forceinline__ void xcd_barrier_complete(unsigned* bar, unsigned x, unsigned& nloc, unsigned& nx) {
    const unsigned G = gridDim.x * gridDim.y * gridDim.z;
    unsigned sum, cnt, mine, sp = 0u;
    for (;;) {
        sum = 0u; cnt = 0u; mine = 0u;
#pragma unroll
        for (unsigned j = 0; j < 16; ++j) { const unsigned c = xb_ld(&bar[XB_XCNT(j)]); sum += c; cnt += (c > 0u) ? 1u : 0u; mine = (j == x) ? c : mine; }
        if (sum == G) break;
        __builtin_amdgcn_s_sleep(1);
        if ((++sp & 255u) == 0u) { if (xb_ld(&bar[XB_TMO])) break; if (sp > XB_SPIN_CAP) { atomicAdd(&bar[XB_TMO], 1u); break; } }
    }
    nloc = mine > 0u ? mine : 1u; nx = cnt > 0u ? cnt : 1u;
}
__device__ __forceinline__ void xcd_barrier(const XcdBarrier& b) {
    asm volatile("s_waitcnt vmcnt(0)" ::: "memory");
    __syncthreads();
    if (threadIdx.x == 0) {
        unsigned* bar = b.bar;
        __builtin_amdgcn_s_waitcnt(0);
        unsigned nloc = b.st[0], nx = b.st[1];
        if (nloc == 0u) { xcd_barrier_complete(bar, b.x, nloc, nx); b.st[0] = nloc; b.st[1] = nx; }
        const unsigned old = xb_add(&bar[XB_XSUB(b.x)], 1u);
        const unsigned gen = old / nloc;
        if (old + 1u == (gen + 1u) * nloc) {
            __builtin_amdgcn_fence(__ATOMIC_RELEASE, "agent");
            asm volatile("s_waitcnt vmcnt(0)" ::: "memory");
            const unsigned og = xb_add(&bar[XB_TOP], 1u);
            const unsigned tg = og / nx;
            if (og + 1u == (tg + 1u) * nx) xb_add(&bar[XB_TOPGEN], 1u);
            else XB_SPIN(xb_ld(&bar[XB_TOPGEN]) == tg, bar);
            __builtin_amdgcn_fence(__ATOMIC_ACQUIRE, "agent");
            xb_add(&bar[XB_XGEN(b.x)], 1u);
            asm volatile("s_waitcnt vmcnt(0)" ::: "memory");
        } else {
            XB_SPIN(xb_ld(&bar[XB_XGEN(b.x)]) == gen, bar);
            __builtin_amdgcn_fence(__ATOMIC_ACQUIRE, "agent");
            asm volatile("s_waitcnt vmcnt(0)" ::: "memory");
        }
    }
    __syncthreads();
}

namespace pg8 {
constexpr int BM = 256, BK = 64, HALF = 128, HTB = HALF * BK * 2, STAGE_BYTES = 8 * HTB, NXCD = 8, WGM = 8;
__host__ __device__ __forceinline__ int lds_byte(int r, int c) { const int st = (r >> 4) * 2 + (c >> 5), rr = r & 15, cc = c & 31, ob = rr * 64 + cc * 2; return st * 1024 + (ob ^ (((ob >> 9) & 1) << 5)); }
__host__ __device__ __forceinline__ void stage_rc(int b, int& R, int& C) { const int st = b / 1024, sb = b % 1024, swz = sb ^ (((sb >> 9) & 1) << 5); R = (st >> 1) * 16 + swz / 64; C = (st & 1) * 32 + (swz % 64) / 2; }
__host__ __device__ __forceinline__ int perm32(int rho) { const int n = rho >> 4, i = rho & 15; return 8 * (i >> 2) + 4 * n + (i & 3); }

struct Unit { const char* A; const char* B; int pm, pn, e, rt; };

__device__ __forceinline__ void static_tile(int L, int nM, int nN, int& pm, int& pn) {
    const int nwg = nM * nN; int wgid = L;
    { const int q = nwg / NXCD, r = nwg % NXCD, xcd = wgid % NXCD, off = wgid / NXCD; wgid = (xcd < r ? xcd * (q + 1) : r * (q + 1) + (xcd - r) * q) + off; }
    const int nig = WGM * nN, gid = wgid / nig, fm = gid * WGM, gsz = (nM - fm) < WGM ? (nM - fm) : WGM;
    pm = fm + ((wgid % nig) % gsz); pn = (wgid % nig) / gsz;
}

typedef int v4i_t __attribute__((ext_vector_type(4)));
typedef int v8i_t __attribute__((ext_vector_type(8)));
template <bool FP8, class Epi, class Sched>
__device__ __forceinline__ void gemm_phase(LAS unsigned char* lds, const int Kb, const Sched& S, const Epi& E) {
    const int tid = threadIdx.x, wid = __builtin_amdgcn_readfirstlane(tid >> 6), lane = tid & 63, wr = wid >> 2, wc = wid & 3, fr = lane & 15, fq = lane >> 4;
    const int nt = Kb / 128;
    int Ri[2], Ci[2]; unsigned voffB[2];
#pragma unroll
    for (int i = 0; i < 2; ++i) { int R, C; stage_rc(tid * 16 + i * 8192, R, C); Ri[i] = R; Ci[i] = C; const int Rb = (R & ~31) + perm32(R & 31); voffB[i] = (unsigned)(Rb * Kb + C * 2); }
    const size_t kstep = (size_t)(BK * 2);
    const size_t hstep = (size_t)HALF * Kb;
    const unsigned ldsw = (unsigned)wid * 1024u;
    const int aoff = lds_byte(wr * 64 + fr, fq * 8), boff = lds_byte(wc * 32 + fr, fq * 8);
#define PG8_SA(b, h) (((b) * 2 + (h)) * HTB)
#define PG8_SB(b, h) ((4 + (b) * 2 + (h)) * HTB)
#define PG8_STAGE(bufoff, gbase, voff) do { _Pragma("unroll") for (int _i = 0; _i < 2; ++_i) \
        __builtin_amdgcn_global_load_lds((const unsigned*)((const char*)(gbase) + (voff)[_i]), (LAS unsigned*)(lds + (bufoff) + ldsw + _i * 8192), 16, 0, 0); } while (0)
#define PG8_LDA(dst, b, h) do { if constexpr (FP8) { _Pragma("unroll") for (int m = 0; m < 4; ++m) { dst##8[m].lo = *(const LAS v4i_t*)(lds + PG8_SA(b, h) + aoff + m * 2048); dst##8[m].hi = *(const LAS v4i_t*)(lds + PG8_SA(b, h) + aoff + m * 2048 + 1024); } } \
        else { _Pragma("unroll") for (int m = 0; m < 4; ++m) _Pragma("unroll") for (int k = 0; k < 2; ++k) dst[m][k] = *(const LAS bf16x8*)(lds + PG8_SA(b, h) + aoff + m * 2048 + k * 1024); } } while (0)
#define PG8_LDB(dst, b, h) do { if constexpr (FP8) { _Pragma("unroll") for (int n = 0; n < 2; ++n) { dst##8[n].lo = *(const LAS v4i_t*)(lds + PG8_SB(b, h) + boff + n * 2048); dst##8[n].hi = *(const LAS v4i_t*)(lds + PG8_SB(b, h) + boff + n * 2048 + 1024); } } \
        else { _Pragma("unroll") for (int n = 0; n < 2; ++n) _Pragma("unroll") for (int k = 0; k < 2; ++k) dst[n][k] = *(const LAS bf16x8*)(lds + PG8_SB(b, h) + boff + n * 2048 + k * 1024); } } while (0)
#define PG8_MMA(ai, bj, At, Bt) do { __builtin_amdgcn_s_setprio(1); \
        if constexpr (FP8) { _Pragma("unroll") for (int m = 0; m < 4; ++m) _Pragma("unroll") for (int n = 0; n < 2; ++n) \
            asm volatile("v_mfma_scale_f32_16x16x128_f8f6f4 %0, %1, %2, %0, %3, %3 op_sel_hi:[0,0,0]" : "+v"(acc[ai][bj][m][n]) : "v"(Bt##8[n]), "v"(At##8[m]), "v"(sc8)); } \
        else { _Pragma("unroll") for (int m = 0; m < 4; ++m) _Pragma("unroll") for (int n = 0; n < 2; ++n) _Pragma("unroll") for (int k = 0; k < 2; ++k) \
            acc[ai][bj][m][n] = __builtin_amdgcn_mfma_f32_16x16x32_bf16(Bt[n][k], At[m][k], acc[ai][bj][m][n], 0, 0, 0); } \
        __builtin_amdgcn_s_setprio(0); } while (0)
#define PG8_WAIT_V(n) asm volatile("s_waitcnt vmcnt(" #n ")" ::: "memory")
#define PG8_WAIT_L(n) asm volatile("s_waitcnt lgkmcnt(" #n ")" ::: "memory")
#define PG8_BAR __builtin_amdgcn_s_barrier()
#define PG8_SCHED __builtin_amdgcn_sched_barrier(0)
    Unit cur, nxt; int ui = 0;
    if (!S.next(0, cur)) return;
    unsigned vc[2][2], vn[2][2];
    int pfa = -1; float pfw = 0.f;
    S.pf_issue(cur, pfa, pfw); S.pf_commit(0, pfa, pfw);
    asm volatile("s_waitcnt vmcnt(0) lgkmcnt(0)" ::: "memory"); PG8_BAR; asm volatile("" ::: "memory");
    S.rowoffs(cur, 0, vc, Ri, Ci);
    f32x4 acc[2][2][4][2];
#pragma unroll
    for (int a = 0; a < 2; ++a)
#pragma unroll
        for (int b = 0; b < 2; ++b)
#pragma unroll
            for (int m = 0; m < 4; ++m)
#pragma unroll
                for (int n = 0; n < 2; ++n) acc[a][b][m][n] = (f32x4){0.f, 0.f, 0.f, 0.f};
    const int sc8 = 0x7f7f7f7f;
    bf16x8 At[4][2], B0[2][2], B1[2][2]; v8i_t At8[4], B08[2], B18[2];
    const char* cA = cur.A; const char* cB = cur.B;
    PG8_STAGE(PG8_SB(0, 0), cB, voffB); PG8_STAGE(PG8_SB(0, 1), cB + hstep, voffB); PG8_STAGE(PG8_SA(0, 0), cA, vc[0]); PG8_STAGE(PG8_SA(0, 1), cA, vc[1]);
    if (wr == 1) PG8_BAR;
    PG8_WAIT_V(2); PG8_BAR;
    PG8_STAGE(PG8_SB(1, 0), cB + kstep, voffB); PG8_STAGE(PG8_SA(1, 0), cA + kstep, vc[0]); PG8_STAGE(PG8_SB(1, 1), cB + hstep + kstep, voffB);
    PG8_WAIT_V(6); PG8_BAR;
    for (;;) {
        const bool has_next = S.next(ui + 1, nxt);
        const int scur = ui % 3, snxt = (ui + 1) % 3;
        const char* nA = has_next ? nxt.A : cA; const char* nB = has_next ? nxt.B : cB;
        if (has_next) S.pf_issue(nxt, pfa, pfw);
        for (int t = 0; t < nt; t += 2) {
            const bool last = (t == nt - 2);
            if (t == (nt >= 8 ? nt - 4 : 0) && has_next) S.pf_commit(snxt, pfa, pfw);
            const char* a1 = cA + (size_t)(t + 1) * kstep;
            const char* a2 = last ? nA : cA + (size_t)(t + 2) * kstep; const char* b2 = last ? nB : cB + (size_t)(t + 2) * kstep;
            const char* a3 = a2 + kstep; const char* b3 = b2 + kstep;
            if (last) {
                if (has_next) S.rowoffs(nxt, snxt, vn, Ri, Ci);
                else { vn[0][0] = vc[0][0]; vn[0][1] = vc[0][1]; vn[1][0] = vc[1][0]; vn[1][1] = vc[1][1]; }
            }
            unsigned v2[2][2];
            v2[0][0] = last ? vn[0][0] : vc[0][0]; v2[0][1] = last ? vn[0][1] : vc[0][1]; v2[1][0] = last ? vn[1][0] : vc[1][0]; v2[1][1] = last ? vn[1][1] : vc[1][1];
            PG8_LDB(B0, 0, 0); PG8_LDB(B1, 0, 1); PG8_SCHED; PG8_LDA(At, 0, 0); PG8_STAGE(PG8_SA(1, 1), a1, vc[1]);
            PG8_WAIT_V(8); PG8_WAIT_L(0); PG8_BAR; PG8_MMA(0, 0, At, B0); PG8_MMA(0, 1, At, B1); PG8_BAR; PG8_SCHED;
            PG8_LDA(At, 0, 1); PG8_STAGE(PG8_SB(0, 0), b2, voffB); PG8_STAGE(PG8_SB(0, 1), b2 + hstep, voffB); PG8_STAGE(PG8_SA(0, 0), a2, v2[0]);
            PG8_WAIT_V(8); PG8_WAIT_L(0); PG8_BAR; PG8_MMA(1, 0, At, B0); PG8_MMA(1, 1, At, B1); PG8_BAR; PG8_SCHED;
            PG8_LDB(B0, 1, 0); PG8_LDB(B1, 1, 1); PG8_SCHED; PG8_LDA(At, 1, 0); PG8_STAGE(PG8_SA(0, 1), a2, v2[1]);
            PG8_WAIT_V(8); PG8_WAIT_L(0); PG8_BAR; PG8_MMA(0, 0, At, B0); PG8_MMA(0, 1, At, B1); PG8_BAR; PG8_SCHED;
            PG8_LDA(At, 1, 1); PG8_STAGE(PG8_SB(1, 0), b3, voffB); PG8_STAGE(PG8_SB(1, 1), b3 + hstep, voffB); PG8_STAGE(PG8_SA(1, 0), a3, v2[0]);
            PG8_WAIT_V(8); PG8_WAIT_L(0); PG8_BAR; PG8_MMA(1, 0, At, B0); PG8_MMA(1, 1, At, B1); PG8_BAR; PG8_SCHED;
        }
        if (wr == 0) PG8_BAR;
        if constexpr (FP8) {
            asm volatile("s_nop 15\n\ts_nop 15" ::: "memory");
#pragma unroll
            for (int a = 0; a < 2; ++a)
#pragma unroll
                for (int b = 0; b < 2; ++b)
#pragma unroll
                    for (int m = 0; m < 4; ++m)
#pragma unroll
                        for (int n = 0; n < 2; ++n) asm volatile("" : "+v"(acc[a][b][m][n]));
        }
        E(acc, cur, scur, wr, wc, fr, fq);
        if (!has_next) break;
#pragma unroll
        for (int a = 0; a < 2; ++a)
#pragma unroll
            for (int b = 0; b < 2; ++b)
#pragma unroll
                for (int m = 0; m < 4; ++m)
#pragma unroll
                    for (int n = 0; n < 2; ++n) acc[a][b][m][n] = (f32x4){0.f, 0.f, 0.f, 0.f};
        cur = nxt; cA = nA; cB = nB; ++ui;
        vc[0][0] = vn[0][0]; vc[0][1] = vn[0][1]; vc[1][0] = vn[1][0]; vc[1][1] = vn[1][1];
        if (wr == 1) PG8_BAR;
    }
    PG8_WAIT_V(0);
    PG8_BAR;
#undef PG8_SA
#undef PG8_SB
#undef PG8_STAGE
#undef PG8_LDA
#undef PG8_LDB
#undef PG8_MMA
#undef PG8_WAIT_V
#undef PG8_WAIT_L
#undef PG8_BAR
#undef PG8_SCHED
}
}
using pg8::Unit;

struct Args { const float* in[18]; float* out; unsigned char* ws; int ph_lo, ph_hi; };
struct Frame {
    LAS unsigned char* lds; volatile LAS unsigned* MISC; unsigned* ctl; unsigned char* ws;
    int tid, lane, wave, vcu, G;
};

struct DenseSched {
    const char* A; const char* Bt; int nM, nN, K, G, c, dup;
    __device__ __forceinline__ bool next(int i, Unit& u) const {
        int L = i * G + c; if (L >= nM * nN * dup) return false; if (L >= nM * nN) L -= nM * nN;
        int pm, pn; pg8::static_tile(L, nM, nN, pm, pn);
        u.pm = pm; u.pn = pn; u.e = 0; u.rt = 0; u.A = A + (size_t)pm * 256 * K * 2; u.B = Bt + (size_t)pn * 256 * K * 2; return true;
    }
    __device__ __forceinline__ void pf_issue(const Unit&, int&, float&) const {}
    __device__ __forceinline__ void pf_commit(int, int, float) const {}
    __device__ __forceinline__ void rowoffs(const Unit&, int, unsigned (&vo)[2][2], const int (&R)[2], const int (&C)[2]) const {
#pragma unroll
        for (int h = 0; h < 2; ++h)
#pragma unroll
            for (int i = 0; i < 2; ++i) vo[h][i] = (unsigned)((R[i] + 128 * h) * K + C[i]) * 2u;
    }
};
struct BranchSched {
    const char* A0; const char* A1; const char* B0; const char* B1; int nM, nN, K, G, c, dup;
    __device__ __forceinline__ bool next(int i, Unit& u) const {
        int L = (i >> 1) * G + c; if (L >= nM * nN * dup) return false; if (L >= nM * nN) L -= nM * nN;
        int pm, pn; pg8::static_tile(L, nM, nN, pm, pn);
        const int br = i & 1;
        u.pm = pm; u.pn = pn; u.e = br; u.rt = 0; u.A = (br ? A1 : A0) + (size_t)pm * 256 * K * 2; u.B = (br ? B1 : B0) + (size_t)pn * 256 * K * 2; return true;
    }
    __device__ __forceinline__ void pf_issue(const Unit&, int&, float&) const {}
    __device__ __forceinline__ void pf_commit(int, int, float) const {}
    __device__ __forceinline__ void rowoffs(const Unit&, int, unsigned (&vo)[2][2], const int (&R)[2], const int (&C)[2]) const {
#pragma unroll
        for (int h = 0; h < 2; ++h)
#pragma unroll
            for (int i = 0; i < 2; ++i) vo[h][i] = (unsigned)((R[i] + 128 * h) * K + C[i]) * 2u;
    }
};
template <int MODE> struct MoeSched {
    const LAS int* tab; const int* list; const float* listw; const char* A; const char* Bt; LAS int* rowA; LAS float* rowW; int total, G, vcu, dup;
    static constexpr int MULT = MODE == 0 ? 4 : 8, KB = MODE == 0 ? 2048 : 512  , NCOLS = MODE == 0 ? 1024 : 2048;
    __device__ __forceinline__ bool next(int i, Unit& u) const {
        int L = i * G + vcu; if (L >= total * dup) return false; if (L >= total) L -= total;
        int e, j, nrt;
        if (L < 32 * MULT) { e = 64; j = L; nrt = 32; }
        else {
            const int Lr = L - 32 * MULT; const int lane = threadIdx.x & 63;
            const int pin = tab[lane];
            const unsigned long long bal = __ballot(pin <= Lr);
            e = __builtin_popcountll(bal); e = e > 63 ? 63 : e;
            const int pex = e > 0 ? tab[e - 1] : 0; const int cnt = tab[64 + e];
            j = Lr - pex; nrt = (cnt + 255) >> 8; nrt = nrt < 1 ? 1 : nrt;
        }
        e = __builtin_amdgcn_readfirstlane(e); j = __builtin_amdgcn_readfirstlane(j); nrt = __builtin_amdgcn_readfirstlane(nrt);
        u.e = e; u.rt = j % nrt; u.pn = j / nrt; u.pm = 0;
        u.A = A; u.B = Bt + ((size_t)e * NCOLS + (size_t)u.pn * 256) * KB; return true;
    }
    __device__ __forceinline__ void pf_issue(const Unit& u, int& pa, float& pw) const {
        const int tid = threadIdx.x; pa = -1; pw = 0.f;
        if (tid < 256) { const int idx = u.rt * 256 + tid;
            if (u.e == 64) { pa = NASSIGN + idx; pw = 1.f; }
            else if (idx < tab[64 + u.e]) { pa = list[u.e * T + idx]; if (MODE == 1) pw = listw[u.e * T + idx]; } }
    }
    __device__ __forceinline__ void pf_commit(int s, int pa, float pw) const { const int tid = threadIdx.x; if (tid < 256) { rowA[s * 256 + tid] = pa; rowW[s * 256 + tid] = pw; } }
    __device__ __forceinline__ void rowoffs(const Unit& u, int s, unsigned (&vo)[2][2], const int (&R)[2], const int (&C)[2]) const {
#pragma unroll
        for (int h = 0; h < 2; ++h)
#pragma unroll
            for (int i = 0; i < 2; ++i) {
                int a = rowA[s * 256 + R[i] + 128 * h];
                unsigned row;
                if (MODE == 0) { a = a < 0 ? 0 : a; row = a < NASSIGN ? (unsigned)(a >> 3) : (unsigned)(a - NASSIGN); }
                else row = a < 0 ? 0u : (unsigned)a;
                vo[h][i] = row * (unsigned)KB + (unsigned)C[i] * 2u;
            }
    }
};

struct EpiZ {
    bf16_t* Z; float* FL; const float* fbias;
    __device__ __forceinline__ void operator()(const f32x4 (&acc)[2][2][4][2], const Unit& u, int slot, int wr, int wc, int fr, int fq) const {
        const int row0 = u.pm * 256 + wr * 64 + fr;
        if (u.pn == 34) {
            if (wc == 0 && fq < 2) {
                float fb[8];
#pragma unroll
                for (int j = 0; j < 8; ++j) fb[j] = fbias[8 * fq + j];
#pragma unroll
                for (int ai = 0; ai < 2; ++ai)
#pragma unroll
                    for (int m = 0; m < 4; ++m) {
                        float* o = FL + (size_t)(row0 + ai * 128 + m * 16) * 16 + 8 * fq;
#pragma unroll
                        for (int n = 0; n < 2; ++n) { f32x4 r;
#pragma unroll
                            for (int j = 0; j < 4; ++j) { const float x = acc[ai][0][m][n][j] + fb[4 * n + j]; const float ls = x >= 0.f ? -log1pf(expf(-x)) : x - log1pf(expf(x)); r[j] = ls * LOG2E; }
                            *(f32x4*)(o + 4 * n) = r; }
                    }
            }
            return;
        }
        const int mode = (u.pn < 4 || (u.pn >= 6 && u.pn < 10)) ? 1 : (u.pn >= 18 ? 2 : 0);
        const int col0 = u.pn * 256 + wc * 32 + 8 * fq;
#pragma unroll
        for (int ai = 0; ai < 2; ++ai)
#pragma unroll
            for (int m = 0; m < 4; ++m) { bf16_t* rowp = Z + (size_t)(row0 + ai * 128 + m * 16) * ZP + col0;
#pragma unroll
                for (int bj = 0; bj < 2; ++bj) { f32x4 v0 = acc[ai][bj][m][0], v1 = acc[ai][bj][m][1];
                    if (mode == 1) { v0 = v0 * QSCALE; v1 = v1 * QSCALE; }
                    else if (mode == 2) {
#pragma unroll
                        for (int j = 0; j < 4; ++j) { v0[j] = sigmoidf_(v0[j]); v1[j] = sigmoidf_(v1[j]); } }
                    u32x4 w; w.x = cvtpk(v0[0], v0[1]); w.y = cvtpk(v0[2], v0[3]); w.z = cvtpk(v1[0], v1[1]); w.w = cvtpk(v1[2], v1[3]);
                    *(u32x4*)(rowp + bj * 128) = w; } }
    }
};
struct EpiMix {
    const bf16_t* Z; bf16_t* MIX;
    __device__ __forceinline__ void operator()(const f32x4 (&acc)[2][2][4][2], const Unit& u, int slot, int wr, int wc, int fr, int fq) const {
        const int row0 = u.pm * 256 + wr * 64 + fr, col0 = u.pn * 256 + wc * 32 + 8 * fq;
        const int gcol = (u.e ? ZGF : ZGS) + col0;
#pragma unroll
        for (int ai = 0; ai < 2; ++ai)
#pragma unroll
            for (int m = 0; m < 4; ++m) { const size_t row = (size_t)(row0 + ai * 128 + m * 16);
#pragma unroll
                for (int bj = 0; bj < 2; ++bj) {
                    const u32x4 g = *(const u32x4*)(Z + row * ZP + gcol + bj * 128);
                    f32x4 v0 = acc[ai][bj][m][0], v1 = acc[ai][bj][m][1];
                    v0[0] *= bflo(g.x); v0[1] *= bfhi(g.x); v0[2] *= bflo(g.y); v0[3] *= bfhi(g.y);
                    v1[0] *= bflo(g.z); v1[1] *= bfhi(g.z); v1[2] *= bflo(g.w); v1[3] *= bfhi(g.w);
                    u32x4* mp = (u32x4*)(MIX + row * D + col0 + bj * 128);
                    if (u.e != 0) { const u32x4 t = *mp;
                        v0[0] += bflo(t.x); v0[1] += bfhi(t.x); v0[2] += bflo(t.y); v0[3] += bfhi(t.y);
                        v1[0] += bflo(t.z); v1[1] += bfhi(t.z); v1[2] += bflo(t.w); v1[3] += bfhi(t.w); }
                    u32x4 w; w.x = cvtpk(v0[0], v0[1]); w.y = cvtpk(v0[2], v0[3]); w.z = cvtpk(v1[0], v1[1]); w.w = cvtpk(v1[2], v1[3]);
                    *mp = w; } }
    }
};
struct EpiOut {
    const float* X; float* H1; float* PSQ;
    __device__ __forceinline__ void operator()(const f32x4 (&acc)[2][2][4][2], const Unit& u, int slot, int wr, int wc, int fr, int fq) const {
        const int row0 = u.pm * 256 + wr * 64 + fr, col0 = u.pn * 256 + wc * 32 + 8 * fq;
#pragma unroll
        for (int ai = 0; ai < 2; ++ai)
#pragma unroll
            for (int m = 0; m < 4; ++m) { const size_t row = (size_t)(row0 + ai * 128 + m * 16); float sq = 0.f;
#pragma unroll
                for (int bj = 0; bj < 2; ++bj) {
                    const float* xp = X + row * D + col0 + bj * 128; float* hp = H1 + row * D + col0 + bj * 128;
                    const f32x4 x0 = *(const f32x4*)xp, x1 = *(const f32x4*)(xp + 4);
                    const f32x4 h0 = acc[ai][bj][m][0] + x0, h1 = acc[ai][bj][m][1] + x1;
                    *(f32x4*)hp = h0; *(f32x4*)(hp + 4) = h1;
                    sq += (h0[0] * h0[0] + h0[1] * h0[1]) + (h0[2] * h0[2] + h0[3] * h0[3]) + (h1[0] * h1[0] + h1[1] * h1[1]) + (h1[2] * h1[2] + h1[3] * h1[3]); }
                sq += __shfl_xor(sq, 16); sq += __shfl_xor(sq, 32);
                if (fq == 0) PSQ[row * 32 + u.pn * 4 + wc] = sq; }
    }
};
__device__ __forceinline__ unsigned pk_fp8x4(float a, float b, float c, float d) {
    a = __builtin_amdgcn_fmed3f(a, -448.f, 448.f); b = __builtin_amdgcn_fmed3f(b, -448.f, 448.f); c = __builtin_amdgcn_fmed3f(c, -448.f, 448.f); d = __builtin_amdgcn_fmed3f(d, -448.f, 448.f);
    int r = __builtin_amdgcn_cvt_pk_fp8_f32(a, b, 0, false); r = __builtin_amdgcn_cvt_pk_fp8_f32(c, d, r, true); return (unsigned)r;
}
constexpr float WGU_SCALE = 32.f, WD_SCALE = 16.f;
struct EpiSwiglu {
    const MoeSched<0>* S; unsigned char* HB8;
    __device__ __forceinline__ void operator()(const f32x4 (&acc)[2][2][4][2], const Unit& u, int slot, int wr, int wc, int fr, int fq) const {
        const int ff0 = u.pn * 128 + wc * 32 + 8 * fq;
#pragma unroll
        for (int ai = 0; ai < 2; ++ai)
#pragma unroll
            for (int m = 0; m < 4; ++m) { const int a = S->rowA[slot * 256 + ai * 128 + wr * 64 + m * 16 + fr];
                if (a >= 0) { float h[8];
#pragma unroll
                    for (int n = 0; n < 2; ++n)
#pragma unroll
                        for (int j = 0; j < 4; ++j) { const float g = acc[ai][0][m][n][j] * (1.f / WGU_SCALE), up = acc[ai][1][m][n][j] * (1.f / WGU_SCALE); h[4 * n + j] = g * sigmoidf_(g) * up; }
                    u32x2 w; w.x = pk_fp8x4(h[0], h[1], h[2], h[3]); w.y = pk_fp8x4(h[4], h[5], h[6], h[7]);
                    *(u32x2*)(HB8 + (size_t)a * FF + ff0) = w; } }
    }
};
struct EpiDown {
    const MoeSched<1>* S; bf16_t* YB;
    __device__ __forceinline__ void operator()(const f32x4 (&acc)[2][2][4][2], const Unit& u, int slot, int wr, int wc, int fr, int fq) const {
        const int col0 = u.pn * 256 + wc * 32 + 8 * fq;
#pragma unroll
        for (int ai = 0; ai < 2; ++ai)
#pragma unroll
            for (int m = 0; m < 4; ++m) { const int ri = slot * 256 + ai * 128 + wr * 64 + m * 16 + fr; const int a = S->rowA[ri];
                if (a >= 0) { const float w8 = S->rowW[ri] * (1.f / WD_SCALE);
#pragma unroll
                    for (int bj = 0; bj < 2; ++bj) { const f32x4 v0 = acc[ai][bj][m][0] * w8, v1 = acc[ai][bj][m][1] * w8;
                        u32x4 w; w.x = cvtpk(v0[0], v0[1]); w.y = cvtpk(v0[2], v0[3]); w.z = cvtpk(v1[0], v1[1]); w.w = cvtpk(v1[2], v1[3]);
                        *(u32x4*)(YB + (size_t)a * D + col0 + bj * 128) = w; } } }
    }
};

struct P0Item { const float* src; unsigned char* dst; int ldw, nvalid, K, fp8; float scale; };
__device__ __forceinline__ P0Item p0_decode(int pr, int half, const Args& a, unsigned char* ws) {
    constexpr int P_IN = 16 * 140, P_SW = 8 * 32, P_OUT = 16 * 32, P_GU = 16 * 8, P_DN = 4 * 32, P_EXP = 2 * P_GU + P_DN;
    P0Item q; q.fp8 = 0; q.scale = 1.f; int r = pr;
    if (r < P_IN) { const int kb = 2 * (r / 140) + half, nb = r % 140, n0 = nb * 64;
        int c0, nv; if (n0 < 4608) { c0 = n0; nv = 64; } else if (n0 < 8704) { c0 = n0 + 16; nv = 64; } else if (n0 == 8704) { c0 = 4608; nv = 16; } else { c0 = 0; nv = 0; }
        q.src = a.in[2] + (size_t)kb * 64 * 8720 + c0; q.ldw = 8720; q.nvalid = nv; q.K = D; q.dst = ws + WS_WINT + ((size_t)n0 * D + kb * 64) * 2; return q; }
    r -= P_IN;
    if (r < P_SW) { const int kb = 2 * (r / 32) + half, nb = r % 32; q.src = a.in[5] + (size_t)kb * 64 * D + nb * 64; q.ldw = D; q.nvalid = 64; q.K = 1024; q.dst = ws + WS_WSWAT + ((size_t)nb * 64 * 1024 + kb * 64) * 2; return q; }
    r -= P_SW;
    if (r < P_SW) { const int kb = 2 * (r / 32) + half, nb = r % 32; q.src = a.in[6] + (size_t)kb * 64 * D + nb * 64; q.ldw = D; q.nvalid = 64; q.K = 1024; q.dst = ws + WS_WFOXT + ((size_t)nb * 64 * 1024 + kb * 64) * 2; return q; }
    r -= P_SW;
    if (r < P_OUT) { const int kb = 2 * (r / 32) + half, nb = r % 32; q.src = a.in[7] + (size_t)kb * 64 * D + nb * 64; q.ldw = D; q.nvalid = 64; q.K = D; q.dst = ws + WS_WOUTT + ((size_t)nb * 64 * D + kb * 64) * 2; return q; }
    r -= P_OUT;
    const int e = r / P_EXP; r -= e * P_EXP; q.fp8 = 1;
    if (r < 2 * P_GU) { const int up = r >= P_GU; r -= up * P_GU; const int kb = 2 * (r / 8) + half, nb = r % 8, n0 = nb * 64;
        const float* src = e < 64 ? (up ? a.in[12] : a.in[11]) + (size_t)e * D * FF : (up ? a.in[15] : a.in[14]);
        const int drow = 256 * (n0 >> 7) + (n0 & 127) + 128 * up;
        q.src = src + (size_t)kb * 64 * FF + n0; q.ldw = FF; q.nvalid = 64; q.K = D; q.scale = WGU_SCALE; q.dst = ws + WS_WGU + ((size_t)e * 1024 + drow) * D + kb * 64; return q; }
    r -= 2 * P_GU;
    { const int kb = 2 * (r / 32) + half, nb = r % 32;
        const float* src = e < 64 ? a.in[13] + (size_t)e * FF * D : a.in[16];
        q.src = src + (size_t)kb * 64 * D + nb * 64; q.ldw = D; q.nvalid = 64; q.K = FF; q.scale = WD_SCALE; q.dst = ws + WS_WD + ((size_t)e * D + nb * 64) * FF + kb * 64; return q; }
}
__device__ __forceinline__ void p0_load(const P0Item& q, f32x4 (&v)[16], int lane) {
    const int kr = lane >> 4, nc = (lane & 15) * 4; const bool ok = nc < q.nvalid;
    const float* p = q.src + (size_t)kr * q.ldw + nc;
#pragma unroll
    for (int i = 0; i < 16; ++i) v[i] = ok ? *(const f32x4*)(p + (size_t)(4 * i) * q.ldw) : (f32x4){0.f, 0.f, 0.f, 0.f};
}
__device__ __forceinline__ void p0_process(const P0Item& q, const f32x4 (&v)[16], LAS float* scr, int lane) {
    const int kr = lane >> 4, nc = (lane & 15) * 4;
#pragma unroll
    for (int i = 0; i < 16; ++i) { LAS float* w = scr + (4 * i + kr) * 65 + nc; w[0] = v[i][0]; w[1] = v[i][1]; w[2] = v[i][2]; w[3] = v[i][3]; }
    LDS_WAIT(); asm volatile("" ::: "memory");
    if (q.fp8) {
        const int c = lane & 3; const float sc = q.scale;
#pragma unroll
        for (int j = 0; j < 4; ++j) { const int n = (lane >> 2) + 16 * j; const LAS float* s = scr + (16 * c) * 65 + n;
            u32x4 o; o.x = pk_fp8x4(s[0 * 65] * sc, s[1 * 65] * sc, s[2 * 65] * sc, s[3 * 65] * sc); o.y = pk_fp8x4(s[4 * 65] * sc, s[5 * 65] * sc, s[6 * 65] * sc, s[7 * 65] * sc);
            o.z = pk_fp8x4(s[8 * 65] * sc, s[9 * 65] * sc, s[10 * 65] * sc, s[11 * 65] * sc); o.w = pk_fp8x4(s[12 * 65] * sc, s[13 * 65] * sc, s[14 * 65] * sc, s[15 * 65] * sc);
            *(u32x4*)(q.dst + (size_t)n * q.K + 16 * c) = o; }
    } else {
        const int c = lane & 7;
#pragma unroll
        for (int j = 0; j < 8; ++j) { const int n = (lane >> 3) + 8 * j; const LAS float* s = scr + (8 * c) * 65 + n;
            u32x4 o; o.x = cvtpk(s[0 * 65], s[1 * 65]); o.y = cvtpk(s[2 * 65], s[3 * 65]); o.z = cvtpk(s[4 * 65], s[5 * 65]); o.w = cvtpk(s[6 * 65], s[7 * 65]);
            *(u32x4*)(q.dst + ((size_t)n * q.K + 8 * c) * 2) = o; }
    }
    LDS_WAIT(); asm volatile("" ::: "memory");
}
__device__ __forceinline__ void p0_prologue(Frame& F, const Args& a) {
    LAS float* scr = (LAS float*)(F.lds + F.wave * 16640);
    const int gw = F.vcu * NWAVES + F.wave, NGW = F.G * NWAVES;
    unsigned char* ws = F.ws;
    {
        const float* g = a.in[1];
        for (int m = gw; m < T; m += NGW) {
            const f32x4* xr = (const f32x4*)(a.in[0] + (size_t)m * D) + F.lane;
            f32x4 v[8]; float s = 0.f;
#pragma unroll
            for (int j = 0; j < 8; ++j) { v[j] = xr[64 * j]; s += (v[j].x * v[j].x + v[j].y * v[j].y) + (v[j].z * v[j].z + v[j].w * v[j].w); }
            const float rinv = rsqrtf(wave_sum(s) * (1.f / D) + RMS_EPS);
            u32x2* o = (u32x2*)((bf16_t*)(ws + WS_U) + (size_t)m * D) + F.lane;
#pragma unroll
            for (int j = 0; j < 8; ++j) { const f32x4 gg = *((const f32x4*)g + F.lane + 64 * j); u32x2 w; w.x = cvtpk(v[j].x * rinv * gg.x, v[j].y * rinv * gg.y); w.y = cvtpk(v[j].z * rinv * gg.z, v[j].w * rinv * gg.w); o[64 * j] = w; }
        }
    }
    {
        const float* wr = a.in[9]; const float* g = a.in[8]; float* o = (float*)(ws + WS_WRG);
        for (int i = gw * 64 + F.lane; i < D * NE; i += NGW * 64) o[i] = wr[i] * g[i >> 6];
    }
    constexpr int NPAIRS = 16 * 140 + 2 * 8 * 32 + 16 * 32 + 65 * (2 * 16 * 8 + 4 * 32);
    f32x4 va[16], vb[16]; P0Item qa, qb;
    int pr = gw;
    if (pr < NPAIRS) { qa = p0_decode(pr, 0, a, ws); p0_load(qa, va, F.lane); }
    while (pr < NPAIRS) {
        qb = p0_decode(pr, 1, a, ws); p0_load(qb, vb, F.lane);
        p0_process(qa, va, scr, F.lane);
        const int pn = pr + NGW;
        if (pn < NPAIRS) { qa = p0_decode(pn, 0, a, ws); p0_load(qa, va, F.lane); }
        p0_process(qb, vb, scr, F.lane);
        pr = pn;
    }
}

__device__ __forceinline__ int crow(int r, int hi) { return (r & 3) + 8 * (r >> 2) + 4 * hi; }
__device__ __forceinline__ s16x4 vtr(LAS const char* p) { typedef short v4i16_t __attribute__((ext_vector_type(4))); return __builtin_bit_cast(s16x4, __builtin_amdgcn_ds_read_tr16_b64_v4i16((LAS v4i16_t*)p)); }

__device__ __forceinline__ void attn_qk(f32x16 (&p)[2], const bf16x8 (&qf)[4], LAS const char* Kt, int r32, int hi) {
#pragma unroll
    for (int kb = 0; kb < 2; ++kb) { const int kv = 32 * kb + r32; const int sw = (kv >> 1) & 7; LAS const char* rowp = Kt + kv * 128;
        f32x16 c = {};
#pragma unroll
        for (int s = 0; s < 4; ++s) { const bf16x8 a = *(const LAS bf16x8*)(rowp + (((2 * s + hi) ^ sw) * 16)); c = __builtin_amdgcn_mfma_f32_32x32x16_bf16(a, qf[s], c, 0, 0, 0); }
        p[kb] = c; }
}
__device__ __forceinline__ void attn_softmax_pv(f32x16 (&p)[2], f32x16 (&o)[2], float& m, float& l, LAS const char* Vt, int lane) {
    float mx = p[0][0];
#pragma unroll
    for (int kb = 0; kb < 2; ++kb)
#pragma unroll
        for (int r = 0; r < 16; ++r) mx = fmaxf(mx, p[kb][r]);
    mx = fmaxf(mx, __shfl_xor(mx, 32));
    const float mn = fmaxf(m, mx);
    const float alpha = __builtin_amdgcn_exp2f(m - mn);
    float rs = 0.f;
#pragma unroll
    for (int kb = 0; kb < 2; ++kb)
#pragma unroll
        for (int r = 0; r < 16; ++r) { const float e = __builtin_amdgcn_exp2f(p[kb][r] - mn); p[kb][r] = e; rs += e; }
    rs += __shfl_xor(rs, 32);
    l = l * alpha + rs; m = mn;
#pragma unroll
    for (int db = 0; db < 2; ++db)
#pragma unroll
        for (int r = 0; r < 16; ++r) o[db][r] *= alpha;
    const int g = lane >> 4, i = lane & 15;
    LAS const char* vb = Vt + (4 * (g >> 1) + (i >> 2)) * 64 + (g & 1) * 32 + (i & 3) * 8;
#pragma unroll
    for (int kb = 0; kb < 2; ++kb)
#pragma unroll
        for (int ks = 0; ks < 2; ++ks) {
            u32x4 pw; pw.x = cvtpk(p[kb][8 * ks + 0], p[kb][8 * ks + 1]); pw.y = cvtpk(p[kb][8 * ks + 2], p[kb][8 * ks + 3]); pw.z = cvtpk(p[kb][8 * ks + 4], p[kb][8 * ks + 5]); pw.w = cvtpk(p[kb][8 * ks + 6], p[kb][8 * ks + 7]);
            const bf16x8 pb = __builtin_bit_cast(bf16x8, pw);
#pragma unroll
            for (int db = 0; db < 2; ++db) {
                const s16x4 lo = vtr(vb + db * 4096 + (32 * kb + 16 * ks) * 64), hi4 = vtr(vb + db * 4096 + (32 * kb + 16 * ks + 8) * 64);
                const bf16x8 va = (bf16x8){lo[0], lo[1], lo[2], lo[3], hi4[0], hi4[1], hi4[2], hi4[3]};
                o[db] = __builtin_amdgcn_mfma_f32_32x32x16_bf16(va, pb, o[db], 0, 0, 0); } }
}
__device__ __forceinline__ void attn_store_kv(LAS char* Kt, LAS char* Vt, const u32x4& kr, const u32x4& vr, int tid) {
    const int kv = tid >> 3, c = tid & 7;
    *(LAS u32x4*)(Kt + kv * 128 + ((c ^ ((kv >> 1) & 7)) * 16)) = kr;
    *(LAS u32x4*)(Vt + (c >> 2) * 4096 + kv * 64 + (c & 3) * 16) = vr;
}
__device__ __forceinline__ void attn_store_o(const f32x16 (&o)[2], float l, bf16_t* orow, int hi) {
    const float rl = 1.0f / l;
#pragma unroll
    for (int db = 0; db < 2; ++db)
#pragma unroll
        for (int rq = 0; rq < 4; ++rq) { u32x2 w; w.x = cvtpk(o[db][4 * rq] * rl, o[db][4 * rq + 1] * rl); w.y = cvtpk(o[db][4 * rq + 2] * rl, o[db][4 * rq + 3] * rl);
            *(u32x2*)(orow + 32 * db + 8 * rq + 4 * hi) = w; }
}

__device__ __forceinline__ void swa_unit(Frame& F, int unit, const float* sinks) {
    const bf16_t* Z = (const bf16_t*)(F.ws + WS_Z); bf16_t* YS = (bf16_t*)(F.ws + WS_YS);
    const int b = unit >> 6, kvh = (unit >> 4) & 3, nb = unit & 15;
    const int tid = F.tid, lane = F.lane, r32 = lane & 31, hi = lane >> 5, w = F.wave;
    LAS char* Kl = (LAS char*)F.lds; LAS char* Vl = (LAS char*)F.lds + 32768;
    const int t0 = nb * 128;
    {
        const int kv = tid >> 3, c = tid & 7;
#pragma unroll
        for (int tl = 0; tl < 4; ++tl) {
            if (nb > 0 || tl >= 2) {
                const size_t row = (size_t)(b * SEQ + t0 - 128 + tl * 64 + kv);
                const u32x4 kr = *(const u32x4*)(Z + row * ZP + ZK + kvh * 64 + c * 8);
                const u32x4 vr = *(const u32x4*)(Z + row * ZP + ZV + kvh * 64 + c * 8);
                attn_store_kv(Kl + tl * 8192, Vl + tl * 8192, kr, vr, tid);
            }
        }
    }
    __syncthreads();
    const int qh = kvh * 4 + (w >> 1);
    const float slope2 = exp2f(-0.5f * (float)(qh + 1)) * LOG2E;
    const float sink2 = sinks[qh] * LOG2E;
#pragma unroll 1
    for (int sb = 0; sb < 2; ++sb) {
        const int r0 = 64 * (w & 1) + 32 * sb;
        const int qrel = r0 + r32;
        const size_t qrow = (size_t)(b * SEQ + t0 + qrel);
        bf16x8 qf[4];
#pragma unroll
        for (int s = 0; s < 4; ++s) qf[s] = *(const bf16x8*)(Z + qrow * ZP + ZQ + qh * 64 + 16 * s + 8 * hi);
        f32x16 o[2]; o[0] = f32x16{}; o[1] = f32x16{};
        float m = sink2, l = 1.0f;
        const int tl0 = (r0 + 1) >> 6;
#pragma unroll 1
        for (int tt = 0; tt < 3; ++tt) {
            const int tl = tl0 + tt;
            if (nb == 0 && tl < 2) continue;
            f32x16 p[2];
            attn_qk(p, qf, Kl + tl * 8192, r32, hi);
#pragma unroll
            for (int kb = 0; kb < 2; ++kb)
#pragma unroll
                for (int r = 0; r < 16; ++r) {
                    const int krel = tl * 64 + 32 * kb + crow(r, hi) - 128;
                    const int dist = qrel - krel;
                    const float s = p[kb][r] - slope2 * (float)dist;
                    p[kb][r] = (dist >= 0 && dist < 128) ? s : -INFINITY;
                }
            attn_softmax_pv(p, o, m, l, Vl + tl * 8192, lane);
        }
        attn_store_o(o, l, YS + qrow * 1024 + qh * 64, hi);
    }
    __syncthreads();
}

__device__ __forceinline__ void fox_unit(Frame& F, int bh, int qb, LAS const float* c2) {
    const bf16_t* Z = (const bf16_t*)(F.ws + WS_Z); bf16_t* YF = (bf16_t*)(F.ws + WS_YF);
    const int b = bh >> 4, h = bh & 15;
    const int tid = F.tid, lane = F.lane, r32 = lane & 31, hi = lane >> 5, w = F.wave;
    LAS char* Kl = (LAS char*)F.lds; LAS char* Vl = (LAS char*)F.lds + 16384;
    const int q0 = qb * 256, qw = q0 + 32 * w, qabs = qw + r32;
    const size_t qrow = (size_t)(b * SEQ + qabs);
    const int NT = 4 * (qb + 1);
    const int kvr = tid >> 3, kc = tid & 7;
    const bf16_t* kbase = Z + (size_t)(b * SEQ + kvr) * ZP + ZFK + h * 64 + kc * 8;
    const bf16_t* vbase = Z + (size_t)(b * SEQ + kvr) * ZP + ZFV + h * 64 + kc * 8;
    u32x4 kr = *(const u32x4*)kbase, vr = *(const u32x4*)vbase;
    bf16x8 qf[4];
#pragma unroll
    for (int s = 0; s < 4; ++s) qf[s] = *(const bf16x8*)(Z + qrow * ZP + ZFQ + h * 64 + 16 * s + 8 * hi);
    attn_store_kv(Kl, Vl, kr, vr, tid);
    __syncthreads();
    f32x16 o[2]; o[0] = f32x16{}; o[1] = f32x16{};
    float m = -1e30f, l = 0.f;
#pragma unroll 1
    for (int t = 0; t < NT; ++t) {
        const int buf = t & 1;
        if (t + 1 < NT) { kr = *(const u32x4*)(kbase + (size_t)(t + 1) * 64 * ZP); vr = *(const u32x4*)(vbase + (size_t)(t + 1) * 64 * ZP); }
        const int k0 = t * 64;
        if (k0 <= qw + 31) {
            f32x16 p[2];
            attn_qk(p, qf, Kl + buf * 8192, r32, hi);
            const bool diag = (k0 + 63 > qw);
#pragma unroll
            for (int kb = 0; kb < 2; ++kb)
#pragma unroll
                for (int rq = 0; rq < 4; ++rq) {
                    const int kk = k0 + 32 * kb + 8 * rq + 4 * hi;
                    const f32x4 cc = *(const LAS f32x4*)(c2 + kk);
#pragma unroll
                    for (int j = 0; j < 4; ++j) { float s = p[kb][4 * rq + j] - cc[j]; if (diag && (kk + j > qabs)) s = -INFINITY; p[kb][4 * rq + j] = s; }
                }
            attn_softmax_pv(p, o, m, l, Vl + buf * 8192, lane);
        }
        if (t + 1 < NT) attn_store_kv(Kl + (buf ^ 1) * 8192, Vl + (buf ^ 1) * 8192, kr, vr, tid);
        __syncthreads();
    }
    attn_store_o(o, l, YF + qrow * 1024 + h * 64, hi);
}
__device__ __forceinline__ void p2_attention(Frame& F, const Args& a) {
    for (int u = F.vcu; u < 256; u += F.G) swa_unit(F, u, a.in[4]);
    LAS float* c2 = (LAS float*)(F.lds + 32768);
    LAS float* wtot = (LAS float*)(F.lds + 32768 + 8192);
    const float* FL = (const float*)(F.ws + WS_FL);
    for (int it = F.vcu; it < 256; it += F.G) {
        const int bh = it >> 2, s = it & 3, b = bh >> 4, h = bh & 15;
        {
            float v[4]; float run = 0.f;
#pragma unroll
            for (int j = 0; j < 4; ++j) { run += FL[(size_t)(b * SEQ + 4 * F.tid + j) * 16 + h]; v[j] = run; }
            float inc = run;
#pragma unroll
            for (int o = 1; o < 64; o <<= 1) { const float n = __shfl_up(inc, o); if (F.lane >= o) inc += n; }
            if (F.lane == 63) wtot[F.wave] = inc;
            __syncthreads();
            float base = inc - run;
            for (int ww = 0; ww < F.wave; ++ww) base += wtot[ww];
#pragma unroll
            for (int j = 0; j < 4; ++j) c2[4 * F.tid + j] = base + v[j];
            __syncthreads();
        }
        fox_unit(F, bh, s, c2);
        fox_unit(F, bh, 7 - s, c2);
        __syncthreads();
    }
}

__device__ __forceinline__ void p5_router(Frame& F, const Args& a, unsigned* CNT, float* LISTW, int* LIST) {
    const float* H1 = (const float*)(F.ws + WS_H1); const float* PSQ = (const float*)(F.ws + WS_PSQ); const float* WRG = (const float*)(F.ws + WS_WRG);
    unsigned char* V8 = F.ws + WS_V;
    const float* g = a.in[8]; const float* rbias = a.in[10];
    const int lane = F.lane, w = F.wave, tid = F.tid;
    LAS float* part = (LAS float*)F.lds;
    LAS float* logit = (LAS float*)(F.lds + 65536);
    LAS float* rinvs = (LAS float*)(F.lds + 65536 + 8192);
    LAS int* lcnt = (LAS int*)(F.lds + 65536 + 8192 + 128);
    LAS int* gbase = (LAS int*)(F.lds + 65536 + 8192 + 128 + 256);
    for (int tile = F.vcu; tile < T / 32; tile += F.G) {
        const int tok0 = tile * 32;
        if (tid < 64) lcnt[tid] = 0;
#pragma unroll 1
        for (int j = 0; j < 4; ++j) {
            const int tok = tok0 + 4 * w + j;
            float sq = lane < 32 ? PSQ[(size_t)tok * 32 + lane] : 0.f;
            sq = wave_sum(sq);
            const float rinv = rsqrtf(sq * (1.f / D) + RMS_EPS);
            if (lane == 0) rinvs[4 * w + j] = rinv;
            const f32x4* hr = (const f32x4*)(H1 + (size_t)tok * D) + lane;
            unsigned* o = (unsigned*)(V8 + (size_t)tok * D) + lane;
#pragma unroll
            for (int jj = 0; jj < 8; ++jj) { const f32x4 hv = hr[64 * jj]; const f32x4 gg = *((const f32x4*)g + lane + 64 * jj);
                o[64 * jj] = pk_fp8x4(hv.x * rinv * gg.x, hv.y * rinv * gg.y, hv.z * rinv * gg.z, hv.w * rinv * gg.w); }
        }
        {
            f32x16 acc0 = {}, acc1 = {};
            const int tk = lane & 31, half = lane >> 5;
            const float* hp = H1 + (size_t)(tok0 + tk) * D + 256 * w + 4 * half;
            const float* wp = WRG + (size_t)(256 * w + 4 * half) * NE + tk;
#pragma unroll 4
            for (int kk = 0; kk < 32; ++kk) {
                const f32x4 av = *(const f32x4*)(hp + 8 * kk);
#pragma unroll
                for (int s = 0; s < 4; ++s) {
                    const float b0 = wp[(size_t)(8 * kk + s) * NE], b1 = wp[(size_t)(8 * kk + s) * NE + 32];
                    acc0 = __builtin_amdgcn_mfma_f32_32x32x2f32(av[s], b0, acc0, 0, 0, 0);
                    acc1 = __builtin_amdgcn_mfma_f32_32x32x2f32(av[s], b1, acc1, 0, 0, 0);
                }
            }
#pragma unroll
            for (int r = 0; r < 16; ++r) { const int tr = crow(r, half); part[(w * 32 + tr) * 64 + tk] = acc0[r]; part[(w * 32 + tr) * 64 + 32 + tk] = acc1[r]; }
        }
        __syncthreads();
#pragma unroll
        for (int q = 0; q < 4; ++q) { const int idx = tid + 512 * q; float s = 0.f;
#pragma unroll
            for (int ww = 0; ww < 8; ++ww) s += part[ww * 2048 + idx];
            logit[idx] = s * rinvs[idx >> 6]; }
        __syncthreads();
        int sel_k[4], sel_ls[4]; float sel_w[4];
        const float bias = rbias[lane];
#pragma unroll
        for (int j = 0; j < 4; ++j) {
            const int tl = 4 * w + j;
            const float score = sigmoidf_(logit[tl * 64 + lane]);
            const float biased = score + bias;
            float m1 = biased; m1 = fmaxf(m1, __shfl_xor(m1, 1)); m1 = fmaxf(m1, __shfl_xor(m1, 2)); m1 = fmaxf(m1, __shfl_xor(m1, 4));
            const unsigned long long gm = 0xFFull << (lane & 56);
            const unsigned long long b1 = __ballot(biased == m1) & gm;
            const int i1 = __builtin_ctzll(b1);
            float v2 = (lane == i1) ? -INFINITY : biased;
            float m2 = v2; m2 = fmaxf(m2, __shfl_xor(m2, 1)); m2 = fmaxf(m2, __shfl_xor(m2, 2)); m2 = fmaxf(m2, __shfl_xor(m2, 4));
            const float gs = m1 + m2; const int gi = lane >> 3;
            int rank = 0;
#pragma unroll
            for (int gg = 0; gg < 8; ++gg) { const float o = __shfl(gs, 8 * gg); rank += (o > gs || (o == gs && gg < gi)) ? 1 : 0; }
            float mv = rank < 4 ? biased : -INFINITY;
            int myk = -1;
#pragma unroll
            for (int it = 0; it < 8; ++it) { const float mx = wave_max(mv); const unsigned long long bb = __ballot(mv == mx); const int sl = __builtin_ctzll(bb); if (lane == sl) { myk = it; mv = -INFINITY; } }
            const float ssum = wave_sum(myk >= 0 ? score : 0.f);
            sel_k[j] = myk; sel_w[j] = score / ssum * 2.5f;
            sel_ls[j] = 0;
            if (myk >= 0) sel_ls[j] = __hip_atomic_fetch_add((LAS int*)&lcnt[lane], 1, __ATOMIC_RELAXED, __HIP_MEMORY_SCOPE_WORKGROUP);
        }
        __syncthreads();
        if (tid < 64) gbase[tid] = (int)atomicAdd(CNT + tid, (unsigned)lcnt[tid]);
        __syncthreads();
#pragma unroll
        for (int j = 0; j < 4; ++j) if (sel_k[j] >= 0) { const int tok = tok0 + 4 * w + j; const int aid = tok * 8 + sel_k[j];
            const size_t li = (size_t)lane * T + gbase[lane] + sel_ls[j]; LIST[li] = aid; LISTW[li] = sel_w[j]; }
        __syncthreads();
    }
}

template <int MULT> __device__ __forceinline__ int moe_table(Frame& F, LAS int* tab) {
    if (F.tid < 64) {
        const int cnt = (int)__hip_atomic_load(F.ctl + CW_CNT + F.tid, __ATOMIC_RELAXED, __HIP_MEMORY_SCOPE_AGENT);
        int inc = ((cnt + 255) >> 8) * MULT;
#pragma unroll
        for (int o = 1; o < 64; o <<= 1) { const int n = __shfl_up(inc, o); if (F.lane >= o) inc += n; }
        tab[F.tid] = inc; tab[64 + F.tid] = cnt;
    }
    __syncthreads();
    return 32 * MULT + tab[63];
}

__device__ __forceinline__ void p8_final(Frame& F, const Args& a) {
    const float* H1 = (const float*)(F.ws + WS_H1); const bf16_t* YB = (const bf16_t*)(F.ws + WS_YB); const float* g = a.in[17];
    const int gw = F.vcu * NWAVES + F.wave, NGW = F.G * NWAVES;
    for (int tok = gw; tok < T; tok += NGW) {
        const f32x4* hr = (const f32x4*)(H1 + (size_t)tok * D) + F.lane;
        f32x4 v[8];
#pragma unroll
        for (int j = 0; j < 8; ++j) v[j] = hr[64 * j];
#pragma unroll 1
        for (int k = 0; k < 9; ++k) {
            const size_t row = k < 8 ? (size_t)tok * 8 + k : (size_t)NASSIGN + tok;
            const u32x2* yr = (const u32x2*)(YB + row * D) + F.lane;
#pragma unroll
            for (int j = 0; j < 8; ++j) { const u32x2 y = yr[64 * j]; v[j].x += bflo(y.x); v[j].y += bfhi(y.x); v[j].z += bflo(y.y); v[j].w += bfhi(y.y); }
        }
        float s = 0.f;
#pragma unroll
        for (int j = 0; j < 8; ++j) s += (v[j].x * v[j].x + v[j].y * v[j].y) + (v[j].z * v[j].z + v[j].w * v[j].w);
        const float rinv = rsqrtf(wave_sum(s) * (1.f / D) + RMS_EPS);
        f32x4* o = (f32x4*)(a.out + (size_t)tok * D) + F.lane;
#pragma unroll
        for (int j = 0; j < 8; ++j) { const f32x4 gg = *((const f32x4*)g + F.lane + 64 * j); o[64 * j] = (f32x4){v[j].x * rinv * gg.x, v[j].y * rinv * gg.y, v[j].z * rinv * gg.z, v[j].w * rinv * gg.w}; }
    }
}

constexpr int N_PHASES = 9;
__global__ void __launch_bounds__(NTHREADS, 2) fwd_kernel(Args args) {
    extern __shared__ __attribute__((aligned(16))) unsigned char lds_raw[];
    Frame F;
    F.lds = (LAS unsigned char*)lds_raw;
    F.MISC = (volatile LAS unsigned*)(F.lds + MISC_OFF);
    F.tid = threadIdx.x; F.lane = F.tid & 63; F.wave = __builtin_amdgcn_readfirstlane(F.tid >> 6);
    F.G = gridDim.x; { const int bx = blockIdx.x; F.vcu = (F.G % 8 == 0) ? (bx % 8) * (F.G / 8) + bx / 8 : bx; }
    F.ws = args.ws; F.ctl = (unsigned*)(args.ws + WS_CTL);
    for (int u = F.tid; u < (LDS_BYTES - MISC_OFF) / 4; u += NTHREADS) ((LAS unsigned*)(F.lds + MISC_OFF))[u] = 0u;
    __syncthreads();
    const int lo = args.ph_lo, hi = args.ph_hi;
    XcdBarrier bar; bar.bar = F.ctl + CW_BAR; bar.x = 0; bar.st = nullptr;
    if (hi - lo > 1) bar = xcd_barrier_post(F.ctl + CW_BAR, F.MISC + 8);
#define IN(k) (lo <= (k) && (k) < hi)
#define SEAM(k) do { if (IN(k) && IN((k) + 1)) xcd_barrier(bar); } while (0)
    unsigned char* ws = args.ws;
    LAS int* tab = (LAS int*)(F.lds + MISC_OFF + 256);

#define REPS(k) for (int rep_ = 0; rep_ < (PROBE_DUP == (k) ? 2 : 1); ++rep_)
#define REPBAR(k) do { if (PROBE_DUP == (k) && rep_ == 0) xcd_barrier(bar); } while (0)
    if (IN(0)) { REPS(0) { p0_prologue(F, args); REPBAR(0); } SEAM(0); }
    if (IN(1)) {
        DenseSched S{(const char*)(ws + WS_U), (const char*)(ws + WS_WINT), T / 256, NIN / 256, D, F.G, (int)blockIdx.x, PROBE_DUP == 1 ? 2 : 1};
        EpiZ E{(bf16_t*)(ws + WS_Z), (float*)(ws + WS_FL), args.in[3]};
        pg8::gemm_phase<false>(F.lds, 2 * D, S, E);
        SEAM(1);
    }
    if (IN(2)) { REPS(2) { p2_attention(F, args); REPBAR(2); } SEAM(2); }
    if (IN(3)) {
        BranchSched S{(const char*)(ws + WS_YS), (const char*)(ws + WS_YF), (const char*)(ws + WS_WSWAT), (const char*)(ws + WS_WFOXT), T / 256, D / 256, 1024, F.G, (int)blockIdx.x, PROBE_DUP == 3 ? 2 : 1};
        EpiMix E{(const bf16_t*)(ws + WS_Z), (bf16_t*)(ws + WS_MIX)};
        pg8::gemm_phase<false>(F.lds, 2 * 1024, S, E);
        SEAM(3);
    }
    if (IN(4)) {
        DenseSched S{(const char*)(ws + WS_MIX), (const char*)(ws + WS_WOUTT), T / 256, D / 256, D, F.G, (int)blockIdx.x, PROBE_DUP == 4 ? 2 : 1};
        EpiOut E{args.in[0], (float*)(ws + WS_H1), (float*)(ws + WS_PSQ)};
        pg8::gemm_phase<false>(F.lds, 2 * D, S, E);
        SEAM(4);
    }
    if (IN(5)) {
        if (PROBE_DUP == 5) { p5_router(F, args, F.ctl + 256, (float*)(ws + WS_T1), (int*)(ws + WS_T1 + 2 * MiB)); xcd_barrier(bar); }
        p5_router(F, args, F.ctl + CW_CNT, (float*)(ws + WS_LISTW), (int*)(ws + WS_LIST));
        if (PROBE_DUP == 9) { for (int q = 0; q < 16; ++q) xcd_barrier(bar); }
        SEAM(5); }
    if (IN(6)) {
        const int total = moe_table<4>(F, tab);
        MoeSched<0> S{tab, (const int*)(ws + WS_LIST), (const float*)(ws + WS_LISTW), (const char*)(ws + WS_V), (const char*)(ws + WS_WGU), (LAS int*)(F.lds + MISC_OFF + 1024), (LAS float*)(F.lds + MISC_OFF + 4096), total, F.G, F.vcu, PROBE_DUP == 6 ? 2 : 1};
        EpiSwiglu E{&S, (unsigned char*)(ws + WS_HB)};
        pg8::gemm_phase<true>(F.lds, 2048, S, E);
        SEAM(6);
    }
    if (IN(7)) {
        const int total = moe_table<8>(F, tab);
        MoeSched<1> S{tab, (const int*)(ws + WS_LIST), (const float*)(ws + WS_LISTW), (const char*)(ws + WS_HB), (const char*)(ws + WS_WD), (LAS int*)(F.lds + MISC_OFF + 1024), (LAS float*)(F.lds + MISC_OFF + 4096), total, F.G, F.vcu, PROBE_DUP == 7 ? 2 : 1};
        EpiDown E{&S, (bf16_t*)(ws + WS_YB)};
        pg8::gemm_phase<true>(F.lds, 512, S, E);
        SEAM(7);
    }
    if (IN(8)) { REPS(8) { p8_final(F, args); REPBAR(8); } }
#undef IN
#undef SEAM
}

extern "C" void kernel_launch(void* const* d_in, const int* in_sizes, int n_in, void* d_out, int out_size, void* d_ws, size_t ws_size, hipStream_t stream) {
    static int grid = 0;
    if (grid == 0) {
        if (n_in != 18 || out_size != T * D || ws_size < WS_END) { fprintf(stderr, "kernel_launch: unexpected shapes (n_in %d out %d ws %zu)\n", n_in, out_size, ws_size); grid = -1; return; }
        int dev = 0, cus = 0, per_cu = 0;
        if (hipGetDevice(&dev) != hipSuccess || hipDeviceGetAttribute(&cus, hipDeviceAttributeMultiprocessorCount, dev) != hipSuccess) { grid = -1; return; }
        if (hipFuncSetAttribute((const void*)fwd_kernel, hipFuncAttributeMaxDynamicSharedMemorySize, LDS_BYTES) != hipSuccess) { fprintf(stderr, "kernel_launch: hipFuncSetAttribute failed\n"); grid = -1; return; }
        if (hipOccupancyMaxActiveBlocksPerMultiprocessor(&per_cu, (const void*)fwd_kernel, NTHREADS, LDS_BYTES) != hipSuccess || per_cu < 1) { fprintf(stderr, "kernel_launch: occupancy query says %d blocks per CU\n", per_cu); (void)hipGetLastError(); grid = -1; return; }
        grid = cus;
        if (grid % 8 != 0 || grid > 256) grid = (grid / 8) * 8 > 256 ? 256 : (grid / 8) * 8;
    }
    if (grid <= 0) return;
    (void)hipMemsetAsync((char*)d_ws + WS_CTL, 0, CTL_ZERO_BYTES, stream);
    Args a{};
    for (int i = 0; i < 18; ++i) a.in[i] = (const float*)d_in[i];
    a.out = (float*)d_out; a.ws = (unsigned char*)d_ws;
#if MK_N_LAUNCHES == 1
    a.ph_lo = 0; a.ph_hi = N_PHASES;
    hipLaunchKernelGGL(fwd_kernel, dim3(grid), dim3(NTHREADS), LDS_BYTES, stream, a);
#else
    for (int p = 0; p < N_PHASES; ++p) { a.ph_lo = p; a.ph_hi = p + 1; hipLaunchKernelGGL(fwd_kernel, dim3(grid), dim3(NTHREADS), LDS_BYTES, stream, a); }
#endif
}
```

```cpp
#include <hip/hip_runtime.h>
#include <cstdio>
#include <cstdint>

#ifndef MK_N_LAUNCHES
#define MK_N_LAUNCHES 1
#endif
#define PROBE_DUP -1

#define LAS __attribute__((address_space(3)))
#define GAS __attribute__((address_space(1)))
typedef unsigned short bf16_t;
typedef short bf16x8 __attribute__((ext_vector_type(8)));
typedef short s16x4 __attribute__((ext_vector_type(4)));
typedef float f32x2 __attribute__((ext_vector_type(2)));
typedef float f32x4 __attribute__((ext_vector_type(4)));
typedef float f32x16 __attribute__((ext_vector_type(16)));
typedef unsigned u32x2 __attribute__((ext_vector_type(2)));
typedef unsigned u32x4 __attribute__((ext_vector_type(4)));
typedef __bf16 bf16x2_t __attribute__((ext_vector_type(2)));

constexpr int T = 8192, D = 2048, SEQ = 2048, NBATCH = 4;
constexpr int NE = 64, FF = 512, TOPK = 8;
constexpr int ZP = 8704;
constexpr int ZQ = 0, ZK = 1024, ZV = 1280, ZFQ = 1536, ZFK = 2560, ZFV = 3584, ZGS = 4608, ZGF = 6656;
constexpr int NIN = 8960;
constexpr float RMS_EPS = 1e-6f;
constexpr float LOG2E = 1.4426950408889634f;
constexpr float QSCALE = 0.125f * LOG2E;
constexpr int NASSIGN = T * TOPK;
constexpr int NROWS_H = NASSIGN + T;

constexpr size_t MiB = 1u << 20;
constexpr size_t WS_CTL = 0, CTL_ZERO_BYTES = 64 * 1024;
constexpr size_t WS_FL = 1 * MiB;
constexpr size_t WS_WTS = 1 * MiB + 512 * 1024;
constexpr size_t WS_LIST = 2 * MiB;
constexpr size_t WS_WSWAT = 4 * MiB, WS_WFOXT = 8 * MiB, WS_WOUTT = 12 * MiB;
constexpr size_t WS_WINT = 20 * MiB;
constexpr size_t WS_WRG = 55 * MiB;
constexpr size_t WS_PSQ = 55 * MiB + 512 * 1024;
constexpr size_t WS_U = 56 * MiB;
constexpr size_t WS_Z = 88 * MiB;
constexpr size_t WS_YS = 224 * MiB, WS_YF = 240 * MiB;
constexpr size_t WS_T1 = 256 * MiB;
constexpr size_t WS_MIX = 320 * MiB;
constexpr size_t WS_H1 = 352 * MiB;
constexpr size_t WS_V = 416 * MiB;
constexpr size_t WS_HB = 448 * MiB;
constexpr size_t WS_WGU = 520 * MiB;
constexpr size_t WS_WD = 780 * MiB;
constexpr size_t WS_YB = 56 * MiB;
constexpr size_t WS_LISTW = 910 * MiB;
constexpr size_t WS_END = 912 * MiB;
static_assert(WS_YB + (size_t)NROWS_H * D * 2 <= WS_MIX + 32 * MiB, "YB overlay");
constexpr int CW_CNT = 64;
constexpr int CW_BAR = 4096;

constexpr int RING_BYTES = 131072;
constexpr int MISC_OFF = 139264;
constexpr int LDS_BYTES = 147456;
constexpr int NWAVES = 8, NTHREADS = 512;

__device__ __forceinline__ unsigned cvtpk(float lo, float hi) { f32x2 v = {lo, hi}; bf16x2_t b = __builtin_convertvector(v, bf16x2_t); return __builtin_bit_cast(unsigned, b); }
__device__ __forceinline__ float bf2f(bf16_t h) { return __builtin_bit_cast(float, (unsigned)h << 16); }
__device__ __forceinline__ float bflo(unsigned w) { return __builtin_bit_cast(float, w << 16); }
__device__ __forceinline__ float bfhi(unsigned w) { return __builtin_bit_cast(float, w & 0xffff0000u); }
__device__ __forceinline__ float wave_sum(float v) {
#pragma unroll
    for (int o = 1; o < 64; o <<= 1) v += __shfl_xor(v, o);
    return v;
}
__device__ __forceinline__ float wave_max(float v) {
#pragma unroll
    for (int o = 1; o < 64; o <<= 1) v = fmaxf(v, __shfl_xor(v, o));
    return v;
}
__device__ __forceinline__ float sigmoidf_(float x) { return 1.0f / (1.0f + __expf(-x)); }
#define LDS_WAIT() asm volatile("s_waitcnt lgkmcnt(0)" ::: "memory")
#define VM_WAIT() asm volatile("s_waitcnt vmcnt(0)" ::: "memory")

#define XB_TMO      128
#define XB_XCNT(j)  (256  + 64 * (j))
#define XB_XSUB(j)  (1280 + 64 * (j))
#define XB_XGEN(j)  (2304 + 64 * (j))
#define XB_TOP      3328
#define XB_TOPGEN   3392
#define XCD_BAR_WORDS 3456
#define XB_SPIN_CAP (1u << 20)
__device__ __forceinline__ unsigned xb_ld(unsigned* p)              { return __hip_atomic_load(p, __ATOMIC_RELAXED, __HIP_MEMORY_SCOPE_AGENT); }
__device__ __forceinline__ unsigned xb_add(unsigned* p, unsigned v) { return __hip_atomic_fetch_add(p, v, __ATOMIC_RELAXED, __HIP_MEMORY_SCOPE_AGENT); }
__device__ __forceinline__ unsigned xb_xcc_id() { return (unsigned)__builtin_amdgcn_s_getreg((3 << 11) | 20) & 0xFu; }
#define XB_SPIN(cond, bar) do { unsigned _sp = 0; while (cond) { __builtin_amdgcn_s_sleep(1); \
    if ((++_sp & 255u) == 0u) { if (xb_ld(&(bar)[XB_TMO])) break; if (_sp > XB_SPIN_CAP) { atomicAdd(&(bar)[XB_TMO], 1u); break; } } } } while (0)
struct XcdBarrier { unsigned* bar; unsigned x; volatile LAS unsigned* st; };
__device__ __forceinline__ XcdBarrier xcd_barrier_post(unsigned* bar, volatile LAS unsigned* st) {
    XcdBarrier b; b.bar = bar; b.x = xb_xcc_id(); b.st = st;
    if (threadIdx.x == 0) (void)xb_add(&bar[XB_XCNT(b.x)], 1u);
    return b;
}
__device__ __forceinline__ void xcd_barrier_complete(unsigned* bar, unsigned x, unsigned& nloc, unsigned& nx) {
    const unsigned G = gridDim.x * gridDim.y * gridDim.z;
    unsigned sum, cnt, mine, sp = 0u;
    for (;;) {
        sum = 0u; cnt = 0u; mine = 0u;
#pragma unroll
        for (unsigned j = 0; j < 16; ++j) { const unsigned c = xb_ld(&bar[XB_XCNT(j)]); sum += c; cnt += (c > 0u) ? 1u : 0u; mine = (j == x) ? c : mine; }
        if (sum == G) break;
        __builtin_amdgcn_s_sleep(1);
        if ((++sp & 255u) == 0u) { if (xb_ld(&bar[XB_TMO])) break; if (sp > XB_SPIN_CAP) { atomicAdd(&bar[XB_TMO], 1u); break; } }
    }
    nloc = mine > 0u ? mine : 1u; nx = cnt > 0u ? cnt : 1u;
}
__device__ __forceinline__ void xcd_barrier(const XcdBarrier& b) {
    asm volatile("s_waitcnt vmcnt(0)" ::: "memory");
    __syncthreads();
    if (threadIdx.x == 0) {
        unsigned* bar = b.bar;
        __builtin_amdgcn_s_waitcnt(0);
        unsigned nloc = b.st[0], nx = b.st[1];
        if (nloc == 0u) { xcd_barrier_complete(bar, b.x, nloc, nx); b.st[0] = nloc; b.st[1] = nx; }
        const unsigned old = xb_add(&bar[XB_XSUB(b.x)], 1u);
        const unsigned gen = old / nloc;
        if (old + 1u == (gen + 1u) * nloc) {
            __builtin_amdgcn_fence(__ATOMIC_RELEASE, "agent");
            asm volatile("s_waitcnt vmcnt(0)" ::: "memory");
            const unsigned og = xb_add(&bar[XB_TOP], 1u);
            const unsigned tg = og / nx;
            if (og + 1u == (tg + 1u) * nx) xb_add(&bar[XB_TOPGEN], 1u);
            else XB_SPIN(xb_ld(&bar[XB_TOPGEN]) == tg, bar);
            __builtin_amdgcn_fence(__ATOMIC_ACQUIRE, "agent");
            xb_add(&bar[XB_XGEN(b.x)], 1u);
            asm volatile("s_waitcnt vmcnt(0)" ::: "memory");
        } else {
            XB_SPIN(xb_ld(&bar[XB_XGEN(b.x)]) == gen, bar);
            __builtin_amdgcn_fence(__ATOMIC_ACQUIRE, "agent");
            asm volatile("s_waitcnt vmcnt(0)" ::: "memory");
        }
    }
    __syncthreads();
}

namespace pg8 {
constexpr int BM = 256, BK = 64, HALF = 128, HTB = HALF * BK * 2, STAGE_BYTES = 8 * HTB, NXCD = 8, WGM = 8;
__host__ __device__ __forceinline__ int lds_byte(int r, int c) { const int st = (r >> 4) * 2 + (c >> 5), rr = r & 15, cc = c & 31, ob = rr * 64 + cc * 2; return st * 1024 + (ob ^ (((ob >> 9) & 1) << 5)); }
__host__ __device__ __forceinline__ void stage_rc(int b, int& R, int& C) { const int st = b / 1024, sb = b % 1024, swz = sb ^ (((sb >> 9) & 1) << 5); R = (st >> 1) * 16 + swz / 64; C = (st & 1) * 32 + (swz % 64) / 2; }
__host__ __device__ __forceinline__ int perm32(int rho) { const int n = rho >> 4, i = rho & 15; return 8 * (i >> 2) + 4 * n + (i & 3); }

struct Unit { const char* A; const char* B; int pm, pn, e, rt; };

__device__ __forceinline__ void static_tile(int L, int nM, int nN, int& pm, int& pn) {
    const int nwg = nM * nN; int wgid = L;
    { const int q = nwg / NXCD, r = nwg % NXCD, xcd = wgid % NXCD, off = wgid / NXCD; wgid = (xcd < r ? xcd * (q + 1) : r * (q + 1) + (xcd - r) * q) + off; }
    const int nig = WGM * nN, gid = wgid / nig, fm = gid * WGM, gsz = (nM - fm) < WGM ? (nM - fm) : WGM;
    pm = fm + ((wgid % nig) % gsz); pn = (wgid % nig) / gsz;
}

typedef int v4i_t __attribute__((ext_vector_type(4)));
typedef int v8i_t __attribute__((ext_vector_type(8)));
template <bool FP8, class Epi, class Sched>
__device__ __forceinline__ void gemm_phase(LAS unsigned char* lds, const int Kb, const Sched& S, const Epi& E) {
    const int tid = threadIdx.x, wid = __builtin_amdgcn_readfirstlane(tid >> 6), lane = tid & 63, wr = wid >> 2, wc = wid & 3, fr = lane & 15, fq = lane >> 4;
    const int nt = Kb / 128;
    int Ri[2], Ci[2]; unsigned voffB[2];
#pragma unroll
    for (int i = 0; i < 2; ++i) { int R, C; stage_rc(tid * 16 + i * 8192, R, C); Ri[i] = R; Ci[i] = C; const int Rb = (R & ~31) + perm32(R & 31); voffB[i] = (unsigned)(Rb * Kb + C * 2); }
    const size_t kstep = (size_t)(BK * 2);
    const size_t hstep = (size_t)HALF * Kb;
    const unsigned ldsw = (unsigned)wid * 1024u;
    const int aoff = lds_byte(wr * 64 + fr, fq * 8), boff = lds_byte(wc * 32 + fr, fq * 8);
#define PG8_SA(b, h) (((b) * 2 + (h)) * HTB)
#define PG8_SB(b, h) ((4 + (b) * 2 + (h)) * HTB)
#define PG8_STAGE(bufoff, gbase, voff) do { _Pragma("unroll") for (int _i = 0; _i < 2; ++_i) \
        __builtin_amdgcn_global_load_lds((const unsigned*)((const char*)(gbase) + (voff)[_i]), (LAS unsigned*)(lds + (bufoff) + ldsw + _i * 8192), 16, 0, 0); } while (0)
#define PG8_LDA(dst, b, h) do { if constexpr (FP8) { _Pragma("unroll") for (int m = 0; m < 4; ++m) { dst##8[m].lo = *(const LAS v4i_t*)(lds + PG8_SA(b, h) + aoff + m * 2048); dst##8[m].hi = *(const LAS v4i_t*)(lds + PG8_SA(b, h) + aoff + m * 2048 + 1024); } } \
        else { _Pragma("unroll") for (int m = 0; m < 4; ++m) _Pragma("unroll") for (int k = 0; k < 2; ++k) dst[m][k] = *(const LAS bf16x8*)(lds + PG8_SA(b, h) + aoff + m * 2048 + k * 1024); } } while (0)
#define PG8_LDB(dst, b, h) do { if constexpr (FP8) { _Pragma("unroll") for (int n = 0; n < 2; ++n) { dst##8[n].lo = *(const LAS v4i_t*)(lds + PG8_SB(b, h) + boff + n * 2048); dst##8[n].hi = *(const LAS v4i_t*)(lds + PG8_SB(b, h) + boff + n * 2048 + 1024); } } \
        else { _Pragma("unroll") for (int n = 0; n < 2; ++n) _Pragma("unroll") for (int k = 0; k < 2; ++k) dst[n][k] = *(const LAS bf16x8*)(lds + PG8_SB(b, h) + boff + n * 2048 + k * 1024); } } while (0)
#define PG8_MMA(ai, bj, At, Bt) do { __builtin_amdgcn_s_setprio(1); \
        if constexpr (FP8) { _Pragma("unroll") for (int m = 0; m < 4; ++m) _Pragma("unroll") for (int n = 0; n < 2; ++n) \
            asm volatile("v_mfma_scale_f32_16x16x128_f8f6f4 %0, %1, %2, %0, %3, %3 op_sel_hi:[0,0,0]" : "+v"(acc[ai][bj][m][n]) : "v"(Bt##8[n]), "v"(At##8[m]), "v"(sc8)); } \
        else { _Pragma("unroll") for (int m = 0; m < 4; ++m) _Pragma("unroll") for (int n = 0; n < 2; ++n) _Pragma("unroll") for (int k = 0; k < 2; ++k) \
            acc[ai][bj][m][n] = __builtin_amdgcn_mfma_f32_16x16x32_bf16(Bt[n][k], At[m][k], acc[ai][bj][m][n], 0, 0, 0); } \
        __builtin_amdgcn_s_setprio(0); } while (0)
#define PG8_WAIT_V(n) asm volatile("s_waitcnt vmcnt(" #n ")" ::: "memory")
#define PG8_WAIT_L(n) asm volatile("s_waitcnt lgkmcnt(" #n ")" ::: "memory")
#define PG8_BAR __builtin_amdgcn_s_barrier()
#define PG8_SCHED __builtin_amdgcn_sched_barrier(0)
    Unit cur, nxt; int ui = 0;
    if (!S.next(0, cur)) return;
    unsigned vc[2][2], vn[2][2];
    int pfa = -1; float pfw = 0.f;
    S.pf_issue(cur, pfa, pfw); S.pf_commit(0, pfa, pfw);
    asm volatile("s_waitcnt vmcnt(0) lgkmcnt(0)" ::: "memory"); PG8_BAR; asm volatile("" ::: "memory");
    S.rowoffs(cur, 0, vc, Ri, Ci);
    f32x4 acc[2][2][4][2];
#pragma unroll
    for (int a = 0; a < 2; ++a)
#pragma unroll
        for (int b = 0; b < 2; ++b)
#pragma unroll
            for (int m = 0; m < 4; ++m)
#pragma unroll
                for (int n = 0; n < 2; ++n) acc[a][b][m][n] = (f32x4){0.f, 0.f, 0.f, 0.f};
    const int sc8 = 0x7f7f7f7f;
    bf16x8 At[4][2], B0[2][2], B1[2][2]; v8i_t At8[4], B08[2], B18[2];
    const char* cA = cur.A; const char* cB = cur.B;
    PG8_STAGE(PG8_SB(0, 0), cB, voffB); PG8_STAGE(PG8_SB(0, 1), cB + hstep, voffB); PG8_STAGE(PG8_SA(0, 0), cA, vc[0]); PG8_STAGE(PG8_SA(0, 1), cA, vc[1]);
    if (wr == 1) PG8_BAR;
    PG8_WAIT_V(2); PG8_BAR;
    PG8_STAGE(PG8_SB(1, 0), cB + kstep, voffB); PG8_STAGE(PG8_SA(1, 0), cA + kstep, vc[0]); PG8_STAGE(PG8_SB(1, 1), cB + hstep + kstep, voffB);
    PG8_WAIT_V(6); PG8_BAR;
    for (;;) {
        const bool has_next = S.next(ui + 1, nxt);
        const int scur = ui % 3, snxt = (ui + 1) % 3;
        const char* nA = has_next ? nxt.A : cA; const char* nB = has_next ? nxt.B : cB;
        if (has_next) S.pf_issue(nxt, pfa, pfw);
        for (int t = 0; t < nt; t += 2) {
            const bool last = (t == nt - 2);
            if (t == (nt >= 8 ? nt - 4 : 0) && has_next) S.pf_commit(snxt, pfa, pfw);
            const char* a1 = cA + (size_t)(t + 1) * kstep;
            const char* a2 = last ? nA : cA + (size_t)(t + 2) * kstep; const char* b2 = last ? nB : cB + (size_t)(t + 2) * kstep;
            const char* a3 = a2 + kstep; const char* b3 = b2 + kstep;
            if (last) {
                if (has_next) S.rowoffs(nxt, snxt, vn, Ri, Ci);
                else { vn[0][0] = vc[0][0]; vn[0][1] = vc[0][1]; vn[1][0] = vc[1][0]; vn[1][1] = vc[1][1]; }
            }
            unsigned v2[2][2];
            v2[0][0] = last ? vn[0][0] : vc[0][0]; v2[0][1] = last ? vn[0][1] : vc[0][1]; v2[1][0] = last ? vn[1][0] : vc[1][0]; v2[1][1] = last ? vn[1][1] : vc[1][1];
            PG8_LDB(B0, 0, 0); PG8_LDB(B1, 0, 1); PG8_SCHED; PG8_LDA(At, 0, 0); PG8_STAGE(PG8_SA(1, 1), a1, vc[1]);
            PG8_WAIT_V(8); PG8_WAIT_L(0); PG8_BAR; PG8_MMA(0, 0, At, B0); PG8_MMA(0, 1, At, B1); PG8_BAR; PG8_SCHED;
            PG8_LDA(At, 0, 1); PG8_STAGE(PG8_SB(0, 0), b2, voffB); PG8_STAGE(PG8_SB(0, 1), b2 + hstep, voffB); PG8_STAGE(PG8_SA(0, 0), a2, v2[0]);
            PG8_WAIT_V(8); PG8_WAIT_L(0); PG8_BAR; PG8_MMA(1, 0, At, B0); PG8_MMA(1, 1, At, B1); PG8_BAR; PG8_SCHED;
            PG8_LDB(B0, 1, 0); PG8_LDB(B1, 1, 1); PG8_SCHED; PG8_LDA(At, 1, 0); PG8_STAGE(PG8_SA(0, 1), a2, v2[1]);
            PG8_WAIT_V(8); PG8_WAIT_L(0); PG8_BAR; PG8_MMA(0, 0, At, B0); PG8_MMA(0, 1, At, B1); PG8_BAR; PG8_SCHED;
            PG8_LDA(At, 1, 1); PG8_STAGE(PG8_SB(1, 0), b3, voffB); PG8_STAGE(PG8_SB(1, 1), b3 + hstep, voffB); PG8_STAGE(PG8_SA(1, 0), a3, v2[0]);
            PG8_WAIT_V(8); PG8_WAIT_L(0); PG8_BAR; PG8_MMA(1, 0, At, B0); PG8_MMA(1, 1, At, B1); PG8_BAR; PG8_SCHED;
        }
        if (wr == 0) PG8_BAR;
        if constexpr (FP8) {
            asm volatile("s_nop 15\n\ts_nop 15" ::: "memory");
#pragma unroll
            for (int a = 0; a < 2; ++a)
#pragma unroll
                for (int b = 0; b < 2; ++b)
#pragma unroll
                    for (int m = 0; m < 4; ++m)
#pragma unroll
                        for (int n = 0; n < 2; ++n) asm volatile("" : "+v"(acc[a][b][m][n]));
        }
        E(acc, cur, scur, wr, wc, fr, fq);
        if (!has_next) break;
#pragma unroll
        for (int a = 0; a < 2; ++a)
#pragma unroll
            for (int b = 0; b < 2; ++b)
#pragma unroll
                for (int m = 0; m < 4; ++m)
#pragma unroll
                    for (int n = 0; n < 2; ++n) acc[a][b][m][n] = (f32x4){0.f, 0.f, 0.f, 0.f};
        cur = nxt; cA = nA; cB = nB; ++ui;
        vc[0][0] = vn[0][0]; vc[0][1] = vn[0][1]; vc[1][0] = vn[1][0]; vc[1][1] = vn[1][1];
        if (wr == 1) PG8_BAR;
    }
    PG8_WAIT_V(0);
    PG8_BAR;
#undef PG8_SA
#undef PG8_SB
#undef PG8_STAGE
#undef PG8_LDA
#undef PG8_LDB
#undef PG8_MMA
#undef PG8_WAIT_V
#undef PG8_WAIT_L
#undef PG8_BAR
#undef PG8_SCHED
}
}
using pg8::Unit;

struct Args { const float* in[18]; float* out; unsigned char* ws; int ph_lo, ph_hi; };
struct Frame {
    LAS unsigned char* lds; volatile LAS unsigned* MISC; unsigned* ctl; unsigned char* ws;
    int tid, lane, wave, vcu, G;
};

struct DenseSched {
    const char* A; const char* Bt; int nM, nN, K, G, c, dup;
    __device__ __forceinline__ bool next(int i, Unit& u) const {
        int L = i * G + c; if (L >= nM * nN * dup) return false; if (L >= nM * nN) L -= nM * nN;
        int pm, pn; pg8::static_tile(L, nM, nN, pm, pn);
        u.pm = pm; u.pn = pn; u.e = 0; u.rt = 0; u.A = A + (size_t)pm * 256 * K * 2; u.B = Bt + (size_t)pn * 256 * K * 2; return true;
    }
    __device__ __forceinline__ void pf_issue(const Unit&, int&, float&) const {}
    __device__ __forceinline__ void pf_commit(int, int, float) const {}
    __device__ __forceinline__ void rowoffs(const Unit&, int, unsigned (&vo)[2][2], const int (&R)[2], const int (&C)[2]) const {
#pragma unroll
        for (int h = 0; h < 2; ++h)
#pragma unroll
            for (int i = 0; i < 2; ++i) vo[h][i] = (unsigned)((R[i] + 128 * h) * K + C[i]) * 2u;
    }
};
struct BranchSched {
    const char* A0; const char* A1; const char* B0; const char* B1; int nM, nN, K, G, c, dup;
    __device__ __forceinline__ bool next(int i, Unit& u) const {
        int L = (i >> 1) * G + c; if (L >= nM * nN * dup) return false; if (L >= nM * nN) L -= nM * nN;
        int pm, pn; pg8::static_tile(L, nM, nN, pm, pn);
        const int br = i & 1;
        u.pm = pm; u.pn = pn; u.e = br; u.rt = 0; u.A = (br ? A1 : A0) + (size_t)pm * 256 * K * 2; u.B = (br ? B1 : B0) + (size_t)pn * 256 * K * 2; return true;
    }
    __device__ __forceinline__ void pf_issue(const Unit&, int&, float&) const {}
    __device__ __forceinline__ void pf_commit(int, int, float) const {}
    __device__ __forceinline__ void rowoffs(const Unit&, int, unsigned (&vo)[2][2], const int (&R)[2], const int (&C)[2]) const {
#pragma unroll
        for (int h = 0; h < 2; ++h)
#pragma unroll
            for (int i = 0; i < 2; ++i) vo[h][i] = (unsigned)((R[i] + 128 * h) * K + C[i]) * 2u;
    }
};
template <int MODE> struct MoeSched {
    const LAS int* tab; const int* list; const float* listw; const char* A; const char* Bt; LAS int* rowA; LAS float* rowW; int total, G, vcu, dup;
    static constexpr int MULT = MODE == 0 ? 4 : 8, KB = MODE == 0 ? 2048 : 512  , NCOLS = MODE == 0 ? 1024 : 2048;
    __device__ __forceinline__ bool next(int i, Unit& u) const {
        int L = i * G + vcu; if (L >= total * dup) return false; if (L >= total) L -= total;
        int e, j, nrt;
        if (L < 32 * MULT) { e = 64; j = L; nrt = 32; }
        else {
            const int Lr = L - 32 * MULT; const int lane = threadIdx.x & 63;
            const int pin = tab[lane];
            const unsigned long long bal = __ballot(pin <= Lr);
            e = __builtin_popcountll(bal); e = e > 63 ? 63 : e;
            const int pex = e > 0 ? tab[e - 1] : 0; const int cnt = tab[64 + e];
            j = Lr - pex; nrt = (cnt + 255) >> 8; nrt = nrt < 1 ? 1 : nrt;
        }
        e = __builtin_amdgcn_readfirstlane(e); j = __builtin_amdgcn_readfirstlane(j); nrt = __builtin_amdgcn_readfirstlane(nrt);
        u.e = e; u.rt = j % nrt; u.pn = j / nrt; u.pm = 0;
        u.A = A; u.B = Bt + ((size_t)e * NCOLS + (size_t)u.pn * 256) * KB; return true;
    }
    __device__ __forceinline__ void pf_issue(const Unit& u, int& pa, float& pw) const {
        const int tid = threadIdx.x; pa = -1; pw = 0.f;
        if (tid < 256) { const int idx = u.rt * 256 + tid;
            if (u.e == 64) { pa = NASSIGN + idx; pw = 1.f; }
            else if (idx < tab[64 + u.e]) { pa = list[u.e * T + idx]; if (MODE == 1) pw = listw[u.e * T + idx]; } }
    }
    __device__ __forceinline__ void pf_commit(int s, int pa, float pw) const { const int tid = threadIdx.x; if (tid < 256) { rowA[s * 256 + tid] = pa; rowW[s * 256 + tid] = pw; } }
    __device__ __forceinline__ void rowoffs(const Unit& u, int s, unsigned (&vo)[2][2], const int (&R)[2], const int (&C)[2]) const {
#pragma unroll
        for (int h = 0; h < 2; ++h)
#pragma unroll
            for (int i = 0; i < 2; ++i) {
                int a = rowA[s * 256 + R[i] + 128 * h];
                unsigned row;
                if (MODE == 0) { a = a < 0 ? 0 : a; row = a < NASSIGN ? (unsigned)(a >> 3) : (unsigned)(a - NASSIGN); }
                else row = a < 0 ? 0u : (unsigned)a;
                vo[h][i] = row * (unsigned)KB + (unsigned)C[i] * 2u;
            }
    }
};

struct EpiZ {
    bf16_t* Z; float* FL; const float* fbias;
    __device__ __forceinline__ void operator()(const f32x4 (&acc)[2][2][4][2], const Unit& u, int slot, int wr, int wc, int fr, int fq) const {
        const int row0 = u.pm * 256 + wr * 64 + fr;
        if (u.pn == 34) {
            if (wc == 0 && fq < 2) {
                float fb[8];
#pragma unroll
                for (int j = 0; j < 8; ++j) fb[j] = fbias[8 * fq + j];
#pragma unroll
                for (int ai = 0; ai < 2; ++ai)
#pragma unroll
                    for (int m = 0; m < 4; ++m) {
                        float* o = FL + (size_t)(row0 + ai * 128 + m * 16) * 16 + 8 * fq;
#pragma unroll
                        for (int n = 0; n < 2; ++n) { f32x4 r;
#pragma unroll
                            for (int j = 0; j < 4; ++j) { const float x = acc[ai][0][m][n][j] + fb[4 * n + j]; const float ls = x >= 0.f ? -log1pf(expf(-x)) : x - log1pf(expf(x)); r[j] = ls * LOG2E; }
                            *(f32x4*)(o + 4 * n) = r; }
                    }
            }
            return;
        }
        const int mode = (u.pn < 4 || (u.pn >= 6 && u.pn < 10)) ? 1 : (u.pn >= 18 ? 2 : 0);
        const int col0 = u.pn * 256 + wc * 32 + 8 * fq;
#pragma unroll
        for (int ai = 0; ai < 2; ++ai)
#pragma unroll
            for (int m = 0; m < 4; ++m) { bf16_t* rowp = Z + (size_t)(row0 + ai * 128 + m * 16) * ZP + col0;
#pragma unroll
                for (int bj = 0; bj < 2; ++bj) { f32x4 v0 = acc[ai][bj][m][0], v1 = acc[ai][bj][m][1];
                    if (mode == 1) { v0 = v0 * QSCALE; v1 = v1 * QSCALE; }
                    else if (mode == 2) {
#pragma unroll
                        for (int j = 0; j < 4; ++j) { v0[j] = sigmoidf_(v0[j]); v1[j] = sigmoidf_(v1[j]); } }
                    u32x4 w; w.x = cvtpk(v0[0], v0[1]); w.y = cvtpk(v0[2], v0[3]); w.z = cvtpk(v1[0], v1[1]); w.w = cvtpk(v1[2], v1[3]);
                    *(u32x4*)(rowp + bj * 128) = w; } }
    }
};
struct EpiMix {
    const bf16_t* Z; bf16_t* MIX;
    __device__ __forceinline__ void operator()(const f32x4 (&acc)[2][2][4][2], const Unit& u, int slot, int wr, int wc, int fr, int fq) const {
        const int row0 = u.pm * 256 + wr * 64 + fr, col0 = u.pn * 256 + wc * 32 + 8 * fq;
        const int gcol = (u.e ? ZGF : ZGS) + col0;
#pragma unroll
        for (int ai = 0; ai < 2; ++ai)
#pragma unroll
            for (int m = 0; m < 4; ++m) { const size_t row = (size_t)(row0 + ai * 128 + m * 16);
#pragma unroll
                for (int bj = 0; bj < 2; ++bj) {
                    const u32x4 g = *(const u32x4*)(Z + row * ZP + gcol + bj * 128);
                    f32x4 v0 = acc[ai][bj][m][0], v1 = acc[ai][bj][m][1];
                    v0[0] *= bflo(g.x); v0[1] *= bfhi(g.x); v0[2] *= bflo(g.y); v0[3] *= bfhi(g.y);
                    v1[0] *= bflo(g.z); v1[1] *= bfhi(g.z); v1[2] *= bflo(g.w); v1[3] *= bfhi(g.w);
                    u32x4* mp = (u32x4*)(MIX + row * D + col0 + bj * 128);
                    if (u.e != 0) { const u32x4 t = *mp;
                        v0[0] += bflo(t.x); v0[1] += bfhi(t.x); v0[2] += bflo(t.y); v0[3] += bfhi(t.y);
                        v1[0] += bflo(t.z); v1[1] += bfhi(t.z); v1[2] += bflo(t.w); v1[3] += bfhi(t.w); }
                    u32x4 w; w.x = cvtpk(v0[0], v0[1]); w.y = cvtpk(v0[2], v0[3]); w.z = cvtpk(v1[0], v1[1]); w.w = cvtpk(v1[2], v1[3]);
                    *mp = w; } }
    }
};
struct EpiOut {
    const float* X; float* H1; float* PSQ;
    __device__ __forceinline__ void operator()(const f32x4 (&acc)[2][2][4][2], const Unit& u, int slot, int wr, int wc, int fr, int fq) const {
        const int row0 = u.pm * 256 + wr * 64 + fr, col0 = u.pn * 256 + wc * 32 + 8 * fq;
#pragma unroll
        for (int ai = 0; ai < 2; ++ai)
#pragma unroll
            for (int m = 0; m < 4; ++m) { const size_t row = (size_t)(row0 + ai * 128 + m * 16); float sq = 0.f;
#pragma unroll
                for (int bj = 0; bj < 2; ++bj) {
                    const float* xp = X + row * D + col0 + bj * 128; float* hp = H1 + row * D + col0 + bj * 128;
                    const f32x4 x0 = *(const f32x4*)xp, x1 = *(const f32x4*)(xp + 4);
                    const f32x4 h0 = acc[ai][bj][m][0] + x0, h1 = acc[ai][bj][m][1] + x1;
                    *(f32x4*)hp = h0; *(f32x4*)(hp + 4) = h1;
                    sq += (h0[0] * h0[0] + h0[1] * h0[1]) + (h0[2] * h0[2] + h0[3] * h0[3]) + (h1[0] * h1[0] + h1[1] * h1[1]) + (h1[2] * h1[2] + h1[3] * h1[3]); }
                sq += __shfl_xor(sq, 16); sq += __shfl_xor(sq, 32);
                if (fq == 0) PSQ[row * 32 + u.pn * 4 + wc] = sq; }
    }
};
__device__ __forceinline__ unsigned pk_fp8x4(float a, float b, float c, float d) {
    a = __builtin_amdgcn_fmed3f(a, -448.f, 448.f); b = __builtin_amdgcn_fmed3f(b, -448.f, 448.f); c = __builtin_amdgcn_fmed3f(c, -448.f, 448.f); d = __builtin_amdgcn_fmed3f(d, -448.f, 448.f);
    int r = __builtin_amdgcn_cvt_pk_fp8_f32(a, b, 0, false); r = __builtin_amdgcn_cvt_pk_fp8_f32(c, d, r, true); return (unsigned)r;
}
constexpr float WGU_SCALE = 32.f, WD_SCALE = 16.f;
struct EpiSwiglu {
    const MoeSched<0>* S; unsigned char* HB8;
    __device__ __forceinline__ void operator()(const f32x4 (&acc)[2][2][4][2], const Unit& u, int slot, int wr, int wc, int fr, int fq) const {
        const int ff0 = u.pn * 128 + wc * 32 + 8 * fq;
#pragma unroll
        for (int ai = 0; ai < 2; ++ai)
#pragma unroll
            for (int m = 0; m < 4; ++m) { const int a = S->rowA[slot * 256 + ai * 128 + wr * 64 + m * 16 + fr];
                if (a >= 0) { float h[8];
#pragma unroll
                    for (int n = 0; n < 2; ++n)
#pragma unroll
                        for (int j = 0; j < 4; ++j) { const float g = acc[ai][0][m][n][j] * (1.f / WGU_SCALE), up = acc[ai][1][m][n][j] * (1.f / WGU_SCALE); h[4 * n + j] = g * sigmoidf_(g) * up; }
                    u32x2 w; w.x = pk_fp8x4(h[0], h[1], h[2], h[3]); w.y = pk_fp8x4(h[4], h[5], h[6], h[7]);
                    *(u32x2*)(HB8 + (size_t)a * FF + ff0) = w; } }
    }
};
struct EpiDown {
    const MoeSched<1>* S; bf16_t* YB;
    __device__ __forceinline__ void operator()(const f32x4 (&acc)[2][2][4][2], const Unit& u, int slot, int wr, int wc, int fr, int fq) const {
        const int col0 = u.pn * 256 + wc * 32 + 8 * fq;
#pragma unroll
        for (int ai = 0; ai < 2; ++ai)
#pragma unroll
            for (int m = 0; m < 4; ++m) { const int ri = slot * 256 + ai * 128 + wr * 64 + m * 16 + fr; const int a = S->rowA[ri];
                if (a >= 0) { const float w8 = S->rowW[ri] * (1.f / WD_SCALE);
#pragma unroll
                    for (int bj = 0; bj < 2; ++bj) { const f32x4 v0 = acc[ai][bj][m][0] * w8, v1 = acc[ai][bj][m][1] * w8;
                        u32x4 w; w.x = cvtpk(v0[0], v0[1]); w.y = cvtpk(v0[2], v0[3]); w.z = cvtpk(v1[0], v1[1]); w.w = cvtpk(v1[2], v1[3]);
                        *(u32x4*)(YB + (size_t)a * D + col0 + bj * 128) = w; } } }
    }
};

struct P0Item { const float* src; unsigned char* dst; int ldw, nvalid, K, fp8; float scale; };
__device__ __forceinline__ P0Item p0_decode(int pr, int half, const Args& a, unsigned char* ws) {
    constexpr int P_IN = 16 * 140, P_SW = 8 * 32, P_OUT = 16 * 32, P_GU = 16 * 8, P_DN = 4 * 32, P_EXP = 2 * P_GU + P_DN;
    P0Item q; q.fp8 = 0; q.scale = 1.f; int r = pr;
    if (r < P_IN) { const int kb = 2 * (r / 140) + half, nb = r % 140, n0 = nb * 64;
        int c0, nv; if (n0 < 4608) { c0 = n0; nv = 64; } else if (n0 < 8704) { c0 = n0 + 16; nv = 64; } else if (n0 == 8704) { c0 = 4608; nv = 16; } else { c0 = 0; nv = 0; }
        q.src = a.in[2] + (size_t)kb * 64 * 8720 + c0; q.ldw = 8720; q.nvalid = nv; q.K = D; q.dst = ws + WS_WINT + ((size_t)n0 * D + kb * 64) * 2; return q; }
    r -= P_IN;
    if (r < P_SW) { const int kb = 2 * (r / 32) + half, nb = r % 32; q.src = a.in[5] + (size_t)kb * 64 * D + nb * 64; q.ldw = D; q.nvalid = 64; q.K = 1024; q.dst = ws + WS_WSWAT + ((size_t)nb * 64 * 1024 + kb * 64) * 2; return q; }
    r -= P_SW;
    if (r < P_SW) { const int kb = 2 * (r / 32) + half, nb = r % 32; q.src = a.in[6] + (size_t)kb * 64 * D + nb * 64; q.ldw = D; q.nvalid = 64; q.K = 1024; q.dst = ws + WS_WFOXT + ((size_t)nb * 64 * 1024 + kb * 64) * 2; return q; }
    r -= P_SW;
    if (r < P_OUT) { const int kb = 2 * (r / 32) + half, nb = r % 32; q.src = a.in[7] + (size_t)kb * 64 * D + nb * 64; q.ldw = D; q.nvalid = 64; q.K = D; q.dst = ws + WS_WOUTT + ((size_t)nb * 64 * D + kb * 64) * 2; return q; }
    r -= P_OUT;
    const int e = r / P_EXP; r -= e * P_EXP; q.fp8 = 1;
    if (r < 2 * P_GU) { const int up = r >= P_GU; r -= up * P_GU; const int kb = 2 * (r / 8) + half, nb = r % 8, n0 = nb * 64;
        const float* src = e < 64 ? (up ? a.in[12] : a.in[11]) + (size_t)e * D * FF : (up ? a.in[15] : a.in[14]);
        const int drow = 256 * (n0 >> 7) + (n0 & 127) + 128 * up;
        q.src = src + (size_t)kb * 64 * FF + n0; q.ldw = FF; q.nvalid = 64; q.K = D; q.scale = WGU_SCALE; q.dst = ws + WS_WGU + ((size_t)e * 1024 + drow) * D + kb * 64; return q; }
    r -= 2 * P_GU;
    { const int kb = 2 * (r / 32) + half, nb = r % 32;
        const float* src = e < 64 ? a.in[13] + (size_t)e * FF * D : a.in[16];
        q.src = src + (size_t)kb * 64 * D + nb * 64; q.ldw = D; q.nvalid = 64; q.K = FF; q.scale = WD_SCALE; q.dst = ws + WS_WD + ((size_t)e * D + nb * 64) * FF + kb * 64; return q; }
}
__device__ __forceinline__ void p0_load(const P0Item& q, f32x4 (&v)[16], int lane) {
    const int kr = lane >> 4, nc = (lane & 15) * 4; const bool ok = nc < q.nvalid;
    const float* p = q.src + (size_t)kr * q.ldw + nc;
#pragma unroll
    for (int i = 0; i < 16; ++i) v[i] = ok ? *(const f32x4*)(p + (size_t)(4 * i) * q.ldw) : (f32x4){0.f, 0.f, 0.f, 0.f};
}
__device__ __forceinline__ void p0_process(const P0Item& q, const f32x4 (&v)[16], LAS float* scr, int lane) {
    const int kr = lane >> 4, nc = (lane & 15) * 4;
#pragma unroll
    for (int i = 0; i < 16; ++i) { LAS float* w = scr + (4 * i + kr) * 65 + nc; w[0] = v[i][0]; w[1] = v[i][1]; w[2] = v[i][2]; w[3] = v[i][3]; }
    LDS_WAIT(); asm volatile("" ::: "memory");
    if (q.fp8) {
        const int c = lane & 3; const float sc = q.scale;
#pragma unroll
        for (int j = 0; j < 4; ++j) { const int n = (lane >> 2) + 16 * j; const LAS float* s = scr + (16 * c) * 65 + n;
            u32x4 o; o.x = pk_fp8x4(s[0 * 65] * sc, s[1 * 65] * sc, s[2 * 65] * sc, s[3 * 65] * sc); o.y = pk_fp8x4(s[4 * 65] * sc, s[5 * 65] * sc, s[6 * 65] * sc, s[7 * 65] * sc);
            o.z = pk_fp8x4(s[8 * 65] * sc, s[9 * 65] * sc, s[10 * 65] * sc, s[11 * 65] * sc); o.w = pk_fp8x4(s[12 * 65] * sc, s[13 * 65] * sc, s[14 * 65] * sc, s[15 * 65] * sc);
            *(u32x4*)(q.dst + (size_t)n * q.K + 16 * c) = o; }
    } else {
        const int c = lane & 7;
#pragma unroll
        for (int j = 0; j < 8; ++j) { const int n = (lane >> 3) + 8 * j; const LAS float* s = scr + (8 * c) * 65 + n;
            u32x4 o; o.x = cvtpk(s[0 * 65], s[1 * 65]); o.y = cvtpk(s[2 * 65], s[3 * 65]); o.z = cvtpk(s[4 * 65], s[5 * 65]); o.w = cvtpk(s[6 * 65], s[7 * 65]);
            *(u32x4*)(q.dst + ((size_t)n * q.K + 8 * c) * 2) = o; }
    }
    LDS_WAIT(); asm volatile("" ::: "memory");
}
__device__ __forceinline__ void p0_prologue(Frame& F, const Args& a) {
    LAS float* scr = (LAS float*)(F.lds + F.wave * 16640);
    const int gw = F.vcu * NWAVES + F.wave, NGW = F.G * NWAVES;
    unsigned char* ws = F.ws;
    {
        const float* g = a.in[1];
        for (int m = gw; m < T; m += NGW) {
            const f32x4* xr = (const f32x4*)(a.in[0] + (size_t)m * D) + F.lane;
            f32x4 v[8]; float s = 0.f;
#pragma unroll
            for (int j = 0; j < 8; ++j) { v[j] = xr[64 * j]; s += (v[j].x * v[j].x + v[j].y * v[j].y) + (v[j].z * v[j].z + v[j].w * v[j].w); }
            const float rinv = rsqrtf(wave_sum(s) * (1.f / D) + RMS_EPS);
            u32x2* o = (u32x2*)((bf16_t*)(ws + WS_U) + (size_t)m * D) + F.lane;
#pragma unroll
            for (int j = 0; j < 8; ++j) { const f32x4 gg = *((const f32x4*)g + F.lane + 64 * j); u32x2 w; w.x = cvtpk(v[j].x * rinv * gg.x, v[j].y * rinv * gg.y); w.y = cvtpk(v[j].z * rinv * gg.z, v[j].w * rinv * gg.w); o[64 * j] = w; }
        }
    }
    {
        const float* wr = a.in[9]; const float* g = a.in[8]; float* o = (float*)(ws + WS_WRG);
        for (int i = gw * 64 + F.lane; i < D * NE; i += NGW * 64) o[i] = wr[i] * g[i >> 6];
    }
    constexpr int NPAIRS = 16 * 140 + 2 * 8 * 32 + 16 * 32 + 65 * (2 * 16 * 8 + 4 * 32);
    f32x4 va[16], vb[16]; P0Item qa, qb;
    int pr = gw;
    if (pr < NPAIRS) { qa = p0_decode(pr, 0, a, ws); p0_load(qa, va, F.lane); }
    while (pr < NPAIRS) {
        qb = p0_decode(pr, 1, a, ws); p0_load(qb, vb, F.lane);
        p0_process(qa, va, scr, F.lane);
        const int pn = pr + NGW;
        if (pn < NPAIRS) { qa = p0_decode(pn, 0, a, ws); p0_load(qa, va, F.lane); }
        p0_process(qb, vb, scr, F.lane);
        pr = pn;
    }
}

__device__ __forceinline__ int crow(int r, int hi) { return (r & 3) + 8 * (r >> 2) + 4 * hi; }
__device__ __forceinline__ s16x4 vtr(LAS const char* p) { typedef short v4i16_t __attribute__((ext_vector_type(4))); return __builtin_bit_cast(s16x4, __builtin_amdgcn_ds_read_tr16_b64_v4i16((LAS v4i16_t*)p)); }

__device__ __forceinline__ void attn_qk(f32x16 (&p)[2], const bf16x8 (&qf)[4], LAS const char* Kt, int r32, int hi) {
#pragma unroll
    for (int kb = 0; kb < 2; ++kb) { const int kv = 32 * kb + r32; const int sw = (kv >> 1) & 7; LAS const char* rowp = Kt + kv * 128;
        f32x16 c = {};
#pragma unroll
        for (int s = 0; s < 4; ++s) { const bf16x8 a = *(const LAS bf16x8*)(rowp + (((2 * s + hi) ^ sw) * 16)); c = __builtin_amdgcn_mfma_f32_32x32x16_bf16(a, qf[s], c, 0, 0, 0); }
        p[kb] = c; }
}
__device__ __forceinline__ void attn_softmax_pv(f32x16 (&p)[2], f32x16 (&o)[2], float& m, float& l, LAS const char* Vt, int lane) {
    float mx = p[0][0];
#pragma unroll
    for (int kb = 0; kb < 2; ++kb)
#pragma unroll
        for (int r = 0; r < 16; ++r) mx = fmaxf(mx, p[kb][r]);
    mx = fmaxf(mx, __shfl_xor(mx, 32));
    const float mn = fmaxf(m, mx);
    const float alpha = __builtin_amdgcn_exp2f(m - mn);
    float rs = 0.f;
#pragma unroll
    for (int kb = 0; kb < 2; ++kb)
#pragma unroll
        for (int r = 0; r < 16; ++r) { const float e = __builtin_amdgcn_exp2f(p[kb][r] - mn); p[kb][r] = e; rs += e; }
    rs += __shfl_xor(rs, 32);
    l = l * alpha + rs; m = mn;
#pragma unroll
    for (int db = 0; db < 2; ++db)
#pragma unroll
        for (int r = 0; r < 16; ++r) o[db][r] *= alpha;
    const int g = lane >> 4, i = lane & 15;
    LAS const char* vb = Vt + (4 * (g >> 1) + (i >> 2)) * 64 + (g & 1) * 32 + (i & 3) * 8;
#pragma unroll
    for (int kb = 0; kb < 2; ++kb)
#pragma unroll
        for (int ks = 0; ks < 2; ++ks) {
            u32x4 pw; pw.x = cvtpk(p[kb][8 * ks + 0], p[kb][8 * ks + 1]); pw.y = cvtpk(p[kb][8 * ks + 2], p[kb][8 * ks + 3]); pw.z = cvtpk(p[kb][8 * ks + 4], p[kb][8 * ks + 5]); pw.w = cvtpk(p[kb][8 * ks + 6], p[kb][8 * ks + 7]);
            const bf16x8 pb = __builtin_bit_cast(bf16x8, pw);
#pragma unroll
            for (int db = 0; db < 2; ++db) {
                const s16x4 lo = vtr(vb + db * 4096 + (32 * kb + 16 * ks) * 64), hi4 = vtr(vb + db * 4096 + (32 * kb + 16 * ks + 8) * 64);
                const bf16x8 va = (bf16x8){lo[0], lo[1], lo[2], lo[3], hi4[0], hi4[1], hi4[2], hi4[3]};
                o[db] = __builtin_amdgcn_mfma_f32_32x32x16_bf16(va, pb, o[db], 0, 0, 0); } }
}
__device__ __forceinline__ void attn_store_kv(LAS char* Kt, LAS char* Vt, const u32x4& kr, const u32x4& vr, int tid) {
    const int kv = tid >> 3, c = tid & 7;
    *(LAS u32x4*)(Kt + kv * 128 + ((c ^ ((kv >> 1) & 7)) * 16)) = kr;
    *(LAS u32x4*)(Vt + (c >> 2) * 4096 + kv * 64 + (c & 3) * 16) = vr;
}
__device__ __forceinline__ void attn_store_o(const f32x16 (&o)[2], float l, bf16_t* orow, int hi) {
    const float rl = 1.0f / l;
#pragma unroll
    for (int db = 0; db < 2; ++db)
#pragma unroll
        for (int rq = 0; rq < 4; ++rq) { u32x2 w; w.x = cvtpk(o[db][4 * rq] * rl, o[db][4 * rq + 1] * rl); w.y = cvtpk(o[db][4 * rq + 2] * rl, o[db][4 * rq + 3] * rl);
            *(u32x2*)(orow + 32 * db + 8 * rq + 4 * hi) = w; }
}

__device__ __forceinline__ void swa_unit(Frame& F, int unit, const float* sinks) {
    const bf16_t* Z = (const bf16_t*)(F.ws + WS_Z); bf16_t* YS = (bf16_t*)(F.ws + WS_YS);
    const int b = unit >> 6, kvh = (unit >> 4) & 3, nb = unit & 15;
    const int tid = F.tid, lane = F.lane, r32 = lane & 31, hi = lane >> 5, w = F.wave;
    LAS char* Kl = (LAS char*)F.lds; LAS char* Vl = (LAS char*)F.lds + 32768;
    const int t0 = nb * 128;
    {
        const int kv = tid >> 3, c = tid & 7;
#pragma unroll
        for (int tl = 0; tl < 4; ++tl) {
            if (nb > 0 || tl >= 2) {
                const size_t row = (size_t)(b * SEQ + t0 - 128 + tl * 64 + kv);
                const u32x4 kr = *(const u32x4*)(Z + row * ZP + ZK + kvh * 64 + c * 8);
                const u32x4 vr = *(const u32x4*)(Z + row * ZP + ZV + kvh * 64 + c * 8);
                attn_store_kv(Kl + tl * 8192, Vl + tl * 8192, kr, vr, tid);
            }
        }
    }
    __syncthreads();
    const int qh = kvh * 4 + (w >> 1);
    const float slope2 = exp2f(-0.5f * (float)(qh + 1)) * LOG2E;
    const float sink2 = sinks[qh] * LOG2E;
#pragma unroll 1
    for (int sb = 0; sb < 2; ++sb) {
        const int r0 = 64 * (w & 1) + 32 * sb;
        const int qrel = r0 + r32;
        const size_t qrow = (size_t)(b * SEQ + t0 + qrel);
        bf16x8 qf[4];
#pragma unroll
        for (int s = 0; s < 4; ++s) qf[s] = *(const bf16x8*)(Z + qrow * ZP + ZQ + qh * 64 + 16 * s + 8 * hi);
        f32x16 o[2]; o[0] = f32x16{}; o[1] = f32x16{};
        float m = sink2, l = 1.0f;
        const int tl0 = (r0 + 1) >> 6;
#pragma unroll 1
        for (int tt = 0; tt < 3; ++tt) {
            const int tl = tl0 + tt;
            if (nb == 0 && tl < 2) continue;
            f32x16 p[2];
            attn_qk(p, qf, Kl + tl * 8192, r32, hi);
#pragma unroll
            for (int kb = 0; kb < 2; ++kb)
#pragma unroll
                for (int r = 0; r < 16; ++r) {
                    const int krel = tl * 64 + 32 * kb + crow(r, hi) - 128;
                    const int dist = qrel - krel;
                    const float s = p[kb][r] - slope2 * (float)dist;
                    p[kb][r] = (dist >= 0 && dist < 128) ? s : -INFINITY;
                }
            attn_softmax_pv(p, o, m, l, Vl + tl * 8192, lane);
        }
        attn_store_o(o, l, YS + qrow * 1024 + qh * 64, hi);
    }
    __syncthreads();
}

__device__ __forceinline__ void fox_unit(Frame& F, int bh, int qb, LAS const float* c2) {
    const bf16_t* Z = (const bf16_t*)(F.ws + WS_Z); bf16_t* YF = (bf16_t*)(F.ws + WS_YF);
    const int b = bh >> 4, h = bh & 15;
    const int tid = F.tid, lane = F.lane, r32 = lane & 31, hi = lane >> 5, w = F.wave;
    LAS char* Kl = (LAS char*)F.lds; LAS char* Vl = (LAS char*)F.lds + 16384;
    const int q0 = qb * 256, qw = q0 + 32 * w, qabs = qw + r32;
    const size_t qrow = (size_t)(b * SEQ + qabs);
    const int NT = 4 * (qb + 1);
    const int kvr = tid >> 3, kc = tid & 7;
    const bf16_t* kbase = Z + (size_t)(b * SEQ + kvr) * ZP + ZFK + h * 64 + kc * 8;
    const bf16_t* vbase = Z + (size_t)(b * SEQ + kvr) * ZP + ZFV + h * 64 + kc * 8;
    u32x4 kr = *(const u32x4*)kbase, vr = *(const u32x4*)vbase;
    bf16x8 qf[4];
#pragma unroll
    for (int s = 0; s < 4; ++s) qf[s] = *(const bf16x8*)(Z + qrow * ZP + ZFQ + h * 64 + 16 * s + 8 * hi);
    attn_store_kv(Kl, Vl, kr, vr, tid);
    __syncthreads();
    f32x16 o[2]; o[0] = f32x16{}; o[1] = f32x16{};
    float m = -1e30f, l = 0.f;
#pragma unroll 1
    for (int t = 0; t < NT; ++t) {
        const int buf = t & 1;
        if (t + 1 < NT) { kr = *(const u32x4*)(kbase + (size_t)(t + 1) * 64 * ZP); vr = *(const u32x4*)(vbase + (size_t)(t + 1) * 64 * ZP); }
        const int k0 = t * 64;
        if (k0 <= qw + 31) {
            f32x16 p[2];
            attn_qk(p, qf, Kl + buf * 8192, r32, hi);
            const bool diag = (k0 + 63 > qw);
#pragma unroll
            for (int kb = 0; kb < 2; ++kb)
#pragma unroll
                for (int rq = 0; rq < 4; ++rq) {
                    const int kk = k0 + 32 * kb + 8 * rq + 4 * hi;
                    const f32x4 cc = *(const LAS f32x4*)(c2 + kk);
#pragma unroll
                    for (int j = 0; j < 4; ++j) { float s = p[kb][4 * rq + j] - cc[j]; if (diag && (kk + j > qabs)) s = -INFINITY; p[kb][4 * rq + j] = s; }
                }
            attn_softmax_pv(p, o, m, l, Vl + buf * 8192, lane);
        }
        if (t + 1 < NT) attn_store_kv(Kl + (buf ^ 1) * 8192, Vl + (buf ^ 1) * 8192, kr, vr, tid);
        __syncthreads();
    }
    attn_store_o(o, l, YF + qrow * 1024 + h * 64, hi);
}
__device__ __forceinline__ void p2_attention(Frame& F, const Args& a) {
    for (int u = F.vcu; u < 256; u += F.G) swa_unit(F, u, a.in[4]);
    LAS float* c2 = (LAS float*)(F.lds + 32768);
    LAS float* wtot = (LAS float*)(F.lds + 32768 + 8192);
    const float* FL = (const float*)(F.ws + WS_FL);
    for (int it = F.vcu; it < 256; it += F.G) {
        const int bh = it >> 2, s = it & 3, b = bh >> 4, h = bh & 15;
        {
            float v[4]; float run = 0.f;
#pragma unroll
            for (int j = 0; j < 4; ++j) { run += FL[(size_t)(b * SEQ + 4 * F.tid + j) * 16 + h]; v[j] = run; }
            float inc = run;
#pragma unroll
            for (int o = 1; o < 64; o <<= 1) { const float n = __shfl_up(inc, o); if (F.lane >= o) inc += n; }
            if (F.lane == 63) wtot[F.wave] = inc;
            __syncthreads();
            float base = inc - run;
            for (int ww = 0; ww < F.wave; ++ww) base += wtot[ww];
#pragma unroll
            for (int j = 0; j < 4; ++j) c2[4 * F.tid + j] = base + v[j];
            __syncthreads();
        }
        fox_unit(F, bh, s, c2);
        fox_unit(F, bh, 7 - s, c2);
        __syncthreads();
    }
}

__device__ __forceinline__ void p5_router(Frame& F, const Args& a, unsigned* CNT, float* LISTW, int* LIST) {
    const float* H1 = (const float*)(F.ws + WS_H1); const float* PSQ = (const float*)(F.ws + WS_PSQ); const float* WRG = (const float*)(F.ws + WS_WRG);
    unsigned char* V8 = F.ws + WS_V;
    const float* g = a.in[8]; const float* rbias = a.in[10];
    const int lane = F.lane, w = F.wave, tid = F.tid;
    LAS float* part = (LAS float*)F.lds;
    LAS float* logit = (LAS float*)(F.lds + 65536);
    LAS float* rinvs = (LAS float*)(F.lds + 65536 + 8192);
    LAS int* lcnt = (LAS int*)(F.lds + 65536 + 8192 + 128);
    LAS int* gbase = (LAS int*)(F.lds + 65536 + 8192 + 128 + 256);
    for (int tile = F.vcu; tile < T / 32; tile += F.G) {
        const int tok0 = tile * 32;
        if (tid < 64) lcnt[tid] = 0;
#pragma unroll 1
        for (int j = 0; j < 4; ++j) {
            const int tok = tok0 + 4 * w + j;
            float sq = lane < 32 ? PSQ[(size_t)tok * 32 + lane] : 0.f;
            sq = wave_sum(sq);
            const float rinv = rsqrtf(sq * (1.f / D) + RMS_EPS);
            if (lane == 0) rinvs[4 * w + j] = rinv;
            const f32x4* hr = (const f32x4*)(H1 + (size_t)tok * D) + lane;
            unsigned* o = (unsigned*)(V8 + (size_t)tok * D) + lane;
#pragma unroll
            for (int jj = 0; jj < 8; ++jj) { const f32x4 hv = hr[64 * jj]; const f32x4 gg = *((const f32x4*)g + lane + 64 * jj);
                o[64 * jj] = pk_fp8x4(hv.x * rinv * gg.x, hv.y * rinv * gg.y, hv.z * rinv * gg.z, hv.w * rinv * gg.w); }
        }
        {
            f32x16 acc0 = {}, acc1 = {};
            const int tk = lane & 31, half = lane >> 5;
            const float* hp = H1 + (size_t)(tok0 + tk) * D + 256 * w + 4 * half;
            const float* wp = WRG + (size_t)(256 * w + 4 * half) * NE + tk;
#pragma unroll 4
            for (int kk = 0; kk < 32; ++kk) {
                const f32x4 av = *(const f32x4*)(hp + 8 * kk);
#pragma unroll
                for (int s = 0; s < 4; ++s) {
                    const float b0 = wp[(size_t)(8 * kk + s) * NE], b1 = wp[(size_t)(8 * kk + s) * NE + 32];
                    acc0 = __builtin_amdgcn_mfma_f32_32x32x2f32(av[s], b0, acc0, 0, 0, 0);
                    acc1 = __builtin_amdgcn_mfma_f32_32x32x2f32(av[s], b1, acc1, 0, 0, 0);
                }
            }
#pragma unroll
            for (int r = 0; r < 16; ++r) { const int tr = crow(r, half); part[(w * 32 + tr) * 64 + tk] = acc0[r]; part[(w * 32 + tr) * 64 + 32 + tk] = acc1[r]; }
        }
        __syncthreads();
#pragma unroll
        for (int q = 0; q < 4; ++q) { const int idx = tid + 512 * q; float s = 0.f;
#pragma unroll
            for (int ww = 0; ww < 8; ++ww) s += part[ww * 2048 + idx];
            logit[idx] = s * rinvs[idx >> 6]; }
        __syncthreads();
        int sel_k[4], sel_ls[4]; float sel_w[4];
        const float bias = rbias[lane];
#pragma unroll
        for (int j = 0; j < 4; ++j) {
            const int tl = 4 * w + j;
            const float score = sigmoidf_(logit[tl * 64 + lane]);
            const float biased = score + bias;
            float m1 = biased; m1 = fmaxf(m1, __shfl_xor(m1, 1)); m1 = fmaxf(m1, __shfl_xor(m1, 2)); m1 = fmaxf(m1, __shfl_xor(m1, 4));
            const unsigned long long gm = 0xFFull << (lane & 56);
            const unsigned long long b1 = __ballot(biased == m1) & gm;
            const int i1 = __builtin_ctzll(b1);
            float v2 = (lane == i1) ? -INFINITY : biased;
            float m2 = v2; m2 = fmaxf(m2, __shfl_xor(m2, 1)); m2 = fmaxf(m2, __shfl_xor(m2, 2)); m2 = fmaxf(m2, __shfl_xor(m2, 4));
            const float gs = m1 + m2; const int gi = lane >> 3;
            int rank = 0;
#pragma unroll
            for (int gg = 0; gg < 8; ++gg) { const float o = __shfl(gs, 8 * gg); rank += (o > gs || (o == gs && gg < gi)) ? 1 : 0; }
            float mv = rank < 4 ? biased : -INFINITY;
            int myk = -1;
#pragma unroll
            for (int it = 0; it < 8; ++it) { const float mx = wave_max(mv); const unsigned long long bb = __ballot(mv == mx); const int sl = __builtin_ctzll(bb); if (lane == sl) { myk = it; mv = -INFINITY; } }
            const float ssum = wave_sum(myk >= 0 ? score : 0.f);
            sel_k[j] = myk; sel_w[j] = score / ssum * 2.5f;
            sel_ls[j] = 0;
            if (myk >= 0) sel_ls[j] = __hip_atomic_fetch_add((LAS int*)&lcnt[lane], 1, __ATOMIC_RELAXED, __HIP_MEMORY_SCOPE_WORKGROUP);
        }
        __syncthreads();
        if (tid < 64) gbase[tid] = (int)atomicAdd(CNT + tid, (unsigned)lcnt[tid]);
        __syncthreads();
#pragma unroll
        for (int j = 0; j < 4; ++j) if (sel_k[j] >= 0) { const int tok = tok0 + 4 * w + j; const int aid = tok * 8 + sel_k[j];
            const size_t li = (size_t)lane * T + gbase[lane] + sel_ls[j]; LIST[li] = aid; LISTW[li] = sel_w[j]; }
        __syncthreads();
    }
}

template <int MULT> __device__ __forceinline__ int moe_table(Frame& F, LAS int* tab) {
    if (F.tid < 64) {
        const int cnt = (int)__hip_atomic_load(F.ctl + CW_CNT + F.tid, __ATOMIC_RELAXED, __HIP_MEMORY_SCOPE_AGENT);
        int inc = ((cnt + 255) >> 8) * MULT;
#pragma unroll
        for (int o = 1; o < 64; o <<= 1) { const int n = __shfl_up(inc, o); if (F.lane >= o) inc += n; }
        tab[F.tid] = inc; tab[64 + F.tid] = cnt;
    }
    __syncthreads();
    return 32 * MULT + tab[63];
}

__device__ __forceinline__ void p8_final(Frame& F, const Args& a) {
    const float* H1 = (const float*)(F.ws + WS_H1); const bf16_t* YB = (const bf16_t*)(F.ws + WS_YB); const float* g = a.in[17];
    const int gw = F.vcu * NWAVES + F.wave, NGW = F.G * NWAVES;
    for (int tok = gw; tok < T; tok += NGW) {
        const f32x4* hr = (const f32x4*)(H1 + (size_t)tok * D) + F.lane;
        f32x4 v[8];
#pragma unroll
        for (int j = 0; j < 8; ++j) v[j] = hr[64 * j];
#pragma unroll 1
        for (int k = 0; k < 9; ++k) {
            const size_t row = k < 8 ? (size_t)tok * 8 + k : (size_t)NASSIGN + tok;
            const u32x2* yr = (const u32x2*)(YB + row * D) + F.lane;
#pragma unroll
            for (int j = 0; j < 8; ++j) { const u32x2 y = yr[64 * j]; v[j].x += bflo(y.x); v[j].y += bfhi(y.x); v[j].z += bflo(y.y); v[j].w += bfhi(y.y); }
        }
        float s = 0.f;
#pragma unroll
        for (int j = 0; j < 8; ++j) s += (v[j].x * v[j].x + v[j].y * v[j].y) + (v[j].z * v[j].z + v[j].w * v[j].w);
        const float rinv = rsqrtf(wave_sum(s) * (1.f / D) + RMS_EPS);
        f32x4* o = (f32x4*)(a.out + (size_t)tok * D) + F.lane;
#pragma unroll
        for (int j = 0; j < 8; ++j) { const f32x4 gg = *((const f32x4*)g + F.lane + 64 * j); o[64 * j] = (f32x4){v[j].x * rinv * gg.x, v[j].y * rinv * gg.y, v[j].z * rinv * gg.z, v[j].w * rinv * gg.w}; }
    }
}

constexpr int N_PHASES = 9;
__global__ void __launch_bounds__(NTHREADS, 2) fwd_kernel(Args args) {
    extern __shared__ __attribute__((aligned(16))) unsigned char lds_raw[];
    Frame F;
    F.lds = (LAS unsigned char*)lds_raw;
    F.MISC = (volatile LAS unsigned*)(F.lds + MISC_OFF);
    F.tid = threadIdx.x; F.lane = F.tid & 63; F.wave = __builtin_amdgcn_readfirstlane(F.tid >> 6);
    F.G = gridDim.x; { const int bx = blockIdx.x; F.vcu = (F.G % 8 == 0) ? (bx % 8) * (F.G / 8) + bx / 8 : bx; }
    F.ws = args.ws; F.ctl = (unsigned*)(args.ws + WS_CTL);
    for (int u = F.tid; u < (LDS_BYTES - MISC_OFF) / 4; u += NTHREADS) ((LAS unsigned*)(F.lds + MISC_OFF))[u] = 0u;
    __syncthreads();
    const int lo = args.ph_lo, hi = args.ph_hi;
    XcdBarrier bar; bar.bar = F.ctl + CW_BAR; bar.x = 0; bar.st = nullptr;
    if (hi - lo > 1) bar = xcd_barrier_post(F.ctl + CW_BAR, F.MISC + 8);
#define IN(k) (lo <= (k) && (k) < hi)
#define SEAM(k) do { if (IN(k) && IN((k) + 1)) xcd_barrier(bar); } while (0)
    unsigned char* ws = args.ws;
    LAS int* tab = (LAS int*)(F.lds + MISC_OFF + 256);

#define REPS(k) for (int rep_ = 0; rep_ < (PROBE_DUP == (k) ? 2 : 1); ++rep_)
#define REPBAR(k) do { if (PROBE_DUP == (k) && rep_ == 0) xcd_barrier(bar); } while (0)
    if (IN(0)) { REPS(0) { p0_prologue(F, args); REPBAR(0); } SEAM(0); }
    if (IN(1)) {
        DenseSched S{(const char*)(ws + WS_U), (const char*)(ws + WS_WINT), T / 256, NIN / 256, D, F.G, (int)blockIdx.x, PROBE_DUP == 1 ? 2 : 1};
        EpiZ E{(bf16_t*)(ws + WS_Z), (float*)(ws + WS_FL), args.in[3]};
        pg8::gemm_phase<false>(F.lds, 2 * D, S, E);
        SEAM(1);
    }
    if (IN(2)) { REPS(2) { p2_attention(F, args); REPBAR(2); } SEAM(2); }
    if (IN(3)) {
        BranchSched S{(const char*)(ws + WS_YS), (const char*)(ws + WS_YF), (const char*)(ws + WS_WSWAT), (const char*)(ws + WS_WFOXT), T / 256, D / 256, 1024, F.G, (int)blockIdx.x, PROBE_DUP == 3 ? 2 : 1};
        EpiMix E{(const bf16_t*)(ws + WS_Z), (bf16_t*)(ws + WS_MIX)};
        pg8::gemm_phase<false>(F.lds, 2 * 1024, S, E);
        SEAM(3);
    }
    if (IN(4)) {
        DenseSched S{(const char*)(ws + WS_MIX), (const char*)(ws + WS_WOUTT), T / 256, D / 256, D, F.G, (int)blockIdx.x, PROBE_DUP == 4 ? 2 : 1};
        EpiOut E{args.in[0], (float*)(ws + WS_H1), (float*)(ws + WS_PSQ)};
        pg8::gemm_phase<false>(F.lds, 2 * D, S, E);
        SEAM(4);
    }
    if (IN(5)) {
        if (PROBE_DUP == 5) { p5_router(F, args, F.ctl + 256, (float*)(ws + WS_T1), (int*)(ws + WS_T1 + 2 * MiB)); xcd_barrier(bar); }
        p5_router(F, args, F.ctl + CW_CNT, (float*)(ws + WS_LISTW), (int*)(ws + WS_LIST));
        if (PROBE_DUP == 9) { for (int q = 0; q < 16; ++q) xcd_barrier(bar); }
        SEAM(5); }
    if (IN(6)) {
        const int total = moe_table<4>(F, tab);
        MoeSched<0> S{tab, (const int*)(ws + WS_LIST), (const float*)(ws + WS_LISTW), (const char*)(ws + WS_V), (const char*)(ws + WS_WGU), (LAS int*)(F.lds + MISC_OFF + 1024), (LAS float*)(F.lds + MISC_OFF + 4096), total, F.G, F.vcu, PROBE_DUP == 6 ? 2 : 1};
        EpiSwiglu E{&S, (unsigned char*)(ws + WS_HB)};
        pg8::gemm_phase<true>(F.lds, 2048, S, E);
        SEAM(6);
    }
    if (IN(7)) {
        const int total = moe_table<8>(F, tab);
        MoeSched<1> S{tab, (const int*)(ws + WS_LIST), (const float*)(ws + WS_LISTW), (const char*)(ws + WS_HB), (const char*)(ws + WS_WD), (LAS int*)(F.lds + MISC_OFF + 1024), (LAS float*)(F.lds + MISC_OFF + 4096), total, F.G, F.vcu, PROBE_DUP == 7 ? 2 : 1};
        EpiDown E{&S, (bf16_t*)(ws + WS_YB)};
        pg8::gemm_phase<true>(F.lds, 512, S, E);
        SEAM(7);
    }
    if (IN(8)) { REPS(8) { p8_final(F, args); REPBAR(8); } }
#undef IN
#undef SEAM
}

extern "C" void kernel_launch(void* const* d_in, const int* in_sizes, int n_in, void* d_out, int out_size, void* d_ws, size_t ws_size, hipStream_t stream) {
    static int grid = 0;
    if (grid == 0) {
        if (n_in != 18 || out_size != T * D || ws_size < WS_END) { fprintf(stderr, "kernel_launch: unexpected shapes (n_in %d out %d ws %zu)\n", n_in, out_size, ws_size); grid = -1; return; }
        int dev = 0, cus = 0, per_cu = 0;
        if (hipGetDevice(&dev) != hipSuccess || hipDeviceGetAttribute(&cus, hipDeviceAttributeMultiprocessorCount, dev) != hipSuccess) { grid = -1; return; }
        if (hipFuncSetAttribute((const void*)fwd_kernel, hipFuncAttributeMaxDynamicSharedMemorySize, LDS_BYTES) != hipSuccess) { fprintf(stderr, "kernel_launch: hipFuncSetAttribute failed\n"); grid = -1; return; }
        if (hipOccupancyMaxActiveBlocksPerMultiprocessor(&per_cu, (const void*)fwd_kernel, NTHREADS, LDS_BYTES) != hipSuccess || per_cu < 1) { fprintf(stderr, "kernel_launch: occupancy query says %d blocks per CU\n", per_cu); (void)hipGetLastError(); grid = -1; return; }
        grid = cus;
        if (grid % 8 != 0 || grid > 256) grid = (grid / 8) * 8 > 256 ? 256 : (grid / 8) * 8;
    }
    if (grid <= 0) return;
    (void)hipMemsetAsync((char*)d_ws + WS_CTL, 0, CTL_ZERO_BYTES, stream);
    Args a{};
    for (int i = 0; i < 18; ++i) a.in[i] = (const float*)d_in[i];
    a.out = (float*)d_out; a.ws = (unsigned char*)d_ws;
#if MK_N_LAUNCHES == 1
    a.ph_lo = 0; a.ph_hi = N_PHASES;
    hipLaunchKernelGGL(fwd_kernel, dim3(grid), dim3(NTHREADS), LDS_BYTES, stream, a);
#else
    for (int p = 0; p < N_PHASES; ++p) { a.ph_lo = p; a.ph_hi = p + 1; hipLaunchKernelGGL(fwd_kernel, dim3(grid), dim3(NTHREADS), LDS_BYTES, stream, a); }
#endif
}
```

```cpp
#include <hip/hip_runtime.h>
#include <cstdio>
#include <cstdint>

#ifndef MK_N_LAUNCHES
#define MK_N_LAUNCHES 1
#endif
#define PROBE_DUP -1

#define LAS __attribute__((address_space(3)))
#define GAS __attribute__((address_space(1)))
typedef unsigned short bf16_t;
typedef short bf16x8 __attribute__((ext_vector_type(8)));
typedef short s16x4 __attribute__((ext_vector_type(4)));
typedef float f32x2 __attribute__((ext_vector_type(2)));
typedef float f32x4 __attribute__((ext_vector_type(4)));
typedef float f32x16 __attribute__((ext_vector_type(16)));
typedef unsigned u32x2 __attribute__((ext_vector_type(2)));
typedef unsigned u32x4 __attribute__((ext_vector_type(4)));
typedef __bf16 bf16x2_t __attribute__((ext_vector_type(2)));

constexpr int T = 8192, D = 2048, SEQ = 2048, NBATCH = 4;
constexpr int NE = 64, FF = 512, TOPK = 8;
constexpr int ZP = 8704;
constexpr int ZQ = 0, ZK = 1024, ZV = 1280, ZFQ = 1536, ZFK = 2560, ZFV = 3584, ZGS = 4608, ZGF = 6656;
constexpr int NIN = 8960;
constexpr float RMS_EPS = 1e-6f;
constexpr float LOG2E = 1.4426950408889634f;
constexpr float QSCALE = 0.125f * LOG2E;
constexpr int NASSIGN = T * TOPK;
constexpr int NROWS_H = NASSIGN + T;

constexpr size_t MiB = 1u << 20;
constexpr size_t WS_CTL = 0, CTL_ZERO_BYTES = 64 * 1024;
constexpr size_t WS_FL = 1 * MiB;
constexpr size_t WS_WTS = 1 * MiB + 512 * 1024;
constexpr size_t WS_LIST = 2 * MiB;
constexpr size_t WS_WSWAT = 4 * MiB, WS_WFOXT = 8 * MiB, WS_WOUTT = 12 * MiB;
constexpr size_t WS_WINT = 20 * MiB;
constexpr size_t WS_WRG = 55 * MiB;
constexpr size_t WS_PSQ = 55 * MiB + 512 * 1024;
constexpr size_t WS_U = 56 * MiB;
constexpr size_t WS_Z = 88 * MiB;
constexpr size_t WS_YS = 224 * MiB, WS_YF = 240 * MiB;
constexpr size_t WS_T1 = 256 * MiB;
constexpr size_t WS_MIX = 320 * MiB;
constexpr size_t WS_H1 = 352 * MiB;
constexpr size_t WS_V = 416 * MiB;
constexpr size_t WS_HB = 448 * MiB;
constexpr size_t WS_WGU = 520 * MiB;
constexpr size_t WS_WD = 780 * MiB;
constexpr size_t WS_YB = 56 * MiB;
constexpr size_t WS_LISTW = 910 * MiB;
constexpr size_t WS_END = 912 * MiB;
static_assert(WS_YB + (size_t)NROWS_H * D * 2 <= WS_MIX + 32 * MiB, "YB overlay");
constexpr int CW_CNT = 64;
constexpr int CW_BAR = 4096;

constexpr int RING_BYTES = 131072;
constexpr int MISC_OFF = 139264;
constexpr int LDS_BYTES = 147456;
constexpr int NWAVES = 8, NTHREADS = 512;

__device__ __forceinline__ unsigned cvtpk(float lo, float hi) { f32x2 v = {lo, hi}; bf16x2_t b = __builtin_convertvector(v, bf16x2_t); return __builtin_bit_cast(unsigned, b); }
__device__ __forceinline__ float bf2f(bf16_t h) { return __builtin_bit_cast(float, (unsigned)h << 16); }
__device__ __forceinline__ float bflo(unsigned w) { return __builtin_bit_cast(float, w << 16); }
__device__ __forceinline__ float bfhi(unsigned w) { return __builtin_bit_cast(float, w & 0xffff0000u); }
__device__ __forceinline__ float wave_sum(float v) {
#pragma unroll
    for (int o = 1; o < 64; o <<= 1) v += __shfl_xor(v, o);
    return v;
}
__device__ __forceinline__ float wave_max(float v) {
#pragma unroll
    for (int o = 1; o < 64; o <<= 1) v = fmaxf(v, __shfl_xor(v, o));
    return v;
}
__device__ __forceinline__ float sigmoidf_(float x) { return 1.0f / (1.0f + __expf(-x)); }
#define LDS_WAIT() asm volatile("s_waitcnt lgkmcnt(0)" ::: "memory")
#define VM_WAIT() asm volatile("s_waitcnt vmcnt(0)" ::: "memory")

#define XB_TMO      128
#define XB_XCNT(j)  (256  + 64 * (j))
#define XB_XSUB(j)  (1280 + 64 * (j))
#define XB_XGEN(j)  (2304 + 64 * (j))
#define XB_TOP      3328
#define XB_TOPGEN   3392
#define XCD_BAR_WORDS 3456
#define XB_SPIN_CAP (1u << 20)
__device__ __forceinline__ unsigned xb_ld(unsigned* p)              { return __hip_atomic_load(p, __ATOMIC_RELAXED, __HIP_MEMORY_SCOPE_AGENT); }
__device__ __forceinline__ unsigned xb_add(unsigned* p, unsigned v) { return __hip_atomic_fetch_add(p, v, __ATOMIC_RELAXED, __HIP_MEMORY_SCOPE_AGENT); }
__device__ __forceinline__ unsigned xb_xcc_id() { return (unsigned)__builtin_amdgcn_s_getreg((3 << 11) | 20) & 0xFu; }
#define XB_SPIN(cond, bar) do { unsigned _sp = 0; while (cond) { __builtin_amdgcn_s_sleep(1); \
    if ((++_sp & 255u) == 0u) { if (xb_ld(&(bar)[XB_TMO])) break; if (_sp > XB_SPIN_CAP) { atomicAdd(&(bar)[XB_TMO], 1u); break; } } } } while (0)
struct XcdBarrier { unsigned* bar; unsigned x; volatile LAS unsigned* st; };
__device__ __forceinline__ XcdBarrier xcd_barrier_post(unsigned* bar, volatile LAS unsigned* st) {
    XcdBarrier b; b.bar = bar; b.x = xb_xcc_id(); b.st = st;
    if (threadIdx.x == 0) (void)xb_add(&bar[XB_XCNT(b.x)], 1u);
    return b;
}
__device__ __forceinline__ void xcd_barrier_complete(unsigned* bar, unsigned x, unsigned& nloc, unsigned& nx) {
    const unsigned G = gridDim.x * gridDim.y * gridDim.z;
    unsigned sum, cnt, mine, sp = 0u;
    for (;;) {
        sum = 0u; cnt = 0u; mine = 0u;
#pragma unroll
        for (unsigned j = 0; j < 16; ++j) { const unsigned c = xb_ld(&bar[XB_XCNT(j)]); sum += c; cnt += (c > 0u) ? 1u : 0u; mine = (j == x) ? c : mine; }
        if (sum == G) break;
        __builtin_amdgcn_s_sleep(1);
        if ((++sp & 255u) == 0u) { if (xb_ld(&bar[XB_TMO])) break; if (sp > XB_SPIN_CAP) { atomicAdd(&bar[XB_TMO], 1u); break; } }
    }
    nloc = mine > 0u ? mine : 1u; nx = cnt > 0u ? cnt : 1u;
}
__device__ __forceinline__ void xcd_barrier(const XcdBarrier& b) {
    asm volatile("s_waitcnt vmcnt(0)" ::: "memory");
    __syncthreads();
    if (threadIdx.x == 0) {
        unsigned* bar = b.bar;
        __builtin_amdgcn_s_waitcnt(0);
        unsigned nloc = b.st[0], nx = b.st[1];
        if (nloc == 0u) { xcd_barrier_complete(bar, b.x, nloc, nx); b.st[0] = nloc; b.st[1] = nx; }
        const unsigned old = xb_add(&bar[XB_XSUB(b.x)], 1u);
        const unsigned gen = old / nloc;
        if (old + 1u == (gen + 1u) * nloc) {
            __builtin_amdgcn_fence(__ATOMIC_RELEASE, "agent");
            asm volatile("s_waitcnt vmcnt(0)" ::: "memory");
            const unsigned og = xb_add(&bar[XB_TOP], 1u);
            const unsigned tg = og / nx;
            if (og + 1u == (tg + 1u) * nx) xb_add(&bar[XB_TOPGEN], 1u);
            else XB_SPIN(xb_ld(&bar[XB_TOPGEN]) == tg, bar);
            __builtin_amdgcn_fence(__ATOMIC_ACQUIRE, "agent");
            xb_add(&bar[XB_XGEN(b.x)], 1u);
            asm volatile("s_waitcnt vmcnt(0)" ::: "memory");
        } else {
            XB_SPIN(xb_ld(&bar[XB_XGEN(b.x)]) == gen, bar);
            __builtin_amdgcn_fence(__ATOMIC_ACQUIRE, "agent");
            asm volatile("s_waitcnt vmcnt(0)" ::: "memory");
        }
    }
    __syncthreads();
}

namespace pg8 {
constexpr int BM = 256, BK = 64, HALF = 128, HTB = HALF * BK * 2, STAGE_BYTES = 8 * HTB, NXCD = 8, WGM = 8;
__host__ __device__ __forceinline__ int lds_byte(int r, int c) { const int st = (r >> 4) * 2 + (c >> 5), rr = r & 15, cc = c & 31, ob = rr * 64 + cc * 2; return st * 1024 + (ob ^ (((ob >> 9) & 1) << 5)); }
__host__ __device__ __forceinline__ void stage_rc(int b, int& R, int& C) { const int st = b / 1024, sb = b % 1024, swz = sb ^ (((sb >> 9) & 1) << 5); R = (st >> 1) * 16 + swz / 64; C = (st & 1) * 32 + (swz % 64) / 2; }
__host__ __device__ __forceinline__ int perm32(int rho) { const int n = rho >> 4, i = rho & 15; return 8 * (i >> 2) + 4 * n + (i & 3); }

struct Unit { const char* A; const char* B; int pm, pn, e, rt; };

__device__ __forceinline__ void static_tile(int L, int nM, int nN, int& pm, int& pn) {
    const int nwg = nM * nN; int wgid = L;
    { const int q = nwg / NXCD, r = nwg % NXCD, xcd = wgid % NXCD, off = wgid / NXCD; wgid = (xcd < r ? xcd * (q + 1) : r * (q + 1) + (xcd - r) * q) + off; }
    const int nig = WGM * nN, gid = wgid / nig, fm = gid * WGM, gsz = (nM - fm) < WGM ? (nM - fm) : WGM;
    pm = fm + ((wgid % nig) % gsz); pn = (wgid % nig) / gsz;
}

typedef int v4i_t __attribute__((ext_vector_type(4)));
typedef int v8i_t __attribute__((ext_vector_type(8)));
template <bool FP8, class Epi, class Sched>
__device__ __forceinline__ void gemm_phase(LAS unsigned char* lds, const int Kb, const Sched& S, const Epi& E) {
    const int tid = threadIdx.x, wid = __builtin_amdgcn_readfirstlane(tid >> 6), lane = tid & 63, wr = wid >> 2, wc = wid & 3, fr = lane & 15, fq = lane >> 4;
    const int nt = Kb / 128;
    int Ri[2], Ci[2]; unsigned voffB[2];
#pragma unroll
    for (int i = 0; i < 2; ++i) { int R, C; stage_rc(tid * 16 + i * 8192, R, C); Ri[i] = R; Ci[i] = C; const int Rb = (R & ~31) + perm32(R & 31); voffB[i] = (unsigned)(Rb * Kb + C * 2); }
    const size_t kstep = (size_t)(BK * 2);
    const size_t hstep = (size_t)HALF * Kb;
    const unsigned ldsw = (unsigned)wid * 1024u;
    const int aoff = lds_byte(wr * 64 + fr, fq * 8), boff = lds_byte(wc * 32 + fr, fq * 8);
#define PG8_SA(b, h) (((b) * 2 + (h)) * HTB)
#define PG8_SB(b, h) ((4 + (b) * 2 + (h)) * HTB)
#define PG8_STAGE(bufoff, gbase, voff) do { _Pragma("unroll") for (int _i = 0; _i < 2; ++_i) \
        __builtin_amdgcn_global_load_lds((const unsigned*)((const char*)(gbase) + (voff)[_i]), (LAS unsigned*)(lds + (bufoff) + ldsw + _i * 8192), 16, 0, 0); } while (0)
#define PG8_LDA(dst, b, h) do { if constexpr (FP8) { _Pragma("unroll") for (int m = 0; m < 4; ++m) { dst##8[m].lo = *(const LAS v4i_t*)(lds + PG8_SA(b, h) + aoff + m * 2048); dst##8[m].hi = *(const LAS v4i_t*)(lds + PG8_SA(b, h) + aoff + m * 2048 + 1024); } } \
        else { _Pragma("unroll") for (int m = 0; m < 4; ++m) _Pragma("unroll") for (int k = 0; k < 2; ++k) dst[m][k] = *(const LAS bf16x8*)(lds + PG8_SA(b, h) + aoff + m * 2048 + k * 1024); } } while (0)
#define PG8_LDB(dst, b, h) do { if constexpr (FP8) { _Pragma("unroll") for (int n = 0; n < 2; ++n) { dst##8[n].lo = *(const LAS v4i_t*)(lds + PG8_SB(b, h) + boff + n * 2048); dst##8[n].hi = *(const LAS v4i_t*)(lds + PG8_SB(b, h) + boff + n * 2048 + 1024); } } \
        else { _Pragma("unroll") for (int n = 0; n < 2; ++n) _Pragma("unroll") for (int k = 0; k < 2; ++k) dst[n][k] = *(const LAS bf16x8*)(lds + PG8_SB(b, h) + boff + n * 2048 + k * 1024); } } while (0)
#define PG8_MMA(ai, bj, At, Bt) do { __builtin_amdgcn_s_setprio(1); \
        if constexpr (FP8) { _Pragma("unroll") for (int m = 0; m < 4; ++m) _Pragma("unroll") for (int n = 0; n < 2; ++n) \
            asm volatile("v_mfma_scale_f32_16x16x128_f8f6f4 %0, %1, %2, %0, %3, %3 op_sel_hi:[0,0,0]" : "+v"(acc[ai][bj][m][n]) : "v"(Bt##8[n]), "v"(At##8[m]), "v"(sc8)); } \
        else { _Pragma("unroll") for (int m = 0; m < 4; ++m) _Pragma("unroll") for (int n = 0; n < 2; ++n) _Pragma("unroll") for (int k = 0; k < 2; ++k) \
            acc[ai][bj][m][n] = __builtin_amdgcn_mfma_f32_16x16x32_bf16(Bt[n][k], At[m][k], acc[ai][bj][m][n], 0, 0, 0); } \
        __builtin_amdgcn_s_setprio(0); } while (0)
#define PG8_WAIT_V(n) asm volatile("s_waitcnt vmcnt(" #n ")" ::: "memory")
#define PG8_WAIT_L(n) asm volatile("s_waitcnt lgkmcnt(" #n ")" ::: "memory")
#define PG8_BAR __builtin_amdgcn_s_barrier()
#define PG8_SCHED __builtin_amdgcn_sched_barrier(0)
    Unit cur, nxt; int ui = 0;
    if (!S.next(0, cur)) return;
    unsigned vc[2][2], vn[2][2];
    int pfa = -1; float pfw = 0.f;
    S.pf_issue(cur, pfa, pfw); S.pf_commit(0, pfa, pfw);
    asm volatile("s_waitcnt vmcnt(0) lgkmcnt(0)" ::: "memory"); PG8_BAR; asm volatile("" ::: "memory");
    S.rowoffs(cur, 0, vc, Ri, Ci);
    f32x4 acc[2][2][4][2];
#pragma unroll
    for (int a = 0; a < 2; ++a)
#pragma unroll
        for (int b = 0; b < 2; ++b)
#pragma unroll
            for (int m = 0; m < 4; ++m)
#pragma unroll
                for (int n = 0; n < 2; ++n) acc[a][b][m][n] = (f32x4){0.f, 0.f, 0.f, 0.f};
    const int sc8 = 0x7f7f7f7f;
    bf16x8 At[4][2], B0[2][2], B1[2][2]; v8i_t At8[4], B08[2], B18[2];
    const char* cA = cur.A; const char* cB = cur.B;
    PG8_STAGE(PG8_SB(0, 0), cB, voffB); PG8_STAGE(PG8_SB(0, 1), cB + hstep, voffB); PG8_STAGE(PG8_SA(0, 0), cA, vc[0]); PG8_STAGE(PG8_SA(0, 1), cA, vc[1]);
    if (wr == 1) PG8_BAR;
    PG8_WAIT_V(2); PG8_BAR;
    PG8_STAGE(PG8_SB(1, 0), cB + kstep, voffB); PG8_STAGE(PG8_SA(1, 0), cA + kstep, vc[0]); PG8_STAGE(PG8_SB(1, 1), cB + hstep + kstep, voffB);
    PG8_WAIT_V(6); PG8_BAR;
    for (;;) {
        const bool has_next = S.next(ui + 1, nxt);
        const int scur = ui % 3, snxt = (ui + 1) % 3;
        const char* nA = has_next ? nxt.A : cA; const char* nB = has_next ? nxt.B : cB;
        if (has_next) S.pf_issue(nxt, pfa, pfw);
        for (int t = 0; t < nt; t += 2) {
            const bool last = (t == nt - 2);
            if (t == (nt >= 8 ? nt - 4 : 0) && has_next) S.pf_commit(snxt, pfa, pfw);
            const char* a1 = cA + (size_t)(t + 1) * kstep;
            const char* a2 = last ? nA : cA + (size_t)(t + 2) * kstep; const char* b2 = last ? nB : cB + (size_t)(t + 2) * kstep;
            const char* a3 = a2 + kstep; const char* b3 = b2 + kstep;
            if (last) {
                if (has_next) S.rowoffs(nxt, snxt, vn, Ri, Ci);
                else { vn[0][0] = vc[0][0]; vn[0][1] = vc[0][1]; vn[1][0] = vc[1][0]; vn[1][1] = vc[1][1]; }
            }
            unsigned v2[2][2];
            v2[0][0] = last ? vn[0][0] : vc[0][0]; v2[0][1] = last ? vn[0][1] : vc[0][1]; v2[1][0] = last ? vn[1][0] : vc[1][0]; v2[1][1] = last ? vn[1][1] : vc[1][1];
            PG8_LDB(B0, 0, 0); PG8_LDB(B1, 0, 1); PG8_SCHED; PG8_LDA(At, 0, 0); PG8_STAGE(PG8_SA(1, 1), a1, vc[1]);
            PG8_WAIT_V(8); PG8_WAIT_L(0); PG8_BAR; PG8_MMA(0, 0, At, B0); PG8_MMA(0, 1, At, B1); PG8_BAR; PG8_SCHED;
            PG8_LDA(At, 0, 1); PG8_STAGE(PG8_SB(0, 0), b2, voffB); PG8_STAGE(PG8_SB(0, 1), b2 + hstep, voffB); PG8_STAGE(PG8_SA(0, 0), a2, v2[0]);
            PG8_WAIT_V(8); PG8_WAIT_L(0); PG8_BAR; PG8_MMA(1, 0, At, B0); PG8_MMA(1, 1, At, B1); PG8_BAR; PG8_SCHED;
            PG8_LDB(B0, 1, 0); PG8_LDB(B1, 1, 1); PG8_SCHED; PG8_LDA(At, 1, 0); PG8_STAGE(PG8_SA(0, 1), a2, v2[1]);
            PG8_WAIT_V(8); PG8_WAIT_L(0); PG8_BAR; PG8_MMA(0, 0, At, B0); PG8_MMA(0, 1, At, B1); PG8_BAR; PG8_SCHED;
            PG8_LDA(At, 1, 1); PG8_STAGE(PG8_SB(1, 0), b3, voffB); PG8_STAGE(PG8_SB(1, 1), b3 + hstep, voffB); PG8_STAGE(PG8_SA(1, 0), a3, v2[0]);
            PG8_WAIT_V(8); PG8_WAIT_L(0); PG8_BAR; PG8_MMA(1, 0, At, B0); PG8_MMA(1, 1, At, B1); PG8_BAR; PG8_SCHED;
        }
        if (wr == 0) PG8_BAR;
        if constexpr (FP8) {
            asm volatile("s_nop 15\n\ts_nop 15" ::: "memory");
#pragma unroll
            for (int a = 0; a < 2; ++a)
#pragma unroll
                for (int b = 0; b < 2; ++b)
#pragma unroll
                    for (int m = 0; m < 4; ++m)
#pragma unroll
                        for (int n = 0; n < 2; ++n) asm volatile("" : "+v"(acc[a][b][m][n]));
        }
        E(acc, cur, scur, wr, wc, fr, fq);
        if (!has_next) break;
#pragma unroll
        for (int a = 0; a < 2; ++a)
#pragma unroll
            for (int b = 0; b < 2; ++b)
#pragma unroll
                for (int m = 0; m < 4; ++m)
#pragma unroll
                    for (int n = 0; n < 2; ++n) acc[a][b][m][n] = (f32x4){0.f, 0.f, 0.f, 0.f};
        cur = nxt; cA = nA; cB = nB; ++ui;
        vc[0][0] = vn[0][0]; vc[0][1] = vn[0][1]; vc[1][0] = vn[1][0]; vc[1][1] = vn[1][1];
        if (wr == 1) PG8_BAR;
    }
    PG8_WAIT_V(0);
    PG8_BAR;
#undef PG8_SA
#undef PG8_SB
#undef PG8_STAGE
#undef PG8_LDA
#undef PG8_LDB
#undef PG8_MMA
#undef PG8_WAIT_V
#undef PG8_WAIT_L
#undef PG8_BAR
#undef PG8_SCHED
}
}
using pg8::Unit;

struct Args { const float* in[18]; float* out; unsigned char* ws; int ph_lo, ph_hi; };
struct Frame {
    LAS unsigned char* lds; volatile LAS unsigned* MISC; unsigned* ctl; unsigned char* ws;
    int tid, lane, wave, vcu, G;
};

struct DenseSched {
    const char* A; const char* Bt; int nM, nN, K, G, c, dup;
    __device__ __forceinline__ bool next(int i, Unit& u) const {
        int L = i * G + c; if (L >= nM * nN * dup) return false; if (L >= nM * nN) L -= nM * nN;
        int pm, pn; pg8::static_tile(L, nM, nN, pm, pn);
        u.pm = pm; u.pn = pn; u.e = 0; u.rt = 0; u.A = A + (size_t)pm * 256 * K * 2; u.B = Bt + (size_t)pn * 256 * K * 2; return true;
    }
    __device__ __forceinline__ void pf_issue(const Unit&, int&, float&) const {}
    __device__ __forceinline__ void pf_commit(int, int, float) const {}
    __device__ __forceinline__ void rowoffs(const Unit&, int, unsigned (&vo)[2][2], const int (&R)[2], const int (&C)[2]) const {
#pragma unroll
        for (int h = 0; h < 2; ++h)
#pragma unroll
            for (int i = 0; i < 2; ++i) vo[h][i] = (unsigned)((R[i] + 128 * h) * K + C[i]) * 2u;
    }
};
struct BranchSched {
    const char* A0; const char* A1; const char* B0; const char* B1; int nM, nN, K, G, c, dup;
    __device__ __forceinline__ bool next(int i, Unit& u) const {
        int L = (i >> 1) * G + c; if (L >= nM * nN * dup) return false; if (L >= nM * nN) L -= nM * nN;
        int pm, pn; pg8::static_tile(L, nM, nN, pm, pn);
        const int br = i & 1;
        u.pm = pm; u.pn = pn; u.e = br; u.rt = 0; u.A = (br ? A1 : A0) + (size_t)pm * 256 * K * 2; u.B = (br ? B1 : B0) + (size_t)pn * 256 * K * 2; return true;
    }
    __device__ __forceinline__ void pf_issue(const Unit&, int&, float&) const {}
    __device__ __forceinline__ void pf_commit(int, int, float) const {}
    __device__ __forceinline__ void rowoffs(const Unit&, int, unsigned (&vo)[2][2], const int (&R)[2], const int (&C)[2]) const {
#pragma unroll
        for (int h = 0; h < 2; ++h)
#pragma unroll
            for (int i = 0; i < 2; ++i) vo[h][i] = (unsigned)((R[i] + 128 * h) * K + C[i]) * 2u;
    }
};
template <int MODE> struct MoeSched {
    const LAS int* tab; const int* list; const float* listw; const char* A; const char* Bt; LAS int* rowA; LAS float* rowW; int total, G, vcu, dup;
    static constexpr int MULT = MODE == 0 ? 4 : 8, KB = MODE == 0 ? 2048 : 512  , NCOLS = MODE == 0 ? 1024 : 2048;
    __device__ __forceinline__ bool next(int i, Unit& u) const {
        int L = i * G + vcu; if (L >= total * dup) return false; if (L >= total) L -= total;
        int e, j, nrt;
        if (L < 32 * MULT) { e = 64; j = L; nrt = 32; }
        else {
            const int Lr = L - 32 * MULT; const int lane = threadIdx.x & 63;
            const int pin = tab[lane];
            const unsigned long long bal = __ballot(pin <= Lr);
            e = __builtin_popcountll(bal); e = e > 63 ? 63 : e;
            const int pex = e > 0 ? tab[e - 1] : 0; const int cnt = tab[64 + e];
            j = Lr - pex; nrt = (cnt + 255) >> 8; nrt = nrt < 1 ? 1 : nrt;
        }
        e = __builtin_amdgcn_readfirstlane(e); j = __builtin_amdgcn_readfirstlane(j); nrt = __builtin_amdgcn_readfirstlane(nrt);
        u.e = e; u.rt = j % nrt; u.pn = j / nrt; u.pm = 0;
        u.A = A; u.B = Bt + ((size_t)e * NCOLS + (size_t)u.pn * 256) * KB; return true;
    }
    __device__ __forceinline__ void pf_issue(const Unit& u, int& pa, float& pw) const {
        const int tid = threadIdx.x; pa = -1; pw = 0.f;
        if (tid < 256) { const int idx = u.rt * 256 + tid;
            if (u.e == 64) { pa = NASSIGN + idx; pw = 1.f; }
            else if (idx < tab[64 + u.e]) { pa = list[u.e * T + idx]; if (MODE == 1) pw = listw[u.e * T + idx]; } }
    }
    __device__ __forceinline__ void pf_commit(int s, int pa, float pw) const { const int tid = threadIdx.x; if (tid < 256) { rowA[s * 256 + tid] = pa; rowW[s * 256 + tid] = pw; } }
    __device__ __forceinline__ void rowoffs(const Unit& u, int s, unsigned (&vo)[2][2], const int (&R)[2], const int (&C)[2]) const {
#pragma unroll
        for (int h = 0; h < 2; ++h)
#pragma unroll
            for (int i = 0; i < 2; ++i) {
                int a = rowA[s * 256 + R[i] + 128 * h];
                unsigned row;
                if (MODE == 0) { a = a < 0 ? 0 : a; row = a < NASSIGN ? (unsigned)(a >> 3) : (unsigned)(a - NASSIGN); }
                else row = a < 0 ? 0u : (unsigned)a;
                vo[h][i] = row * (unsigned)KB + (unsigned)C[i] * 2u;
            }
    }
};

struct EpiZ {
    bf16_t* Z; float* FL; const float* fbias;
    __device__ __forceinline__ void operator()(const f32x4 (&acc)[2][2][4][2], const Unit& u, int slot, int wr, int wc, int fr, int fq) const {
        const int row0 = u.pm * 256 + wr * 64 + fr;
        if (u.pn == 34) {
            if (wc == 0 && fq < 2) {
                float fb[8];
#pragma unroll
                for (int j = 0; j < 8; ++j) fb[j] = fbias[8 * fq + j];
#pragma unroll
                for (int ai = 0; ai < 2; ++ai)
#pragma unroll
                    for (int m = 0; m < 4; ++m) {
                        float* o = FL + (size_t)(row0 + ai * 128 + m * 16) * 16 + 8 * fq;
#pragma unroll
                        for (int n = 0; n < 2; ++n) { f32x4 r;
#pragma unroll
                            for (int j = 0; j < 4; ++j) { const float x = acc[ai][0][m][n][j] + fb[4 * n + j]; const float ls = x >= 0.f ? -log1pf(expf(-x)) : x - log1pf(expf(x)); r[j] = ls * LOG2E; }
                            *(f32x4*)(o + 4 * n) = r; }
                    }
            }
            return;
        }
        const int mode = (u.pn < 4 || (u.pn >= 6 && u.pn < 10)) ? 1 : (u.pn >= 18 ? 2 : 0);
        const int col0 = u.pn * 256 + wc * 32 + 8 * fq;
#pragma unroll
        for (int ai = 0; ai < 2; ++ai)
#pragma unroll
            for (int m = 0; m < 4; ++m) { bf16_t* rowp = Z + (size_t)(row0 + ai * 128 + m * 16) * ZP + col0;
#pragma unroll
                for (int bj = 0; bj < 2; ++bj) { f32x4 v0 = acc[ai][bj][m][0], v1 = acc[ai][bj][m][1];
                    if (mode == 1) { v0 = v0 * QSCALE; v1 = v1 * QSCALE; }
                    else if (mode == 2) {
#pragma unroll
                        for (int j = 0; j < 4; ++j) { v0[j] = sigmoidf_(v0[j]); v1[j] = sigmoidf_(v1[j]); } }
                    u32x4 w; w.x = cvtpk(v0[0], v0[1]); w.y = cvtpk(v0[2], v0[3]); w.z = cvtpk(v1[0], v1[1]); w.w = cvtpk(v1[2], v1[3]);
                    *(u32x4*)(rowp + bj * 128) = w; } }
    }
};
struct EpiMix {
    const bf16_t* Z; bf16_t* MIX;
    __device__ __forceinline__ void operator()(const f32x4 (&acc)[2][2][4][2], const Unit& u, int slot, int wr, int wc, int fr, int fq) const {
        const int row0 = u.pm * 256 + wr * 64 + fr, col0 = u.pn * 256 + wc * 32 + 8 * fq;
        const int gcol = (u.e ? ZGF : ZGS) + col0;
#pragma unroll
        for (int ai = 0; ai < 2; ++ai)
#pragma unroll
            for (int m = 0; m < 4; ++m) { const size_t row = (size_t)(row0 + ai * 128 + m * 16);
#pragma unroll
                for (int bj = 0; bj < 2; ++bj) {
                    const u32x4 g = *(const u32x4*)(Z + row * ZP + gcol + bj * 128);
                    f32x4 v0 = acc[ai][bj][m][0], v1 = acc[ai][bj][m][1];
                    v0[0] *= bflo(g.x); v0[1] *= bfhi(g.x); v0[2] *= bflo(g.y); v0[3] *= bfhi(g.y);
                    v1[0] *= bflo(g.z); v1[1] *= bfhi(g.z); v1[2] *= bflo(g.w); v1[3] *= bfhi(g.w);
                    u32x4* mp = (u32x4*)(MIX + row * D + col0 + bj * 128);
                    if (u.e != 0) { const u32x4 t = *mp;
                        v0[0] += bflo(t.x); v0[1] += bfhi(t.x); v0[2] += bflo(t.y); v0[3] += bfhi(t.y);
                        v1[0] += bflo(t.z); v1[1] += bfhi(t.z); v1[2] += bflo(t.w); v1[3] += bfhi(t.w); }
                    u32x4 w; w.x = cvtpk(v0[0], v0[1]); w.y = cvtpk(v0[2], v0[3]); w.z = cvtpk(v1[0], v1[1]); w.w = cvtpk(v1[2], v1[3]);
                    *mp = w; } }
    }
};
struct EpiOut {
    const float* X; float* H1; float* PSQ;
    __device__ __forceinline__ void operator()(const f32x4 (&acc)[2][2][4][2], const Unit& u, int slot, int wr, int wc, int fr, int fq) const {
        const int row0 = u.pm * 256 + wr * 64 + fr, col0 = u.pn * 256 + wc * 32 + 8 * fq;
#pragma unroll
        for (int ai = 0; ai < 2; ++ai)
#pragma unroll
            for (int m = 0; m < 4; ++m) { const size_t row = (size_t)(row0 + ai * 128 + m * 16); float sq = 0.f;
#pragma unroll
                for (int bj = 0; bj < 2; ++bj) {
                    const float* xp = X + row * D + col0 + bj * 128; float* hp = H1 + row * D + col0 + bj * 128;
                    const f32x4 x0 = *(const f32x4*)xp, x1 = *(const f32x4*)(xp + 4);
                    const f32x4 h0 = acc[ai][bj][m][0] + x0, h1 = acc[ai][bj][m][1] + x1;
                    *(f32x4*)hp = h0; *(f32x4*)(hp + 4) = h1;
                    sq += (h0[0] * h0[0] + h0[1] * h0[1]) + (h0[2] * h0[2] + h0[3] * h0[3]) + (h1[0] * h1[0] + h1[1] * h1[1]) + (h1[2] * h1[2] + h1[3] * h1[3]); }
                sq += __shfl_xor(sq, 16); sq += __shfl_xor(sq, 32);
                if (fq == 0) PSQ[row * 32 + u.pn * 4 + wc] = sq; }
    }
};
__device__ __forceinline__ unsigned pk_fp8x4(float a, float b, float c, float d) {
    a = __builtin_amdgcn_fmed3f(a, -448.f, 448.f); b = __builtin_amdgcn_fmed3f(b, -448.f, 448.f); c = __builtin_amdgcn_fmed3f(c, -448.f, 448.f); d = __builtin_amdgcn_fmed3f(d, -448.f, 448.f);
    int r = __builtin_amdgcn_cvt_pk_fp8_f32(a, b, 0, false); r = __builtin_amdgcn_cvt_pk_fp8_f32(c, d, r, true); return (unsigned)r;
}
constexpr float WGU_SCALE = 32.f, WD_SCALE = 16.f;
struct EpiSwiglu {
    const MoeSched<0>* S; unsigned char* HB8;
    __device__ __forceinline__ void operator()(const f32x4 (&acc)[2][2][4][2], const Unit& u, int slot, int wr, int wc, int fr, int fq) const {
        const int ff0 = u.pn * 128 + wc * 32 + 8 * fq;
#pragma unroll
        for (int ai = 0; ai < 2; ++ai)
#pragma unroll
            for (int m = 0; m < 4; ++m) { const int a = S->rowA[slot * 256 + ai * 128 + wr * 64 + m * 16 + fr];
                if (a >= 0) { float h[8];
#pragma unroll
                    for (int n = 0; n < 2; ++n)
#pragma unroll
                        for (int j = 0; j < 4; ++j) { const float g = acc[ai][0][m][n][j] * (1.f / WGU_SCALE), up = acc[ai][1][m][n][j] * (1.f / WGU_SCALE); h[4 * n + j] = g * sigmoidf_(g) * up; }
                    u32x2 w; w.x = pk_fp8x4(h[0], h[1], h[2], h[3]); w.y = pk_fp8x4(h[4], h[5], h[6], h[7]);
                    *(u32x2*)(HB8 + (size_t)a * FF + ff0) = w; } }
    }
};
constexpr float YB_SCALE = 16.f;
struct EpiDown {
    const MoeSched<1>* S; unsigned char* YB8;
    __device__ __forceinline__ void operator()(const f32x4 (&acc)[2][2][4][2], const Unit& u, int slot, int wr, int wc, int fr, int fq) const {
        const int col0 = u.pn * 256 + wc * 32 + 8 * fq;
#pragma unroll
        for (int ai = 0; ai < 2; ++ai)
#pragma unroll
            for (int m = 0; m < 4; ++m) { const int ri = slot * 256 + ai * 128 + wr * 64 + m * 16 + fr; const int a = S->rowA[ri];
                if (a >= 0) { const float w8 = S->rowW[ri] * (YB_SCALE / WD_SCALE);
#pragma unroll
                    for (int bj = 0; bj < 2; ++bj) { const f32x4 v0 = acc[ai][bj][m][0] * w8, v1 = acc[ai][bj][m][1] * w8;
                        u32x2 w; w.x = pk_fp8x4(v0[0], v0[1], v0[2], v0[3]); w.y = pk_fp8x4(v1[0], v1[1], v1[2], v1[3]);
                        *(u32x2*)(YB8 + (size_t)a * D + col0 + bj * 128) = w; } } }
    }
};

struct P0Item { const float* src; unsigned char* dst; int ldw, nvalid, K, fp8; float scale; };
__device__ __forceinline__ P0Item p0_decode(int pr, int half, const Args& a, unsigned char* ws) {
    constexpr int P_IN = 16 * 140, P_SW = 8 * 32, P_OUT = 16 * 32, P_GU = 16 * 8, P_DN = 4 * 32, P_EXP = 2 * P_GU + P_DN;
    P0Item q; q.fp8 = 0; q.scale = 1.f; int r = pr;
    if (r < P_IN) { const int kb = 2 * (r / 140) + half, nb = r % 140, n0 = nb * 64;
        int c0, nv; if (n0 < 4608) { c0 = n0; nv = 64; } else if (n0 < 8704) { c0 = n0 + 16; nv = 64; } else if (n0 == 8704) { c0 = 4608; nv = 16; } else { c0 = 0; nv = 0; }
        q.src = a.in[2] + (size_t)kb * 64 * 8720 + c0; q.ldw = 8720; q.nvalid = nv; q.K = D; q.dst = ws + WS_WINT + ((size_t)n0 * D + kb * 64) * 2; return q; }
    r -= P_IN;
    if (r < P_SW) { const int kb = 2 * (r / 32) + half, nb = r % 32; q.src = a.in[5] + (size_t)kb * 64 * D + nb * 64; q.ldw = D; q.nvalid = 64; q.K = 1024; q.dst = ws + WS_WSWAT + ((size_t)nb * 64 * 1024 + kb * 64) * 2; return q; }
    r -= P_SW;
    if (r < P_SW) { const int kb = 2 * (r / 32) + half, nb = r % 32; q.src = a.in[6] + (size_t)kb * 64 * D + nb * 64; q.ldw = D; q.nvalid = 64; q.K = 1024; q.dst = ws + WS_WFOXT + ((size_t)nb * 64 * 1024 + kb * 64) * 2; return q; }
    r -= P_SW;
    if (r < P_OUT) { const int kb = 2 * (r / 32) + half, nb = r % 32; q.src = a.in[7] + (size_t)kb * 64 * D + nb * 64; q.ldw = D; q.nvalid = 64; q.K = D; q.dst = ws + WS_WOUTT + ((size_t)nb * 64 * D + kb * 64) * 2; return q; }
    r -= P_OUT;
    const int e = r / P_EXP; r -= e * P_EXP; q.fp8 = 1;
    if (r < 2 * P_GU) { const int up = r >= P_GU; r -= up * P_GU; const int kb = 2 * (r / 8) + half, nb = r % 8, n0 = nb * 64;
        const float* src = e < 64 ? (up ? a.in[12] : a.in[11]) + (size_t)e * D * FF : (up ? a.in[15] : a.in[14]);
        const int drow = 256 * (n0 >> 7) + (n0 & 127) + 128 * up;
        q.src = src + (size_t)kb * 64 * FF + n0; q.ldw = FF; q.nvalid = 64; q.K = D; q.scale = WGU_SCALE; q.dst = ws + WS_WGU + ((size_t)e * 1024 + drow) * D + kb * 64; return q; }
    r -= 2 * P_GU;
    { const int kb = 2 * (r / 32) + half, nb = r % 32;
        const float* src = e < 64 ? a.in[13] + (size_t)e * FF * D : a.in[16];
        q.src = src + (size_t)kb * 64 * D + nb * 64; q.ldw = D; q.nvalid = 64; q.K = FF; q.scale = WD_SCALE; q.dst = ws + WS_WD + ((size_t)e * D + nb * 64) * FF + kb * 64; return q; }
}
__device__ __forceinline__ void p0_load(const P0Item& q, f32x4 (&v)[16], int lane) {
    const int kr = lane >> 4, nc = (lane & 15) * 4; const bool ok = nc < q.nvalid;
    const float* p = q.src + (size_t)kr * q.ldw + nc;
#pragma unroll
    for (int i = 0; i < 16; ++i) v[i] = ok ? *(const f32x4*)(p + (size_t)(4 * i) * q.ldw) : (f32x4){0.f, 0.f, 0.f, 0.f};
}
__device__ __forceinline__ void p0_process(const P0Item& q, const f32x4 (&v)[16], LAS float* scr, int lane) {
    const int kr = lane >> 4, nc = (lane & 15) * 4;
#pragma unroll
    for (int i = 0; i < 16; ++i) { LAS float* w = scr + (4 * i + kr) * 65 + nc; w[0] = v[i][0]; w[1] = v[i][1]; w[2] = v[i][2]; w[3] = v[i][3]; }
    LDS_WAIT(); asm volatile("" ::: "memory");
    if (q.fp8) {
        const int c = lane & 3; const float sc = q.scale;
#pragma unroll
        for (int j = 0; j < 4; ++j) { const int n = (lane >> 2) + 16 * j; const LAS float* s = scr + (16 * c) * 65 + n;
            u32x4 o; o.x = pk_fp8x4(s[0 * 65] * sc, s[1 * 65] * sc, s[2 * 65] * sc, s[3 * 65] * sc); o.y = pk_fp8x4(s[4 * 65] * sc, s[5 * 65] * sc, s[6 * 65] * sc, s[7 * 65] * sc);
            o.z = pk_fp8x4(s[8 * 65] * sc, s[9 * 65] * sc, s[10 * 65] * sc, s[11 * 65] * sc); o.w = pk_fp8x4(s[12 * 65] * sc, s[13 * 65] * sc, s[14 * 65] * sc, s[15 * 65] * sc);
            *(u32x4*)(q.dst + (size_t)n * q.K + 16 * c) = o; }
    } else {
        const int c = lane & 7;
#pragma unroll
        for (int j = 0; j < 8; ++j) { const int n = (lane >> 3) + 8 * j; const LAS float* s = scr + (8 * c) * 65 + n;
            u32x4 o; o.x = cvtpk(s[0 * 65], s[1 * 65]); o.y = cvtpk(s[2 * 65], s[3 * 65]); o.z = cvtpk(s[4 * 65], s[5 * 65]); o.w = cvtpk(s[6 * 65], s[7 * 65]);
            *(u32x4*)(q.dst + ((size_t)n * q.K + 8 * c) * 2) = o; }
    }
    LDS_WAIT(); asm volatile("" ::: "memory");
}
__device__ __forceinline__ void p0_prologue(Frame& F, const Args& a) {
    LAS float* scr = (LAS float*)(F.lds + F.wave * 16640);
    const int gw = F.vcu * NWAVES + F.wave, NGW = F.G * NWAVES;
    unsigned char* ws = F.ws;
    {
        const float* g = a.in[1];
        for (int m = gw; m < T; m += NGW) {
            const f32x4* xr = (const f32x4*)(a.in[0] + (size_t)m * D) + F.lane;
            f32x4 v[8]; float s = 0.f;
#pragma unroll
            for (int j = 0; j < 8; ++j) { v[j] = xr[64 * j]; s += (v[j].x * v[j].x + v[j].y * v[j].y) + (v[j].z * v[j].z + v[j].w * v[j].w); }
            const float rinv = rsqrtf(wave_sum(s) * (1.f / D) + RMS_EPS);
            u32x2* o = (u32x2*)((bf16_t*)(ws + WS_U) + (size_t)m * D) + F.lane;
#pragma unroll
            for (int j = 0; j < 8; ++j) { const f32x4 gg = *((const f32x4*)g + F.lane + 64 * j); u32x2 w; w.x = cvtpk(v[j].x * rinv * gg.x, v[j].y * rinv * gg.y); w.y = cvtpk(v[j].z * rinv * gg.z, v[j].w * rinv * gg.w); o[64 * j] = w; }
        }
    }
    {
        const float* wr = a.in[9]; const float* g = a.in[8]; float* o = (float*)(ws + WS_WRG);
        for (int i = gw * 64 + F.lane; i < D * NE; i += NGW * 64) o[i] = wr[i] * g[i >> 6];
    }
    constexpr int NPAIRS = 16 * 140 + 2 * 8 * 32 + 16 * 32 + 65 * (2 * 16 * 8 + 4 * 32);
    f32x4 va[16], vb[16]; P0Item qa, qb;
    int pr = gw;
    if (pr < NPAIRS) { qa = p0_decode(pr, 0, a, ws); p0_load(qa, va, F.lane); }
    while (pr < NPAIRS) {
        qb = p0_decode(pr, 1, a, ws); p0_load(qb, vb, F.lane);
        p0_process(qa, va, scr, F.lane);
        const int pn = pr + NGW;
        if (pn < NPAIRS) { qa = p0_decode(pn, 0, a, ws); p0_load(qa, va, F.lane); }
        p0_process(qb, vb, scr, F.lane);
        pr = pn;
    }
}

__device__ __forceinline__ int crow(int r, int hi) { return (r & 3) + 8 * (r >> 2) + 4 * hi; }
__device__ __forceinline__ s16x4 vtr(LAS const char* p) { typedef short v4i16_t __attribute__((ext_vector_type(4))); return __builtin_bit_cast(s16x4, __builtin_amdgcn_ds_read_tr16_b64_v4i16((LAS v4i16_t*)p)); }

__device__ __forceinline__ void attn_qk(f32x16 (&p)[2], const bf16x8 (&qf)[4], LAS const char* Kt, int r32, int hi) {
#pragma unroll
    for (int kb = 0; kb < 2; ++kb) { const int kv = 32 * kb + r32; const int sw = (kv >> 1) & 7; LAS const char* rowp = Kt + kv * 128;
        f32x16 c = {};
#pragma unroll
        for (int s = 0; s < 4; ++s) { const bf16x8 a = *(const LAS bf16x8*)(rowp + (((2 * s + hi) ^ sw) * 16)); c = __builtin_amdgcn_mfma_f32_32x32x16_bf16(a, qf[s], c, 0, 0, 0); }
        p[kb] = c; }
}
__device__ __forceinline__ void attn_softmax_pv(f32x16 (&p)[2], f32x16 (&o)[2], float& m, float& l, LAS const char* Vt, int lane) {
    float mx = p[0][0];
#pragma unroll
    for (int kb = 0; kb < 2; ++kb)
#pragma unroll
        for (int r = 0; r < 16; ++r) mx = fmaxf(mx, p[kb][r]);
    mx = fmaxf(mx, __shfl_xor(mx, 32));
    const float mn = fmaxf(m, mx);
    const float alpha = __builtin_amdgcn_exp2f(m - mn);
    float rs = 0.f;
#pragma unroll
    for (int kb = 0; kb < 2; ++kb)
#pragma unroll
        for (int r = 0; r < 16; ++r) { const float e = __builtin_amdgcn_exp2f(p[kb][r] - mn); p[kb][r] = e; rs += e; }
    rs += __shfl_xor(rs, 32);
    l = l * alpha + rs; m = mn;
#pragma unroll
    for (int db = 0; db < 2; ++db)
#pragma unroll
        for (int r = 0; r < 16; ++r) o[db][r] *= alpha;
    const int g = lane >> 4, i = lane & 15;
    LAS const char* vb = Vt + (4 * (g >> 1) + (i >> 2)) * 64 + (g & 1) * 32 + (i & 3) * 8;
#pragma unroll
    for (int kb = 0; kb < 2; ++kb)
#pragma unroll
        for (int ks = 0; ks < 2; ++ks) {
            u32x4 pw; pw.x = cvtpk(p[kb][8 * ks + 0], p[kb][8 * ks + 1]); pw.y = cvtpk(p[kb][8 * ks + 2], p[kb][8 * ks + 3]); pw.z = cvtpk(p[kb][8 * ks + 4], p[kb][8 * ks + 5]); pw.w = cvtpk(p[kb][8 * ks + 6], p[kb][8 * ks + 7]);
            const bf16x8 pb = __builtin_bit_cast(bf16x8, pw);
#pragma unroll
            for (int db = 0; db < 2; ++db) {
                const s16x4 lo = vtr(vb + db * 4096 + (32 * kb + 16 * ks) * 64), hi4 = vtr(vb + db * 4096 + (32 * kb + 16 * ks + 8) * 64);
                const bf16x8 va = (bf16x8){lo[0], lo[1], lo[2], lo[3], hi4[0], hi4[1], hi4[2], hi4[3]};
                o[db] = __builtin_amdgcn_mfma_f32_32x32x16_bf16(va, pb, o[db], 0, 0, 0); } }
}
__device__ __forceinline__ void attn_store_kv(LAS char* Kt, LAS char* Vt, const u32x4& kr, const u32x4& vr, int tid) {
    const int kv = tid >> 3, c = tid & 7;
    *(LAS u32x4*)(Kt + kv * 128 + ((c ^ ((kv >> 1) & 7)) * 16)) = kr;
    *(LAS u32x4*)(Vt + (c >> 2) * 4096 + kv * 64 + (c & 3) * 16) = vr;
}
__device__ __forceinline__ void attn_store_o(const f32x16 (&o)[2], float l, bf16_t* orow, int hi) {
    const float rl = 1.0f / l;
#pragma unroll
    for (int db = 0; db < 2; ++db)
#pragma unroll
        for (int rq = 0; rq < 4; ++rq) { u32x2 w; w.x = cvtpk(o[db][4 * rq] * rl, o[db][4 * rq + 1] * rl); w.y = cvtpk(o[db][4 * rq + 2] * rl, o[db][4 * rq + 3] * rl);
            *(u32x2*)(orow + 32 * db + 8 * rq + 4 * hi) = w; }
}

__device__ __forceinline__ void swa_unit(Frame& F, int unit, const float* sinks) {
    const bf16_t* Z = (const bf16_t*)(F.ws + WS_Z); bf16_t* YS = (bf16_t*)(F.ws + WS_YS);
    const int b = unit >> 6, kvh = (unit >> 4) & 3, nb = unit & 15;
    const int tid = F.tid, lane = F.lane, r32 = lane & 31, hi = lane >> 5, w = F.wave;
    LAS char* Kl = (LAS char*)F.lds; LAS char* Vl = (LAS char*)F.lds + 32768;
    const int t0 = nb * 128;
    {
        const int kv = tid >> 3, c = tid & 7;
#pragma unroll
        for (int tl = 0; tl < 4; ++tl) {
            if (nb > 0 || tl >= 2) {
                const size_t row = (size_t)(b * SEQ + t0 - 128 + tl * 64 + kv);
                const u32x4 kr = *(const u32x4*)(Z + row * ZP + ZK + kvh * 64 + c * 8);
                const u32x4 vr = *(const u32x4*)(Z + row * ZP + ZV + kvh * 64 + c * 8);
                attn_store_kv(Kl + tl * 8192, Vl + tl * 8192, kr, vr, tid);
            }
        }
    }
    __syncthreads();
    const int qh = kvh * 4 + (w >> 1);
    const float slope2 = exp2f(-0.5f * (float)(qh + 1)) * LOG2E;
    const float sink2 = sinks[qh] * LOG2E;
#pragma unroll 1
    for (int sb = 0; sb < 2; ++sb) {
        const int r0 = 64 * (w & 1) + 32 * sb;
        const int qrel = r0 + r32;
        const size_t qrow = (size_t)(b * SEQ + t0 + qrel);
        bf16x8 qf[4];
#pragma unroll
        for (int s = 0; s < 4; ++s) qf[s] = *(const bf16x8*)(Z + qrow * ZP + ZQ + qh * 64 + 16 * s + 8 * hi);
        f32x16 o[2]; o[0] = f32x16{}; o[1] = f32x16{};
        float m = sink2, l = 1.0f;
        const int tl0 = (r0 + 1) >> 6;
#pragma unroll 1
        for (int tt = 0; tt < 3; ++tt) {
            const int tl = tl0 + tt;
            if (nb == 0 && tl < 2) continue;
            f32x16 p[2];
            attn_qk(p, qf, Kl + tl * 8192, r32, hi);
#pragma unroll
            for (int kb = 0; kb < 2; ++kb)
#pragma unroll
                for (int r = 0; r < 16; ++r) {
                    const int krel = tl * 64 + 32 * kb + crow(r, hi) - 128;
                    const int dist = qrel - krel;
                    const float s = p[kb][r] - slope2 * (float)dist;
                    p[kb][r] = (dist >= 0 && dist < 128) ? s : -INFINITY;
                }
            attn_softmax_pv(p, o, m, l, Vl + tl * 8192, lane);
        }
        attn_store_o(o, l, YS + qrow * 1024 + qh * 64, hi);
    }
    __syncthreads();
}

__device__ __forceinline__ void fox_unit(Frame& F, int bh, int qb, LAS const float* c2) {
    const bf16_t* Z = (const bf16_t*)(F.ws + WS_Z); bf16_t* YF = (bf16_t*)(F.ws + WS_YF);
    const int b = bh >> 4, h = bh & 15;
    const int tid = F.tid, lane = F.lane, r32 = lane & 31, hi = lane >> 5, w = F.wave;
    LAS char* Kl = (LAS char*)F.lds; LAS char* Vl = (LAS char*)F.lds + 16384;
    const int q0 = qb * 256, qw = q0 + 32 * w, qabs = qw + r32;
    const size_t qrow = (size_t)(b * SEQ + qabs);
    const int NT = 4 * (qb + 1);
    const int kvr = tid >> 3, kc = tid & 7;
    const bf16_t* kbase = Z + (size_t)(b * SEQ + kvr) * ZP + ZFK + h * 64 + kc * 8;
    const bf16_t* vbase = Z + (size_t)(b * SEQ + kvr) * ZP + ZFV + h * 64 + kc * 8;
    u32x4 kr = *(const u32x4*)kbase, vr = *(const u32x4*)vbase;
    bf16x8 qf[4];
#pragma unroll
    for (int s = 0; s < 4; ++s) qf[s] = *(const bf16x8*)(Z + qrow * ZP + ZFQ + h * 64 + 16 * s + 8 * hi);
    attn_store_kv(Kl, Vl, kr, vr, tid);
    __syncthreads();
    f32x16 o[2]; o[0] = f32x16{}; o[1] = f32x16{};
    float m = -1e30f, l = 0.f;
#pragma unroll 1
    for (int t = 0; t < NT; ++t) {
        const int buf = t & 1;
        if (t + 1 < NT) { kr = *(const u32x4*)(kbase + (size_t)(t + 1) * 64 * ZP); vr = *(const u32x4*)(vbase + (size_t)(t + 1) * 64 * ZP); }
        const int k0 = t * 64;
        if (k0 <= qw + 31) {
            f32x16 p[2];
            attn_qk(p, qf, Kl + buf * 8192, r32, hi);
            const bool diag = (k0 + 63 > qw);
#pragma unroll
            for (int kb = 0; kb < 2; ++kb)
#pragma unroll
                for (int rq = 0; rq < 4; ++rq) {
                    const int kk = k0 + 32 * kb + 8 * rq + 4 * hi;
                    const f32x4 cc = *(const LAS f32x4*)(c2 + kk);
#pragma unroll
                    for (int j = 0; j < 4; ++j) { float s = p[kb][4 * rq + j] - cc[j]; if (diag && (kk + j > qabs)) s = -INFINITY; p[kb][4 * rq + j] = s; }
                }
            attn_softmax_pv(p, o, m, l, Vl + buf * 8192, lane);
        }
        if (t + 1 < NT) attn_store_kv(Kl + (buf ^ 1) * 8192, Vl + (buf ^ 1) * 8192, kr, vr, tid);
        __syncthreads();
    }
    attn_store_o(o, l, YF + qrow * 1024 + h * 64, hi);
}
__device__ __forceinline__ void p2_attention(Frame& F, const Args& a) {
    for (int u = F.vcu; u < 256; u += F.G) swa_unit(F, u, a.in[4]);
    LAS float* c2 = (LAS float*)(F.lds + 32768);
    LAS float* wtot = (LAS float*)(F.lds + 32768 + 8192);
    const float* FL = (const float*)(F.ws + WS_FL);
    for (int it = F.vcu; it < 256; it += F.G) {
        const int bh = it >> 2, s = it & 3, b = bh >> 4, h = bh & 15;
        {
            float v[4]; float run = 0.f;
#pragma unroll
            for (int j = 0; j < 4; ++j) { run += FL[(size_t)(b * SEQ + 4 * F.tid + j) * 16 + h]; v[j] = run; }
            float inc = run;
#pragma unroll
            for (int o = 1; o < 64; o <<= 1) { const float n = __shfl_up(inc, o); if (F.lane >= o) inc += n; }
            if (F.lane == 63) wtot[F.wave] = inc;
            __syncthreads();
            float base = inc - run;
            for (int ww = 0; ww < F.wave; ++ww) base += wtot[ww];
#pragma unroll
            for (int j = 0; j < 4; ++j) c2[4 * F.tid + j] = base + v[j];
            __syncthreads();
        }
        fox_unit(F, bh, s, c2);
        fox_unit(F, bh, 7 - s, c2);
        __syncthreads();
    }
}

__device__ __forceinline__ void p5_router(Frame& F, const Args& a, unsigned* CNT, float* LISTW, int* LIST) {
    const float* H1 = (const float*)(F.ws + WS_H1); const float* PSQ = (const float*)(F.ws + WS_PSQ); const float* WRG = (const float*)(F.ws + WS_WRG);
    unsigned char* V8 = F.ws + WS_V;
    const float* g = a.in[8]; const float* rbias = a.in[10];
    const int lane = F.lane, w = F.wave, tid = F.tid;
    LAS float* part = (LAS float*)F.lds;
    LAS float* logit = (LAS float*)(F.lds + 65536);
    LAS float* rinvs = (LAS float*)(F.lds + 65536 + 8192);
    LAS int* lcnt = (LAS int*)(F.lds + 65536 + 8192 + 128);
    LAS int* gbase = (LAS int*)(F.lds + 65536 + 8192 + 128 + 256);
    for (int tile = F.vcu; tile < T / 32; tile += F.G) {
        const int tok0 = tile * 32;
        if (tid < 64) lcnt[tid] = 0;
#pragma unroll 1
        for (int j = 0; j < 4; ++j) {
            const int tok = tok0 + 4 * w + j;
            float sq = lane < 32 ? PSQ[(size_t)tok * 32 + lane] : 0.f;
            sq = wave_sum(sq);
            const float rinv = rsqrtf(sq * (1.f / D) + RMS_EPS);
            if (lane == 0) rinvs[4 * w + j] = rinv;
            const f32x4* hr = (const f32x4*)(H1 + (size_t)tok * D) + lane;
            unsigned* o = (unsigned*)(V8 + (size_t)tok * D) + lane;
#pragma unroll
            for (int jj = 0; jj < 8; ++jj) { const f32x4 hv = hr[64 * jj]; const f32x4 gg = *((const f32x4*)g + lane + 64 * jj);
                o[64 * jj] = pk_fp8x4(hv.x * rinv * gg.x, hv.y * rinv * gg.y, hv.z * rinv * gg.z, hv.w * rinv * gg.w); }
        }
        {
            f32x16 acc0 = {}, acc1 = {};
            const int tk = lane & 31, half = lane >> 5;
            const float* hp = H1 + (size_t)(tok0 + tk) * D + 256 * w + 4 * half;
            const float* wp = WRG + (size_t)(256 * w + 4 * half) * NE + tk;
#pragma unroll 4
            for (int kk = 0; kk < 32; ++kk) {
                const f32x4 av = *(const f32x4*)(hp + 8 * kk);
#pragma unroll
                for (int s = 0; s < 4; ++s) {
                    const float b0 = wp[(size_t)(8 * kk + s) * NE], b1 = wp[(size_t)(8 * kk + s) * NE + 32];
                    acc0 = __builtin_amdgcn_mfma_f32_32x32x2f32(av[s], b0, acc0, 0, 0, 0);
                    acc1 = __builtin_amdgcn_mfma_f32_32x32x2f32(av[s], b1, acc1, 0, 0, 0);
                }
            }
#pragma unroll
            for (int r = 0; r < 16; ++r) { const int tr = crow(r, half); part[(w * 32 + tr) * 64 + tk] = acc0[r]; part[(w * 32 + tr) * 64 + 32 + tk] = acc1[r]; }
        }
        __syncthreads();
#pragma unroll
        for (int q = 0; q < 4; ++q) { const int idx = tid + 512 * q; float s = 0.f;
#pragma unroll
            for (int ww = 0; ww < 8; ++ww) s += part[ww * 2048 + idx];
            logit[idx] = s * rinvs[idx >> 6]; }
        __syncthreads();
        int sel_k[4], sel_ls[4]; float sel_w[4];
        const float bias = rbias[lane];
#pragma unroll
        for (int j = 0; j < 4; ++j) {
            const int tl = 4 * w + j;
            const float score = sigmoidf_(logit[tl * 64 + lane]);
            const float biased = score + bias;
            float m1 = biased; m1 = fmaxf(m1, __shfl_xor(m1, 1)); m1 = fmaxf(m1, __shfl_xor(m1, 2)); m1 = fmaxf(m1, __shfl_xor(m1, 4));
            const unsigned long long gm = 0xFFull << (lane & 56);
            const unsigned long long b1 = __ballot(biased == m1) & gm;
            const int i1 = __builtin_ctzll(b1);
            float v2 = (lane == i1) ? -INFINITY : biased;
            float m2 = v2; m2 = fmaxf(m2, __shfl_xor(m2, 1)); m2 = fmaxf(m2, __shfl_xor(m2, 2)); m2 = fmaxf(m2, __shfl_xor(m2, 4));
            const float gs = m1 + m2; const int gi = lane >> 3;
            int rank = 0;
#pragma unroll
            for (int gg = 0; gg < 8; ++gg) { const float o = __shfl(gs, 8 * gg); rank += (o > gs || (o == gs && gg < gi)) ? 1 : 0; }
            float mv = rank < 4 ? biased : -INFINITY;
            int myk = -1;
#pragma unroll
            for (int it = 0; it < 8; ++it) { const float mx = wave_max(mv); const unsigned long long bb = __ballot(mv == mx); const int sl = __builtin_ctzll(bb); if (lane == sl) { myk = it; mv = -INFINITY; } }
            const float ssum = wave_sum(myk >= 0 ? score : 0.f);
            sel_k[j] = myk; sel_w[j] = score / ssum * 2.5f;
            sel_ls[j] = 0;
            if (myk >= 0) sel_ls[j] = __hip_atomic_fetch_add((LAS int*)&lcnt[lane], 1, __ATOMIC_RELAXED, __HIP_MEMORY_SCOPE_WORKGROUP);
        }
        __syncthreads();
        if (tid < 64) gbase[tid] = (int)atomicAdd(CNT + tid, (unsigned)lcnt[tid]);
        __syncthreads();
#pragma unroll
        for (int j = 0; j < 4; ++j) if (sel_k[j] >= 0) { const int tok = tok0 + 4 * w + j; const int aid = tok * 8 + sel_k[j];
            const size_t li = (size_t)lane * T + gbase[lane] + sel_ls[j]; LIST[li] = aid; LISTW[li] = sel_w[j]; }
        __syncthreads();
    }
}

template <int MULT> __device__ __forceinline__ int moe_table(Frame& F, LAS int* tab) {
    if (F.tid < 64) {
        const int cnt = (int)__hip_atomic_load(F.ctl + CW_CNT + F.tid, __ATOMIC_RELAXED, __HIP_MEMORY_SCOPE_AGENT);
        int inc = ((cnt + 255) >> 8) * MULT;
#pragma unroll
        for (int o = 1; o < 64; o <<= 1) { const int n = __shfl_up(inc, o); if (F.lane >= o) inc += n; }
        tab[F.tid] = inc; tab[64 + F.tid] = cnt;
    }
    __syncthreads();
    return 32 * MULT + tab[63];
}

__device__ __forceinline__ void p8_final(Frame& F, const Args& a) {
    const float* H1 = (const float*)(F.ws + WS_H1); const unsigned char* YB8 = F.ws + WS_YB; const float* g = a.in[17];
    const int gw = F.vcu * NWAVES + F.wave, NGW = F.G * NWAVES;
    for (int tok = gw; tok < T; tok += NGW) {
        const f32x4* hr = (const f32x4*)(H1 + (size_t)tok * D) + F.lane;
        f32x4 v[8], y[8];
#pragma unroll
        for (int j = 0; j < 8; ++j) { v[j] = hr[64 * j]; y[j] = (f32x4){0.f, 0.f, 0.f, 0.f}; }
#pragma unroll 3
        for (int k = 0; k < 9; ++k) {
            const size_t row = k < 8 ? (size_t)tok * 8 + k : (size_t)NASSIGN + tok;
            const unsigned* yr = (const unsigned*)(YB8 + row * D) + F.lane;
#pragma unroll
            for (int j = 0; j < 8; ++j) { const unsigned w = yr[64 * j]; const f32x2 lo = __builtin_amdgcn_cvt_pk_f32_fp8((int)w, false), hi = __builtin_amdgcn_cvt_pk_f32_fp8((int)w, true);
                y[j].x += lo.x; y[j].y += lo.y; y[j].z += hi.x; y[j].w += hi.y; }
        }
#pragma unroll
        for (int j = 0; j < 8; ++j) v[j] = v[j] + y[j] * (1.f / YB_SCALE);
        float s = 0.f;
#pragma unroll
        for (int j = 0; j < 8; ++j) s += (v[j].x * v[j].x + v[j].y * v[j].y) + (v[j].z * v[j].z + v[j].w * v[j].w);
        const float rinv = rsqrtf(wave_sum(s) * (1.f / D) + RMS_EPS);
        f32x4* o = (f32x4*)(a.out + (size_t)tok * D) + F.lane;
#pragma unroll
        for (int j = 0; j < 8; ++j) { const f32x4 gg = *((const f32x4*)g + F.lane + 64 * j); o[64 * j] = (f32x4){v[j].x * rinv * gg.x, v[j].y * rinv * gg.y, v[j].z * rinv * gg.z, v[j].w * rinv * gg.w}; }
    }
}

constexpr int N_PHASES = 9;
__global__ void __launch_bounds__(NTHREADS, 2) fwd_kernel(Args args) {
    extern __shared__ __attribute__((aligned(16))) unsigned char lds_raw[];
    Frame F;
    F.lds = (LAS unsigned char*)lds_raw;
    F.MISC = (volatile LAS unsigned*)(F.lds + MISC_OFF);
    F.tid = threadIdx.x; F.lane = F.tid & 63; F.wave = __builtin_amdgcn_readfirstlane(F.tid >> 6);
    F.G = gridDim.x; { const int bx = blockIdx.x; F.vcu = (F.G % 8 == 0) ? (bx % 8) * (F.G / 8) + bx / 8 : bx; }
    F.ws = args.ws; F.ctl = (unsigned*)(args.ws + WS_CTL);
    for (int u = F.tid; u < (LDS_BYTES - MISC_OFF) / 4; u += NTHREADS) ((LAS unsigned*)(F.lds + MISC_OFF))[u] = 0u;
    __syncthreads();
    const int lo = args.ph_lo, hi = args.ph_hi;
    XcdBarrier bar; bar.bar = F.ctl + CW_BAR; bar.x = 0; bar.st = nullptr;
    if (hi - lo > 1) bar = xcd_barrier_post(F.ctl + CW_BAR, F.MISC + 8);
#define IN(k) (lo <= (k) && (k) < hi)
#define SEAM(k) do { if (IN(k) && IN((k) + 1)) xcd_barrier(bar); } while (0)
    unsigned char* ws = args.ws;
    LAS int* tab = (LAS int*)(F.lds + MISC_OFF + 256);

#define REPS(k) for (int rep_ = 0; rep_ < (PROBE_DUP == (k) ? 2 : 1); ++rep_)
#define REPBAR(k) do { if (PROBE_DUP == (k) && rep_ == 0) xcd_barrier(bar); } while (0)
    if (IN(0)) { REPS(0) { p0_prologue(F, args); REPBAR(0); } SEAM(0); }
    if (IN(1)) {
        DenseSched S{(const char*)(ws + WS_U), (const char*)(ws + WS_WINT), T / 256, NIN / 256, D, F.G, (int)blockIdx.x, PROBE_DUP == 1 ? 2 : 1};
        EpiZ E{(bf16_t*)(ws + WS_Z), (float*)(ws + WS_FL), args.in[3]};
        pg8::gemm_phase<false>(F.lds, 2 * D, S, E);
        SEAM(1);
    }
    if (IN(2)) { REPS(2) { p2_attention(F, args); REPBAR(2); } SEAM(2); }
    if (IN(3)) {
        BranchSched S{(const char*)(ws + WS_YS), (const char*)(ws + WS_YF), (const char*)(ws + WS_WSWAT), (const char*)(ws + WS_WFOXT), T / 256, D / 256, 1024, F.G, (int)blockIdx.x, PROBE_DUP == 3 ? 2 : 1};
        EpiMix E{(const bf16_t*)(ws + WS_Z), (bf16_t*)(ws + WS_MIX)};
        pg8::gemm_phase<false>(F.lds, 2 * 1024, S, E);
        SEAM(3);
    }
    if (IN(4)) {
        DenseSched S{(const char*)(ws + WS_MIX), (const char*)(ws + WS_WOUTT), T / 256, D / 256, D, F.G, (int)blockIdx.x, PROBE_DUP == 4 ? 2 : 1};
        EpiOut E{args.in[0], (float*)(ws + WS_H1), (float*)(ws + WS_PSQ)};
        pg8::gemm_phase<false>(F.lds, 2 * D, S, E);
        SEAM(4);
    }
    if (IN(5)) {
        if (PROBE_DUP == 5) { p5_router(F, args, F.ctl + 256, (float*)(ws + WS_T1), (int*)(ws + WS_T1 + 2 * MiB)); xcd_barrier(bar); }
        p5_router(F, args, F.ctl + CW_CNT, (float*)(ws + WS_LISTW), (int*)(ws + WS_LIST));
        if (PROBE_DUP == 9) { for (int q = 0; q < 16; ++q) xcd_barrier(bar); }
        SEAM(5); }
    if (IN(6)) {
        const int total = moe_table<4>(F, tab);
        MoeSched<0> S{tab, (const int*)(ws + WS_LIST), (const float*)(ws + WS_LISTW), (const char*)(ws + WS_V), (const char*)(ws + WS_WGU), (LAS int*)(F.lds + MISC_OFF + 1024), (LAS float*)(F.lds + MISC_OFF + 4096), total, F.G, F.vcu, PROBE_DUP == 6 ? 2 : 1};
        EpiSwiglu E{&S, (unsigned char*)(ws + WS_HB)};
        pg8::gemm_phase<true>(F.lds, 2048, S, E);
        SEAM(6);
    }
    if (IN(7)) {
        const int total = moe_table<8>(F, tab);
        MoeSched<1> S{tab, (const int*)(ws + WS_LIST), (const float*)(ws + WS_LISTW), (const char*)(ws + WS_HB), (const char*)(ws + WS_WD), (LAS int*)(F.lds + MISC_OFF + 1024), (LAS float*)(F.lds + MISC_OFF + 4096), total, F.G, F.vcu, PROBE_DUP == 7 ? 2 : 1};
        EpiDown E{&S, (unsigned char*)(ws + WS_YB)};
        pg8::gemm_phase<true>(F.lds, 512, S, E);
        SEAM(7);
    }
    if (IN(8)) { REPS(8) { p8_final(F, args); REPBAR(8); } }
#undef IN
#undef SEAM
}

extern "C" void kernel_launch(void* const* d_in, const int* in_sizes, int n_in, void* d_out, int out_size, void* d_ws, size_t ws_size, hipStream_t stream) {
    static int grid = 0;
    if (grid == 0) {
        if (n_in != 18 || out_size != T * D || ws_size < WS_END) { fprintf(stderr, "kernel_launch: unexpected shapes (n_in %d out %d ws %zu)\n", n_in, out_size, ws_size); grid = -1; return; }
        int dev = 0, cus = 0, per_cu = 0;
        if (hipGetDevice(&dev) != hipSuccess || hipDeviceGetAttribute(&cus, hipDeviceAttributeMultiprocessorCount, dev) != hipSuccess) { grid = -1; return; }
        if (hipFuncSetAttribute((const void*)fwd_kernel, hipFuncAttributeMaxDynamicSharedMemorySize, LDS_BYTES) != hipSuccess) { fprintf(stderr, "kernel_launch: hipFuncSetAttribute failed\n"); grid = -1; return; }
        if (hipOccupancyMaxActiveBlocksPerMultiprocessor(&per_cu, (const void*)fwd_kernel, NTHREADS, LDS_BYTES) != hipSuccess || per_cu < 1) { fprintf(stderr, "kernel_launch: occupancy query says %d blocks per CU\n", per_cu); (void)hipGetLastError(); grid = -1; return; }
        grid = cus;
        if (grid % 8 != 0 || grid > 256) grid = (grid / 8) * 8 > 256 ? 256 : (grid / 8) * 8;
    }
    if (grid <= 0) return;
    (void)hipMemsetAsync((char*)d_ws + WS_CTL, 0, CTL_ZERO_BYTES, stream);
    Args a{};
    for (int i = 0; i < 18; ++i) a.in[i] = (const float*)d_in[i];
    a.out = (float*)d_out; a.ws = (unsigned char*)d_ws;
#if MK_N_LAUNCHES == 1
    a.ph_lo = 0; a.ph_hi = N_PHASES;
    hipLaunchKernelGGL(fwd_kernel, dim3(grid), dim3(NTHREADS), LDS_BYTES, stream, a);
#else
    for (int p = 0; p < N_PHASES; ++p) { a.ph_lo = p; a.ph_hi = p + 1; hipLaunchKernelGGL(fwd_kernel, dim3(grid), dim3(NTHREADS), LDS_BYTES, stream, a); }
#endif
}
```

```cpp
#include <hip/hip_runtime.h>
#include <cstdio>
#include <cstdint>

#ifndef MK_N_LAUNCHES
#define MK_N_LAUNCHES 1
#endif
#define PROBE_DUP -1

#define LAS __attribute__((address_space(3)))
#define GAS __attribute__((address_space(1)))
typedef unsigned short bf16_t;
typedef short bf16x8 __attribute__((ext_vector_type(8)));
typedef short s16x4 __attribute__((ext_vector_type(4)));
typedef float f32x2 __attribute__((ext_vector_type(2)));
typedef float f32x4 __attribute__((ext_vector_type(4)));
typedef float f32x16 __attribute__((ext_vector_type(16)));
typedef unsigned u32x2 __attribute__((ext_vector_type(2)));
typedef unsigned u32x4 __attribute__((ext_vector_type(4)));
typedef __bf16 bf16x2_t __attribute__((ext_vector_type(2)));

constexpr int T = 8192, D = 2048, SEQ = 2048, NBATCH = 4;
constexpr int NE = 64, FF = 512, TOPK = 8;
constexpr int ZP = 8704;
constexpr int ZQ = 0, ZK = 1024, ZV = 1280, ZFQ = 1536, ZFK = 2560, ZFV = 3584, ZGS = 4608, ZGF = 6656;
constexpr int NIN = 8960;
constexpr float RMS_EPS = 1e-6f;
constexpr float LOG2E = 1.4426950408889634f;
constexpr float QSCALE = 0.125f * LOG2E;
constexpr int NASSIGN = T * TOPK;
constexpr int NROWS_H = NASSIGN + T;

constexpr size_t MiB = 1u << 20;
constexpr size_t WS_CTL = 0, CTL_ZERO_BYTES = 64 * 1024;
constexpr size_t WS_FL = 1 * MiB;
constexpr size_t WS_WTS = 1 * MiB + 512 * 1024;
constexpr size_t WS_LIST = 2 * MiB;
constexpr size_t WS_WSWAT = 4 * MiB, WS_WFOXT = 8 * MiB, WS_WOUTT = 12 * MiB;
constexpr size_t WS_WINT = 20 * MiB;
constexpr size_t WS_WRG = 55 * MiB;
constexpr size_t WS_PSQ = 55 * MiB + 512 * 1024;
constexpr size_t WS_U = 56 * MiB;
constexpr size_t WS_Z = 88 * MiB;
constexpr size_t WS_YS = 224 * MiB, WS_YF = 240 * MiB;
constexpr size_t WS_T1 = 256 * MiB;
constexpr size_t WS_MIX = 320 * MiB;
constexpr size_t WS_H1 = 352 * MiB;
constexpr size_t WS_V = 416 * MiB;
constexpr size_t WS_HB = 448 * MiB;
constexpr size_t WS_WGU = 520 * MiB;
constexpr size_t WS_WD = 780 * MiB;
constexpr size_t WS_YB = 56 * MiB;
constexpr size_t WS_LISTW = 910 * MiB;
constexpr size_t WS_END = 912 * MiB;
static_assert(WS_YB + (size_t)NROWS_H * D * 2 <= WS_MIX + 32 * MiB, "YB overlay");
constexpr int CW_CNT = 64;
constexpr int CW_BAR = 4096;

constexpr int RING_BYTES = 131072;
constexpr int MISC_OFF = 139264;
constexpr int LDS_BYTES = 147456;
constexpr int NWAVES = 8, NTHREADS = 512;

__device__ __forceinline__ unsigned cvtpk(float lo, float hi) { f32x2 v = {lo, hi}; bf16x2_t b = __builtin_convertvector(v, bf16x2_t); return __builtin_bit_cast(unsigned, b); }
__device__ __forceinline__ float bf2f(bf16_t h) { return __builtin_bit_cast(float, (unsigned)h << 16); }
__device__ __forceinline__ float bflo(unsigned w) { return __builtin_bit_cast(float, w << 16); }
__device__ __forceinline__ float bfhi(unsigned w) { return __builtin_bit_cast(float, w & 0xffff0000u); }
__device__ __forceinline__ float wave_sum(float v) {
#pragma unroll
    for (int o = 1; o < 64; o <<= 1) v += __shfl_xor(v, o);
    return v;
}
__device__ __forceinline__ float wave_max(float v) {
#pragma unroll
    for (int o = 1; o < 64; o <<= 1) v = fmaxf(v, __shfl_xor(v, o));
    return v;
}
__device__ __forceinline__ float sigmoidf_(float x) { return 1.0f / (1.0f + __expf(-x)); }
#define LDS_WAIT() asm volatile("s_waitcnt lgkmcnt(0)" ::: "memory")
#define VM_WAIT() asm volatile("s_waitcnt vmcnt(0)" ::: "memory")

#define XB_TMO      128
#define XB_XCNT(j)  (256  + 64 * (j))
#define XB_XSUB(j)  (1280 + 64 * (j))
#define XB_XGEN(j)  (2304 + 64 * (j))
#define XB_TOP      3328
#define XB_TOPGEN   3392
#define XCD_BAR_WORDS 3456
#define XB_SPIN_CAP (1u << 20)
__device__ __forceinline__ unsigned xb_ld(unsigned* p)              { return __hip_atomic_load(p, __ATOMIC_RELAXED, __HIP_MEMORY_SCOPE_AGENT); }
__device__ __forceinline__ unsigned xb_add(unsigned* p, unsigned v) { return __hip_atomic_fetch_add(p, v, __ATOMIC_RELAXED, __HIP_MEMORY_SCOPE_AGENT); }
__device__ __forceinline__ unsigned xb_xcc_id() { return (unsigned)__builtin_amdgcn_s_getreg((3 << 11) | 20) & 0xFu; }
#define XB_SPIN(cond, bar) do { unsigned _sp = 0; while (cond) { __builtin_amdgcn_s_sleep(1); \
    if ((++_sp & 255u) == 0u) { if (xb_ld(&(bar)[XB_TMO])) break; if (_sp > XB_SPIN_CAP) { atomicAdd(&(bar)[XB_TMO], 1u); break; } } } } while (0)
struct XcdBarrier { unsigned* bar; unsigned x; volatile LAS unsigned* st; };
__device__ __forceinline__ XcdBarrier xcd_barrier_post(unsigned* bar, volatile LAS unsigned* st) {
    XcdBarrier b; b.bar = bar; b.x = xb_xcc_id(); b.st = st;
    if (threadIdx.x == 0) (void)xb_add(&bar[XB_XCNT(b.x)], 1u);
    return b;
}
__device__ __forceinline__ void xcd_barrier_complete(unsigned* bar, unsigned x, unsigned& nloc, unsigned& nx) {
    const unsigned G = gridDim.x * gridDim.y * gridDim.z;
    unsigned sum, cnt, mine, sp = 0u;
    for (;;) {
        sum = 0u; cnt = 0u; mine = 0u;
#pragma unroll
        for (unsigned j = 0; j < 16; ++j) { const unsigned c = xb_ld(&bar[XB_XCNT(j)]); sum += c; cnt += (c > 0u) ? 1u : 0u; mine = (j == x) ? c : mine; }
        if (sum == G) break;
        __builtin_amdgcn_s_sleep(1);
        if ((++sp & 255u) == 0u) { if (xb_ld(&bar[XB_TMO])) break; if (sp > XB_SPIN_CAP) { atomicAdd(&bar[XB_TMO], 1u); break; } }
    }
    nloc = mine > 0u ? mine : 1u; nx = cnt > 0u ? cnt : 1u;
}
__device__ __forceinline__ void xcd_barrier(const XcdBarrier& b) {
    asm volatile("s_waitcnt vmcnt(0)" ::: "memory");
    __syncthreads();
    if (threadIdx.x == 0) {
        unsigned* bar = b.bar;
        __builtin_amdgcn_s_waitcnt(0);
        unsigned nloc = b.st[0], nx = b.st[1];
        if (nloc == 0u) { xcd_barrier_complete(bar, b.x, nloc, nx); b.st[0] = nloc; b.st[1] = nx; }
        const unsigned old = xb_add(&bar[XB_XSUB(b.x)], 1u);
        const unsigned gen = old / nloc;
        if (old + 1u == (gen + 1u) * nloc) {
            __builtin_amdgcn_fence(__ATOMIC_RELEASE, "agent");
            asm volatile("s_waitcnt vmcnt(0)" ::: "memory");
            const unsigned og = xb_add(&bar[XB_TOP], 1u);
            const unsigned tg = og / nx;
            if (og + 1u == (tg + 1u) * nx) xb_add(&bar[XB_TOPGEN], 1u);
            else XB_SPIN(xb_ld(&bar[XB_TOPGEN]) == tg, bar);
            __builtin_amdgcn_fence(__ATOMIC_ACQUIRE, "agent");
            xb_add(&bar[XB_XGEN(b.x)], 1u);
            asm volatile("s_waitcnt vmcnt(0)" ::: "memory");
        } else {
            XB_SPIN(xb_ld(&bar[XB_XGEN(b.x)]) == gen, bar);
            __builtin_amdgcn_fence(__ATOMIC_ACQUIRE, "agent");
            asm volatile("s_waitcnt vmcnt(0)" ::: "memory");
        }
    }
    __syncthreads();
}

namespace pg8 {
constexpr int BM = 256, BK = 64, HALF = 128, HTB = HALF * BK * 2, STAGE_BYTES = 8 * HTB, NXCD = 8, WGM = 8;
__host__ __device__ __forceinline__ int lds_byte(int r, int c) { const int st = (r >> 4) * 2 + (c >> 5), rr = r & 15, cc = c & 31, ob = rr * 64 + cc * 2; return st * 1024 + (ob ^ (((ob >> 9) & 1) << 5)); }
__host__ __device__ __forceinline__ void stage_rc(int b, int& R, int& C) { const int st = b / 1024, sb = b % 1024, swz = sb ^ (((sb >> 9) & 1) << 5); R = (st >> 1) * 16 + swz / 64; C = (st & 1) * 32 + (swz % 64) / 2; }
__host__ __device__ __forceinline__ int perm32(int rho) { const int n = rho >> 4, i = rho & 15; return 8 * (i >> 2) + 4 * n + (i & 3); }

struct Unit { const char* A; const char* B; int pm, pn, e, rt; };

__device__ __forceinline__ void static_tile(int L, int nM, int nN, int& pm, int& pn) {
    const int nwg = nM * nN; int wgid = L;
    { const int q = nwg / NXCD, r = nwg % NXCD, xcd = wgid % NXCD, off = wgid / NXCD; wgid = (xcd < r ? xcd * (q + 1) : r * (q + 1) + (xcd - r) * q) + off; }
    const int nig = WGM * nN, gid = wgid / nig, fm = gid * WGM, gsz = (nM - fm) < WGM ? (nM - fm) : WGM;
    pm = fm + ((wgid % nig) % gsz); pn = (wgid % nig) / gsz;
}

typedef int v4i_t __attribute__((ext_vector_type(4)));
typedef int v8i_t __attribute__((ext_vector_type(8)));
template <bool FP8, class Epi, class Sched>
__device__ __forceinline__ void gemm_phase(LAS unsigned char* lds, const int Kb, const Sched& S, const Epi& E, const int stagger_ticks = 0) {
    if (stagger_ticks > 0) { const unsigned long long t0_ = __builtin_amdgcn_s_memrealtime(); while (__builtin_amdgcn_s_memrealtime() - t0_ < (unsigned long long)stagger_ticks) __builtin_amdgcn_s_sleep(8); }
    const int tid = threadIdx.x, wid = __builtin_amdgcn_readfirstlane(tid >> 6), lane = tid & 63, wr = wid >> 2, wc = wid & 3, fr = lane & 15, fq = lane >> 4;
    const int nt = Kb / 128;
    int Ri[2], Ci[2]; unsigned voffB[2];
#pragma unroll
    for (int i = 0; i < 2; ++i) { int R, C; stage_rc(tid * 16 + i * 8192, R, C); Ri[i] = R; Ci[i] = C; const int Rb = (R & ~31) + perm32(R & 31); voffB[i] = (unsigned)(Rb * Kb + C * 2); }
    const size_t kstep = (size_t)(BK * 2);
    const size_t hstep = (size_t)HALF * Kb;
    const unsigned ldsw = (unsigned)wid * 1024u;
    const int aoff = lds_byte(wr * 64 + fr, fq * 8), boff = lds_byte(wc * 32 + fr, fq * 8);
#define PG8_SA(b, h) (((b) * 2 + (h)) * HTB)
#define PG8_SB(b, h) ((4 + (b) * 2 + (h)) * HTB)
#define PG8_STAGE(bufoff, gbase, voff) do { _Pragma("unroll") for (int _i = 0; _i < 2; ++_i) \
        __builtin_amdgcn_global_load_lds((const unsigned*)((const char*)(gbase) + (voff)[_i]), (LAS unsigned*)(lds + (bufoff) + ldsw + _i * 8192), 16, 0, 0); } while (0)
#define PG8_LDA(dst, b, h) do { if constexpr (FP8) { _Pragma("unroll") for (int m = 0; m < 4; ++m) { dst##8[m].lo = *(const LAS v4i_t*)(lds + PG8_SA(b, h) + aoff + m * 2048); dst##8[m].hi = *(const LAS v4i_t*)(lds + PG8_SA(b, h) + aoff + m * 2048 + 1024); } } \
        else { _Pragma("unroll") for (int m = 0; m < 4; ++m) _Pragma("unroll") for (int k = 0; k < 2; ++k) dst[m][k] = *(const LAS bf16x8*)(lds + PG8_SA(b, h) + aoff + m * 2048 + k * 1024); } } while (0)
#define PG8_LDB(dst, b, h) do { if constexpr (FP8) { _Pragma("unroll") for (int n = 0; n < 2; ++n) { dst##8[n].lo = *(const LAS v4i_t*)(lds + PG8_SB(b, h) + boff + n * 2048); dst##8[n].hi = *(const LAS v4i_t*)(lds + PG8_SB(b, h) + boff + n * 2048 + 1024); } } \
        else { _Pragma("unroll") for (int n = 0; n < 2; ++n) _Pragma("unroll") for (int k = 0; k < 2; ++k) dst[n][k] = *(const LAS bf16x8*)(lds + PG8_SB(b, h) + boff + n * 2048 + k * 1024); } } while (0)
#define PG8_MMA(ai, bj, At, Bt) do { __builtin_amdgcn_s_setprio(1); \
        if constexpr (FP8) { _Pragma("unroll") for (int m = 0; m < 4; ++m) _Pragma("unroll") for (int n = 0; n < 2; ++n) \
            asm volatile("v_mfma_scale_f32_16x16x128_f8f6f4 %0, %1, %2, %0, %3, %3 op_sel_hi:[0,0,0]" : "+v"(acc[ai][bj][m][n]) : "v"(Bt##8[n]), "v"(At##8[m]), "v"(sc8)); } \
        else { _Pragma("unroll") for (int m = 0; m < 4; ++m) _Pragma("unroll") for (int n = 0; n < 2; ++n) _Pragma("unroll") for (int k = 0; k < 2; ++k) \
            acc[ai][bj][m][n] = __builtin_amdgcn_mfma_f32_16x16x32_bf16(Bt[n][k], At[m][k], acc[ai][bj][m][n], 0, 0, 0); } \
        __builtin_amdgcn_s_setprio(0); } while (0)
#define PG8_WAIT_V(n) asm volatile("s_waitcnt vmcnt(" #n ")" ::: "memory")
#define PG8_WAIT_L(n) asm volatile("s_waitcnt lgkmcnt(" #n ")" ::: "memory")
#define PG8_BAR __builtin_amdgcn_s_barrier()
#define PG8_SCHED __builtin_amdgcn_sched_barrier(0)
    Unit cur, nxt; int ui = 0;
    if (!S.next(0, cur)) return;
    unsigned vc[2][2], vn[2][2];
    int pfa = -1; float pfw = 0.f;
    S.pf_issue(cur, pfa, pfw); S.pf_commit(0, pfa, pfw);
    asm volatile("s_waitcnt vmcnt(0) lgkmcnt(0)" ::: "memory"); PG8_BAR; asm volatile("" ::: "memory");
    S.rowoffs(cur, 0, vc, Ri, Ci);
    f32x4 acc[2][2][4][2];
#pragma unroll
    for (int a = 0; a < 2; ++a)
#pragma unroll
        for (int b = 0; b < 2; ++b)
#pragma unroll
            for (int m = 0; m < 4; ++m)
#pragma unroll
                for (int n = 0; n < 2; ++n) acc[a][b][m][n] = (f32x4){0.f, 0.f, 0.f, 0.f};
    const int sc8 = 0x7f7f7f7f;
    bf16x8 At[4][2], B0[2][2], B1[2][2]; v8i_t At8[4], B08[2], B18[2];
    const char* cA = cur.A; const char* cB = cur.B;
    PG8_STAGE(PG8_SB(0, 0), cB, voffB); PG8_STAGE(PG8_SB(0, 1), cB + hstep, voffB); PG8_STAGE(PG8_SA(0, 0), cA, vc[0]); PG8_STAGE(PG8_SA(0, 1), cA, vc[1]);
    if (wr == 1) PG8_BAR;
    PG8_WAIT_V(2); PG8_BAR;
    PG8_STAGE(PG8_SB(1, 0), cB + kstep, voffB); PG8_STAGE(PG8_SA(1, 0), cA + kstep, vc[0]); PG8_STAGE(PG8_SB(1, 1), cB + hstep + kstep, voffB);
    PG8_WAIT_V(6); PG8_BAR;
    for (;;) {
        const bool has_next = S.next(ui + 1, nxt);
        const int scur = ui % 3, snxt = (ui + 1) % 3;
        const char* nA = has_next ? nxt.A : cA; const char* nB = has_next ? nxt.B : cB;
        if (has_next) S.pf_issue(nxt, pfa, pfw);
        for (int t = 0; t < nt; t += 2) {
            const bool last = (t == nt - 2);
            if (t == (nt >= 8 ? nt - 4 : 0) && has_next) S.pf_commit(snxt, pfa, pfw);
            const char* a1 = cA + (size_t)(t + 1) * kstep;
            const char* a2 = last ? nA : cA + (size_t)(t + 2) * kstep; const char* b2 = last ? nB : cB + (size_t)(t + 2) * kstep;
            const char* a3 = a2 + kstep; const char* b3 = b2 + kstep;
            if (last) {
                if (has_next) S.rowoffs(nxt, snxt, vn, Ri, Ci);
                else { vn[0][0] = vc[0][0]; vn[0][1] = vc[0][1]; vn[1][0] = vc[1][0]; vn[1][1] = vc[1][1]; }
            }
            unsigned v2[2][2];
            v2[0][0] = last ? vn[0][0] : vc[0][0]; v2[0][1] = last ? vn[0][1] : vc[0][1]; v2[1][0] = last ? vn[1][0] : vc[1][0]; v2[1][1] = last ? vn[1][1] : vc[1][1];
            PG8_LDB(B0, 0, 0); PG8_LDB(B1, 0, 1); PG8_SCHED; PG8_LDA(At, 0, 0); PG8_STAGE(PG8_SA(1, 1), a1, vc[1]);
            PG8_WAIT_V(8); PG8_WAIT_L(0); PG8_BAR; PG8_MMA(0, 0, At, B0); PG8_MMA(0, 1, At, B1); PG8_BAR; PG8_SCHED;
            PG8_LDA(At, 0, 1); PG8_STAGE(PG8_SB(0, 0), b2, voffB); PG8_STAGE(PG8_SB(0, 1), b2 + hstep, voffB); PG8_STAGE(PG8_SA(0, 0), a2, v2[0]);
            PG8_WAIT_V(8); PG8_WAIT_L(0); PG8_BAR; PG8_MMA(1, 0, At, B0); PG8_MMA(1, 1, At, B1); PG8_BAR; PG8_SCHED;
            PG8_LDB(B0, 1, 0); PG8_LDB(B1, 1, 1); PG8_SCHED; PG8_LDA(At, 1, 0); PG8_STAGE(PG8_SA(0, 1), a2, v2[1]);
            PG8_WAIT_V(8); PG8_WAIT_L(0); PG8_BAR; PG8_MMA(0, 0, At, B0); PG8_MMA(0, 1, At, B1); PG8_BAR; PG8_SCHED;
            PG8_LDA(At, 1, 1); PG8_STAGE(PG8_SB(1, 0), b3, voffB); PG8_STAGE(PG8_SB(1, 1), b3 + hstep, voffB); PG8_STAGE(PG8_SA(1, 0), a3, v2[0]);
            PG8_WAIT_V(8); PG8_WAIT_L(0); PG8_BAR; PG8_MMA(1, 0, At, B0); PG8_MMA(1, 1, At, B1); PG8_BAR; PG8_SCHED;
        }
        if (wr == 0) PG8_BAR;
        if constexpr (FP8) {
            asm volatile("s_nop 15\n\ts_nop 15" ::: "memory");
#pragma unroll
            for (int a = 0; a < 2; ++a)
#pragma unroll
                for (int b = 0; b < 2; ++b)
#pragma unroll
                    for (int m = 0; m < 4; ++m)
#pragma unroll
                        for (int n = 0; n < 2; ++n) asm volatile("" : "+v"(acc[a][b][m][n]));
        }
        E(acc, cur, scur, wr, wc, fr, fq);
        if (!has_next) break;
#pragma unroll
        for (int a = 0; a < 2; ++a)
#pragma unroll
            for (int b = 0; b < 2; ++b)
#pragma unroll
                for (int m = 0; m < 4; ++m)
#pragma unroll
                    for (int n = 0; n < 2; ++n) acc[a][b][m][n] = (f32x4){0.f, 0.f, 0.f, 0.f};
        cur = nxt; cA = nA; cB = nB; ++ui;
        vc[0][0] = vn[0][0]; vc[0][1] = vn[0][1]; vc[1][0] = vn[1][0]; vc[1][1] = vn[1][1];
        if (wr == 1) PG8_BAR;
    }
    PG8_WAIT_V(0);
    PG8_BAR;
#undef PG8_SA
#undef PG8_SB
#undef PG8_STAGE
#undef PG8_LDA
#undef PG8_LDB
#undef PG8_MMA
#undef PG8_WAIT_V
#undef PG8_WAIT_L
#undef PG8_BAR
#undef PG8_SCHED
}
}
using pg8::Unit;

struct Args { const float* in[18]; float* out; unsigned char* ws; int ph_lo, ph_hi; };
struct Frame {
    LAS unsigned char* lds; volatile LAS unsigned* MISC; unsigned* ctl; unsigned char* ws;
    int tid, lane, wave, vcu, G;
};

struct DenseSched {
    const char* A; const char* Bt; int nM, nN, K, G, c, dup;
    __device__ __forceinline__ bool next(int i, Unit& u) const {
        int L = i * G + c; if (L >= nM * nN * dup) return false; if (L >= nM * nN) L -= nM * nN;
        int pm, pn; pg8::static_tile(L, nM, nN, pm, pn);
        u.pm = pm; u.pn = pn; u.e = 0; u.rt = 0; u.A = A + (size_t)pm * 256 * K * 2; u.B = Bt + (size_t)pn * 256 * K * 2; return true;
    }
    __device__ __forceinline__ void pf_issue(const Unit&, int&, float&) const {}
    __device__ __forceinline__ void pf_commit(int, int, float) const {}
    __device__ __forceinline__ void rowoffs(const Unit&, int, unsigned (&vo)[2][2], const int (&R)[2], const int (&C)[2]) const {
#pragma unroll
        for (int h = 0; h < 2; ++h)
#pragma unroll
            for (int i = 0; i < 2; ++i) vo[h][i] = (unsigned)((R[i] + 128 * h) * K + C[i]) * 2u;
    }
};
struct BranchSched {
    const char* A0; const char* A1; const char* B0; const char* B1; int nM, nN, K, G, c, dup;
    __device__ __forceinline__ bool next(int i, Unit& u) const {
        int L = (i >> 1) * G + c; if (L >= nM * nN * dup) return false; if (L >= nM * nN) L -= nM * nN;
        int pm, pn; pg8::static_tile(L, nM, nN, pm, pn);
        const int br = i & 1;
        u.pm = pm; u.pn = pn; u.e = br; u.rt = 0; u.A = (br ? A1 : A0) + (size_t)pm * 256 * K * 2; u.B = (br ? B1 : B0) + (size_t)pn * 256 * K * 2; return true;
    }
    __device__ __forceinline__ void pf_issue(const Unit&, int&, float&) const {}
    __device__ __forceinline__ void pf_commit(int, int, float) const {}
    __device__ __forceinline__ void rowoffs(const Unit&, int, unsigned (&vo)[2][2], const int (&R)[2], const int (&C)[2]) const {
#pragma unroll
        for (int h = 0; h < 2; ++h)
#pragma unroll
            for (int i = 0; i < 2; ++i) vo[h][i] = (unsigned)((R[i] + 128 * h) * K + C[i]) * 2u;
    }
};
template <int MODE> struct MoeSched {
    const LAS int* tab; const int* list; const float* listw; const char* A; const char* Bt; LAS int* rowA; LAS float* rowW; int total, G, vcu, dup;
    static constexpr int MULT = MODE == 0 ? 4 : 8, KB = MODE == 0 ? 2048 : 512  , NCOLS = MODE == 0 ? 1024 : 2048;
    __device__ __forceinline__ bool next(int i, Unit& u) const {
        int L = i * G + vcu; if (L >= total * dup) return false; if (L >= total) L -= total;
        int e, j, nrt;
        if (L < 32 * MULT) { e = 64; j = L; nrt = 32; }
        else {
            const int Lr = L - 32 * MULT; const int lane = threadIdx.x & 63;
            const int pin = tab[lane];
            const unsigned long long bal = __ballot(pin <= Lr);
            e = __builtin_popcountll(bal); e = e > 63 ? 63 : e;
            const int pex = e > 0 ? tab[e - 1] : 0; const int cnt = tab[64 + e];
            j = Lr - pex; nrt = (cnt + 255) >> 8; nrt = nrt < 1 ? 1 : nrt;
        }
        e = __builtin_amdgcn_readfirstlane(e); j = __builtin_amdgcn_readfirstlane(j); nrt = __builtin_amdgcn_readfirstlane(nrt);
        u.e = e; u.rt = j % nrt; u.pn = j / nrt; u.pm = 0;
        u.A = A; u.B = Bt + ((size_t)e * NCOLS + (size_t)u.pn * 256) * KB; return true;
    }
    __device__ __forceinline__ void pf_issue(const Unit& u, int& pa, float& pw) const {
        const int tid = threadIdx.x; pa = -1; pw = 0.f;
        if (tid < 256) { const int idx = u.rt * 256 + tid;
            if (u.e == 64) { pa = NASSIGN + idx; pw = 1.f; }
            else if (idx < tab[64 + u.e]) { pa = list[u.e * T + idx]; if (MODE == 1) pw = listw[u.e * T + idx]; } }
    }
    __device__ __forceinline__ void pf_commit(int s, int pa, float pw) const { const int tid = threadIdx.x; if (tid < 256) { rowA[s * 256 + tid] = pa; rowW[s * 256 + tid] = pw; } }
    __device__ __forceinline__ void rowoffs(const Unit& u, int s, unsigned (&vo)[2][2], const int (&R)[2], const int (&C)[2]) const {
#pragma unroll
        for (int h = 0; h < 2; ++h)
#pragma unroll
            for (int i = 0; i < 2; ++i) {
                int a = rowA[s * 256 + R[i] + 128 * h];
                unsigned row;
                if (MODE == 0) { a = a < 0 ? 0 : a; row = a < NASSIGN ? (unsigned)(a >> 3) : (unsigned)(a - NASSIGN); }
                else row = a < 0 ? 0u : (unsigned)a;
                vo[h][i] = row * (unsigned)KB + (unsigned)C[i] * 2u;
            }
    }
};

struct EpiZ {
    bf16_t* Z; float* FL; const float* fbias;
    __device__ __forceinline__ void operator()(const f32x4 (&acc)[2][2][4][2], const Unit& u, int slot, int wr, int wc, int fr, int fq) const {
        const int row0 = u.pm * 256 + wr * 64 + fr;
        if (u.pn == 34) {
            if (wc == 0 && fq < 2) {
                float fb[8];
#pragma unroll
                for (int j = 0; j < 8; ++j) fb[j] = fbias[8 * fq + j];
#pragma unroll
                for (int ai = 0; ai < 2; ++ai)
#pragma unroll
                    for (int m = 0; m < 4; ++m) {
                        float* o = FL + (size_t)(row0 + ai * 128 + m * 16) * 16 + 8 * fq;
#pragma unroll
                        for (int n = 0; n < 2; ++n) { f32x4 r;
#pragma unroll
                            for (int j = 0; j < 4; ++j) { const float x = acc[ai][0][m][n][j] + fb[4 * n + j]; const float ls = x >= 0.f ? -log1pf(expf(-x)) : x - log1pf(expf(x)); r[j] = ls * LOG2E; }
                            *(f32x4*)(o + 4 * n) = r; }
                    }
            }
            return;
        }
        const int mode = (u.pn < 4 || (u.pn >= 6 && u.pn < 10)) ? 1 : (u.pn >= 18 ? 2 : 0);
        const int col0 = u.pn * 256 + wc * 32 + 8 * fq;
#pragma unroll
        for (int ai = 0; ai < 2; ++ai)
#pragma unroll
            for (int m = 0; m < 4; ++m) { bf16_t* rowp = Z + (size_t)(row0 + ai * 128 + m * 16) * ZP + col0;
#pragma unroll
                for (int bj = 0; bj < 2; ++bj) { f32x4 v0 = acc[ai][bj][m][0], v1 = acc[ai][bj][m][1];
                    if (mode == 1) { v0 = v0 * QSCALE; v1 = v1 * QSCALE; }
                    else if (mode == 2) {
#pragma unroll
                        for (int j = 0; j < 4; ++j) { v0[j] = sigmoidf_(v0[j]); v1[j] = sigmoidf_(v1[j]); } }
                    u32x4 w; w.x = cvtpk(v0[0], v0[1]); w.y = cvtpk(v0[2], v0[3]); w.z = cvtpk(v1[0], v1[1]); w.w = cvtpk(v1[2], v1[3]);
                    *(u32x4*)(rowp + bj * 128) = w; } }
    }
};
struct EpiMix {
    const bf16_t* Z; bf16_t* MIX;
    __device__ __forceinline__ void operator()(const f32x4 (&acc)[2][2][4][2], const Unit& u, int slot, int wr, int wc, int fr, int fq) const {
        const int row0 = u.pm * 256 + wr * 64 + fr, col0 = u.pn * 256 + wc * 32 + 8 * fq;
        const int gcol = (u.e ? ZGF : ZGS) + col0;
#pragma unroll
        for (int ai = 0; ai < 2; ++ai)
#pragma unroll
            for (int m = 0; m < 4; ++m) { const size_t row = (size_t)(row0 + ai * 128 + m * 16);
#pragma unroll
                for (int bj = 0; bj < 2; ++bj) {
                    const u32x4 g = *(const u32x4*)(Z + row * ZP + gcol + bj * 128);
                    f32x4 v0 = acc[ai][bj][m][0], v1 = acc[ai][bj][m][1];
                    v0[0] *= bflo(g.x); v0[1] *= bfhi(g.x); v0[2] *= bflo(g.y); v0[3] *= bfhi(g.y);
                    v1[0] *= bflo(g.z); v1[1] *= bfhi(g.z); v1[2] *= bflo(g.w); v1[3] *= bfhi(g.w);
                    u32x4* mp = (u32x4*)(MIX + row * D + col0 + bj * 128);
                    if (u.e != 0) { const u32x4 t = *mp;
                        v0[0] += bflo(t.x); v0[1] += bfhi(t.x); v0[2] += bflo(t.y); v0[3] += bfhi(t.y);
                        v1[0] += bflo(t.z); v1[1] += bfhi(t.z); v1[2] += bflo(t.w); v1[3] += bfhi(t.w); }
                    u32x4 w; w.x = cvtpk(v0[0], v0[1]); w.y = cvtpk(v0[2], v0[3]); w.z = cvtpk(v1[0], v1[1]); w.w = cvtpk(v1[2], v1[3]);
                    *mp = w; } }
    }
};
struct EpiOut {
    const float* X; float* H1; float* PSQ;
    __device__ __forceinline__ void operator()(const f32x4 (&acc)[2][2][4][2], const Unit& u, int slot, int wr, int wc, int fr, int fq) const {
        const int row0 = u.pm * 256 + wr * 64 + fr, col0 = u.pn * 256 + wc * 32 + 8 * fq;
#pragma unroll
        for (int ai = 0; ai < 2; ++ai)
#pragma unroll
            for (int m = 0; m < 4; ++m) { const size_t row = (size_t)(row0 + ai * 128 + m * 16); float sq = 0.f;
#pragma unroll
                for (int bj = 0; bj < 2; ++bj) {
                    const float* xp = X + row * D + col0 + bj * 128; float* hp = H1 + row * D + col0 + bj * 128;
                    const f32x4 x0 = *(const f32x4*)xp, x1 = *(const f32x4*)(xp + 4);
                    const f32x4 h0 = acc[ai][bj][m][0] + x0, h1 = acc[ai][bj][m][1] + x1;
                    *(f32x4*)hp = h0; *(f32x4*)(hp + 4) = h1;
                    sq += (h0[0] * h0[0] + h0[1] * h0[1]) + (h0[2] * h0[2] + h0[3] * h0[3]) + (h1[0] * h1[0] + h1[1] * h1[1]) + (h1[2] * h1[2] + h1[3] * h1[3]); }
                sq += __shfl_xor(sq, 16); sq += __shfl_xor(sq, 32);
                if (fq == 0) PSQ[row * 32 + u.pn * 4 + wc] = sq; }
    }
};
__device__ __forceinline__ unsigned pk_fp8x4(float a, float b, float c, float d) {
    a = __builtin_amdgcn_fmed3f(a, -448.f, 448.f); b = __builtin_amdgcn_fmed3f(b, -448.f, 448.f); c = __builtin_amdgcn_fmed3f(c, -448.f, 448.f); d = __builtin_amdgcn_fmed3f(d, -448.f, 448.f);
    int r = __builtin_amdgcn_cvt_pk_fp8_f32(a, b, 0, false); r = __builtin_amdgcn_cvt_pk_fp8_f32(c, d, r, true); return (unsigned)r;
}
constexpr float WGU_SCALE = 32.f, WD_SCALE = 16.f;
struct EpiSwiglu {
    const MoeSched<0>* S; unsigned char* HB8;
    __device__ __forceinline__ void operator()(const f32x4 (&acc)[2][2][4][2], const Unit& u, int slot, int wr, int wc, int fr, int fq) const {
        const int ff0 = u.pn * 128 + wc * 32 + 8 * fq;
#pragma unroll
        for (int ai = 0; ai < 2; ++ai)
#pragma unroll
            for (int m = 0; m < 4; ++m) { const int a = S->rowA[slot * 256 + ai * 128 + wr * 64 + m * 16 + fr];
                if (a >= 0) { float h[8];
#pragma unroll
                    for (int n = 0; n < 2; ++n)
#pragma unroll
                        for (int j = 0; j < 4; ++j) { const float g = acc[ai][0][m][n][j] * (1.f / WGU_SCALE), up = acc[ai][1][m][n][j] * (1.f / WGU_SCALE); h[4 * n + j] = g * sigmoidf_(g) * up; }
                    u32x2 w; w.x = pk_fp8x4(h[0], h[1], h[2], h[3]); w.y = pk_fp8x4(h[4], h[5], h[6], h[7]);
                    *(u32x2*)(HB8 + (size_t)a * FF + ff0) = w; } }
    }
};
constexpr float YB_SCALE = 16.f;
struct EpiDown {
    const MoeSched<1>* S; unsigned char* YB8;
    __device__ __forceinline__ void operator()(const f32x4 (&acc)[2][2][4][2], const Unit& u, int slot, int wr, int wc, int fr, int fq) const {
        const int col0 = u.pn * 256 + wc * 32 + 8 * fq;
#pragma unroll
        for (int ai = 0; ai < 2; ++ai)
#pragma unroll
            for (int m = 0; m < 4; ++m) { const int ri = slot * 256 + ai * 128 + wr * 64 + m * 16 + fr; const int a = S->rowA[ri];
                if (a >= 0) { const float w8 = S->rowW[ri] * (YB_SCALE / WD_SCALE);
#pragma unroll
                    for (int bj = 0; bj < 2; ++bj) { const f32x4 v0 = acc[ai][bj][m][0] * w8, v1 = acc[ai][bj][m][1] * w8;
                        u32x2 w; w.x = pk_fp8x4(v0[0], v0[1], v0[2], v0[3]); w.y = pk_fp8x4(v1[0], v1[1], v1[2], v1[3]);
                        *(u32x2*)(YB8 + (size_t)a * D + col0 + bj * 128) = w; } } }
    }
};

struct P0Item { const float* src; unsigned char* dst; int ldw, nvalid, K, fp8; float scale; };
__device__ __forceinline__ void p0_map(int r, int NB, int& kp, int& nb) { kp = r / NB; nb = r % NB; }
__device__ __forceinline__ P0Item p0_decode(int pr, int half, const Args& a, unsigned char* ws) {
    constexpr int P_IN = 16 * 140, P_SW = 8 * 32, P_OUT = 16 * 32, P_GU = 16 * 8, P_DN = 4 * 32, P_EXP = 2 * P_GU + P_DN;
    P0Item q; q.fp8 = 0; q.scale = 1.f; int r = pr;
    if (r < P_IN) { int kp, nb; p0_map(r, 140, kp, nb); const int kb = 2 * kp + half, n0 = nb * 64;
        int c0, nv; if (n0 < 4608) { c0 = n0; nv = 64; } else if (n0 < 8704) { c0 = n0 + 16; nv = 64; } else if (n0 == 8704) { c0 = 4608; nv = 16; } else { c0 = 0; nv = 0; }
        q.src = a.in[2] + (size_t)kb * 64 * 8720 + c0; q.ldw = 8720; q.nvalid = nv; q.K = D; q.dst = ws + WS_WINT + ((size_t)n0 * D + kb * 64) * 2; return q; }
    r -= P_IN;
    if (r < P_SW) { int kp, nb; p0_map(r, 32, kp, nb); const int kb = 2 * kp + half; q.src = a.in[5] + (size_t)kb * 64 * D + nb * 64; q.ldw = D; q.nvalid = 64; q.K = 1024; q.dst = ws + WS_WSWAT + ((size_t)nb * 64 * 1024 + kb * 64) * 2; return q; }
    r -= P_SW;
    if (r < P_SW) { int kp, nb; p0_map(r, 32, kp, nb); const int kb = 2 * kp + half; q.src = a.in[6] + (size_t)kb * 64 * D + nb * 64; q.ldw = D; q.nvalid = 64; q.K = 1024; q.dst = ws + WS_WFOXT + ((size_t)nb * 64 * 1024 + kb * 64) * 2; return q; }
    r -= P_SW;
    if (r < P_OUT) { int kp, nb; p0_map(r, 32, kp, nb); const int kb = 2 * kp + half; q.src = a.in[7] + (size_t)kb * 64 * D + nb * 64; q.ldw = D; q.nvalid = 64; q.K = D; q.dst = ws + WS_WOUTT + ((size_t)nb * 64 * D + kb * 64) * 2; return q; }
    r -= P_OUT;
    const int e = r / P_EXP; r -= e * P_EXP; q.fp8 = 1;
    if (r < 2 * P_GU) { const int up = r >= P_GU; r -= up * P_GU; int kp, nb; p0_map(r, 8, kp, nb); const int kb = 2 * kp + half, n0 = nb * 64;
        const float* src = e < 64 ? (up ? a.in[12] : a.in[11]) + (size_t)e * D * FF : (up ? a.in[15] : a.in[14]);
        const int drow = 256 * (n0 >> 7) + (n0 & 127) + 128 * up;
        q.src = src + (size_t)kb * 64 * FF + n0; q.ldw = FF; q.nvalid = 64; q.K = D; q.scale = WGU_SCALE; q.dst = ws + WS_WGU + ((size_t)e * 1024 + drow) * D + kb * 64; return q; }
    r -= 2 * P_GU;
    { int kp, nb; p0_map(r, 32, kp, nb); const int kb = 2 * kp + half;
        const float* src = e < 64 ? a.in[13] + (size_t)e * FF * D : a.in[16];
        q.src = src + (size_t)kb * 64 * D + nb * 64; q.ldw = D; q.nvalid = 64; q.K = FF; q.scale = WD_SCALE; q.dst = ws + WS_WD + ((size_t)e * D + nb * 64) * FF + kb * 64; return q; }
}
__device__ __forceinline__ void p0_load(const P0Item& q, f32x4 (&v)[16], int lane) {
    const int kr = lane >> 4, nc = (lane & 15) * 4; const bool ok = nc < q.nvalid;
    const float* p = q.src + (size_t)kr * q.ldw + nc;
#pragma unroll
    for (int i = 0; i < 16; ++i) v[i] = ok ? *(const f32x4*)(p + (size_t)(4 * i) * q.ldw) : (f32x4){0.f, 0.f, 0.f, 0.f};
}
__device__ __forceinline__ void p0_process(const P0Item& q, const f32x4 (&v)[16], LAS float* scr, int lane, bool st = true) {
    const int kr = lane >> 4, nc = (lane & 15) * 4;
#pragma unroll
    for (int i = 0; i < 16; ++i) { LAS float* w = scr + (4 * i + kr) * 65 + nc; w[0] = v[i][0]; w[1] = v[i][1]; w[2] = v[i][2]; w[3] = v[i][3]; }
    LDS_WAIT(); asm volatile("" ::: "memory");
    if (q.fp8) {
        const int c = lane & 3; const float sc = q.scale;
#pragma unroll
        for (int j = 0; j < 4; ++j) { const int n = (lane >> 2) + 16 * j; const LAS float* s = scr + (16 * c) * 65 + n;
            u32x4 o; o.x = pk_fp8x4(s[0 * 65] * sc, s[1 * 65] * sc, s[2 * 65] * sc, s[3 * 65] * sc); o.y = pk_fp8x4(s[4 * 65] * sc, s[5 * 65] * sc, s[6 * 65] * sc, s[7 * 65] * sc);
            o.z = pk_fp8x4(s[8 * 65] * sc, s[9 * 65] * sc, s[10 * 65] * sc, s[11 * 65] * sc); o.w = pk_fp8x4(s[12 * 65] * sc, s[13 * 65] * sc, s[14 * 65] * sc, s[15 * 65] * sc);
            if (st) *(u32x4*)(q.dst + (size_t)n * q.K + 16 * c) = o; else asm volatile("" :: "v"(o)); }
    } else {
        const int c = lane & 7;
#pragma unroll
        for (int j = 0; j < 8; ++j) { const int n = (lane >> 3) + 8 * j; const LAS float* s = scr + (8 * c) * 65 + n;
            u32x4 o; o.x = cvtpk(s[0 * 65], s[1 * 65]); o.y = cvtpk(s[2 * 65], s[3 * 65]); o.z = cvtpk(s[4 * 65], s[5 * 65]); o.w = cvtpk(s[6 * 65], s[7 * 65]);
            if (st) *(u32x4*)(q.dst + ((size_t)n * q.K + 8 * c) * 2) = o; else asm volatile("" :: "v"(o)); }
    }
    LDS_WAIT(); asm volatile("" ::: "memory");
}
__device__ __forceinline__ void p0_prologue(Frame& F, const Args& a) {
    LAS float* scr = (LAS float*)(F.lds + F.wave * 16640);
    const int gw = F.vcu * NWAVES + F.wave, NGW = F.G * NWAVES;
    unsigned char* ws = F.ws;
    {
        const float* g = a.in[1];
        for (int m = gw; m < T; m += NGW) {
            const f32x4* xr = (const f32x4*)(a.in[0] + (size_t)m * D) + F.lane;
            f32x4 v[8]; float s = 0.f;
#pragma unroll
            for (int j = 0; j < 8; ++j) { v[j] = xr[64 * j]; s += (v[j].x * v[j].x + v[j].y * v[j].y) + (v[j].z * v[j].z + v[j].w * v[j].w); }
            const float rinv = rsqrtf(wave_sum(s) * (1.f / D) + RMS_EPS);
            u32x2* o = (u32x2*)((bf16_t*)(ws + WS_U) + (size_t)m * D) + F.lane;
#pragma unroll
            for (int j = 0; j < 8; ++j) { const f32x4 gg = *((const f32x4*)g + F.lane + 64 * j); u32x2 w; w.x = cvtpk(v[j].x * rinv * gg.x, v[j].y * rinv * gg.y); w.y = cvtpk(v[j].z * rinv * gg.z, v[j].w * rinv * gg.w); o[64 * j] = w; }
        }
    }
    {
        const float* wr = a.in[9]; const float* g = a.in[8]; float* o = (float*)(ws + WS_WRG);
        for (int i = gw * 64 + F.lane; i < D * NE; i += NGW * 64) o[i] = wr[i] * g[i >> 6];
    }
    constexpr int NPAIRS = 16 * 140 + 2 * 8 * 32 + 16 * 32 + 65 * (2 * 16 * 8 + 4 * 32);
    f32x4 va[16], vb[16]; P0Item qa, qb;
    constexpr int NPR = NPAIRS * ((PROBE_DUP == 0 || PROBE_DUP == 11) ? 2 : (PROBE_DUP == 10 ? 3 : 1));
    constexpr int NJ = (NPR + 2047) / 2048;
    const int nj = (NPR + NGW - 1) / NGW;
    int pr = gw;
    if (pr < NPR) { qa = p0_decode(pr % NPAIRS, 0, a, ws); p0_load(qa, va, F.lane); }
    for (int j = 0; j < nj; ++j) {
        const bool act = pr < NPR;
        if (act) { qb = p0_decode(pr % NPAIRS, 1, a, ws); p0_load(qb, vb, F.lane); }
        const bool st = !(PROBE_DUP == 11 && pr >= NPAIRS);
        if (act) p0_process(qa, va, scr, F.lane, st);
        __builtin_amdgcn_s_barrier();
        const int pn = pr + NGW;
        if (pn < NPR) { qa = p0_decode(pn % NPAIRS, 0, a, ws); p0_load(qa, va, F.lane); }
        if (act) p0_process(qb, vb, scr, F.lane, st);
        __builtin_amdgcn_s_barrier();
        pr = pn;
    }
    (void)NJ;
}

__device__ __forceinline__ int crow(int r, int hi) { return (r & 3) + 8 * (r >> 2) + 4 * hi; }
__device__ __forceinline__ s16x4 vtr(LAS const char* p) { typedef short v4i16_t __attribute__((ext_vector_type(4))); return __builtin_bit_cast(s16x4, __builtin_amdgcn_ds_read_tr16_b64_v4i16((LAS v4i16_t*)p)); }

__device__ __forceinline__ void attn_qk(f32x16 (&p)[2], const bf16x8 (&qf)[4], LAS const char* Kt, int r32, int hi) {
#pragma unroll
    for (int kb = 0; kb < 2; ++kb) { const int kv = 32 * kb + r32; const int sw = (kv >> 1) & 7; LAS const char* rowp = Kt + kv * 128;
        f32x16 c = {};
#pragma unroll
        for (int s = 0; s < 4; ++s) { const bf16x8 a = *(const LAS bf16x8*)(rowp + (((2 * s + hi) ^ sw) * 16)); c = __builtin_amdgcn_mfma_f32_32x32x16_bf16(a, qf[s], c, 0, 0, 0); }
        p[kb] = c; }
}
__device__ __forceinline__ void attn_softmax_pv(f32x16 (&p)[2], f32x16 (&o)[2], float& m, float& l, LAS const char* Vt, int lane) {
    float mx = p[0][0];
#pragma unroll
    for (int kb = 0; kb < 2; ++kb)
#pragma unroll
        for (int r = 0; r < 16; ++r) mx = fmaxf(mx, p[kb][r]);
    mx = fmaxf(mx, __shfl_xor(mx, 32));
    const float mn = fmaxf(m, mx);
    const float alpha = __builtin_amdgcn_exp2f(m - mn);
    float rs = 0.f;
#pragma unroll
    for (int kb = 0; kb < 2; ++kb)
#pragma unroll
        for (int r = 0; r < 16; ++r) { const float e = __builtin_amdgcn_exp2f(p[kb][r] - mn); p[kb][r] = e; rs += e; }
    rs += __shfl_xor(rs, 32);
    l = l * alpha + rs; m = mn;
#pragma unroll
    for (int db = 0; db < 2; ++db)
#pragma unroll
        for (int r = 0; r < 16; ++r) o[db][r] *= alpha;
    const int g = lane >> 4, i = lane & 15;
    LAS const char* vb = Vt + (4 * (g >> 1) + (i >> 2)) * 64 + (g & 1) * 32 + (i & 3) * 8;
#pragma unroll
    for (int kb = 0; kb < 2; ++kb)
#pragma unroll
        for (int ks = 0; ks < 2; ++ks) {
            u32x4 pw; pw.x = cvtpk(p[kb][8 * ks + 0], p[kb][8 * ks + 1]); pw.y = cvtpk(p[kb][8 * ks + 2], p[kb][8 * ks + 3]); pw.z = cvtpk(p[kb][8 * ks + 4], p[kb][8 * ks + 5]); pw.w = cvtpk(p[kb][8 * ks + 6], p[kb][8 * ks + 7]);
            const bf16x8 pb = __builtin_bit_cast(bf16x8, pw);
#pragma unroll
            for (int db = 0; db < 2; ++db) {
                const s16x4 lo = vtr(vb + db * 4096 + (32 * kb + 16 * ks) * 64), hi4 = vtr(vb + db * 4096 + (32 * kb + 16 * ks + 8) * 64);
                const bf16x8 va = (bf16x8){lo[0], lo[1], lo[2], lo[3], hi4[0], hi4[1], hi4[2], hi4[3]};
                o[db] = __builtin_amdgcn_mfma_f32_32x32x16_bf16(va, pb, o[db], 0, 0, 0); } }
}
__device__ __forceinline__ void attn_store_kv(LAS char* Kt, LAS char* Vt, const u32x4& kr, const u32x4& vr, int tid) {
    const int kv = tid >> 3, c = tid & 7;
    *(LAS u32x4*)(Kt + kv * 128 + ((c ^ ((kv >> 1) & 7)) * 16)) = kr;
    *(LAS u32x4*)(Vt + (c >> 2) * 4096 + kv * 64 + (c & 3) * 16) = vr;
}
__device__ __forceinline__ void attn_store_o(const f32x16 (&o)[2], float l, bf16_t* orow, int hi) {
    const float rl = 1.0f / l;
#pragma unroll
    for (int db = 0; db < 2; ++db)
#pragma unroll
        for (int rq = 0; rq < 4; ++rq) { u32x2 w; w.x = cvtpk(o[db][4 * rq] * rl, o[db][4 * rq + 1] * rl); w.y = cvtpk(o[db][4 * rq + 2] * rl, o[db][4 * rq + 3] * rl);
            *(u32x2*)(orow + 32 * db + 8 * rq + 4 * hi) = w; }
}

__device__ __forceinline__ void swa_unit(Frame& F, int unit, const float* sinks) {
    const bf16_t* Z = (const bf16_t*)(F.ws + WS_Z); bf16_t* YS = (bf16_t*)(F.ws + WS_YS);
    const int b = unit >> 6, kvh = (unit >> 4) & 3, nb = unit & 15;
    const int tid = F.tid, lane = F.lane, r32 = lane & 31, hi = lane >> 5, w = F.wave;
    LAS char* Kl = (LAS char*)F.lds; LAS char* Vl = (LAS char*)F.lds + 32768;
    const int t0 = nb * 128;
    {
        const int kv = tid >> 3, c = tid & 7;
#pragma unroll
        for (int tl = 0; tl < 4; ++tl) {
            if (nb > 0 || tl >= 2) {
                const size_t row = (size_t)(b * SEQ + t0 - 128 + tl * 64 + kv);
                const u32x4 kr = *(const u32x4*)(Z + row * ZP + ZK + kvh * 64 + c * 8);
                const u32x4 vr = *(const u32x4*)(Z + row * ZP + ZV + kvh * 64 + c * 8);
                attn_store_kv(Kl + tl * 8192, Vl + tl * 8192, kr, vr, tid);
            }
        }
    }
    __syncthreads();
    const int qh = kvh * 4 + (w >> 1);
    const float slope2 = exp2f(-0.5f * (float)(qh + 1)) * LOG2E;
    const float sink2 = sinks[qh] * LOG2E;
#pragma unroll 1
    for (int sb = 0; sb < 2; ++sb) {
        const int r0 = 64 * (w & 1) + 32 * sb;
        const int qrel = r0 + r32;
        const size_t qrow = (size_t)(b * SEQ + t0 + qrel);
        bf16x8 qf[4];
#pragma unroll
        for (int s = 0; s < 4; ++s) qf[s] = *(const bf16x8*)(Z + qrow * ZP + ZQ + qh * 64 + 16 * s + 8 * hi);
        f32x16 o[2]; o[0] = f32x16{}; o[1] = f32x16{};
        float m = sink2, l = 1.0f;
        const int tl0 = (r0 + 1) >> 6;
#pragma unroll 1
        for (int tt = 0; tt < 3; ++tt) {
            const int tl = tl0 + tt;
            if (nb == 0 && tl < 2) continue;
            f32x16 p[2];
            attn_qk(p, qf, Kl + tl * 8192, r32, hi);
#pragma unroll
            for (int kb = 0; kb < 2; ++kb)
#pragma unroll
                for (int r = 0; r < 16; ++r) {
                    const int krel = tl * 64 + 32 * kb + crow(r, hi) - 128;
                    const int dist = qrel - krel;
                    const float s = p[kb][r] - slope2 * (float)dist;
                    p[kb][r] = (dist >= 0 && dist < 128) ? s : -INFINITY;
                }
            attn_softmax_pv(p, o, m, l, Vl + tl * 8192, lane);
        }
        attn_store_o(o, l, YS + qrow * 1024 + qh * 64, hi);
    }
    __syncthreads();
}

__device__ __forceinline__ void fox_unit(Frame& F, int bh, int qb, LAS const float* c2) {
    const bf16_t* Z = (const bf16_t*)(F.ws + WS_Z); bf16_t* YF = (bf16_t*)(F.ws + WS_YF);
    const int b = bh >> 4, h = bh & 15;
    const int tid = F.tid, lane = F.lane, r32 = lane & 31, hi = lane >> 5, w = F.wave;
    LAS char* Kl = (LAS char*)F.lds; LAS char* Vl = (LAS char*)F.lds + 16384;
    const int q0 = qb * 256, qw = q0 + 32 * w, qabs = qw + r32;
    const size_t qrow = (size_t)(b * SEQ + qabs);
    const int NT = 4 * (qb + 1);
    const int kvr = tid >> 3, kc = tid & 7;
    const bf16_t* kbase = Z + (size_t)(b * SEQ + kvr) * ZP + ZFK + h * 64 + kc * 8;
    const bf16_t* vbase = Z + (size_t)(b * SEQ + kvr) * ZP + ZFV + h * 64 + kc * 8;
    u32x4 kr = *(const u32x4*)kbase, vr = *(const u32x4*)vbase;
    bf16x8 qf[4];
#pragma unroll
    for (int s = 0; s < 4; ++s) qf[s] = *(const bf16x8*)(Z + qrow * ZP + ZFQ + h * 64 + 16 * s + 8 * hi);
    attn_store_kv(Kl, Vl, kr, vr, tid);
    __syncthreads();
    f32x16 o[2]; o[0] = f32x16{}; o[1] = f32x16{};
    float m = -1e30f, l = 0.f;
#pragma unroll 1
    for (int t = 0; t < NT; ++t) {
        const int buf = t & 1;
        if (t + 1 < NT) { kr = *(const u32x4*)(kbase + (size_t)(t + 1) * 64 * ZP); vr = *(const u32x4*)(vbase + (size_t)(t + 1) * 64 * ZP); }
        const int k0 = t * 64;
        if (k0 <= qw + 31) {
            f32x16 p[2];
            attn_qk(p, qf, Kl + buf * 8192, r32, hi);
            const bool diag = (k0 + 63 > qw);
#pragma unroll
            for (int kb = 0; kb < 2; ++kb)
#pragma unroll
                for (int rq = 0; rq < 4; ++rq) {
                    const int kk = k0 + 32 * kb + 8 * rq + 4 * hi;
                    const f32x4 cc = *(const LAS f32x4*)(c2 + kk);
#pragma unroll
                    for (int j = 0; j < 4; ++j) { float s = p[kb][4 * rq + j] - cc[j]; if (diag && (kk + j > qabs)) s = -INFINITY; p[kb][4 * rq + j] = s; }
                }
            attn_softmax_pv(p, o, m, l, Vl + buf * 8192, lane);
        }
        if (t + 1 < NT) attn_store_kv(Kl + (buf ^ 1) * 8192, Vl + (buf ^ 1) * 8192, kr, vr, tid);
        __syncthreads();
    }
    attn_store_o(o, l, YF + qrow * 1024 + h * 64, hi);
}
__device__ __forceinline__ void p2_attention(Frame& F, const Args& a) {
    for (int u = F.vcu; u < 256; u += F.G) swa_unit(F, u, a.in[4]);
    LAS float* c2 = (LAS float*)(F.lds + 32768);
    LAS float* wtot = (LAS float*)(F.lds + 32768 + 8192);
    const float* FL = (const float*)(F.ws + WS_FL);
    for (int it = F.vcu; it < 256; it += F.G) {
        const int bh = it >> 2, s = it & 3, b = bh >> 4, h = bh & 15;
        {
            float v[4]; float run = 0.f;
#pragma unroll
            for (int j = 0; j < 4; ++j) { run += FL[(size_t)(b * SEQ + 4 * F.tid + j) * 16 + h]; v[j] = run; }
            float inc = run;
#pragma unroll
            for (int o = 1; o < 64; o <<= 1) { const float n = __shfl_up(inc, o); if (F.lane >= o) inc += n; }
            if (F.lane == 63) wtot[F.wave] = inc;
            __syncthreads();
            float base = inc - run;
            for (int ww = 0; ww < F.wave; ++ww) base += wtot[ww];
#pragma unroll
            for (int j = 0; j < 4; ++j) c2[4 * F.tid + j] = base + v[j];
            __syncthreads();
        }
        fox_unit(F, bh, s, c2);
        fox_unit(F, bh, 7 - s, c2);
        __syncthreads();
    }
}

__device__ __forceinline__ void p5_router(Frame& F, const Args& a, unsigned* CNT, float* LISTW, int* LIST) {
    const float* H1 = (const float*)(F.ws + WS_H1); const float* PSQ = (const float*)(F.ws + WS_PSQ); const float* WRG = (const float*)(F.ws + WS_WRG);
    unsigned char* V8 = F.ws + WS_V;
    const float* g = a.in[8]; const float* rbias = a.in[10];
    const int lane = F.lane, w = F.wave, tid = F.tid;
    LAS float* part = (LAS float*)F.lds;
    LAS float* logit = (LAS float*)(F.lds + 65536);
    LAS float* rinvs = (LAS float*)(F.lds + 65536 + 8192);
    LAS int* lcnt = (LAS int*)(F.lds + 65536 + 8192 + 128);
    LAS int* gbase = (LAS int*)(F.lds + 65536 + 8192 + 128 + 256);
    for (int tile = F.vcu; tile < T / 32; tile += F.G) {
        const int tok0 = tile * 32;
        if (tid < 64) lcnt[tid] = 0;
#pragma unroll 1
        for (int j = 0; j < 4; ++j) {
            const int tok = tok0 + 4 * w + j;
            float sq = lane < 32 ? PSQ[(size_t)tok * 32 + lane] : 0.f;
            sq = wave_sum(sq);
            const float rinv = rsqrtf(sq * (1.f / D) + RMS_EPS);
            if (lane == 0) rinvs[4 * w + j] = rinv;
            const f32x4* hr = (const f32x4*)(H1 + (size_t)tok * D) + lane;
            unsigned* o = (unsigned*)(V8 + (size_t)tok * D) + lane;
#pragma unroll
            for (int jj = 0; jj < 8; ++jj) { const f32x4 hv = hr[64 * jj]; const f32x4 gg = *((const f32x4*)g + lane + 64 * jj);
                o[64 * jj] = pk_fp8x4(hv.x * rinv * gg.x, hv.y * rinv * gg.y, hv.z * rinv * gg.z, hv.w * rinv * gg.w); }
        }
        {
            f32x16 acc0 = {}, acc1 = {};
            const int tk = lane & 31, half = lane >> 5;
            const float* hp = H1 + (size_t)(tok0 + tk) * D + 256 * w + 4 * half;
            const float* wp = WRG + (size_t)(256 * w + 4 * half) * NE + tk;
#pragma unroll 4
            for (int kk = 0; kk < 32; ++kk) {
                const f32x4 av = *(const f32x4*)(hp + 8 * kk);
#pragma unroll
                for (int s = 0; s < 4; ++s) {
                    const float b0 = wp[(size_t)(8 * kk + s) * NE], b1 = wp[(size_t)(8 * kk + s) * NE + 32];
                    acc0 = __builtin_amdgcn_mfma_f32_32x32x2f32(av[s], b0, acc0, 0, 0, 0);
                    acc1 = __builtin_amdgcn_mfma_f32_32x32x2f32(av[s], b1, acc1, 0, 0, 0);
                }
            }
#pragma unroll
            for (int r = 0; r < 16; ++r) { const int tr = crow(r, half); part[(w * 32 + tr) * 64 + tk] = acc0[r]; part[(w * 32 + tr) * 64 + 32 + tk] = acc1[r]; }
        }
        __syncthreads();
#pragma unroll
        for (int q = 0; q < 4; ++q) { const int idx = tid + 512 * q; float s = 0.f;
#pragma unroll
            for (int ww = 0; ww < 8; ++ww) s += part[ww * 2048 + idx];
            logit[idx] = s * rinvs[idx >> 6]; }
        __syncthreads();
        int sel_k[4], sel_ls[4]; float sel_w[4];
        const float bias = rbias[lane];
#pragma unroll
        for (int j = 0; j < 4; ++j) {
            const int tl = 4 * w + j;
            const float score = sigmoidf_(logit[tl * 64 + lane]);
            const float biased = score + bias;
            float m1 = biased; m1 = fmaxf(m1, __shfl_xor(m1, 1)); m1 = fmaxf(m1, __shfl_xor(m1, 2)); m1 = fmaxf(m1, __shfl_xor(m1, 4));
            const unsigned long long gm = 0xFFull << (lane & 56);
            const unsigned long long b1 = __ballot(biased == m1) & gm;
            const int i1 = __builtin_ctzll(b1);
            float v2 = (lane == i1) ? -INFINITY : biased;
            float m2 = v2; m2 = fmaxf(m2, __shfl_xor(m2, 1)); m2 = fmaxf(m2, __shfl_xor(m2, 2)); m2 = fmaxf(m2, __shfl_xor(m2, 4));
            const float gs = m1 + m2; const int gi = lane >> 3;
            int rank = 0;
#pragma unroll
            for (int gg = 0; gg < 8; ++gg) { const float o = __shfl(gs, 8 * gg); rank += (o > gs || (o == gs && gg < gi)) ? 1 : 0; }
            float mv = rank < 4 ? biased : -INFINITY;
            int myk = -1;
#pragma unroll
            for (int it = 0; it < 8; ++it) { const float mx = wave_max(mv); const unsigned long long bb = __ballot(mv == mx); const int sl = __builtin_ctzll(bb); if (lane == sl) { myk = it; mv = -INFINITY; } }
            const float ssum = wave_sum(myk >= 0 ? score : 0.f);
            sel_k[j] = myk; sel_w[j] = score / ssum * 2.5f;
            sel_ls[j] = 0;
            if (myk >= 0) sel_ls[j] = __hip_atomic_fetch_add((LAS int*)&lcnt[lane], 1, __ATOMIC_RELAXED, __HIP_MEMORY_SCOPE_WORKGROUP);
        }
        __syncthreads();
        if (tid < 64) gbase[tid] = (int)atomicAdd(CNT + tid, (unsigned)lcnt[tid]);
        __syncthreads();
#pragma unroll
        for (int j = 0; j < 4; ++j) if (sel_k[j] >= 0) { const int tok = tok0 + 4 * w + j; const int aid = tok * 8 + sel_k[j];
            const size_t li = (size_t)lane * T + gbase[lane] + sel_ls[j]; LIST[li] = aid; LISTW[li] = sel_w[j]; }
        __syncthreads();
    }
}

template <int MULT> __device__ __forceinline__ int moe_table(Frame& F, LAS int* tab) {
    if (F.tid < 64) {
        const int cnt = (int)__hip_atomic_load(F.ctl + CW_CNT + F.tid, __ATOMIC_RELAXED, __HIP_MEMORY_SCOPE_AGENT);
        int inc = ((cnt + 255) >> 8) * MULT;
#pragma unroll
        for (int o = 1; o < 64; o <<= 1) { const int n = __shfl_up(inc, o); if (F.lane >= o) inc += n; }
        tab[F.tid] = inc; tab[64 + F.tid] = cnt;
    }
    __syncthreads();
    return 32 * MULT + tab[63];
}

__device__ __forceinline__ void p8_final(Frame& F, const Args& a) {
    const float* H1 = (const float*)(F.ws + WS_H1); const unsigned char* YB8 = F.ws + WS_YB; const float* g = a.in[17];
    const int gw = F.vcu * NWAVES + F.wave, NGW = F.G * NWAVES;
    for (int tok = gw; tok < T; tok += NGW) {
        const f32x4* hr = (const f32x4*)(H1 + (size_t)tok * D) + F.lane;
        f32x4 v[8], y[8];
#pragma unroll
        for (int j = 0; j < 8; ++j) { v[j] = hr[64 * j]; y[j] = (f32x4){0.f, 0.f, 0.f, 0.f}; }
#pragma unroll 3
        for (int k = 0; k < 9; ++k) {
            const size_t row = k < 8 ? (size_t)tok * 8 + k : (size_t)NASSIGN + tok;
            const unsigned* yr = (const unsigned*)(YB8 + row * D) + F.lane;
#pragma unroll
            for (int j = 0; j < 8; ++j) { const unsigned w = yr[64 * j]; const f32x2 lo = __builtin_amdgcn_cvt_pk_f32_fp8((int)w, false), hi = __builtin_amdgcn_cvt_pk_f32_fp8((int)w, true);
                y[j].x += lo.x; y[j].y += lo.y; y[j].z += hi.x; y[j].w += hi.y; }
        }
#pragma unroll
        for (int j = 0; j < 8; ++j) v[j] = v[j] + y[j] * (1.f / YB_SCALE);
        float s = 0.f;
#pragma unroll
        for (int j = 0; j < 8; ++j) s += (v[j].x * v[j].x + v[j].y * v[j].y) + (v[j].z * v[j].z + v[j].w * v[j].w);
        const float rinv = rsqrtf(wave_sum(s) * (1.f / D) + RMS_EPS);
        f32x4* o = (f32x4*)(a.out + (size_t)tok * D) + F.lane;
#pragma unroll
        for (int j = 0; j < 8; ++j) { const f32x4 gg = *((const f32x4*)g + F.lane + 64 * j); o[64 * j] = (f32x4){v[j].x * rinv * gg.x, v[j].y * rinv * gg.y, v[j].z * rinv * gg.z, v[j].w * rinv * gg.w}; }
    }
}

constexpr int N_PHASES = 9;
__global__ void __launch_bounds__(NTHREADS, 2) fwd_kernel(Args args) {
    extern __shared__ __attribute__((aligned(16))) unsigned char lds_raw[];
    Frame F;
    F.lds = (LAS unsigned char*)lds_raw;
    F.MISC = (volatile LAS unsigned*)(F.lds + MISC_OFF);
    F.tid = threadIdx.x; F.lane = F.tid & 63; F.wave = __builtin_amdgcn_readfirstlane(F.tid >> 6);
    F.G = gridDim.x; { const int bx = blockIdx.x; F.vcu = (F.G % 8 == 0) ? (bx % 8) * (F.G / 8) + bx / 8 : bx; }
    F.ws = args.ws; F.ctl = (unsigned*)(args.ws + WS_CTL);
    for (int u = F.tid; u < (LDS_BYTES - MISC_OFF) / 4; u += NTHREADS) ((LAS unsigned*)(F.lds + MISC_OFF))[u] = 0u;
    __syncthreads();
    const int lo = args.ph_lo, hi = args.ph_hi;
    XcdBarrier bar; bar.bar = F.ctl + CW_BAR; bar.x = 0; bar.st = nullptr;
    if (hi - lo > 1) bar = xcd_barrier_post(F.ctl + CW_BAR, F.MISC + 8);
#define IN(k) (lo <= (k) && (k) < hi)
#define SEAM(k) do { if (IN(k) && IN((k) + 1)) xcd_barrier(bar); } while (0)
    unsigned char* ws = args.ws;
    LAS int* tab = (LAS int*)(F.lds + MISC_OFF + 256);

#define REPS(k) for (int rep_ = 0; rep_ < (PROBE_DUP == (k) ? 2 : 1); ++rep_)
#define REPBAR(k) do { if (PROBE_DUP == (k) && rep_ == 0) xcd_barrier(bar); } while (0)
    if (IN(0)) { p0_prologue(F, args); SEAM(0); }
    if (IN(1)) {
        DenseSched S{(const char*)(ws + WS_U), (const char*)(ws + WS_WINT), T / 256, NIN / 256, D, F.G, (int)blockIdx.x, PROBE_DUP == 1 ? 2 : 1};
        EpiZ E{(bf16_t*)(ws + WS_Z), (float*)(ws + WS_FL), args.in[3]};
        pg8::gemm_phase<false>(F.lds, 2 * D, S, E);
        SEAM(1);
    }
    if (IN(2)) { REPS(2) { p2_attention(F, args); REPBAR(2); } SEAM(2); }
    if (IN(3)) {
        BranchSched S{(const char*)(ws + WS_YS), (const char*)(ws + WS_YF), (const char*)(ws + WS_WSWAT), (const char*)(ws + WS_WFOXT), T / 256, D / 256, 1024, F.G, (int)blockIdx.x, PROBE_DUP == 3 ? 2 : 1};
        EpiMix E{(const bf16_t*)(ws + WS_Z), (bf16_t*)(ws + WS_MIX)};
        pg8::gemm_phase<false>(F.lds, 2 * 1024, S, E);
        SEAM(3);
    }
    if (IN(4)) {
        DenseSched S{(const char*)(ws + WS_MIX), (const char*)(ws + WS_WOUTT), T / 256, D / 256, D, F.G, (int)blockIdx.x, PROBE_DUP == 4 ? 2 : 1};
        EpiOut E{args.in[0], (float*)(ws + WS_H1), (float*)(ws + WS_PSQ)};
        pg8::gemm_phase<false>(F.lds, 2 * D, S, E);
        SEAM(4);
    }
    if (IN(5)) {
        if (PROBE_DUP == 5) { p5_router(F, args, F.ctl + 256, (float*)(ws + WS_T1), (int*)(ws + WS_T1 + 2 * MiB)); xcd_barrier(bar); }
        p5_router(F, args, F.ctl + CW_CNT, (float*)(ws + WS_LISTW), (int*)(ws + WS_LIST));
        if (PROBE_DUP == 9) { for (int q = 0; q < 16; ++q) xcd_barrier(bar); }
        SEAM(5); }
    if (IN(6)) {
        const int total = moe_table<4>(F, tab);
        MoeSched<0> S{tab, (const int*)(ws + WS_LIST), (const float*)(ws + WS_LISTW), (const char*)(ws + WS_V), (const char*)(ws + WS_WGU), (LAS int*)(F.lds + MISC_OFF + 1024), (LAS float*)(F.lds + MISC_OFF + 4096), total, F.G, F.vcu, PROBE_DUP == 6 ? 2 : 1};
        EpiSwiglu E{&S, (unsigned char*)(ws + WS_HB)};
        pg8::gemm_phase<true>(F.lds, 2048, S, E);
        SEAM(6);
    }
    if (IN(7)) {
        const int total = moe_table<8>(F, tab);
        MoeSched<1> S{tab, (const int*)(ws + WS_LIST), (const float*)(ws + WS_LISTW), (const char*)(ws + WS_HB), (const char*)(ws + WS_WD), (LAS int*)(F.lds + MISC_OFF + 1024), (LAS float*)(F.lds + MISC_OFF + 4096), total, F.G, F.vcu, PROBE_DUP == 7 ? 2 : 1};
        EpiDown E{&S, (unsigned char*)(ws + WS_YB)};
        pg8::gemm_phase<true>(F.lds, 512, S, E);
        SEAM(7);
    }
    if (IN(8)) { REPS(8) { p8_final(F, args); REPBAR(8); } }
#undef IN
#undef SEAM
}

extern "C" void kernel_launch(void* const* d_in, const int* in_sizes, int n_in, void* d_out, int out_size, void* d_ws, size_t ws_size, hipStream_t stream) {
    static int grid = 0;
    if (grid == 0) {
        if (n_in != 18 || out_size != T * D || ws_size < WS_END) { fprintf(stderr, "kernel_launch: unexpected shapes (n_in %d out %d ws %zu)\n", n_in, out_size, ws_size); grid = -1; return; }
        int dev = 0, cus = 0, per_cu = 0;
        if (hipGetDevice(&dev) != hipSuccess || hipDeviceGetAttribute(&cus, hipDeviceAttributeMultiprocessorCount, dev) != hipSuccess) { grid = -1; return; }
        if (hipFuncSetAttribute((const void*)fwd_kernel, hipFuncAttributeMaxDynamicSharedMemorySize, LDS_BYTES) != hipSuccess) { fprintf(stderr, "kernel_launch: hipFuncSetAttribute failed\n"); grid = -1; return; }
        if (hipOccupancyMaxActiveBlocksPerMultiprocessor(&per_cu, (const void*)fwd_kernel, NTHREADS, LDS_BYTES) != hipSuccess || per_cu < 1) { fprintf(stderr, "kernel_launch: occupancy query says %d blocks per CU\n", per_cu); (void)hipGetLastError(); grid = -1; return; }
        grid = cus;
        if (grid % 8 != 0 || grid > 256) grid = (grid / 8) * 8 > 256 ? 256 : (grid / 8) * 8;
    }
    if (grid <= 0) return;
    (void)hipMemsetAsync((char*)d_ws + WS_CTL, 0, CTL_ZERO_BYTES, stream);
    Args a{};
    for (int i = 0; i < 18; ++i) a.in[i] = (const float*)d_in[i];
    a.out = (float*)d_out; a.ws = (unsigned char*)d_ws;
#if MK_N_LAUNCHES == 1
    a.ph_lo = 0; a.ph_hi = N_PHASES;
    hipLaunchKernelGGL(fwd_kernel, dim3(grid), dim3(NTHREADS), LDS_BYTES, stream, a);
#else
    for (int p = 0; p < N_PHASES; ++p) { a.ph_lo = p; a.ph_hi = p + 1; hipLaunchKernelGGL(fwd_kernel, dim3(grid), dim3(NTHREADS), LDS_BYTES, stream, a); }
#endif
}
```

```cpp
#include <hip/hip_runtime.h>
#include <cstdio>
#include <cstdint>

#ifndef MK_N_LAUNCHES
#define MK_N_LAUNCHES 1
#endif
#define PROBE_DUP -1

#define LAS __attribute__((address_space(3)))
#define GAS __attribute__((address_space(1)))
typedef unsigned short bf16_t;
typedef short bf16x8 __attribute__((ext_vector_type(8)));
typedef short s16x4 __attribute__((ext_vector_type(4)));
typedef float f32x2 __attribute__((ext_vector_type(2)));
typedef float f32x4 __attribute__((ext_vector_type(4)));
typedef float f32x16 __attribute__((ext_vector_type(16)));
typedef unsigned u32x2 __attribute__((ext_vector_type(2)));
typedef unsigned u32x4 __attribute__((ext_vector_type(4)));
typedef __bf16 bf16x2_t __attribute__((ext_vector_type(2)));

constexpr int T = 8192, D = 2048, SEQ = 2048, NBATCH = 4;
constexpr int NE = 64, FF = 512, TOPK = 8;
constexpr int ZP = 8704;
constexpr int ZQ = 0, ZK = 1024, ZV = 1280, ZFQ = 1536, ZFK = 2560, ZFV = 3584, ZGS = 4608, ZGF = 6656;
constexpr int NIN = 8960;
constexpr float RMS_EPS = 1e-6f;
constexpr float LOG2E = 1.4426950408889634f;
constexpr float QSCALE = 0.125f * LOG2E;
constexpr int NASSIGN = T * TOPK;
constexpr int NROWS_H = NASSIGN + T;

constexpr size_t MiB = 1u << 20;
constexpr size_t WS_CTL = 0, CTL_ZERO_BYTES = 64 * 1024;
constexpr size_t WS_FL = 1 * MiB;
constexpr size_t WS_WTS = 1 * MiB + 512 * 1024;
constexpr size_t WS_LIST = 2 * MiB;
constexpr size_t WS_WSWAT = 4 * MiB, WS_WFOXT = 8 * MiB, WS_WOUTT = 12 * MiB;
constexpr size_t WS_WINT = 20 * MiB;
constexpr size_t WS_WRG = 55 * MiB;
constexpr size_t WS_PSQ = 55 * MiB + 512 * 1024;
constexpr size_t WS_U = 56 * MiB;
constexpr size_t WS_Z = 88 * MiB;
constexpr size_t WS_YS = 224 * MiB, WS_YF = 240 * MiB;
constexpr size_t WS_T1 = 256 * MiB;
constexpr size_t WS_MIX = 320 * MiB;
constexpr size_t WS_H1 = 352 * MiB;
constexpr size_t WS_V = 416 * MiB;
constexpr size_t WS_HB = 448 * MiB;
constexpr size_t WS_WGU = 520 * MiB;
constexpr size_t WS_WD = 780 * MiB;
constexpr size_t WS_YB = 56 * MiB;
constexpr size_t WS_LISTW = 910 * MiB;
constexpr size_t WS_END = 912 * MiB;
static_assert(WS_YB + (size_t)NROWS_H * D * 2 <= WS_MIX + 32 * MiB, "YB overlay");
constexpr int CW_CNT = 64;
constexpr int CW_BAR = 4096;

constexpr int RING_BYTES = 131072;
constexpr int MISC_OFF = 139264;
constexpr int LDS_BYTES = 147456;
constexpr int NWAVES = 8, NTHREADS = 512;

__device__ __forceinline__ unsigned cvtpk(float lo, float hi) { f32x2 v = {lo, hi}; bf16x2_t b = __builtin_convertvector(v, bf16x2_t); return __builtin_bit_cast(unsigned, b); }
__device__ __forceinline__ float bf2f(bf16_t h) { return __builtin_bit_cast(float, (unsigned)h << 16); }
__device__ __forceinline__ float bflo(unsigned w) { return __builtin_bit_cast(float, w << 16); }
__device__ __forceinline__ float bfhi(unsigned w) { return __builtin_bit_cast(float, w & 0xffff0000u); }
__device__ __forceinline__ float wave_sum(float v) {
#pragma unroll
    for (int o = 1; o < 64; o <<= 1) v += __shfl_xor(v, o);
    return v;
}
__device__ __forceinline__ float wave_max(float v) {
#pragma unroll
    for (int o = 1; o < 64; o <<= 1) v = fmaxf(v, __shfl_xor(v, o));
    return v;
}
__device__ __forceinline__ float sigmoidf_(float x) { return 1.0f / (1.0f + __expf(-x)); }
#define LDS_WAIT() asm volatile("s_waitcnt lgkmcnt(0)" ::: "memory")
#define VM_WAIT() asm volatile("s_waitcnt vmcnt(0)" ::: "memory")

#define XB_TMO      128
#define XB_XCNT(j)  (256  + 64 * (j))
#define XB_XSUB(j)  (1280 + 64 * (j))
#define XB_XGEN(j)  (2304 + 64 * (j))
#define XB_TOP      3328
#define XB_TOPGEN   3392
#define XCD_BAR_WORDS 3456
#define XB_SPIN_CAP (1u << 20)
__device__ __forceinline__ unsigned xb_ld(unsigned* p)              { return __hip_atomic_load(p, __ATOMIC_RELAXED, __HIP_MEMORY_SCOPE_AGENT); }
__device__ __forceinline__ unsigned xb_add(unsigned* p, unsigned v) { return __hip_atomic_fetch_add(p, v, __ATOMIC_RELAXED, __HIP_MEMORY_SCOPE_AGENT); }
__device__ __forceinline__ unsigned xb_xcc_id() { return (unsigned)__builtin_amdgcn_s_getreg((3 << 11) | 20) & 0xFu; }
#define XB_SPIN(cond, bar) do { unsigned _sp = 0; while (cond) { __builtin_amdgcn_s_sleep(1); \
    if ((++_sp & 255u) == 0u) { if (xb_ld(&(bar)[XB_TMO])) break; if (_sp > XB_SPIN_CAP) { atomicAdd(&(bar)[XB_TMO], 1u); break; } } } } while (0)
struct XcdBarrier { unsigned* bar; unsigned x; volatile LAS unsigned* st; };
__device__ __forceinline__ XcdBarrier xcd_barrier_post(unsigned* bar, volatile LAS unsigned* st) {
    XcdBarrier b; b.bar = bar; b.x = xb_xcc_id(); b.st = st;
    if (threadIdx.x == 0) (void)xb_add(&bar[XB_XCNT(b.x)], 1u);
    return b;
}
__device__ __forceinline__ void xcd_barrier_complete(unsigned* bar, unsigned x, unsigned& nloc, unsigned& nx) {
    const unsigned G = gridDim.x * gridDim.y * gridDim.z;
    unsigned sum, cnt, mine, sp = 0u;
    for (;;) {
        sum = 0u; cnt = 0u; mine = 0u;
#pragma unroll
        for (unsigned j = 0; j < 16; ++j) { const unsigned c = xb_ld(&bar[XB_XCNT(j)]); sum += c; cnt += (c > 0u) ? 1u : 0u; mine = (j == x) ? c : mine; }
        if (sum == G) break;
        __builtin_amdgcn_s_sleep(1);
        if ((++sp & 255u) == 0u) { if (xb_ld(&bar[XB_TMO])) break; if (sp > XB_SPIN_CAP) { atomicAdd(&bar[XB_TMO], 1u); break; } }
    }
    nloc = mine > 0u ? mine : 1u; nx = cnt > 0u ? cnt : 1u;
}
__device__ __forceinline__ void xcd_barrier(const XcdBarrier& b) {
    asm volatile("s_waitcnt vmcnt(0)" ::: "memory");
    __syncthreads();
    if (threadIdx.x == 0) {
        unsigned* bar = b.bar;
        __builtin_amdgcn_s_waitcnt(0);
        unsigned nloc = b.st[0], nx = b.st[1];
        if (nloc == 0u) { xcd_barrier_complete(bar, b.x, nloc, nx); b.st[0] = nloc; b.st[1] = nx; }
        const unsigned old = xb_add(&bar[XB_XSUB(b.x)], 1u);
        const unsigned gen = old / nloc;
        if (old + 1u == (gen + 1u) * nloc) {
            __builtin_amdgcn_fence(__ATOMIC_RELEASE, "agent");
            asm volatile("s_waitcnt vmcnt(0)" ::: "memory");
            const unsigned og = xb_add(&bar[XB_TOP], 1u);
            const unsigned tg = og / nx;
            if (og + 1u == (tg + 1u) * nx) xb_add(&bar[XB_TOPGEN], 1u);
            else XB_SPIN(xb_ld(&bar[XB_TOPGEN]) == tg, bar);
            __builtin_amdgcn_fence(__ATOMIC_ACQUIRE, "agent");
            xb_add(&bar[XB_XGEN(b.x)], 1u);
            asm volatile("s_waitcnt vmcnt(0)" ::: "memory");
        } else {
            XB_SPIN(xb_ld(&bar[XB_XGEN(b.x)]) == gen, bar);
            __builtin_amdgcn_fence(__ATOMIC_ACQUIRE, "agent");
            asm volatile("s_waitcnt vmcnt(0)" ::: "memory");
        }
    }
    __syncthreads();
}

namespace pg8 {
constexpr int BM = 256, BK = 64, HALF = 128, HTB = HALF * BK * 2, STAGE_BYTES = 8 * HTB, NXCD = 8, WGM = 8;
__host__ __device__ __forceinline__ int lds_byte(int r, int c) { const int st = (r >> 4) * 2 + (c >> 5), rr = r & 15, cc = c & 31, ob = rr * 64 + cc * 2; return st * 1024 + (ob ^ (((ob >> 9) & 1) << 5)); }
__host__ __device__ __forceinline__ void stage_rc(int b, int& R, int& C) { const int st = b / 1024, sb = b % 1024, swz = sb ^ (((sb >> 9) & 1) << 5); R = (st >> 1) * 16 + swz / 64; C = (st & 1) * 32 + (swz % 64) / 2; }
__host__ __device__ __forceinline__ int perm32(int rho) { const int n = rho >> 4, i = rho & 15; return 8 * (i >> 2) + 4 * n + (i & 3); }

struct Unit { const char* A; const char* B; int pm, pn, e, rt; };

__device__ __forceinline__ void static_tile(int L, int nM, int nN, int& pm, int& pn) {
    const int nwg = nM * nN; int wgid = L;
    { const int q = nwg / NXCD, r = nwg % NXCD, xcd = wgid % NXCD, off = wgid / NXCD; wgid = (xcd < r ? xcd * (q + 1) : r * (q + 1) + (xcd - r) * q) + off; }
    const int nig = WGM * nN, gid = wgid / nig, fm = gid * WGM, gsz = (nM - fm) < WGM ? (nM - fm) : WGM;
    pm = fm + ((wgid % nig) % gsz); pn = (wgid % nig) / gsz;
}

typedef int v4i_t __attribute__((ext_vector_type(4)));
typedef int v8i_t __attribute__((ext_vector_type(8)));
template <bool FP8, class Epi, class Sched>
__device__ __forceinline__ void gemm_phase(LAS unsigned char* lds, const int Kb, const Sched& S, const Epi& E, const int stagger_ticks = 0) {
    if (stagger_ticks > 0) { const unsigned long long t0_ = __builtin_amdgcn_s_memrealtime(); while (__builtin_amdgcn_s_memrealtime() - t0_ < (unsigned long long)stagger_ticks) __builtin_amdgcn_s_sleep(8); }
    const int tid = threadIdx.x, wid = __builtin_amdgcn_readfirstlane(tid >> 6), lane = tid & 63, wr = wid >> 2, wc = wid & 3, fr = lane & 15, fq = lane >> 4;
    const int nt = Kb / 128;
    int Ri[2], Ci[2]; unsigned voffB[2];
#pragma unroll
    for (int i = 0; i < 2; ++i) { int R, C; stage_rc(tid * 16 + i * 8192, R, C); Ri[i] = R; Ci[i] = C; const int Rb = (R & ~31) + perm32(R & 31); voffB[i] = (unsigned)(Rb * Kb + C * 2); }
    const size_t kstep = (size_t)(BK * 2);
    const size_t hstep = (size_t)HALF * Kb;
    const unsigned ldsw = (unsigned)wid * 1024u;
    const int aoff = lds_byte(wr * 64 + fr, fq * 8), boff = lds_byte(wc * 32 + fr, fq * 8);
#define PG8_SA(b, h) (((b) * 2 + (h)) * HTB)
#define PG8_SB(b, h) ((4 + (b) * 2 + (h)) * HTB)
#define PG8_STAGE(bufoff, gbase, voff) do { _Pragma("unroll") for (int _i = 0; _i < 2; ++_i) \
        __builtin_amdgcn_global_load_lds((const unsigned*)((const char*)(gbase) + (voff)[_i]), (LAS unsigned*)(lds + (bufoff) + ldsw + _i * 8192), 16, 0, 0); } while (0)
#define PG8_LDA(dst, b, h) do { if constexpr (FP8) { _Pragma("unroll") for (int m = 0; m < 4; ++m) { dst##8[m].lo = *(const LAS v4i_t*)(lds + PG8_SA(b, h) + aoff + m * 2048); dst##8[m].hi = *(const LAS v4i_t*)(lds + PG8_SA(b, h) + aoff + m * 2048 + 1024); } } \
        else { _Pragma("unroll") for (int m = 0; m < 4; ++m) _Pragma("unroll") for (int k = 0; k < 2; ++k) dst[m][k] = *(const LAS bf16x8*)(lds + PG8_SA(b, h) + aoff + m * 2048 + k * 1024); } } while (0)
#define PG8_LDB(dst, b, h) do { if constexpr (FP8) { _Pragma("unroll") for (int n = 0; n < 2; ++n) { dst##8[n].lo = *(const LAS v4i_t*)(lds + PG8_SB(b, h) + boff + n * 2048); dst##8[n].hi = *(const LAS v4i_t*)(lds + PG8_SB(b, h) + boff + n * 2048 + 1024); } } \
        else { _Pragma("unroll") for (int n = 0; n < 2; ++n) _Pragma("unroll") for (int k = 0; k < 2; ++k) dst[n][k] = *(const LAS bf16x8*)(lds + PG8_SB(b, h) + boff + n * 2048 + k * 1024); } } while (0)
#define PG8_MMA(ai, bj, At, Bt) do { __builtin_amdgcn_s_setprio(1); \
        if constexpr (FP8) { _Pragma("unroll") for (int m = 0; m < 4; ++m) _Pragma("unroll") for (int n = 0; n < 2; ++n) \
            asm volatile("v_mfma_scale_f32_16x16x128_f8f6f4 %0, %1, %2, %0, %3, %3 op_sel_hi:[0,0,0]" : "+v"(acc[ai][bj][m][n]) : "v"(Bt##8[n]), "v"(At##8[m]), "v"(sc8)); } \
        else { _Pragma("unroll") for (int m = 0; m < 4; ++m) _Pragma("unroll") for (int n = 0; n < 2; ++n) _Pragma("unroll") for (int k = 0; k < 2; ++k) \
            acc[ai][bj][m][n] = __builtin_amdgcn_mfma_f32_16x16x32_bf16(Bt[n][k], At[m][k], acc[ai][bj][m][n], 0, 0, 0); } \
        __builtin_amdgcn_s_setprio(0); } while (0)
#define PG8_WAIT_V(n) asm volatile("s_waitcnt vmcnt(" #n ")" ::: "memory")
#define PG8_WAIT_L(n) asm volatile("s_waitcnt lgkmcnt(" #n ")" ::: "memory")
#define PG8_BAR __builtin_amdgcn_s_barrier()
#define PG8_SCHED __builtin_amdgcn_sched_barrier(0)
    Unit cur, nxt; int ui = 0;
    if (!S.next(0, cur)) return;
    unsigned vc[2][2], vn[2][2];
    int pfa = -1; float pfw = 0.f;
    S.pf_issue(cur, pfa, pfw); S.pf_commit(0, pfa, pfw);
    asm volatile("s_waitcnt vmcnt(0) lgkmcnt(0)" ::: "memory"); PG8_BAR; asm volatile("" ::: "memory");
    S.rowoffs(cur, 0, vc, Ri, Ci);
    f32x4 acc[2][2][4][2];
#pragma unroll
    for (int a = 0; a < 2; ++a)
#pragma unroll
        for (int b = 0; b < 2; ++b)
#pragma unroll
            for (int m = 0; m < 4; ++m)
#pragma unroll
                for (int n = 0; n < 2; ++n) acc[a][b][m][n] = (f32x4){0.f, 0.f, 0.f, 0.f};
    const int sc8 = 0x7f7f7f7f;
    bf16x8 At[4][2], B0[2][2], B1[2][2]; v8i_t At8[4], B08[2], B18[2];
    const char* cA = cur.A; const char* cB = cur.B;
    PG8_STAGE(PG8_SB(0, 0), cB, voffB); PG8_STAGE(PG8_SB(0, 1), cB + hstep, voffB); PG8_STAGE(PG8_SA(0, 0), cA, vc[0]); PG8_STAGE(PG8_SA(0, 1), cA, vc[1]);
    if (wr == 1) PG8_BAR;
    PG8_WAIT_V(2); PG8_BAR;
    PG8_STAGE(PG8_SB(1, 0), cB + kstep, voffB); PG8_STAGE(PG8_SA(1, 0), cA + kstep, vc[0]); PG8_STAGE(PG8_SB(1, 1), cB + hstep + kstep, voffB);
    PG8_WAIT_V(6); PG8_BAR;
    for (;;) {
        const bool has_next = S.next(ui + 1, nxt);
        const int scur = ui % 3, snxt = (ui + 1) % 3;
        const char* nA = has_next ? nxt.A : cA; const char* nB = has_next ? nxt.B : cB;
        if (has_next) S.pf_issue(nxt, pfa, pfw);
        for (int t = 0; t < nt; t += 2) {
            const bool last = (t == nt - 2);
            if (t == (nt >= 8 ? nt - 4 : 0) && has_next) S.pf_commit(snxt, pfa, pfw);
            const char* a1 = cA + (size_t)(t + 1) * kstep;
            const char* a2 = last ? nA : cA + (size_t)(t + 2) * kstep; const char* b2 = last ? nB : cB + (size_t)(t + 2) * kstep;
            const char* a3 = a2 + kstep; const char* b3 = b2 + kstep;
            if (last) {
                if (has_next) S.rowoffs(nxt, snxt, vn, Ri, Ci);
                else { vn[0][0] = vc[0][0]; vn[0][1] = vc[0][1]; vn[1][0] = vc[1][0]; vn[1][1] = vc[1][1]; }
            }
            unsigned v2[2][2];
            v2[0][0] = last ? vn[0][0] : vc[0][0]; v2[0][1] = last ? vn[0][1] : vc[0][1]; v2[1][0] = last ? vn[1][0] : vc[1][0]; v2[1][1] = last ? vn[1][1] : vc[1][1];
            PG8_LDB(B0, 0, 0); PG8_LDB(B1, 0, 1); PG8_SCHED; PG8_LDA(At, 0, 0); PG8_STAGE(PG8_SA(1, 1), a1, vc[1]);
            PG8_WAIT_V(8); PG8_WAIT_L(0); PG8_BAR; PG8_MMA(0, 0, At, B0); PG8_MMA(0, 1, At, B1); PG8_BAR; PG8_SCHED;
            PG8_LDA(At, 0, 1); PG8_STAGE(PG8_SB(0, 0), b2, voffB); PG8_STAGE(PG8_SB(0, 1), b2 + hstep, voffB); PG8_STAGE(PG8_SA(0, 0), a2, v2[0]);
            PG8_WAIT_V(8); PG8_WAIT_L(0); PG8_BAR; PG8_MMA(1, 0, At, B0); PG8_MMA(1, 1, At, B1); PG8_BAR; PG8_SCHED;
            PG8_LDB(B0, 1, 0); PG8_LDB(B1, 1, 1); PG8_SCHED; PG8_LDA(At, 1, 0); PG8_STAGE(PG8_SA(0, 1), a2, v2[1]);
            PG8_WAIT_V(8); PG8_WAIT_L(0); PG8_BAR; PG8_MMA(0, 0, At, B0); PG8_MMA(0, 1, At, B1); PG8_BAR; PG8_SCHED;
            PG8_LDA(At, 1, 1); PG8_STAGE(PG8_SB(1, 0), b3, voffB); PG8_STAGE(PG8_SB(1, 1), b3 + hstep, voffB); PG8_STAGE(PG8_SA(1, 0), a3, v2[0]);
            PG8_WAIT_V(8); PG8_WAIT_L(0); PG8_BAR; PG8_MMA(1, 0, At, B0); PG8_MMA(1, 1, At, B1); PG8_BAR; PG8_SCHED;
        }
        if (wr == 0) PG8_BAR;
        if constexpr (FP8) {
            asm volatile("s_nop 15\n\ts_nop 15" ::: "memory");
#pragma unroll
            for (int a = 0; a < 2; ++a)
#pragma unroll
                for (int b = 0; b < 2; ++b)
#pragma unroll
                    for (int m = 0; m < 4; ++m)
#pragma unroll
                        for (int n = 0; n < 2; ++n) asm volatile("" : "+v"(acc[a][b][m][n]));
        }
        E(acc, cur, scur, wr, wc, fr, fq);
        if (!has_next) break;
#pragma unroll
        for (int a = 0; a < 2; ++a)
#pragma unroll
            for (int b = 0; b < 2; ++b)
#pragma unroll
                for (int m = 0; m < 4; ++m)
#pragma unroll
                    for (int n = 0; n < 2; ++n) acc[a][b][m][n] = (f32x4){0.f, 0.f, 0.f, 0.f};
        cur = nxt; cA = nA; cB = nB; ++ui;
        vc[0][0] = vn[0][0]; vc[0][1] = vn[0][1]; vc[1][0] = vn[1][0]; vc[1][1] = vn[1][1];
        if (wr == 1) PG8_BAR;
    }
    PG8_WAIT_V(0);
    PG8_BAR;
#undef PG8_SA
#undef PG8_SB
#undef PG8_STAGE
#undef PG8_LDA
#undef PG8_LDB
#undef PG8_MMA
#undef PG8_WAIT_V
#undef PG8_WAIT_L
#undef PG8_BAR
#undef PG8_SCHED
}
}
using pg8::Unit;

struct Args { const float* in[18]; float* out; unsigned char* ws; int ph_lo, ph_hi; };
struct Frame {
    LAS unsigned char* lds; volatile LAS unsigned* MISC; unsigned* ctl; unsigned char* ws;
    int tid, lane, wave, vcu, G;
};

struct DenseSched {
    const char* A; const char* Bt; int nM, nN, K, G, c, dup;
    __device__ __forceinline__ bool next(int i, Unit& u) const {
        int L = i * G + c; if (L >= nM * nN * dup) return false; if (L >= nM * nN) L -= nM * nN;
        int pm, pn; pg8::static_tile(L, nM, nN, pm, pn);
        u.pm = pm; u.pn = pn; u.e = 0; u.rt = 0; u.A = A + (size_t)pm * 256 * K * 2; u.B = Bt + (size_t)pn * 256 * K * 2; return true;
    }
    __device__ __forceinline__ void pf_issue(const Unit&, int&, float&) const {}
    __device__ __forceinline__ void pf_commit(int, int, float) const {}
    __device__ __forceinline__ void rowoffs(const Unit&, int, unsigned (&vo)[2][2], const int (&R)[2], const int (&C)[2]) const {
#pragma unroll
        for (int h = 0; h < 2; ++h)
#pragma unroll
            for (int i = 0; i < 2; ++i) vo[h][i] = (unsigned)((R[i] + 128 * h) * K + C[i]) * 2u;
    }
};
struct BranchSched {
    const char* A0; const char* A1; const char* B0; const char* B1; int nM, nN, K, G, c, dup;
    __device__ __forceinline__ bool next(int i, Unit& u) const {
        int L = (i >> 1) * G + c; if (L >= nM * nN * dup) return false; if (L >= nM * nN) L -= nM * nN;
        int pm, pn; pg8::static_tile(L, nM, nN, pm, pn);
        const int br = i & 1;
        u.pm = pm; u.pn = pn; u.e = br; u.rt = 0; u.A = (br ? A1 : A0) + (size_t)pm * 256 * K * 2; u.B = (br ? B1 : B0) + (size_t)pn * 256 * K * 2; return true;
    }
    __device__ __forceinline__ void pf_issue(const Unit&, int&, float&) const {}
    __device__ __forceinline__ void pf_commit(int, int, float) const {}
    __device__ __forceinline__ void rowoffs(const Unit&, int, unsigned (&vo)[2][2], const int (&R)[2], const int (&C)[2]) const {
#pragma unroll
        for (int h = 0; h < 2; ++h)
#pragma unroll
            for (int i = 0; i < 2; ++i) vo[h][i] = (unsigned)((R[i] + 128 * h) * K + C[i]) * 2u;
    }
};
template <int MODE> struct MoeSched {
    const LAS int* tab; const int* list; const float* listw; const char* A; const char* Bt; LAS int* rowA; LAS float* rowW; int total, G, vcu, dup;
    static constexpr int MULT = MODE == 0 ? 4 : 8, KB = MODE == 0 ? 2048 : 512  , NCOLS = MODE == 0 ? 1024 : 2048;
    __device__ __forceinline__ bool next(int i, Unit& u) const {
        int L = i * G + vcu; if (L >= total * dup) return false; if (L >= total) L -= total;
        int e, j, nrt;
        if (L < 32 * MULT) { e = 64; j = L; nrt = 32; }
        else {
            const int Lr = L - 32 * MULT; const int lane = threadIdx.x & 63;
            const int pin = tab[lane];
            const unsigned long long bal = __ballot(pin <= Lr);
            e = __builtin_popcountll(bal); e = e > 63 ? 63 : e;
            const int pex = e > 0 ? tab[e - 1] : 0; const int cnt = tab[64 + e];
            j = Lr - pex; nrt = (cnt + 255) >> 8; nrt = nrt < 1 ? 1 : nrt;
        }
        e = __builtin_amdgcn_readfirstlane(e); j = __builtin_amdgcn_readfirstlane(j); nrt = __builtin_amdgcn_readfirstlane(nrt);
        u.e = e; u.rt = j % nrt; u.pn = j / nrt; u.pm = 0;
        u.A = A; u.B = Bt + ((size_t)e * NCOLS + (size_t)u.pn * 256) * KB; return true;
    }
    __device__ __forceinline__ void pf_issue(const Unit& u, int& pa, float& pw) const {
        const int tid = threadIdx.x; pa = -1; pw = 0.f;
        if (tid < 256) { const int idx = u.rt * 256 + tid;
            if (u.e == 64) { pa = NASSIGN + idx; pw = 1.f; }
            else if (idx < tab[64 + u.e]) { pa = list[u.e * T + idx]; if (MODE == 1) pw = listw[u.e * T + idx]; } }
    }
    __device__ __forceinline__ void pf_commit(int s, int pa, float pw) const { const int tid = threadIdx.x; if (tid < 256) { rowA[s * 256 + tid] = pa; rowW[s * 256 + tid] = pw; } }
    __device__ __forceinline__ void rowoffs(const Unit& u, int s, unsigned (&vo)[2][2], const int (&R)[2], const int (&C)[2]) const {
#pragma unroll
        for (int h = 0; h < 2; ++h)
#pragma unroll
            for (int i = 0; i < 2; ++i) {
                int a = rowA[s * 256 + R[i] + 128 * h];
                unsigned row;
                if (MODE == 0) { a = a < 0 ? 0 : a; row = a < NASSIGN ? (unsigned)(a >> 3) : (unsigned)(a - NASSIGN); }
                else row = a < 0 ? 0u : (unsigned)a;
                vo[h][i] = row * (unsigned)KB + (unsigned)C[i] * 2u;
            }
    }
};

struct EpiZ {
    bf16_t* Z; float* FL; const float* fbias;
    __device__ __forceinline__ void operator()(const f32x4 (&acc)[2][2][4][2], const Unit& u, int slot, int wr, int wc, int fr, int fq) const {
        const int row0 = u.pm * 256 + wr * 64 + fr;
        if (u.pn == 34) {
            if (wc == 0 && fq < 2) {
                float fb[8];
#pragma unroll
                for (int j = 0; j < 8; ++j) fb[j] = fbias[8 * fq + j];
#pragma unroll
                for (int ai = 0; ai < 2; ++ai)
#pragma unroll
                    for (int m = 0; m < 4; ++m) {
                        float* o = FL + (size_t)(row0 + ai * 128 + m * 16) * 16 + 8 * fq;
#pragma unroll
                        for (int n = 0; n < 2; ++n) { f32x4 r;
#pragma unroll
                            for (int j = 0; j < 4; ++j) { const float x = acc[ai][0][m][n][j] + fb[4 * n + j]; const float ls = x >= 0.f ? -log1pf(expf(-x)) : x - log1pf(expf(x)); r[j] = ls * LOG2E; }
                            *(f32x4*)(o + 4 * n) = r; }
                    }
            }
            return;
        }
        const int mode = (u.pn < 4 || (u.pn >= 6 && u.pn < 10)) ? 1 : (u.pn >= 18 ? 2 : 0);
        const int col0 = u.pn * 256 + wc * 32 + 8 * fq;
#pragma unroll
        for (int ai = 0; ai < 2; ++ai)
#pragma unroll
            for (int m = 0; m < 4; ++m) { bf16_t* rowp = Z + (size_t)(row0 + ai * 128 + m * 16) * ZP + col0;
#pragma unroll
                for (int bj = 0; bj < 2; ++bj) { f32x4 v0 = acc[ai][bj][m][0], v1 = acc[ai][bj][m][1];
                    if (mode == 1) { v0 = v0 * QSCALE; v1 = v1 * QSCALE; }
                    else if (mode == 2) {
#pragma unroll
                        for (int j = 0; j < 4; ++j) { v0[j] = sigmoidf_(v0[j]); v1[j] = sigmoidf_(v1[j]); } }
                    u32x4 w; w.x = cvtpk(v0[0], v0[1]); w.y = cvtpk(v0[2], v0[3]); w.z = cvtpk(v1[0], v1[1]); w.w = cvtpk(v1[2], v1[3]);
                    *(u32x4*)(rowp + bj * 128) = w; } }
    }
};
struct EpiMix {
    const bf16_t* Z; bf16_t* MIX;
    __device__ __forceinline__ void operator()(const f32x4 (&acc)[2][2][4][2], const Unit& u, int slot, int wr, int wc, int fr, int fq) const {
        const int row0 = u.pm * 256 + wr * 64 + fr, col0 = u.pn * 256 + wc * 32 + 8 * fq;
        const int gcol = (u.e ? ZGF : ZGS) + col0;
#pragma unroll
        for (int ai = 0; ai < 2; ++ai)
#pragma unroll
            for (int m = 0; m < 4; ++m) { const size_t row = (size_t)(row0 + ai * 128 + m * 16);
#pragma unroll
                for (int bj = 0; bj < 2; ++bj) {
                    const u32x4 g = *(const u32x4*)(Z + row * ZP + gcol + bj * 128);
                    f32x4 v0 = acc[ai][bj][m][0], v1 = acc[ai][bj][m][1];
                    v0[0] *= bflo(g.x); v0[1] *= bfhi(g.x); v0[2] *= bflo(g.y); v0[3] *= bfhi(g.y);
                    v1[0] *= bflo(g.z); v1[1] *= bfhi(g.z); v1[2] *= bflo(g.w); v1[3] *= bfhi(g.w);
                    u32x4* mp = (u32x4*)(MIX + row * D + col0 + bj * 128);
                    if (u.e != 0) { const u32x4 t = *mp;
                        v0[0] += bflo(t.x); v0[1] += bfhi(t.x); v0[2] += bflo(t.y); v0[3] += bfhi(t.y);
                        v1[0] += bflo(t.z); v1[1] += bfhi(t.z); v1[2] += bflo(t.w); v1[3] += bfhi(t.w); }
                    u32x4 w; w.x = cvtpk(v0[0], v0[1]); w.y = cvtpk(v0[2], v0[3]); w.z = cvtpk(v1[0], v1[1]); w.w = cvtpk(v1[2], v1[3]);
                    *mp = w; } }
    }
};
struct EpiOut {
    const float* X; float* H1; float* PSQ;
    __device__ __forceinline__ void operator()(const f32x4 (&acc)[2][2][4][2], const Unit& u, int slot, int wr, int wc, int fr, int fq) const {
        const int row0 = u.pm * 256 + wr * 64 + fr, col0 = u.pn * 256 + wc * 32 + 8 * fq;
#pragma unroll
        for (int ai = 0; ai < 2; ++ai)
#pragma unroll
            for (int m = 0; m < 4; ++m) { const size_t row = (size_t)(row0 + ai * 128 + m * 16); float sq = 0.f;
#pragma unroll
                for (int bj = 0; bj < 2; ++bj) {
                    const float* xp = X + row * D + col0 + bj * 128; float* hp = H1 + row * D + col0 + bj * 128;
                    const f32x4 x0 = *(const f32x4*)xp, x1 = *(const f32x4*)(xp + 4);
                    const f32x4 h0 = acc[ai][bj][m][0] + x0, h1 = acc[ai][bj][m][1] + x1;
                    *(f32x4*)hp = h0; *(f32x4*)(hp + 4) = h1;
                    sq += (h0[0] * h0[0] + h0[1] * h0[1]) + (h0[2] * h0[2] + h0[3] * h0[3]) + (h1[0] * h1[0] + h1[1] * h1[1]) + (h1[2] * h1[2] + h1[3] * h1[3]); }
                sq += __shfl_xor(sq, 16); sq += __shfl_xor(sq, 32);
                if (fq == 0) PSQ[row * 32 + u.pn * 4 + wc] = sq; }
    }
};
__device__ __forceinline__ unsigned pk_fp8x4(float a, float b, float c, float d) {
    a = __builtin_amdgcn_fmed3f(a, -448.f, 448.f); b = __builtin_amdgcn_fmed3f(b, -448.f, 448.f); c = __builtin_amdgcn_fmed3f(c, -448.f, 448.f); d = __builtin_amdgcn_fmed3f(d, -448.f, 448.f);
    int r = __builtin_amdgcn_cvt_pk_fp8_f32(a, b, 0, false); r = __builtin_amdgcn_cvt_pk_fp8_f32(c, d, r, true); return (unsigned)r;
}
constexpr float WGU_SCALE = 32.f, WD_SCALE = 16.f;
struct EpiSwiglu {
    const MoeSched<0>* S; unsigned char* HB8;
    __device__ __forceinline__ void operator()(const f32x4 (&acc)[2][2][4][2], const Unit& u, int slot, int wr, int wc, int fr, int fq) const {
        const int ff0 = u.pn * 128 + wc * 32 + 8 * fq;
#pragma unroll
        for (int ai = 0; ai < 2; ++ai)
#pragma unroll
            for (int m = 0; m < 4; ++m) { const int a = S->rowA[slot * 256 + ai * 128 + wr * 64 + m * 16 + fr];
                if (a >= 0) { float h[8];
#pragma unroll
                    for (int n = 0; n < 2; ++n)
#pragma unroll
                        for (int j = 0; j < 4; ++j) { const float g = acc[ai][0][m][n][j] * (1.f / WGU_SCALE), up = acc[ai][1][m][n][j] * (1.f / WGU_SCALE); h[4 * n + j] = g * sigmoidf_(g) * up; }
                    u32x2 w; w.x = pk_fp8x4(h[0], h[1], h[2], h[3]); w.y = pk_fp8x4(h[4], h[5], h[6], h[7]);
                    *(u32x2*)(HB8 + (size_t)a * FF + ff0) = w; } }
    }
};
constexpr float YB_SCALE = 16.f;
struct EpiDown {
    const MoeSched<1>* S; unsigned char* YB8;
    __device__ __forceinline__ void operator()(const f32x4 (&acc)[2][2][4][2], const Unit& u, int slot, int wr, int wc, int fr, int fq) const {
        const int col0 = u.pn * 256 + wc * 32 + 8 * fq;
#pragma unroll
        for (int ai = 0; ai < 2; ++ai)
#pragma unroll
            for (int m = 0; m < 4; ++m) { const int ri = slot * 256 + ai * 128 + wr * 64 + m * 16 + fr; const int a = S->rowA[ri];
                if (a >= 0) { const float w8 = S->rowW[ri] * (YB_SCALE / WD_SCALE);
#pragma unroll
                    for (int bj = 0; bj < 2; ++bj) { const f32x4 v0 = acc[ai][bj][m][0] * w8, v1 = acc[ai][bj][m][1] * w8;
                        u32x2 w; w.x = pk_fp8x4(v0[0], v0[1], v0[2], v0[3]); w.y = pk_fp8x4(v1[0], v1[1], v1[2], v1[3]);
                        *(u32x2*)(YB8 + (size_t)a * D + col0 + bj * 128) = w; } } }
    }
};

struct P0Item { const float* src; unsigned char* dst; int ldw, nvalid, K, fp8; float scale; };
__device__ __forceinline__ void p0_map(int r, int NB, int& kp, int& nb) { kp = r / NB; nb = r % NB; }
__device__ __forceinline__ P0Item p0_decode(int pr, int half, const Args& a, unsigned char* ws) {
    constexpr int P_IN = 16 * 140, P_SW = 8 * 32, P_OUT = 16 * 32, P_GU = 16 * 8, P_DN = 4 * 32, P_EXP = 2 * P_GU + P_DN;
    P0Item q; q.fp8 = 0; q.scale = 1.f; int r = pr;
    if (r < P_IN) { int kp, nb; p0_map(r, 140, kp, nb); const int kb = 2 * kp + half, n0 = nb * 64;
        int c0, nv; if (n0 < 4608) { c0 = n0; nv = 64; } else if (n0 < 8704) { c0 = n0 + 16; nv = 64; } else if (n0 == 8704) { c0 = 4608; nv = 16; } else { c0 = 0; nv = 0; }
        q.src = a.in[2] + (size_t)kb * 64 * 8720 + c0; q.ldw = 8720; q.nvalid = nv; q.K = D; q.dst = ws + WS_WINT + ((size_t)n0 * D + kb * 64) * 2; return q; }
    r -= P_IN;
    if (r < P_SW) { int kp, nb; p0_map(r, 32, kp, nb); const int kb = 2 * kp + half; q.src = a.in[5] + (size_t)kb * 64 * D + nb * 64; q.ldw = D; q.nvalid = 64; q.K = 1024; q.dst = ws + WS_WSWAT + ((size_t)nb * 64 * 1024 + kb * 64) * 2; return q; }
    r -= P_SW;
    if (r < P_SW) { int kp, nb; p0_map(r, 32, kp, nb); const int kb = 2 * kp + half; q.src = a.in[6] + (size_t)kb * 64 * D + nb * 64; q.ldw = D; q.nvalid = 64; q.K = 1024; q.dst = ws + WS_WFOXT + ((size_t)nb * 64 * 1024 + kb * 64) * 2; return q; }
    r -= P_SW;
    if (r < P_OUT) { int kp, nb; p0_map(r, 32, kp, nb); const int kb = 2 * kp + half; q.src = a.in[7] + (size_t)kb * 64 * D + nb * 64; q.ldw = D; q.nvalid = 64; q.K = D; q.dst = ws + WS_WOUTT + ((size_t)nb * 64 * D + kb * 64) * 2; return q; }
    r -= P_OUT;
    const int e = r / P_EXP; r -= e * P_EXP; q.fp8 = 1;
    if (r < 2 * P_GU) { const int up = r >= P_GU; r -= up * P_GU; int kp, nb; p0_map(r, 8, kp, nb); const int kb = 2 * kp + half, n0 = nb * 64;
        const float* src = e < 64 ? (up ? a.in[12] : a.in[11]) + (size_t)e * D * FF : (up ? a.in[15] : a.in[14]);
        const int drow = 256 * (n0 >> 7) + (n0 & 127) + 128 * up;
        q.src = src + (size_t)kb * 64 * FF + n0; q.ldw = FF; q.nvalid = 64; q.K = D; q.scale = WGU_SCALE; q.dst = ws + WS_WGU + ((size_t)e * 1024 + drow) * D + kb * 64; return q; }
    r -= 2 * P_GU;
    { int kp, nb; p0_map(r, 32, kp, nb); const int kb = 2 * kp + half;
        const float* src = e < 64 ? a.in[13] + (size_t)e * FF * D : a.in[16];
        q.src = src + (size_t)kb * 64 * D + nb * 64; q.ldw = D; q.nvalid = 64; q.K = FF; q.scale = WD_SCALE; q.dst = ws + WS_WD + ((size_t)e * D + nb * 64) * FF + kb * 64; return q; }
}
__device__ __forceinline__ void p0_load(const P0Item& q, f32x4 (&v)[16], int lane) {
    const int kr = lane >> 4, nc = (lane & 15) * 4; const bool ok = nc < q.nvalid;
    const float* p = q.src + (size_t)kr * q.ldw + nc;
#pragma unroll
    for (int i = 0; i < 16; ++i) v[i] = ok ? *(const f32x4*)(p + (size_t)(4 * i) * q.ldw) : (f32x4){0.f, 0.f, 0.f, 0.f};
}
__device__ __forceinline__ void p0_process(const P0Item& q, const f32x4 (&v)[16], LAS float* scr, int lane) {
    const int kr = lane >> 4, nc = (lane & 15) * 4;
#pragma unroll
    for (int i = 0; i < 16; ++i) { LAS float* w = scr + (4 * i + kr) * 65 + nc; w[0] = v[i][0]; w[1] = v[i][1]; w[2] = v[i][2]; w[3] = v[i][3]; }
    LDS_WAIT(); asm volatile("" ::: "memory");
    const int c = lane & 7;
#pragma unroll
    for (int j = 0; j < 8; ++j) { const int n = (lane >> 3) + 8 * j; const LAS float* s = scr + (8 * c) * 65 + n;
        u32x4 o; o.x = cvtpk(s[0 * 65], s[1 * 65]); o.y = cvtpk(s[2 * 65], s[3 * 65]); o.z = cvtpk(s[4 * 65], s[5 * 65]); o.w = cvtpk(s[6 * 65], s[7 * 65]);
        *(u32x4*)(q.dst + ((size_t)n * q.K + 8 * c) * 2) = o; }
    LDS_WAIT(); asm volatile("" ::: "memory");
}
__device__ __forceinline__ void p0_load8(const P0Item& q, f32x4 (&v)[16], int lane) {
    const int kq = lane >> 4, nc = (lane & 15) * 4;
    const float* p = q.src + (size_t)(16 * kq) * q.ldw + nc;
#pragma unroll
    for (int i = 0; i < 16; ++i) v[i] = *(const f32x4*)(p + (size_t)i * q.ldw);
}
__device__ __forceinline__ void p0_pack8(const f32x4 (&v)[16], float sc, LAS unsigned char* tile, int chunk, int m) {
#pragma unroll
    for (int j = 0; j < 4; ++j) { const int n = 4 * m + j; u32x4 o;
        o.x = pk_fp8x4(v[0][j] * sc, v[1][j] * sc, v[2][j] * sc, v[3][j] * sc); o.y = pk_fp8x4(v[4][j] * sc, v[5][j] * sc, v[6][j] * sc, v[7][j] * sc);
        o.z = pk_fp8x4(v[8][j] * sc, v[9][j] * sc, v[10][j] * sc, v[11][j] * sc); o.w = pk_fp8x4(v[12][j] * sc, v[13][j] * sc, v[14][j] * sc, v[15][j] * sc);
        *(LAS u32x4*)(tile + n * 128 + ((chunk ^ ((n >> 2) & 7)) * 16)) = o; }
}
__device__ __forceinline__ void p0_prologue(Frame& F, const Args& a) {
    LAS float* scr = (LAS float*)(F.lds + F.wave * 16640);
    const int gw = F.vcu * NWAVES + F.wave, NGW = F.G * NWAVES;
    unsigned char* ws = F.ws;
    {
        const float* g = a.in[1];
        for (int m = gw; m < T; m += NGW) {
            const f32x4* xr = (const f32x4*)(a.in[0] + (size_t)m * D) + F.lane;
            f32x4 v[8]; float s = 0.f;
#pragma unroll
            for (int j = 0; j < 8; ++j) { v[j] = xr[64 * j]; s += (v[j].x * v[j].x + v[j].y * v[j].y) + (v[j].z * v[j].z + v[j].w * v[j].w); }
            const float rinv = rsqrtf(wave_sum(s) * (1.f / D) + RMS_EPS);
            u32x2* o = (u32x2*)((bf16_t*)(ws + WS_U) + (size_t)m * D) + F.lane;
#pragma unroll
            for (int j = 0; j < 8; ++j) { const f32x4 gg = *((const f32x4*)g + F.lane + 64 * j); u32x2 w; w.x = cvtpk(v[j].x * rinv * gg.x, v[j].y * rinv * gg.y); w.y = cvtpk(v[j].z * rinv * gg.z, v[j].w * rinv * gg.w); o[64 * j] = w; }
        }
    }
    {
        const float* wr = a.in[9]; const float* g = a.in[8]; float* o = (float*)(ws + WS_WRG);
        for (int i = gw * 64 + F.lane; i < D * NE; i += NGW * 64) o[i] = wr[i] * g[i >> 6];
    }
    constexpr int NB16 = 16 * 140 + 2 * 8 * 32 + 16 * 32, NPAIRS = NB16 + 65 * (2 * 16 * 8 + 4 * 32);
    constexpr int REP = (PROBE_DUP == 0 || PROBE_DUP == 11) ? 2 : (PROBE_DUP == 10 ? 3 : 1);
    f32x4 va[16], vb[16]; P0Item qa, qb;
    {
        const int nj = (NB16 + NGW - 1) / NGW;
        int pr = gw;
        if (pr < NB16) { qa = p0_decode(pr, 0, a, ws); p0_load(qa, va, F.lane); }
        for (int j = 0; j < nj; ++j) {
            const bool act = pr < NB16;
            if (act) { qb = p0_decode(pr, 1, a, ws); p0_load(qb, vb, F.lane); }
            if (act) p0_process(qa, va, scr, F.lane);
            __builtin_amdgcn_s_barrier();
            const int pn = pr + NGW;
            if (pn < NB16) { qa = p0_decode(pn, 0, a, ws); p0_load(qa, va, F.lane); }
            if (act) p0_process(qb, vb, scr, F.lane);
            __builtin_amdgcn_s_barrier();
            pr = pn;
        }
    }
    {
        constexpr int NF = (NPAIRS - NB16) * REP;
        const int nj = (NF + NGW - 1) / NGW;
        LAS unsigned char* tile = (LAS unsigned char*)scr;
        const int kq = F.lane >> 4, m = F.lane & 15;
        int pr = gw;
        if (pr < NF) { qa = p0_decode(NB16 + pr % (NPAIRS - NB16), 0, a, ws); p0_load8(qa, va, F.lane); }
        for (int j = 0; j < nj; ++j) {
            const bool act = pr < NF;
            if (act) { qb = p0_decode(NB16 + pr % (NPAIRS - NB16), 1, a, ws); p0_load8(qb, vb, F.lane); }
            if (act) p0_pack8(va, qa.scale, tile, kq, m);
            __builtin_amdgcn_s_barrier();
            const int pn = pr + NGW;
            const P0Item qc = qa;
            if (pn < NF) { qa = p0_decode(NB16 + pn % (NPAIRS - NB16), 0, a, ws); p0_load8(qa, va, F.lane); }
            if (act) {
                p0_pack8(vb, qb.scale, tile, 4 + kq, m);
                LDS_WAIT(); asm volatile("" ::: "memory");
                const bool st = !(PROBE_DUP == 11 && pr >= NPAIRS - NB16);
                const int c = F.lane & 7;
#pragma unroll
                for (int jj = 0; jj < 8; ++jj) { const int n = (F.lane >> 3) + 8 * jj;
                    const u32x4 o = *(const LAS u32x4*)(tile + n * 128 + ((c ^ ((n >> 2) & 7)) * 16));
                    if (st) *(u32x4*)(qc.dst + (size_t)n * qc.K + 16 * c) = o; else asm volatile("" :: "v"(o)); }
                LDS_WAIT(); asm volatile("" ::: "memory");
            }
            __builtin_amdgcn_s_barrier();
            pr = pn;
        }
    }
}

__device__ __forceinline__ int crow(int r, int hi) { return (r & 3) + 8 * (r >> 2) + 4 * hi; }
__device__ __forceinline__ s16x4 vtr(LAS const char* p) { typedef short v4i16_t __attribute__((ext_vector_type(4))); return __builtin_bit_cast(s16x4, __builtin_amdgcn_ds_read_tr16_b64_v4i16((LAS v4i16_t*)p)); }

__device__ __forceinline__ void attn_qk(f32x16 (&p)[2], const bf16x8 (&qf)[4], LAS const char* Kt, int r32, int hi) {
#pragma unroll
    for (int kb = 0; kb < 2; ++kb) { const int kv = 32 * kb + r32; const int sw = (kv >> 1) & 7; LAS const char* rowp = Kt + kv * 128;
        f32x16 c = {};
#pragma unroll
        for (int s = 0; s < 4; ++s) { const bf16x8 a = *(const LAS bf16x8*)(rowp + (((2 * s + hi) ^ sw) * 16)); c = __builtin_amdgcn_mfma_f32_32x32x16_bf16(a, qf[s], c, 0, 0, 0); }
        p[kb] = c; }
}
__device__ __forceinline__ void attn_softmax_pv(f32x16 (&p)[2], f32x16 (&o)[2], float& m, float& l, LAS const char* Vt, int lane) {
    float mx = p[0][0];
#pragma unroll
    for (int kb = 0; kb < 2; ++kb)
#pragma unroll
        for (int r = 0; r < 16; ++r) mx = fmaxf(mx, p[kb][r]);
    mx = fmaxf(mx, __shfl_xor(mx, 32));
    const float mn = fmaxf(m, mx);
    const float alpha = __builtin_amdgcn_exp2f(m - mn);
    float rs = 0.f;
#pragma unroll
    for (int kb = 0; kb < 2; ++kb)
#pragma unroll
        for (int r = 0; r < 16; ++r) { const float e = __builtin_amdgcn_exp2f(p[kb][r] - mn); p[kb][r] = e; rs += e; }
    rs += __shfl_xor(rs, 32);
    l = l * alpha + rs; m = mn;
#pragma unroll
    for (int db = 0; db < 2; ++db)
#pragma unroll
        for (int r = 0; r < 16; ++r) o[db][r] *= alpha;
    const int g = lane >> 4, i = lane & 15;
    LAS const char* vb = Vt + (4 * (g >> 1) + (i >> 2)) * 64 + (g & 1) * 32 + (i & 3) * 8;
#pragma unroll
    for (int kb = 0; kb < 2; ++kb)
#pragma unroll
        for (int ks = 0; ks < 2; ++ks) {
            u32x4 pw; pw.x = cvtpk(p[kb][8 * ks + 0], p[kb][8 * ks + 1]); pw.y = cvtpk(p[kb][8 * ks + 2], p[kb][8 * ks + 3]); pw.z = cvtpk(p[kb][8 * ks + 4], p[kb][8 * ks + 5]); pw.w = cvtpk(p[kb][8 * ks + 6], p[kb][8 * ks + 7]);
            const bf16x8 pb = __builtin_bit_cast(bf16x8, pw);
#pragma unroll
            for (int db = 0; db < 2; ++db) {
                const s16x4 lo = vtr(vb + db * 4096 + (32 * kb + 16 * ks) * 64), hi4 = vtr(vb + db * 4096 + (32 * kb + 16 * ks + 8) * 64);
                const bf16x8 va = (bf16x8){lo[0], lo[1], lo[2], lo[3], hi4[0], hi4[1], hi4[2], hi4[3]};
                o[db] = __builtin_amdgcn_mfma_f32_32x32x16_bf16(va, pb, o[db], 0, 0, 0); } }
}
__device__ __forceinline__ void attn_store_kv(LAS char* Kt, LAS char* Vt, const u32x4& kr, const u32x4& vr, int tid) {
    const int kv = tid >> 3, c = tid & 7;
    *(LAS u32x4*)(Kt + kv * 128 + ((c ^ ((kv >> 1) & 7)) * 16)) = kr;
    *(LAS u32x4*)(Vt + (c >> 2) * 4096 + kv * 64 + (c & 3) * 16) = vr;
}
__device__ __forceinline__ void attn_store_o(const f32x16 (&o)[2], float l, bf16_t* orow, int hi) {
    const float rl = 1.0f / l;
#pragma unroll
    for (int db = 0; db < 2; ++db)
#pragma unroll
        for (int rq = 0; rq < 4; ++rq) { u32x2 w; w.x = cvtpk(o[db][4 * rq] * rl, o[db][4 * rq + 1] * rl); w.y = cvtpk(o[db][4 * rq + 2] * rl, o[db][4 * rq + 3] * rl);
            *(u32x2*)(orow + 32 * db + 8 * rq + 4 * hi) = w; }
}

__device__ __forceinline__ void swa_unit(Frame& F, int unit, const float* sinks) {
    const bf16_t* Z = (const bf16_t*)(F.ws + WS_Z); bf16_t* YS = (bf16_t*)(F.ws + WS_YS);
    const int b = unit >> 6, kvh = (unit >> 4) & 3, nb = unit & 15;
    const int tid = F.tid, lane = F.lane, r32 = lane & 31, hi = lane >> 5, w = F.wave;
    LAS char* Kl = (LAS char*)F.lds; LAS char* Vl = (LAS char*)F.lds + 32768;
    const int t0 = nb * 128;
    {
        const int kv = tid >> 3, c = tid & 7;
#pragma unroll
        for (int tl = 0; tl < 4; ++tl) {
            if (nb > 0 || tl >= 2) {
                const size_t row = (size_t)(b * SEQ + t0 - 128 + tl * 64 + kv);
                const u32x4 kr = *(const u32x4*)(Z + row * ZP + ZK + kvh * 64 + c * 8);
                const u32x4 vr = *(const u32x4*)(Z + row * ZP + ZV + kvh * 64 + c * 8);
                attn_store_kv(Kl + tl * 8192, Vl + tl * 8192, kr, vr, tid);
            }
        }
    }
    __syncthreads();
    const int qh = kvh * 4 + (w >> 1);
    const float slope2 = exp2f(-0.5f * (float)(qh + 1)) * LOG2E;
    const float sink2 = sinks[qh] * LOG2E;
#pragma unroll 1
    for (int sb = 0; sb < 2; ++sb) {
        const int r0 = 64 * (w & 1) + 32 * sb;
        const int qrel = r0 + r32;
        const size_t qrow = (size_t)(b * SEQ + t0 + qrel);
        bf16x8 qf[4];
#pragma unroll
        for (int s = 0; s < 4; ++s) qf[s] = *(const bf16x8*)(Z + qrow * ZP + ZQ + qh * 64 + 16 * s + 8 * hi);
        f32x16 o[2]; o[0] = f32x16{}; o[1] = f32x16{};
        float m = sink2, l = 1.0f;
        const int tl0 = (r0 + 1) >> 6;
#pragma unroll 1
        for (int tt = 0; tt < 3; ++tt) {
            const int tl = tl0 + tt;
            if (nb == 0 && tl < 2) continue;
            f32x16 p[2];
            attn_qk(p, qf, Kl + tl * 8192, r32, hi);
#pragma unroll
            for (int kb = 0; kb < 2; ++kb)
#pragma unroll
                for (int r = 0; r < 16; ++r) {
                    const int krel = tl * 64 + 32 * kb + crow(r, hi) - 128;
                    const int dist = qrel - krel;
                    const float s = p[kb][r] - slope2 * (float)dist;
                    p[kb][r] = (dist >= 0 && dist < 128) ? s : -INFINITY;
                }
            attn_softmax_pv(p, o, m, l, Vl + tl * 8192, lane);
        }
        attn_store_o(o, l, YS + qrow * 1024 + qh * 64, hi);
    }
    __syncthreads();
}

__device__ __forceinline__ void fox_unit(Frame& F, int bh, int qb, LAS const float* c2) {
    const bf16_t* Z = (const bf16_t*)(F.ws + WS_Z); bf16_t* YF = (bf16_t*)(F.ws + WS_YF);
    const int b = bh >> 4, h = bh & 15;
    const int tid = F.tid, lane = F.lane, r32 = lane & 31, hi = lane >> 5, w = F.wave;
    LAS char* Kl = (LAS char*)F.lds; LAS char* Vl = (LAS char*)F.lds + 16384;
    const int q0 = qb * 256, qw = q0 + 32 * w, qabs = qw + r32;
    const size_t qrow = (size_t)(b * SEQ + qabs);
    const int NT = 4 * (qb + 1);
    const int kvr = tid >> 3, kc = tid & 7;
    const bf16_t* kbase = Z + (size_t)(b * SEQ + kvr) * ZP + ZFK + h * 64 + kc * 8;
    const bf16_t* vbase = Z + (size_t)(b * SEQ + kvr) * ZP + ZFV + h * 64 + kc * 8;
    u32x4 kr = *(const u32x4*)kbase, vr = *(const u32x4*)vbase;
    bf16x8 qf[4];
#pragma unroll
    for (int s = 0; s < 4; ++s) qf[s] = *(const bf16x8*)(Z + qrow * ZP + ZFQ + h * 64 + 16 * s + 8 * hi);
    attn_store_kv(Kl, Vl, kr, vr, tid);
    __syncthreads();
    f32x16 o[2]; o[0] = f32x16{}; o[1] = f32x16{};
    float m = -1e30f, l = 0.f;
#pragma unroll 1
    for (int t = 0; t < NT; ++t) {
        const int buf = t & 1;
        if (t + 1 < NT) { kr = *(const u32x4*)(kbase + (size_t)(t + 1) * 64 * ZP); vr = *(const u32x4*)(vbase + (size_t)(t + 1) * 64 * ZP); }
        const int k0 = t * 64;
        if (k0 <= qw + 31) {
            f32x16 p[2];
            attn_qk(p, qf, Kl + buf * 8192, r32, hi);
            const bool diag = (k0 + 63 > qw);
#pragma unroll
            for (int kb = 0; kb < 2; ++kb)
#pragma unroll
                for (int rq = 0; rq < 4; ++rq) {
                    const int kk = k0 + 32 * kb + 8 * rq + 4 * hi;
                    const f32x4 cc = *(const LAS f32x4*)(c2 + kk);
#pragma unroll
                    for (int j = 0; j < 4; ++j) { float s = p[kb][4 * rq + j] - cc[j]; if (diag && (kk + j > qabs)) s = -INFINITY; p[kb][4 * rq + j] = s; }
                }
            attn_softmax_pv(p, o, m, l, Vl + buf * 8192, lane);
        }
        if (t + 1 < NT) attn_store_kv(Kl + (buf ^ 1) * 8192, Vl + (buf ^ 1) * 8192, kr, vr, tid);
        __syncthreads();
    }
    attn_store_o(o, l, YF + qrow * 1024 + h * 64, hi);
}
__device__ __forceinline__ void p2_attention(Frame& F, const Args& a) {
    for (int u = F.vcu; u < 256; u += F.G) swa_unit(F, u, a.in[4]);
    LAS float* c2 = (LAS float*)(F.lds + 32768);
    LAS float* wtot = (LAS float*)(F.lds + 32768 + 8192);
    const float* FL = (const float*)(F.ws + WS_FL);
    for (int it = F.vcu; it < 256; it += F.G) {
        const int bh = it >> 2, s = it & 3, b = bh >> 4, h = bh & 15;
        {
            float v[4]; float run = 0.f;
#pragma unroll
            for (int j = 0; j < 4; ++j) { run += FL[(size_t)(b * SEQ + 4 * F.tid + j) * 16 + h]; v[j] = run; }
            float inc = run;
#pragma unroll
            for (int o = 1; o < 64; o <<= 1) { const float n = __shfl_up(inc, o); if (F.lane >= o) inc += n; }
            if (F.lane == 63) wtot[F.wave] = inc;
            __syncthreads();
            float base = inc - run;
            for (int ww = 0; ww < F.wave; ++ww) base += wtot[ww];
#pragma unroll
            for (int j = 0; j < 4; ++j) c2[4 * F.tid + j] = base + v[j];
            __syncthreads();
        }
        fox_unit(F, bh, s, c2);
        fox_unit(F, bh, 7 - s, c2);
        __syncthreads();
    }
}

__device__ __forceinline__ void p5_router(Frame& F, const Args& a, unsigned* CNT, float* LISTW, int* LIST) {
    const float* H1 = (const float*)(F.ws + WS_H1); const float* PSQ = (const float*)(F.ws + WS_PSQ); const float* WRG = (const float*)(F.ws + WS_WRG);
    unsigned char* V8 = F.ws + WS_V;
    const float* g = a.in[8]; const float* rbias = a.in[10];
    const int lane = F.lane, w = F.wave, tid = F.tid;
    LAS float* part = (LAS float*)F.lds;
    LAS float* logit = (LAS float*)(F.lds + 65536);
    LAS float* rinvs = (LAS float*)(F.lds + 65536 + 8192);
    LAS int* lcnt = (LAS int*)(F.lds + 65536 + 8192 + 128);
    LAS int* gbase = (LAS int*)(F.lds + 65536 + 8192 + 128 + 256);
    for (int tile = F.vcu; tile < T / 32; tile += F.G) {
        const int tok0 = tile * 32;
        if (tid < 64) lcnt[tid] = 0;
#pragma unroll 1
        for (int j = 0; j < 4; ++j) {
            const int tok = tok0 + 4 * w + j;
            float sq = lane < 32 ? PSQ[(size_t)tok * 32 + lane] : 0.f;
            sq = wave_sum(sq);
            const float rinv = rsqrtf(sq * (1.f / D) + RMS_EPS);
            if (lane == 0) rinvs[4 * w + j] = rinv;
            const f32x4* hr = (const f32x4*)(H1 + (size_t)tok * D) + lane;
            unsigned* o = (unsigned*)(V8 + (size_t)tok * D) + lane;
#pragma unroll
            for (int jj = 0; jj < 8; ++jj) { const f32x4 hv = hr[64 * jj]; const f32x4 gg = *((const f32x4*)g + lane + 64 * jj);
                o[64 * jj] = pk_fp8x4(hv.x * rinv * gg.x, hv.y * rinv * gg.y, hv.z * rinv * gg.z, hv.w * rinv * gg.w); }
        }
        {
            f32x16 acc0 = {}, acc1 = {};
            const int tk = lane & 31, half = lane >> 5;
            const float* hp = H1 + (size_t)(tok0 + tk) * D + 256 * w + 4 * half;
            const float* wp = WRG + (size_t)(256 * w + 4 * half) * NE + tk;
#pragma unroll 4
            for (int kk = 0; kk < 32; ++kk) {
                const f32x4 av = *(const f32x4*)(hp + 8 * kk);
#pragma unroll
                for (int s = 0; s < 4; ++s) {
                    const float b0 = wp[(size_t)(8 * kk + s) * NE], b1 = wp[(size_t)(8 * kk + s) * NE + 32];
                    acc0 = __builtin_amdgcn_mfma_f32_32x32x2f32(av[s], b0, acc0, 0, 0, 0);
                    acc1 = __builtin_amdgcn_mfma_f32_32x32x2f32(av[s], b1, acc1, 0, 0, 0);
                }
            }
#pragma unroll
            for (int r = 0; r < 16; ++r) { const int tr = crow(r, half); part[(w * 32 + tr) * 64 + tk] = acc0[r]; part[(w * 32 + tr) * 64 + 32 + tk] = acc1[r]; }
        }
        __syncthreads();
#pragma unroll
        for (int q = 0; q < 4; ++q) { const int idx = tid + 512 * q; float s = 0.f;
#pragma unroll
            for (int ww = 0; ww < 8; ++ww) s += part[ww * 2048 + idx];
            logit[idx] = s * rinvs[idx >> 6]; }
        __syncthreads();
        int sel_k[4], sel_ls[4]; float sel_w[4];
        const float bias = rbias[lane];
#pragma unroll
        for (int j = 0; j < 4; ++j) {
            const int tl = 4 * w + j;
            const float score = sigmoidf_(logit[tl * 64 + lane]);
            const float biased = score + bias;
            float m1 = biased; m1 = fmaxf(m1, __shfl_xor(m1, 1)); m1 = fmaxf(m1, __shfl_xor(m1, 2)); m1 = fmaxf(m1, __shfl_xor(m1, 4));
            const unsigned long long gm = 0xFFull << (lane & 56);
            const unsigned long long b1 = __ballot(biased == m1) & gm;
            const int i1 = __builtin_ctzll(b1);
            float v2 = (lane == i1) ? -INFINITY : biased;
            float m2 = v2; m2 = fmaxf(m2, __shfl_xor(m2, 1)); m2 = fmaxf(m2, __shfl_xor(m2, 2)); m2 = fmaxf(m2, __shfl_xor(m2, 4));
            const float gs = m1 + m2; const int gi = lane >> 3;
            int rank = 0;
#pragma unroll
            for (int gg = 0; gg < 8; ++gg) { const float o = __shfl(gs, 8 * gg); rank += (o > gs || (o == gs && gg < gi)) ? 1 : 0; }
            float mv = rank < 4 ? biased : -INFINITY;
            int myk = -1;
#pragma unroll
            for (int it = 0; it < 8; ++it) { const float mx = wave_max(mv); const unsigned long long bb = __ballot(mv == mx); const int sl = __builtin_ctzll(bb); if (lane == sl) { myk = it; mv = -INFINITY; } }
            const float ssum = wave_sum(myk >= 0 ? score : 0.f);
            sel_k[j] = myk; sel_w[j] = score / ssum * 2.5f;
            sel_ls[j] = 0;
            if (myk >= 0) sel_ls[j] = __hip_atomic_fetch_add((LAS int*)&lcnt[lane], 1, __ATOMIC_RELAXED, __HIP_MEMORY_SCOPE_WORKGROUP);
        }
        __syncthreads();
        if (tid < 64) gbase[tid] = (int)atomicAdd(CNT + tid, (unsigned)lcnt[tid]);
        __syncthreads();
#pragma unroll
        for (int j = 0; j < 4; ++j) if (sel_k[j] >= 0) { const int tok = tok0 + 4 * w + j; const int aid = tok * 8 + sel_k[j];
            const size_t li = (size_t)lane * T + gbase[lane] + sel_ls[j]; LIST[li] = aid; LISTW[li] = sel_w[j]; }
        __syncthreads();
    }
}

template <int MULT> __device__ __forceinline__ int moe_table(Frame& F, LAS int* tab) {
    if (F.tid < 64) {
        const int cnt = (int)__hip_atomic_load(F.ctl + CW_CNT + F.tid, __ATOMIC_RELAXED, __HIP_MEMORY_SCOPE_AGENT);
        int inc = ((cnt + 255) >> 8) * MULT;
#pragma unroll
        for (int o = 1; o < 64; o <<= 1) { const int n = __shfl_up(inc, o); if (F.lane >= o) inc += n; }
        tab[F.tid] = inc; tab[64 + F.tid] = cnt;
    }
    __syncthreads();
    return 32 * MULT + tab[63];
}

__device__ __forceinline__ void p8_final(Frame& F, const Args& a) {
    const float* H1 = (const float*)(F.ws + WS_H1); const unsigned char* YB8 = F.ws + WS_YB; const float* g = a.in[17];
    const int gw = F.vcu * NWAVES + F.wave, NGW = F.G * NWAVES;
    for (int tok = gw; tok < T; tok += NGW) {
        const f32x4* hr = (const f32x4*)(H1 + (size_t)tok * D) + F.lane;
        f32x4 v[8], y[8];
#pragma unroll
        for (int j = 0; j < 8; ++j) { v[j] = hr[64 * j]; y[j] = (f32x4){0.f, 0.f, 0.f, 0.f}; }
#pragma unroll 3
        for (int k = 0; k < 9; ++k) {
            const size_t row = k < 8 ? (size_t)tok * 8 + k : (size_t)NASSIGN + tok;
            const unsigned* yr = (const unsigned*)(YB8 + row * D) + F.lane;
#pragma unroll
            for (int j = 0; j < 8; ++j) { const unsigned w = yr[64 * j]; const f32x2 lo = __builtin_amdgcn_cvt_pk_f32_fp8((int)w, false), hi = __builtin_amdgcn_cvt_pk_f32_fp8((int)w, true);
                y[j].x += lo.x; y[j].y += lo.y; y[j].z += hi.x; y[j].w += hi.y; }
        }
#pragma unroll
        for (int j = 0; j < 8; ++j) v[j] = v[j] + y[j] * (1.f / YB_SCALE);
        float s = 0.f;
#pragma unroll
        for (int j = 0; j < 8; ++j) s += (v[j].x * v[j].x + v[j].y * v[j].y) + (v[j].z * v[j].z + v[j].w * v[j].w);
        const float rinv = rsqrtf(wave_sum(s) * (1.f / D) + RMS_EPS);
        f32x4* o = (f32x4*)(a.out + (size_t)tok * D) + F.lane;
#pragma unroll
        for (int j = 0; j < 8; ++j) { const f32x4 gg = *((const f32x4*)g + F.lane + 64 * j); o[64 * j] = (f32x4){v[j].x * rinv * gg.x, v[j].y * rinv * gg.y, v[j].z * rinv * gg.z, v[j].w * rinv * gg.w}; }
    }
}

constexpr int N_PHASES = 9;
__global__ void __launch_bounds__(NTHREADS, 2) fwd_kernel(Args args) {
    extern __shared__ __attribute__((aligned(16))) unsigned char lds_raw[];
    Frame F;
    F.lds = (LAS unsigned char*)lds_raw;
    F.MISC = (volatile LAS unsigned*)(F.lds + MISC_OFF);
    F.tid = threadIdx.x; F.lane = F.tid & 63; F.wave = __builtin_amdgcn_readfirstlane(F.tid >> 6);
    F.G = gridDim.x; { const int bx = blockIdx.x; F.vcu = (F.G % 8 == 0) ? (bx % 8) * (F.G / 8) + bx / 8 : bx; }
    F.ws = args.ws; F.ctl = (unsigned*)(args.ws + WS_CTL);
    for (int u = F.tid; u < (LDS_BYTES - MISC_OFF) / 4; u += NTHREADS) ((LAS unsigned*)(F.lds + MISC_OFF))[u] = 0u;
    __syncthreads();
    const int lo = args.ph_lo, hi = args.ph_hi;
    XcdBarrier bar; bar.bar = F.ctl + CW_BAR; bar.x = 0; bar.st = nullptr;
    if (hi - lo > 1) bar = xcd_barrier_post(F.ctl + CW_BAR, F.MISC + 8);
#define IN(k) (lo <= (k) && (k) < hi)
#define SEAM(k) do { if (IN(k) && IN((k) + 1)) xcd_barrier(bar); } while (0)
    unsigned char* ws = args.ws;
    LAS int* tab = (LAS int*)(F.lds + MISC_OFF + 256);

#define REPS(k) for (int rep_ = 0; rep_ < (PROBE_DUP == (k) ? 2 : 1); ++rep_)
#define REPBAR(k) do { if (PROBE_DUP == (k) && rep_ == 0) xcd_barrier(bar); } while (0)
    if (IN(0)) { p0_prologue(F, args); SEAM(0); }
    if (IN(1)) {
        DenseSched S{(const char*)(ws + WS_U), (const char*)(ws + WS_WINT), T / 256, NIN / 256, D, F.G, (int)blockIdx.x, PROBE_DUP == 1 ? 2 : 1};
        EpiZ E{(bf16_t*)(ws + WS_Z), (float*)(ws + WS_FL), args.in[3]};
        pg8::gemm_phase<false>(F.lds, 2 * D, S, E);
        SEAM(1);
    }
    if (IN(2)) { REPS(2) { p2_attention(F, args); REPBAR(2); } SEAM(2); }
    if (IN(3)) {
        BranchSched S{(const char*)(ws + WS_YS), (const char*)(ws + WS_YF), (const char*)(ws + WS_WSWAT), (const char*)(ws + WS_WFOXT), T / 256, D / 256, 1024, F.G, (int)blockIdx.x, PROBE_DUP == 3 ? 2 : 1};
        EpiMix E{(const bf16_t*)(ws + WS_Z), (bf16_t*)(ws + WS_MIX)};
        pg8::gemm_phase<false>(F.lds, 2 * 1024, S, E);
        SEAM(3);
    }
    if (IN(4)) {
        DenseSched S{(const char*)(ws + WS_MIX), (const char*)(ws + WS_WOUTT), T / 256, D / 256, D, F.G, (int)blockIdx.x, PROBE_DUP == 4 ? 2 : 1};
        EpiOut E{args.in[0], (float*)(ws + WS_H1), (float*)(ws + WS_PSQ)};
        pg8::gemm_phase<false>(F.lds, 2 * D, S, E);
        SEAM(4);
    }
    if (IN(5)) {
        if (PROBE_DUP == 5) { p5_router(F, args, F.ctl + 256, (float*)(ws + WS_T1), (int*)(ws + WS_T1 + 2 * MiB)); xcd_barrier(bar); }
        p5_router(F, args, F.ctl + CW_CNT, (float*)(ws + WS_LISTW), (int*)(ws + WS_LIST));
        if (PROBE_DUP == 9) { for (int q = 0; q < 16; ++q) xcd_barrier(bar); }
        SEAM(5); }
    if (IN(6)) {
        const int total = moe_table<4>(F, tab);
        MoeSched<0> S{tab, (const int*)(ws + WS_LIST), (const float*)(ws + WS_LISTW), (const char*)(ws + WS_V), (const char*)(ws + WS_WGU), (LAS int*)(F.lds + MISC_OFF + 1024), (LAS float*)(F.lds + MISC_OFF + 4096), total, F.G, F.vcu, PROBE_DUP == 6 ? 2 : 1};
        EpiSwiglu E{&S, (unsigned char*)(ws + WS_HB)};
        pg8::gemm_phase<true>(F.lds, 2048, S, E);
        SEAM(6);
    }
    if (IN(7)) {
        const int total = moe_table<8>(F, tab);
        MoeSched<1> S{tab, (const int*)(ws + WS_LIST), (const float*)(ws + WS_LISTW), (const char*)(ws + WS_HB), (const char*)(ws + WS_WD), (LAS int*)(F.lds + MISC_OFF + 1024), (LAS float*)(F.lds + MISC_OFF + 4096), total, F.G, F.vcu, PROBE_DUP == 7 ? 2 : 1};
        EpiDown E{&S, (unsigned char*)(ws + WS_YB)};
        pg8::gemm_phase<true>(F.lds, 512, S, E);
        SEAM(7);
    }
    if (IN(8)) { REPS(8) { p8_final(F, args); REPBAR(8); } }
#undef IN
#undef SEAM
}

extern "C" void kernel_launch(void* const* d_in, const int* in_sizes, int n_in, void* d_out, int out_size, void* d_ws, size_t ws_size, hipStream_t stream) {
    static int grid = 0;
    if (grid == 0) {
        if (n_in != 18 || out_size != T * D || ws_size < WS_END) { fprintf(stderr, "kernel_launch: unexpected shapes (n_in %d out %d ws %zu)\n", n_in, out_size, ws_size); grid = -1; return; }
        int dev = 0, cus = 0, per_cu = 0;
        if (hipGetDevice(&dev) != hipSuccess || hipDeviceGetAttribute(&cus, hipDeviceAttributeMultiprocessorCount, dev) != hipSuccess) { grid = -1; return; }
        if (hipFuncSetAttribute((const void*)fwd_kernel, hipFuncAttributeMaxDynamicSharedMemorySize, LDS_BYTES) != hipSuccess) { fprintf(stderr, "kernel_launch: hipFuncSetAttribute failed\n"); grid = -1; return; }
        if (hipOccupancyMaxActiveBlocksPerMultiprocessor(&per_cu, (const void*)fwd_kernel, NTHREADS, LDS_BYTES) != hipSuccess || per_cu < 1) { fprintf(stderr, "kernel_launch: occupancy query says %d blocks per CU\n", per_cu); (void)hipGetLastError(); grid = -1; return; }
        grid = cus;
        if (grid % 8 != 0 || grid > 256) grid = (grid / 8) * 8 > 256 ? 256 : (grid / 8) * 8;
    }
    if (grid <= 0) return;
    (void)hipMemsetAsync((char*)d_ws + WS_CTL, 0, CTL_ZERO_BYTES, stream);
    Args a{};
    for (int i = 0; i < 18; ++i) a.in[i] = (const float*)d_in[i];
    a.out = (float*)d_out; a.ws = (unsigned char*)d_ws;
#if MK_N_LAUNCHES == 1
    a.ph_lo = 0; a.ph_hi = N_PHASES;
    hipLaunchKernelGGL(fwd_kernel, dim3(grid), dim3(NTHREADS), LDS_BYTES, stream, a);
#else
    for (int p = 0; p < N_PHASES; ++p) { a.ph_lo = p; a.ph_hi = p + 1; hipLaunchKernelGGL(fwd_kernel, dim3(grid), dim3(NTHREADS), LDS_BYTES, stream, a); }
#endif
}
```

```cpp
#include <hip/hip_runtime.h>
#include <cstdio>
#include <cstdint>

#ifndef MK_N_LAUNCHES
#define MK_N_LAUNCHES 1
#endif
#define PROBE_DUP -1

#define LAS __attribute__((address_space(3)))
#define GAS __attribute__((address_space(1)))
typedef unsigned short bf16_t;
typedef short bf16x8 __attribute__((ext_vector_type(8)));
typedef short s16x4 __attribute__((ext_vector_type(4)));
typedef float f32x2 __attribute__((ext_vector_type(2)));
typedef float f32x4 __attribute__((ext_vector_type(4)));
typedef float f32x16 __attribute__((ext_vector_type(16)));
typedef unsigned u32x2 __attribute__((ext_vector_type(2)));
typedef unsigned u32x4 __attribute__((ext_vector_type(4)));
typedef __bf16 bf16x2_t __attribute__((ext_vector_type(2)));

constexpr int T = 8192, D = 2048, SEQ = 2048, NBATCH = 4;
constexpr int NE = 64, FF = 512, TOPK = 8;
constexpr int ZP = 8704;
constexpr int ZQ = 0, ZK = 1024, ZV = 1280, ZFQ = 1536, ZFK = 2560, ZFV = 3584, ZGS = 4608, ZGF = 6656;
constexpr int NIN = 8960;
constexpr float RMS_EPS = 1e-6f;
constexpr float LOG2E = 1.4426950408889634f;
constexpr float QSCALE = 0.125f * LOG2E;
constexpr int NASSIGN = T * TOPK;
constexpr int NROWS_H = NASSIGN + T;

constexpr size_t MiB = 1u << 20;
constexpr size_t WS_CTL = 0, CTL_ZERO_BYTES = 64 * 1024;
constexpr size_t WS_FL = 1 * MiB;
constexpr size_t WS_WTS = 1 * MiB + 512 * 1024;
constexpr size_t WS_LIST = 2 * MiB;
constexpr size_t WS_WSWAT = 4 * MiB, WS_WFOXT = 8 * MiB, WS_WOUTT = 12 * MiB;
constexpr size_t WS_WINT = 20 * MiB;
constexpr size_t WS_WRG = 55 * MiB;
constexpr size_t WS_PSQ = 55 * MiB + 512 * 1024;
constexpr size_t WS_U = 56 * MiB;
constexpr size_t WS_Z = 88 * MiB;
constexpr size_t WS_YS = 224 * MiB, WS_YF = 240 * MiB;
constexpr size_t WS_T1 = 256 * MiB;
constexpr size_t WS_MIX = 320 * MiB;
constexpr size_t WS_H1 = 352 * MiB;
constexpr size_t WS_V = 416 * MiB;
constexpr size_t WS_HB = 448 * MiB;
constexpr size_t WS_WGU = 520 * MiB;
constexpr size_t WS_WD = 780 * MiB;
constexpr size_t WS_YB = 56 * MiB;
constexpr size_t WS_LISTW = 910 * MiB;
constexpr size_t WS_END = 912 * MiB;
static_assert(WS_YB + (size_t)NROWS_H * D * 2 <= WS_MIX + 32 * MiB, "YB overlay");
constexpr int CW_CNT = 64;
constexpr int CW_BAR = 4096;

constexpr int RING_BYTES = 131072;
constexpr int MISC_OFF = 139264;
constexpr int LDS_BYTES = 147456;
constexpr int NWAVES = 8, NTHREADS = 512;

__device__ __forceinline__ unsigned cvtpk(float lo, float hi) { f32x2 v = {lo, hi}; bf16x2_t b = __builtin_convertvector(v, bf16x2_t); return __builtin_bit_cast(unsigned, b); }
__device__ __forceinline__ float bf2f(bf16_t h) { return __builtin_bit_cast(float, (unsigned)h << 16); }
__device__ __forceinline__ float bflo(unsigned w) { return __builtin_bit_cast(float, w << 16); }
__device__ __forceinline__ float bfhi(unsigned w) { return __builtin_bit_cast(float, w & 0xffff0000u); }
__device__ __forceinline__ float wave_sum(float v) {
#pragma unroll
    for (int o = 1; o < 64; o <<= 1) v += __shfl_xor(v, o);
    return v;
}
__device__ __forceinline__ float wave_max(float v) {
#pragma unroll
    for (int o = 1; o < 64; o <<= 1) v = fmaxf(v, __shfl_xor(v, o));
    return v;
}
__device__ __forceinline__ float sigmoidf_(float x) { return 1.0f / (1.0f + __expf(-x)); }
#define LDS_WAIT() asm volatile("s_waitcnt lgkmcnt(0)" ::: "memory")
#define VM_WAIT() asm volatile("s_waitcnt vmcnt(0)" ::: "memory")

#define XB_TMO      128
#define XB_XCNT(j)  (256  + 64 * (j))
#define XB_XSUB(j)  (1280 + 64 * (j))
#define XB_XGEN(j)  (2304 + 64 * (j))
#define XB_TOP      3328
#define XB_TOPGEN   3392
#define XCD_BAR_WORDS 3456
#define XB_SPIN_CAP (1u << 20)
__device__ __forceinline__ unsigned xb_ld(unsigned* p)              { return __hip_atomic_load(p, __ATOMIC_RELAXED, __HIP_MEMORY_SCOPE_AGENT); }
__device__ __forceinline__ unsigned xb_add(unsigned* p, unsigned v) { return __hip_atomic_fetch_add(p, v, __ATOMIC_RELAXED, __HIP_MEMORY_SCOPE_AGENT); }
__device__ __forceinline__ unsigned xb_xcc_id() { return (unsigned)__builtin_amdgcn_s_getreg((3 << 11) | 20) & 0xFu; }
#define XB_SPIN(cond, bar) do { unsigned _sp = 0; while (cond) { __builtin_amdgcn_s_sleep(1); \
    if ((++_sp & 255u) == 0u) { if (xb_ld(&(bar)[XB_TMO])) break; if (_sp > XB_SPIN_CAP) { atomicAdd(&(bar)[XB_TMO], 1u); break; } } } } while (0)
struct XcdBarrier { unsigned* bar; unsigned x; volatile LAS unsigned* st; };
__device__ __forceinline__ XcdBarrier xcd_barrier_post(unsigned* bar, volatile LAS unsigned* st) {
    XcdBarrier b; b.bar = bar; b.x = xb_xcc_id(); b.st = st;
    if (threadIdx.x == 0) (void)xb_add(&bar[XB_XCNT(b.x)], 1u);
    return b;
}
__device__ __forceinline__ void xcd_barrier_complete(unsigned* bar, unsigned x, unsigned& nloc, unsigned& nx) {
    const unsigned G = gridDim.x * gridDim.y * gridDim.z;
    unsigned sum, cnt, mine, sp = 0u;
    for (;;) {
        sum = 0u; cnt = 0u; mine = 0u;
#pragma unroll
        for (unsigned j = 0; j < 16; ++j) { const unsigned c = xb_ld(&bar[XB_XCNT(j)]); sum += c; cnt += (c > 0u) ? 1u : 0u; mine = (j == x) ? c : mine; }
        if (sum == G) break;
        __builtin_amdgcn_s_sleep(1);
        if ((++sp & 255u) == 0u) { if (xb_ld(&bar[XB_TMO])) break; if (sp > XB_SPIN_CAP) { atomicAdd(&bar[XB_TMO], 1u); break; } }
    }
    nloc = mine > 0u ? mine : 1u; nx = cnt > 0u ? cnt : 1u;
}
__device__ __forceinline__ void xcd_barrier(const XcdBarrier& b) {
    asm volatile("s_waitcnt vmcnt(0)" ::: "memory");
    __syncthreads();
    if (threadIdx.x == 0) {
        unsigned* bar = b.bar;
        __builtin_amdgcn_s_waitcnt(0);
        unsigned nloc = b.st[0], nx = b.st[1];
        if (nloc == 0u) { xcd_barrier_complete(bar, b.x, nloc, nx); b.st[0] = nloc; b.st[1] = nx; }
        const unsigned old = xb_add(&bar[XB_XSUB(b.x)], 1u);
        const unsigned gen = old / nloc;
        if (old + 1u == (gen + 1u) * nloc) {
            __builtin_amdgcn_fence(__ATOMIC_RELEASE, "agent");
            asm volatile("s_waitcnt vmcnt(0)" ::: "memory");
            const unsigned og = xb_add(&bar[XB_TOP], 1u);
            const unsigned tg = og / nx;
            if (og + 1u == (tg + 1u) * nx) xb_add(&bar[XB_TOPGEN], 1u);
            else XB_SPIN(xb_ld(&bar[XB_TOPGEN]) == tg, bar);
            __builtin_amdgcn_fence(__ATOMIC_ACQUIRE, "agent");
            xb_add(&bar[XB_XGEN(b.x)], 1u);
            asm volatile("s_waitcnt vmcnt(0)" ::: "memory");
        } else {
            XB_SPIN(xb_ld(&bar[XB_XGEN(b.x)]) == gen, bar);
            __builtin_amdgcn_fence(__ATOMIC_ACQUIRE, "agent");
            asm volatile("s_waitcnt vmcnt(0)" ::: "memory");
        }
    }
    __syncthreads();
}

namespace pg8 {
constexpr int BM = 256, BK = 64, HALF = 128, HTB = HALF * BK * 2, STAGE_BYTES = 8 * HTB, NXCD = 8, WGM = 8;
__host__ __device__ __forceinline__ int lds_byte(int r, int c) { const int st = (r >> 4) * 2 + (c >> 5), rr = r & 15, cc = c & 31, ob = rr * 64 + cc * 2; return st * 1024 + (ob ^ (((ob >> 9) & 1) << 5)); }
__host__ __device__ __forceinline__ void stage_rc(int b, int& R, int& C) { const int st = b / 1024, sb = b % 1024, swz = sb ^ (((sb >> 9) & 1) << 5); R = (st >> 1) * 16 + swz / 64; C = (st & 1) * 32 + (swz % 64) / 2; }
__host__ __device__ __forceinline__ int perm32(int rho) { const int n = rho >> 4, i = rho & 15; return 8 * (i >> 2) + 4 * n + (i & 3); }

struct Unit { const char* A; const char* B; int pm, pn, e, rt, hm; };

__device__ __forceinline__ void static_tile(int L, int nM, int nN, int& pm, int& pn) {
    const int nwg = nM * nN; int wgid = L;
    { const int q = nwg / NXCD, r = nwg % NXCD, xcd = wgid % NXCD, off = wgid / NXCD; wgid = (xcd < r ? xcd * (q + 1) : r * (q + 1) + (xcd - r) * q) + off; }
    const int nig = WGM * nN, gid = wgid / nig, fm = gid * WGM, gsz = (nM - fm) < WGM ? (nM - fm) : WGM;
    pm = fm + ((wgid % nig) % gsz); pn = (wgid % nig) / gsz;
}

typedef int v4i_t __attribute__((ext_vector_type(4)));
typedef int v8i_t __attribute__((ext_vector_type(8)));
template <bool FP8, class Epi, class Sched>
__device__ __forceinline__ void gemm_phase(LAS unsigned char* lds, const int Kb, const Sched& S, const Epi& E, const int stagger_ticks = 0) {
    if (stagger_ticks > 0) { const unsigned long long t0_ = __builtin_amdgcn_s_memrealtime(); while (__builtin_amdgcn_s_memrealtime() - t0_ < (unsigned long long)stagger_ticks) __builtin_amdgcn_s_sleep(8); }
    const int tid = threadIdx.x, wid = __builtin_amdgcn_readfirstlane(tid >> 6), lane = tid & 63, wr = wid >> 2, wc = wid & 3, fr = lane & 15, fq = lane >> 4;
    const int nt = Kb / 128;
    int Ri[2], Ci[2]; unsigned voffB[2];
#pragma unroll
    for (int i = 0; i < 2; ++i) { int R, C; stage_rc(tid * 16 + i * 8192, R, C); Ri[i] = R; Ci[i] = C; const int Rb = (R & ~31) + perm32(R & 31); voffB[i] = (unsigned)(Rb * Kb + C * 2); }
    const size_t kstep = (size_t)(BK * 2);
    const size_t hstep = (size_t)HALF * Kb;
    const unsigned ldsw = (unsigned)wid * 1024u;
    const int aoff = lds_byte(wr * 64 + fr, fq * 8), boff = lds_byte(wc * 32 + fr, fq * 8);
#define PG8_SA(b, h) (((b) * 2 + (h)) * HTB)
#define PG8_SB(b, h) ((4 + (b) * 2 + (h)) * HTB)
#define PG8_STAGE(bufoff, gbase, voff) do { _Pragma("unroll") for (int _i = 0; _i < 2; ++_i) \
        __builtin_amdgcn_global_load_lds((const unsigned*)((const char*)(gbase) + (voff)[_i]), (LAS unsigned*)(lds + (bufoff) + ldsw + _i * 8192), 16, 0, 0); } while (0)
#define PG8_LDA(dst, b, h) do { if constexpr (FP8) { _Pragma("unroll") for (int m = 0; m < 4; ++m) { dst##8[m].lo = *(const LAS v4i_t*)(lds + PG8_SA(b, h) + aoff + m * 2048); dst##8[m].hi = *(const LAS v4i_t*)(lds + PG8_SA(b, h) + aoff + m * 2048 + 1024); } } \
        else { _Pragma("unroll") for (int m = 0; m < 4; ++m) _Pragma("unroll") for (int k = 0; k < 2; ++k) dst[m][k] = *(const LAS bf16x8*)(lds + PG8_SA(b, h) + aoff + m * 2048 + k * 1024); } } while (0)
#define PG8_LDB(dst, b, h) do { if constexpr (FP8) { _Pragma("unroll") for (int n = 0; n < 2; ++n) { dst##8[n].lo = *(const LAS v4i_t*)(lds + PG8_SB(b, h) + boff + n * 2048); dst##8[n].hi = *(const LAS v4i_t*)(lds + PG8_SB(b, h) + boff + n * 2048 + 1024); } } \
        else { _Pragma("unroll") for (int n = 0; n < 2; ++n) _Pragma("unroll") for (int k = 0; k < 2; ++k) dst[n][k] = *(const LAS bf16x8*)(lds + PG8_SB(b, h) + boff + n * 2048 + k * 1024); } } while (0)
#define PG8_MMA(ai, bj, At, Bt) do { __builtin_amdgcn_s_setprio(1); \
        if constexpr (FP8) { _Pragma("unroll") for (int m = 0; m < 4; ++m) _Pragma("unroll") for (int n = 0; n < 2; ++n) \
            asm volatile("v_mfma_scale_f32_16x16x128_f8f6f4 %0, %1, %2, %0, %3, %3 op_sel_hi:[0,0,0]" : "+v"(acc[ai][bj][m][n]) : "v"(Bt##8[n]), "v"(At##8[m]), "v"(sc8)); } \
        else { _Pragma("unroll") for (int m = 0; m < 4; ++m) _Pragma("unroll") for (int n = 0; n < 2; ++n) _Pragma("unroll") for (int k = 0; k < 2; ++k) \
            acc[ai][bj][m][n] = __builtin_amdgcn_mfma_f32_16x16x32_bf16(Bt[n][k], At[m][k], acc[ai][bj][m][n], 0, 0, 0); } \
        __builtin_amdgcn_s_setprio(0); } while (0)
#define PG8_WAIT_V(n) asm volatile("s_waitcnt vmcnt(" #n ")" ::: "memory")
#define PG8_WAIT_L(n) asm volatile("s_waitcnt lgkmcnt(" #n ")" ::: "memory")
#define PG8_BAR __builtin_amdgcn_s_barrier()
#define PG8_SCHED __builtin_amdgcn_sched_barrier(0)
    Unit cur, nxt; int ui = 0;
    if (!S.next(0, cur)) return;
    unsigned vc[2][2], vn[2][2];
    int pfa = -1; float pfw = 0.f;
    S.pf_issue(cur, pfa, pfw); S.pf_commit(0, pfa, pfw);
    asm volatile("s_waitcnt vmcnt(0) lgkmcnt(0)" ::: "memory"); PG8_BAR; asm volatile("" ::: "memory");
    S.rowoffs(cur, 0, vc, Ri, Ci);
    f32x4 acc[2][2][4][2];
#pragma unroll
    for (int a = 0; a < 2; ++a)
#pragma unroll
        for (int b = 0; b < 2; ++b)
#pragma unroll
            for (int m = 0; m < 4; ++m)
#pragma unroll
                for (int n = 0; n < 2; ++n) acc[a][b][m][n] = (f32x4){0.f, 0.f, 0.f, 0.f};
    const int sc8 = 0x7f7f7f7f;
    bf16x8 At[4][2], B0[2][2], B1[2][2]; v8i_t At8[4], B08[2], B18[2];
    const char* cA = cur.A; const char* cB = cur.B;
    PG8_STAGE(PG8_SB(0, 0), cB, voffB); PG8_STAGE(PG8_SB(0, 1), cB + hstep, voffB); PG8_STAGE(PG8_SA(0, 0), cA, vc[0]); PG8_STAGE(PG8_SA(0, 1), cA, vc[1]);
    if (wr == 1) PG8_BAR;
    PG8_WAIT_V(2); PG8_BAR;
    PG8_STAGE(PG8_SB(1, 0), cB + kstep, voffB); PG8_STAGE(PG8_SA(1, 0), cA + kstep, vc[0]); PG8_STAGE(PG8_SB(1, 1), cB + hstep + kstep, voffB);
    PG8_WAIT_V(6); PG8_BAR;
    for (;;) {
        const bool has_next = S.next(ui + 1, nxt);
        const int scur = ui % 3, snxt = (ui + 1) % 3;
        const bool h0 = (cur.hm & 1) != 0, h1 = (cur.hm & 2) != 0;
        const char* nA = has_next ? nxt.A : cA; const char* nB = has_next ? nxt.B : cB;
        if (has_next) S.pf_issue(nxt, pfa, pfw);
        for (int t = 0; t < nt; t += 2) {
            const bool last = (t == nt - 2);
            if (t == (nt >= 8 ? nt - 4 : 0) && has_next) S.pf_commit(snxt, pfa, pfw);
            const char* a1 = cA + (size_t)(t + 1) * kstep;
            const char* a2 = last ? nA : cA + (size_t)(t + 2) * kstep; const char* b2 = last ? nB : cB + (size_t)(t + 2) * kstep;
            const char* a3 = a2 + kstep; const char* b3 = b2 + kstep;
            if (last) {
                if (has_next) S.rowoffs(nxt, snxt, vn, Ri, Ci);
                else { vn[0][0] = vc[0][0]; vn[0][1] = vc[0][1]; vn[1][0] = vc[1][0]; vn[1][1] = vc[1][1]; }
            }
            unsigned v2[2][2];
            v2[0][0] = last ? vn[0][0] : vc[0][0]; v2[0][1] = last ? vn[0][1] : vc[0][1]; v2[1][0] = last ? vn[1][0] : vc[1][0]; v2[1][1] = last ? vn[1][1] : vc[1][1];
            PG8_LDB(B0, 0, 0); PG8_LDB(B1, 0, 1); PG8_SCHED; PG8_LDA(At, 0, 0); PG8_STAGE(PG8_SA(1, 1), a1, vc[1]);
            PG8_WAIT_V(8); PG8_WAIT_L(0); PG8_BAR; if (h0) { PG8_MMA(0, 0, At, B0); PG8_MMA(0, 1, At, B1); } PG8_BAR; PG8_SCHED;
            PG8_LDA(At, 0, 1); PG8_STAGE(PG8_SB(0, 0), b2, voffB); PG8_STAGE(PG8_SB(0, 1), b2 + hstep, voffB); PG8_STAGE(PG8_SA(0, 0), a2, v2[0]);
            PG8_WAIT_V(8); PG8_WAIT_L(0); PG8_BAR; if (h1) { PG8_MMA(1, 0, At, B0); PG8_MMA(1, 1, At, B1); } PG8_BAR; PG8_SCHED;
            PG8_LDB(B0, 1, 0); PG8_LDB(B1, 1, 1); PG8_SCHED; PG8_LDA(At, 1, 0); PG8_STAGE(PG8_SA(0, 1), a2, v2[1]);
            PG8_WAIT_V(8); PG8_WAIT_L(0); PG8_BAR; if (h0) { PG8_MMA(0, 0, At, B0); PG8_MMA(0, 1, At, B1); } PG8_BAR; PG8_SCHED;
            PG8_LDA(At, 1, 1); PG8_STAGE(PG8_SB(1, 0), b3, voffB); PG8_STAGE(PG8_SB(1, 1), b3 + hstep, voffB); PG8_STAGE(PG8_SA(1, 0), a3, v2[0]);
            PG8_WAIT_V(8); PG8_WAIT_L(0); PG8_BAR; if (h1) { PG8_MMA(1, 0, At, B0); PG8_MMA(1, 1, At, B1); } PG8_BAR; PG8_SCHED;
        }
        if (wr == 0) PG8_BAR;
        if constexpr (FP8) {
            asm volatile("s_nop 15\n\ts_nop 15" ::: "memory");
#pragma unroll
            for (int a = 0; a < 2; ++a)
#pragma unroll
                for (int b = 0; b < 2; ++b)
#pragma unroll
                    for (int m = 0; m < 4; ++m)
#pragma unroll
                        for (int n = 0; n < 2; ++n) asm volatile("" : "+v"(acc[a][b][m][n]));
        }
        E(acc, cur, scur, wr, wc, fr, fq);
        if (!has_next) break;
#pragma unroll
        for (int a = 0; a < 2; ++a)
#pragma unroll
            for (int b = 0; b < 2; ++b)
#pragma unroll
                for (int m = 0; m < 4; ++m)
#pragma unroll
                    for (int n = 0; n < 2; ++n) acc[a][b][m][n] = (f32x4){0.f, 0.f, 0.f, 0.f};
        cur = nxt; cA = nA; cB = nB; ++ui;
        vc[0][0] = vn[0][0]; vc[0][1] = vn[0][1]; vc[1][0] = vn[1][0]; vc[1][1] = vn[1][1];
        if (wr == 1) PG8_BAR;
    }
    PG8_WAIT_V(0);
    PG8_BAR;
#undef PG8_SA
#undef PG8_SB
#undef PG8_STAGE
#undef PG8_LDA
#undef PG8_LDB
#undef PG8_MMA
#undef PG8_WAIT_V
#undef PG8_WAIT_L
#undef PG8_BAR
#undef PG8_SCHED
}
}
using pg8::Unit;

struct Args { const float* in[18]; float* out; unsigned char* ws; int ph_lo, ph_hi; };
struct Frame {
    LAS unsigned char* lds; volatile LAS unsigned* MISC; unsigned* ctl; unsigned char* ws;
    int tid, lane, wave, vcu, G;
};

struct DenseSched {
    const char* A; const char* Bt; int nM, nN, K, G, c, dup, nsplit;
    __device__ __forceinline__ bool next(int i, Unit& u) const {
        int L = i * G + c; int hm_ = 3;
        if (nsplit > 0) {
            const int nfull = nM * nN - nsplit, tot = nfull + 2 * nsplit;
            if (L >= tot * dup) return false; if (L >= tot) L -= tot;
            if (L >= nfull) { hm_ = 1 << ((L - nfull) & 1); L = nfull + ((L - nfull) >> 1); }
        } else { if (L >= nM * nN * dup) return false; if (L >= nM * nN) L -= nM * nN; }
        int pm, pn; pg8::static_tile(L, nM, nN, pm, pn);
        u.pm = pm; u.pn = pn; u.e = 0; u.rt = 0; u.hm = hm_; u.A = A + (size_t)pm * 256 * K * 2; u.B = Bt + (size_t)pn * 256 * K * 2; return true;
    }
    __device__ __forceinline__ void pf_issue(const Unit&, int&, float&) const {}
    __device__ __forceinline__ void pf_commit(int, int, float) const {}
    __device__ __forceinline__ void rowoffs(const Unit&, int, unsigned (&vo)[2][2], const int (&R)[2], const int (&C)[2]) const {
#pragma unroll
        for (int h = 0; h < 2; ++h)
#pragma unroll
            for (int i = 0; i < 2; ++i) vo[h][i] = (unsigned)((R[i] + 128 * h) * K + C[i]) * 2u;
    }
};
struct BranchSched {
    const char* A0; const char* A1; const char* B0; const char* B1; int nM, nN, K, G, c, dup;
    __device__ __forceinline__ bool next(int i, Unit& u) const {
        int L = (i >> 1) * G + c; if (L >= nM * nN * dup) return false; if (L >= nM * nN) L -= nM * nN;
        int pm, pn; pg8::static_tile(L, nM, nN, pm, pn);
        const int br = i & 1;
        u.pm = pm; u.pn = pn; u.e = br; u.rt = 0; u.hm = 3; u.A = (br ? A1 : A0) + (size_t)pm * 256 * K * 2; u.B = (br ? B1 : B0) + (size_t)pn * 256 * K * 2; return true;
    }
    __device__ __forceinline__ void pf_issue(const Unit&, int&, float&) const {}
    __device__ __forceinline__ void pf_commit(int, int, float) const {}
    __device__ __forceinline__ void rowoffs(const Unit&, int, unsigned (&vo)[2][2], const int (&R)[2], const int (&C)[2]) const {
#pragma unroll
        for (int h = 0; h < 2; ++h)
#pragma unroll
            for (int i = 0; i < 2; ++i) vo[h][i] = (unsigned)((R[i] + 128 * h) * K + C[i]) * 2u;
    }
};
template <int MODE> struct MoeSched {
    const LAS int* tab; const int* list; const float* listw; const char* A; const char* Bt; LAS int* rowA; LAS float* rowW; int total, G, vcu, dup;
    static constexpr int MULT = MODE == 0 ? 4 : 8, KB = MODE == 0 ? 2048 : 512  , NCOLS = MODE == 0 ? 1024 : 2048;
    __device__ __forceinline__ bool next(int i, Unit& u) const {
        int L = i * G + vcu; if (L >= total * dup) return false; if (L >= total) L -= total;
        int e, j, nrt, cnte = T;
        if (L < 32 * MULT) { e = 64; j = L; nrt = 32; }
        else {
            const int Lr = L - 32 * MULT; const int lane = threadIdx.x & 63;
            const int pin = tab[lane];
            const unsigned long long bal = __ballot(pin <= Lr);
            e = __builtin_popcountll(bal); e = e > 63 ? 63 : e;
            const int pex = e > 0 ? tab[e - 1] : 0; const int cnt = tab[64 + e];
            j = Lr - pex; nrt = (cnt + 255) >> 8; nrt = nrt < 1 ? 1 : nrt; cnte = cnt;
        }
        e = __builtin_amdgcn_readfirstlane(e); j = __builtin_amdgcn_readfirstlane(j); nrt = __builtin_amdgcn_readfirstlane(nrt);
        u.e = e; u.rt = j % nrt; u.pn = j / nrt; u.pm = 0;
        u.hm = (__builtin_amdgcn_readfirstlane(cnte) - u.rt * 256 > 128) ? 3 : 1;
        u.A = A; u.B = Bt + ((size_t)e * NCOLS + (size_t)u.pn * 256) * KB; return true;
    }
    __device__ __forceinline__ void pf_issue(const Unit& u, int& pa, float& pw) const {
        const int tid = threadIdx.x; pa = -1; pw = 0.f;
        if (tid < 256) { const int idx = u.rt * 256 + tid;
            if (u.e == 64) { pa = NASSIGN + idx; pw = 1.f; }
            else if (idx < tab[64 + u.e]) { pa = list[u.e * T + idx]; if (MODE == 1) pw = listw[u.e * T + idx]; } }
    }
    __device__ __forceinline__ void pf_commit(int s, int pa, float pw) const { const int tid = threadIdx.x; if (tid < 256) { rowA[s * 256 + tid] = pa; rowW[s * 256 + tid] = pw; } }
    __device__ __forceinline__ void rowoffs(const Unit& u, int s, unsigned (&vo)[2][2], const int (&R)[2], const int (&C)[2]) const {
#pragma unroll
        for (int h = 0; h < 2; ++h)
#pragma unroll
            for (int i = 0; i < 2; ++i) {
                int a = rowA[s * 256 + R[i] + 128 * h];
                unsigned row;
                if (MODE == 0) { a = a < 0 ? 0 : a; row = a < NASSIGN ? (unsigned)(a >> 3) : (unsigned)(a - NASSIGN); }
                else row = a < 0 ? 0u : (unsigned)a;
                vo[h][i] = row * (unsigned)KB + (unsigned)C[i] * 2u;
            }
    }
};

struct EpiZ {
    bf16_t* Z; float* FL; const float* fbias;
    __device__ __forceinline__ void operator()(const f32x4 (&acc)[2][2][4][2], const Unit& u, int slot, int wr, int wc, int fr, int fq) const {
        const int row0 = u.pm * 256 + wr * 64 + fr;
        if (u.pn == 34) {
            if (wc == 0 && fq < 2) {
                float fb[8];
#pragma unroll
                for (int j = 0; j < 8; ++j) fb[j] = fbias[8 * fq + j];
#pragma unroll
                for (int ai = 0; ai < 2; ++ai) if (u.hm & (1 << ai))
#pragma unroll
                    for (int m = 0; m < 4; ++m) {
                        float* o = FL + (size_t)(row0 + ai * 128 + m * 16) * 16 + 8 * fq;
#pragma unroll
                        for (int n = 0; n < 2; ++n) { f32x4 r;
#pragma unroll
                            for (int j = 0; j < 4; ++j) { const float x = acc[ai][0][m][n][j] + fb[4 * n + j]; const float ls = x >= 0.f ? -log1pf(expf(-x)) : x - log1pf(expf(x)); r[j] = ls * LOG2E; }
                            *(f32x4*)(o + 4 * n) = r; }
                    }
            }
            return;
        }
        const int mode = (u.pn < 4 || (u.pn >= 6 && u.pn < 10)) ? 1 : (u.pn >= 18 ? 2 : 0);
        const int col0 = u.pn * 256 + wc * 32 + 8 * fq;
#pragma unroll
        for (int ai = 0; ai < 2; ++ai) if (u.hm & (1 << ai))
#pragma unroll
            for (int m = 0; m < 4; ++m) { bf16_t* rowp = Z + (size_t)(row0 + ai * 128 + m * 16) * ZP + col0;
#pragma unroll
                for (int bj = 0; bj < 2; ++bj) { f32x4 v0 = acc[ai][bj][m][0], v1 = acc[ai][bj][m][1];
                    if (mode == 1) { v0 = v0 * QSCALE; v1 = v1 * QSCALE; }
                    else if (mode == 2) {
#pragma unroll
                        for (int j = 0; j < 4; ++j) { v0[j] = sigmoidf_(v0[j]); v1[j] = sigmoidf_(v1[j]); } }
                    u32x4 w; w.x = cvtpk(v0[0], v0[1]); w.y = cvtpk(v0[2], v0[3]); w.z = cvtpk(v1[0], v1[1]); w.w = cvtpk(v1[2], v1[3]);
                    *(u32x4*)(rowp + bj * 128) = w; } }
    }
};
struct EpiMix {
    const bf16_t* Z; bf16_t* MIX;
    __device__ __forceinline__ void operator()(const f32x4 (&acc)[2][2][4][2], const Unit& u, int slot, int wr, int wc, int fr, int fq) const {
        const int row0 = u.pm * 256 + wr * 64 + fr, col0 = u.pn * 256 + wc * 32 + 8 * fq;
        const int gcol = (u.e ? ZGF : ZGS) + col0;
#pragma unroll
        for (int ai = 0; ai < 2; ++ai) if (u.hm & (1 << ai))
#pragma unroll
            for (int m = 0; m < 4; ++m) { const size_t row = (size_t)(row0 + ai * 128 + m * 16);
#pragma unroll
                for (int bj = 0; bj < 2; ++bj) {
                    const u32x4 g = *(const u32x4*)(Z + row * ZP + gcol + bj * 128);
                    f32x4 v0 = acc[ai][bj][m][0], v1 = acc[ai][bj][m][1];
                    v0[0] *= bflo(g.x); v0[1] *= bfhi(g.x); v0[2] *= bflo(g.y); v0[3] *= bfhi(g.y);
                    v1[0] *= bflo(g.z); v1[1] *= bfhi(g.z); v1[2] *= bflo(g.w); v1[3] *= bfhi(g.w);
                    u32x4* mp = (u32x4*)(MIX + row * D + col0 + bj * 128);
                    if (u.e != 0) { const u32x4 t = *mp;
                        v0[0] += bflo(t.x); v0[1] += bfhi(t.x); v0[2] += bflo(t.y); v0[3] += bfhi(t.y);
                        v1[0] += bflo(t.z); v1[1] += bfhi(t.z); v1[2] += bflo(t.w); v1[3] += bfhi(t.w); }
                    u32x4 w; w.x = cvtpk(v0[0], v0[1]); w.y = cvtpk(v0[2], v0[3]); w.z = cvtpk(v1[0], v1[1]); w.w = cvtpk(v1[2], v1[3]);
                    *mp = w; } }
    }
};
struct EpiOut {
    const float* X; float* H1; float* PSQ;
    __device__ __forceinline__ void operator()(const f32x4 (&acc)[2][2][4][2], const Unit& u, int slot, int wr, int wc, int fr, int fq) const {
        const int row0 = u.pm * 256 + wr * 64 + fr, col0 = u.pn * 256 + wc * 32 + 8 * fq;
#pragma unroll
        for (int ai = 0; ai < 2; ++ai) if (u.hm & (1 << ai))
#pragma unroll
            for (int m = 0; m < 4; ++m) { const size_t row = (size_t)(row0 + ai * 128 + m * 16); float sq = 0.f;
#pragma unroll
                for (int bj = 0; bj < 2; ++bj) {
                    const float* xp = X + row * D + col0 + bj * 128; float* hp = H1 + row * D + col0 + bj * 128;
                    const f32x4 x0 = *(const f32x4*)xp, x1 = *(const f32x4*)(xp + 4);
                    const f32x4 h0 = acc[ai][bj][m][0] + x0, h1 = acc[ai][bj][m][1] + x1;
                    *(f32x4*)hp = h0; *(f32x4*)(hp + 4) = h1;
                    sq += (h0[0] * h0[0] + h0[1] * h0[1]) + (h0[2] * h0[2] + h0[3] * h0[3]) + (h1[0] * h1[0] + h1[1] * h1[1]) + (h1[2] * h1[2] + h1[3] * h1[3]); }
                sq += __shfl_xor(sq, 16); sq += __shfl_xor(sq, 32);
                if (fq == 0) PSQ[row * 32 + u.pn * 4 + wc] = sq; }
    }
};
__device__ __forceinline__ unsigned pk_fp8x4(float a, float b, float c, float d) {
    a = __builtin_amdgcn_fmed3f(a, -448.f, 448.f); b = __builtin_amdgcn_fmed3f(b, -448.f, 448.f); c = __builtin_amdgcn_fmed3f(c, -448.f, 448.f); d = __builtin_amdgcn_fmed3f(d, -448.f, 448.f);
    int r = __builtin_amdgcn_cvt_pk_fp8_f32(a, b, 0, false); r = __builtin_amdgcn_cvt_pk_fp8_f32(c, d, r, true); return (unsigned)r;
}
constexpr float WGU_SCALE = 32.f, WD_SCALE = 16.f;
struct EpiSwiglu {
    const MoeSched<0>* S; unsigned char* HB8;
    __device__ __forceinline__ void operator()(const f32x4 (&acc)[2][2][4][2], const Unit& u, int slot, int wr, int wc, int fr, int fq) const {
        const int ff0 = u.pn * 128 + wc * 32 + 8 * fq;
#pragma unroll
        for (int ai = 0; ai < 2; ++ai) if (u.hm & (1 << ai))
#pragma unroll
            for (int m = 0; m < 4; ++m) { const int a = S->rowA[slot * 256 + ai * 128 + wr * 64 + m * 16 + fr];
                if (a >= 0) { float h[8];
#pragma unroll
                    for (int n = 0; n < 2; ++n)
#pragma unroll
                        for (int j = 0; j < 4; ++j) { const float g = acc[ai][0][m][n][j] * (1.f / WGU_SCALE), up = acc[ai][1][m][n][j] * (1.f / WGU_SCALE); h[4 * n + j] = g * sigmoidf_(g) * up; }
                    u32x2 w; w.x = pk_fp8x4(h[0], h[1], h[2], h[3]); w.y = pk_fp8x4(h[4], h[5], h[6], h[7]);
                    *(u32x2*)(HB8 + (size_t)a * FF + ff0) = w; } }
    }
};
constexpr float YB_SCALE = 16.f;
struct EpiDown {
    const MoeSched<1>* S; unsigned char* YB8;
    __device__ __forceinline__ void operator()(const f32x4 (&acc)[2][2][4][2], const Unit& u, int slot, int wr, int wc, int fr, int fq) const {
        const int col0 = u.pn * 256 + wc * 32 + 8 * fq;
#pragma unroll
        for (int ai = 0; ai < 2; ++ai) if (u.hm & (1 << ai))
#pragma unroll
            for (int m = 0; m < 4; ++m) { const int ri = slot * 256 + ai * 128 + wr * 64 + m * 16 + fr; const int a = S->rowA[ri];
                if (a >= 0) { const float w8 = S->rowW[ri] * (YB_SCALE / WD_SCALE);
#pragma unroll
                    for (int bj = 0; bj < 2; ++bj) { const f32x4 v0 = acc[ai][bj][m][0] * w8, v1 = acc[ai][bj][m][1] * w8;
                        u32x2 w; w.x = pk_fp8x4(v0[0], v0[1], v0[2], v0[3]); w.y = pk_fp8x4(v1[0], v1[1], v1[2], v1[3]);
                        *(u32x2*)(YB8 + (size_t)a * D + col0 + bj * 128) = w; } } }
    }
};

struct P0Item { const float* src; unsigned char* dst; int ldw, nvalid, K, fp8; float scale; };
__device__ __forceinline__ void p0_map(int r, int NB, int& kp, int& nb) { kp = r / NB; nb = r % NB; }
__device__ __forceinline__ P0Item p0_decode(int pr, int half, const Args& a, unsigned char* ws) {
    constexpr int P_IN = 16 * 140, P_SW = 8 * 32, P_OUT = 16 * 32, P_GU = 16 * 8, P_DN = 4 * 32, P_EXP = 2 * P_GU + P_DN;
    P0Item q; q.fp8 = 0; q.scale = 1.f; int r = pr;
    if (r < P_IN) { int kp, nb; p0_map(r, 140, kp, nb); const int kb = 2 * kp + half, n0 = nb * 64;
        int c0, nv; if (n0 < 4608) { c0 = n0; nv = 64; } else if (n0 < 8704) { c0 = n0 + 16; nv = 64; } else if (n0 == 8704) { c0 = 4608; nv = 16; } else { c0 = 0; nv = 0; }
        q.src = a.in[2] + (size_t)kb * 64 * 8720 + c0; q.ldw = 8720; q.nvalid = nv; q.K = D; q.dst = ws + WS_WINT + ((size_t)n0 * D + kb * 64) * 2; return q; }
    r -= P_IN;
    if (r < P_SW) { int kp, nb; p0_map(r, 32, kp, nb); const int kb = 2 * kp + half; q.src = a.in[5] + (size_t)kb * 64 * D + nb * 64; q.ldw = D; q.nvalid = 64; q.K = 1024; q.dst = ws + WS_WSWAT + ((size_t)nb * 64 * 1024 + kb * 64) * 2; return q; }
    r -= P_SW;
    if (r < P_SW) { int kp, nb; p0_map(r, 32, kp, nb); const int kb = 2 * kp + half; q.src = a.in[6] + (size_t)kb * 64 * D + nb * 64; q.ldw = D; q.nvalid = 64; q.K = 1024; q.dst = ws + WS_WFOXT + ((size_t)nb * 64 * 1024 + kb * 64) * 2; return q; }
    r -= P_SW;
    if (r < P_OUT) { int kp, nb; p0_map(r, 32, kp, nb); const int kb = 2 * kp + half; q.src = a.in[7] + (size_t)kb * 64 * D + nb * 64; q.ldw = D; q.nvalid = 64; q.K = D; q.dst = ws + WS_WOUTT + ((size_t)nb * 64 * D + kb * 64) * 2; return q; }
    r -= P_OUT;
    const int e = r / P_EXP; r -= e * P_EXP; q.fp8 = 1;
    if (r < 2 * P_GU) { const int up = r >= P_GU; r -= up * P_GU; int kp, nb; p0_map(r, 8, kp, nb); const int kb = 2 * kp + half, n0 = nb * 64;
        const float* src = e < 64 ? (up ? a.in[12] : a.in[11]) + (size_t)e * D * FF : (up ? a.in[15] : a.in[14]);
        const int drow = 256 * (n0 >> 7) + (n0 & 127) + 128 * up;
        q.src = src + (size_t)kb * 64 * FF + n0; q.ldw = FF; q.nvalid = 64; q.K = D; q.scale = WGU_SCALE; q.dst = ws + WS_WGU + ((size_t)e * 1024 + drow) * D + kb * 64; return q; }
    r -= 2 * P_GU;
    { int kp, nb; p0_map(r, 32, kp, nb); const int kb = 2 * kp + half;
        const float* src = e < 64 ? a.in[13] + (size_t)e * FF * D : a.in[16];
        q.src = src + (size_t)kb * 64 * D + nb * 64; q.ldw = D; q.nvalid = 64; q.K = FF; q.scale = WD_SCALE; q.dst = ws + WS_WD + ((size_t)e * D + nb * 64) * FF + kb * 64; return q; }
}
__device__ __forceinline__ void p0_load(const P0Item& q, f32x4 (&v)[16], int lane) {
    const int kr = lane >> 4, nc = (lane & 15) * 4; const bool ok = nc < q.nvalid;
    const float* p = q.src + (size_t)kr * q.ldw + nc;
#pragma unroll
    for (int i = 0; i < 16; ++i) v[i] = ok ? *(const f32x4*)(p + (size_t)(4 * i) * q.ldw) : (f32x4){0.f, 0.f, 0.f, 0.f};
}
__device__ __forceinline__ void p0_process(const P0Item& q, const f32x4 (&v)[16], LAS float* scr, int lane) {
    const int kr = lane >> 4, nc = (lane & 15) * 4;
#pragma unroll
    for (int i = 0; i < 16; ++i) { LAS float* w = scr + (4 * i + kr) * 65 + nc; w[0] = v[i][0]; w[1] = v[i][1]; w[2] = v[i][2]; w[3] = v[i][3]; }
    LDS_WAIT(); asm volatile("" ::: "memory");
    const int c = lane & 7;
#pragma unroll
    for (int j = 0; j < 8; ++j) { const int n = (lane >> 3) + 8 * j; const LAS float* s = scr + (8 * c) * 65 + n;
        u32x4 o; o.x = cvtpk(s[0 * 65], s[1 * 65]); o.y = cvtpk(s[2 * 65], s[3 * 65]); o.z = cvtpk(s[4 * 65], s[5 * 65]); o.w = cvtpk(s[6 * 65], s[7 * 65]);
        *(u32x4*)(q.dst + ((size_t)n * q.K + 8 * c) * 2) = o; }
    LDS_WAIT(); asm volatile("" ::: "memory");
}
__device__ __forceinline__ void p0_load8(const P0Item& q, f32x4 (&v)[16], int lane) {
    const int kq = lane >> 4, nc = (lane & 15) * 4;
    const float* p = q.src + (size_t)(16 * kq) * q.ldw + nc;
#pragma unroll
    for (int i = 0; i < 16; ++i) v[i] = __builtin_nontemporal_load((const f32x4*)(p + (size_t)i * q.ldw));
}
__device__ __forceinline__ void p0_pack8(const f32x4 (&v)[16], float sc, LAS unsigned char* tile, int chunk, int m) {
#pragma unroll
    for (int j = 0; j < 4; ++j) { const int n = 4 * m + j; u32x4 o;
        o.x = pk_fp8x4(v[0][j] * sc, v[1][j] * sc, v[2][j] * sc, v[3][j] * sc); o.y = pk_fp8x4(v[4][j] * sc, v[5][j] * sc, v[6][j] * sc, v[7][j] * sc);
        o.z = pk_fp8x4(v[8][j] * sc, v[9][j] * sc, v[10][j] * sc, v[11][j] * sc); o.w = pk_fp8x4(v[12][j] * sc, v[13][j] * sc, v[14][j] * sc, v[15][j] * sc);
        *(LAS u32x4*)(tile + n * 128 + ((chunk ^ ((n >> 2) & 7)) * 16)) = o; }
}
__device__ __forceinline__ void p0_prologue(Frame& F, const Args& a) {
    LAS float* scr = (LAS float*)(F.lds + F.wave * 16640);
    const int gw = F.vcu * NWAVES + F.wave, NGW = F.G * NWAVES;
    unsigned char* ws = F.ws;
    {
        const float* g = a.in[1];
        for (int m = gw; m < T; m += NGW) {
            const f32x4* xr = (const f32x4*)(a.in[0] + (size_t)m * D) + F.lane;
            f32x4 v[8]; float s = 0.f;
#pragma unroll
            for (int j = 0; j < 8; ++j) { v[j] = xr[64 * j]; s += (v[j].x * v[j].x + v[j].y * v[j].y) + (v[j].z * v[j].z + v[j].w * v[j].w); }
            const float rinv = rsqrtf(wave_sum(s) * (1.f / D) + RMS_EPS);
            u32x2* o = (u32x2*)((bf16_t*)(ws + WS_U) + (size_t)m * D) + F.lane;
#pragma unroll
            for (int j = 0; j < 8; ++j) { const f32x4 gg = *((const f32x4*)g + F.lane + 64 * j); u32x2 w; w.x = cvtpk(v[j].x * rinv * gg.x, v[j].y * rinv * gg.y); w.y = cvtpk(v[j].z * rinv * gg.z, v[j].w * rinv * gg.w); o[64 * j] = w; }
        }
    }
    {
        const float* wr = a.in[9]; const float* g = a.in[8]; float* o = (float*)(ws + WS_WRG);
        for (int i = gw * 64 + F.lane; i < D * NE; i += NGW * 64) o[i] = wr[i] * g[i >> 6];
    }
    constexpr int NB16 = 16 * 140 + 2 * 8 * 32 + 16 * 32, NPAIRS = NB16 + 65 * (2 * 16 * 8 + 4 * 32);
    constexpr int REP = (PROBE_DUP == 0 || PROBE_DUP == 11) ? 2 : (PROBE_DUP == 10 ? 3 : 1);
    f32x4 va[16], vb[16]; P0Item qa, qb;
    {
        const int nj = (NB16 + NGW - 1) / NGW;
        int pr = gw;
        if (pr < NB16) { qa = p0_decode(pr, 0, a, ws); p0_load(qa, va, F.lane); }
        for (int j = 0; j < nj; ++j) {
            const bool act = pr < NB16;
            if (act) { qb = p0_decode(pr, 1, a, ws); p0_load(qb, vb, F.lane); }
            if (act) p0_process(qa, va, scr, F.lane);
            __builtin_amdgcn_s_barrier();
            const int pn = pr + NGW;
            if (pn < NB16) { qa = p0_decode(pn, 0, a, ws); p0_load(qa, va, F.lane); }
            if (act) p0_process(qb, vb, scr, F.lane);
            __builtin_amdgcn_s_barrier();
            pr = pn;
        }
    }
    {
        constexpr int NF = (NPAIRS - NB16) * REP;
        const int nj = (NF + NGW - 1) / NGW;
        LAS unsigned char* tile = (LAS unsigned char*)scr;
        const int kq = F.lane >> 4, m = F.lane & 15;
        int pr = gw;
        if (pr < NF) { qa = p0_decode(NB16 + pr % (NPAIRS - NB16), 0, a, ws); p0_load8(qa, va, F.lane); }
        for (int j = 0; j < nj; ++j) {
            const bool act = pr < NF;
            if (act) { qb = p0_decode(NB16 + pr % (NPAIRS - NB16), 1, a, ws); p0_load8(qb, vb, F.lane); }
            if (act) p0_pack8(va, qa.scale, tile, kq, m);
            __builtin_amdgcn_s_barrier();
            const int pn = pr + NGW;
            const P0Item qc = qa;
            if (pn < NF) { qa = p0_decode(NB16 + pn % (NPAIRS - NB16), 0, a, ws); p0_load8(qa, va, F.lane); }
            if (act) {
                p0_pack8(vb, qb.scale, tile, 4 + kq, m);
                LDS_WAIT(); asm volatile("" ::: "memory");
                const bool st = !(PROBE_DUP == 11 && pr >= NPAIRS - NB16);
                const int c = F.lane & 7;
#pragma unroll
                for (int jj = 0; jj < 8; ++jj) { const int n = (F.lane >> 3) + 8 * jj;
                    const u32x4 o = *(const LAS u32x4*)(tile + n * 128 + ((c ^ ((n >> 2) & 7)) * 16));
                    if (st) *(u32x4*)(qc.dst + (size_t)n * qc.K + 16 * c) = o; else asm volatile("" :: "v"(o)); }
                LDS_WAIT(); asm volatile("" ::: "memory");
            }
            __builtin_amdgcn_s_barrier();
            pr = pn;
        }
    }
}

__device__ __forceinline__ int crow(int r, int hi) { return (r & 3) + 8 * (r >> 2) + 4 * hi; }
__device__ __forceinline__ s16x4 vtr(LAS const char* p) { typedef short v4i16_t __attribute__((ext_vector_type(4))); return __builtin_bit_cast(s16x4, __builtin_amdgcn_ds_read_tr16_b64_v4i16((LAS v4i16_t*)p)); }

__device__ __forceinline__ void attn_qk(f32x16 (&p)[2], const bf16x8 (&qf)[4], LAS const char* Kt, int r32, int hi) {
#pragma unroll
    for (int kb = 0; kb < 2; ++kb) { const int kv = 32 * kb + r32; const int sw = (kv >> 1) & 7; LAS const char* rowp = Kt + kv * 128;
        f32x16 c = {};
#pragma unroll
        for (int s = 0; s < 4; ++s) { const bf16x8 a = *(const LAS bf16x8*)(rowp + (((2 * s + hi) ^ sw) * 16)); c = __builtin_amdgcn_mfma_f32_32x32x16_bf16(a, qf[s], c, 0, 0, 0); }
        p[kb] = c; }
}
__device__ __forceinline__ void attn_softmax_pv(f32x16 (&p)[2], f32x16 (&o)[2], float& m, float& l, LAS const char* Vt, int lane) {
    float mx = p[0][0];
#pragma unroll
    for (int kb = 0; kb < 2; ++kb)
#pragma unroll
        for (int r = 0; r < 16; ++r) mx = fmaxf(mx, p[kb][r]);
    mx = fmaxf(mx, __shfl_xor(mx, 32));
    const float mn = fmaxf(m, mx);
    const float alpha = __builtin_amdgcn_exp2f(m - mn);
    float rs = 0.f;
#pragma unroll
    for (int kb = 0; kb < 2; ++kb)
#pragma unroll
        for (int r = 0; r < 16; ++r) { const float e = __builtin_amdgcn_exp2f(p[kb][r] - mn); p[kb][r] = e; rs += e; }
    rs += __shfl_xor(rs, 32);
    l = l * alpha + rs; m = mn;
#pragma unroll
    for (int db = 0; db < 2; ++db)
#pragma unroll
        for (int r = 0; r < 16; ++r) o[db][r] *= alpha;
    const int g = lane >> 4, i = lane & 15;
    LAS const char* vb = Vt + (4 * (g >> 1) + (i >> 2)) * 64 + (g & 1) * 32 + (i & 3) * 8;
#pragma unroll
    for (int kb = 0; kb < 2; ++kb)
#pragma unroll
        for (int ks = 0; ks < 2; ++ks) {
            u32x4 pw; pw.x = cvtpk(p[kb][8 * ks + 0], p[kb][8 * ks + 1]); pw.y = cvtpk(p[kb][8 * ks + 2], p[kb][8 * ks + 3]); pw.z = cvtpk(p[kb][8 * ks + 4], p[kb][8 * ks + 5]); pw.w = cvtpk(p[kb][8 * ks + 6], p[kb][8 * ks + 7]);
            const bf16x8 pb = __builtin_bit_cast(bf16x8, pw);
#pragma unroll
            for (int db = 0; db < 2; ++db) {
                const s16x4 lo = vtr(vb + db * 4096 + (32 * kb + 16 * ks) * 64), hi4 = vtr(vb + db * 4096 + (32 * kb + 16 * ks + 8) * 64);
                const bf16x8 va = (bf16x8){lo[0], lo[1], lo[2], lo[3], hi4[0], hi4[1], hi4[2], hi4[3]};
                o[db] = __builtin_amdgcn_mfma_f32_32x32x16_bf16(va, pb, o[db], 0, 0, 0); } }
}
__device__ __forceinline__ void attn_store_kv(LAS char* Kt, LAS char* Vt, const u32x4& kr, const u32x4& vr, int tid) {
    const int kv = tid >> 3, c = tid & 7;
    *(LAS u32x4*)(Kt + kv * 128 + ((c ^ ((kv >> 1) & 7)) * 16)) = kr;
    *(LAS u32x4*)(Vt + (c >> 2) * 4096 + kv * 64 + (c & 3) * 16) = vr;
}
__device__ __forceinline__ void attn_store_o(const f32x16 (&o)[2], float l, bf16_t* orow, int hi) {
    const float rl = 1.0f / l;
#pragma unroll
    for (int db = 0; db < 2; ++db)
#pragma unroll
        for (int rq = 0; rq < 4; ++rq) { u32x2 w; w.x = cvtpk(o[db][4 * rq] * rl, o[db][4 * rq + 1] * rl); w.y = cvtpk(o[db][4 * rq + 2] * rl, o[db][4 * rq + 3] * rl);
            *(u32x2*)(orow + 32 * db + 8 * rq + 4 * hi) = w; }
}

__device__ __forceinline__ void swa_unit(Frame& F, int unit, const float* sinks) {
    const bf16_t* Z = (const bf16_t*)(F.ws + WS_Z); bf16_t* YS = (bf16_t*)(F.ws + WS_YS);
    const int b = unit >> 6, kvh = (unit >> 4) & 3, nb = unit & 15;
    const int tid = F.tid, lane = F.lane, r32 = lane & 31, hi = lane >> 5, w = F.wave;
    LAS char* Kl = (LAS char*)F.lds; LAS char* Vl = (LAS char*)F.lds + 32768;
    const int t0 = nb * 128;
    {
        const int kv = tid >> 3, c = tid & 7;
#pragma unroll
        for (int tl = 0; tl < 4; ++tl) {
            if (nb > 0 || tl >= 2) {
                const size_t row = (size_t)(b * SEQ + t0 - 128 + tl * 64 + kv);
                const u32x4 kr = *(const u32x4*)(Z + row * ZP + ZK + kvh * 64 + c * 8);
                const u32x4 vr = *(const u32x4*)(Z + row * ZP + ZV + kvh * 64 + c * 8);
                attn_store_kv(Kl + tl * 8192, Vl + tl * 8192, kr, vr, tid);
            }
        }
    }
    __syncthreads();
    const int qh = kvh * 4 + (w >> 1);
    const float slope2 = exp2f(-0.5f * (float)(qh + 1)) * LOG2E;
    const float sink2 = sinks[qh] * LOG2E;
#pragma unroll 1
    for (int sb = 0; sb < 2; ++sb) {
        const int r0 = 64 * (w & 1) + 32 * sb;
        const int qrel = r0 + r32;
        const size_t qrow = (size_t)(b * SEQ + t0 + qrel);
        bf16x8 qf[4];
#pragma unroll
        for (int s = 0; s < 4; ++s) qf[s] = *(const bf16x8*)(Z + qrow * ZP + ZQ + qh * 64 + 16 * s + 8 * hi);
        f32x16 o[2]; o[0] = f32x16{}; o[1] = f32x16{};
        float m = sink2, l = 1.0f;
        const int tl0 = (r0 + 1) >> 6;
#pragma unroll 1
        for (int tt = 0; tt < 3; ++tt) {
            const int tl = tl0 + tt;
            if (nb == 0 && tl < 2) continue;
            f32x16 p[2];
            attn_qk(p, qf, Kl + tl * 8192, r32, hi);
#pragma unroll
            for (int kb = 0; kb < 2; ++kb)
#pragma unroll
                for (int r = 0; r < 16; ++r) {
                    const int krel = tl * 64 + 32 * kb + crow(r, hi) - 128;
                    const int dist = qrel - krel;
                    const float s = p[kb][r] - slope2 * (float)dist;
                    p[kb][r] = (dist >= 0 && dist < 128) ? s : -INFINITY;
                }
            attn_softmax_pv(p, o, m, l, Vl + tl * 8192, lane);
        }
        attn_store_o(o, l, YS + qrow * 1024 + qh * 64, hi);
    }
    __syncthreads();
}

__device__ __forceinline__ void fox_unit(Frame& F, int bh, int qb, LAS const float* c2) {
    const bf16_t* Z = (const bf16_t*)(F.ws + WS_Z); bf16_t* YF = (bf16_t*)(F.ws + WS_YF);
    const int b = bh >> 4, h = bh & 15;
    const int tid = F.tid, lane = F.lane, r32 = lane & 31, hi = lane >> 5, w = F.wave;
    LAS char* Kl = (LAS char*)F.lds; LAS char* Vl = (LAS char*)F.lds + 16384;
    const int q0 = qb * 256, qw = q0 + 32 * w, qabs = qw + r32;
    const size_t qrow = (size_t)(b * SEQ + qabs);
    const int NT = 4 * (qb + 1);
    const int kvr = tid >> 3, kc = tid & 7;
    const bf16_t* kbase = Z + (size_t)(b * SEQ + kvr) * ZP + ZFK + h * 64 + kc * 8;
    const bf16_t* vbase = Z + (size_t)(b * SEQ + kvr) * ZP + ZFV + h * 64 + kc * 8;
    u32x4 kr = *(const u32x4*)kbase, vr = *(const u32x4*)vbase;
    bf16x8 qf[4];
#pragma unroll
    for (int s = 0; s < 4; ++s) qf[s] = *(const bf16x8*)(Z + qrow * ZP + ZFQ + h * 64 + 16 * s + 8 * hi);
    attn_store_kv(Kl, Vl, kr, vr, tid);
    __syncthreads();
    f32x16 o[2]; o[0] = f32x16{}; o[1] = f32x16{};
    float m = -1e30f, l = 0.f;
#pragma unroll 1
    for (int t = 0; t < NT; ++t) {
        const int buf = t & 1;
        if (t + 1 < NT) { kr = *(const u32x4*)(kbase + (size_t)(t + 1) * 64 * ZP); vr = *(const u32x4*)(vbase + (size_t)(t + 1) * 64 * ZP); }
        const int k0 = t * 64;
        if (k0 <= qw + 31) {
            f32x16 p[2];
            attn_qk(p, qf, Kl + buf * 8192, r32, hi);
            const bool diag = (k0 + 63 > qw);
#pragma unroll
            for (int kb = 0; kb < 2; ++kb)
#pragma unroll
                for (int rq = 0; rq < 4; ++rq) {
                    const int kk = k0 + 32 * kb + 8 * rq + 4 * hi;
                    const f32x4 cc = *(const LAS f32x4*)(c2 + kk);
#pragma unroll
                    for (int j = 0; j < 4; ++j) { float s = p[kb][4 * rq + j] - cc[j]; if (diag && (kk + j > qabs)) s = -INFINITY; p[kb][4 * rq + j] = s; }
                }
            attn_softmax_pv(p, o, m, l, Vl + buf * 8192, lane);
        }
        if (t + 1 < NT) attn_store_kv(Kl + (buf ^ 1) * 8192, Vl + (buf ^ 1) * 8192, kr, vr, tid);
        __syncthreads();
    }
    attn_store_o(o, l, YF + qrow * 1024 + h * 64, hi);
}
__device__ __forceinline__ void p2_attention(Frame& F, const Args& a) {
    for (int u = F.vcu; u < 256; u += F.G) swa_unit(F, u, a.in[4]);
    LAS float* c2 = (LAS float*)(F.lds + 32768);
    LAS float* wtot = (LAS float*)(F.lds + 32768 + 8192);
    const float* FL = (const float*)(F.ws + WS_FL);
    for (int it = F.vcu; it < 256; it += F.G) {
        const int bh = it >> 2, s = it & 3, b = bh >> 4, h = bh & 15;
        {
            float v[4]; float run = 0.f;
#pragma unroll
            for (int j = 0; j < 4; ++j) { run += FL[(size_t)(b * SEQ + 4 * F.tid + j) * 16 + h]; v[j] = run; }
            float inc = run;
#pragma unroll
            for (int o = 1; o < 64; o <<= 1) { const float n = __shfl_up(inc, o); if (F.lane >= o) inc += n; }
            if (F.lane == 63) wtot[F.wave] = inc;
            __syncthreads();
            float base = inc - run;
            for (int ww = 0; ww < F.wave; ++ww) base += wtot[ww];
#pragma unroll
            for (int j = 0; j < 4; ++j) c2[4 * F.tid + j] = base + v[j];
            __syncthreads();
        }
        fox_unit(F, bh, s, c2);
        fox_unit(F, bh, 7 - s, c2);
        __syncthreads();
    }
}

__device__ __forceinline__ void p5_router(Frame& F, const Args& a, unsigned* CNT, float* LISTW, int* LIST) {
    const float* H1 = (const float*)(F.ws + WS_H1); const float* PSQ = (const float*)(F.ws + WS_PSQ); const float* WRG = (const float*)(F.ws + WS_WRG);
    unsigned char* V8 = F.ws + WS_V;
    const float* g = a.in[8]; const float* rbias = a.in[10];
    const int lane = F.lane, w = F.wave, tid = F.tid;
    LAS float* part = (LAS float*)F.lds;
    LAS float* logit = (LAS float*)(F.lds + 65536);
    LAS float* rinvs = (LAS float*)(F.lds + 65536 + 8192);
    LAS int* lcnt = (LAS int*)(F.lds + 65536 + 8192 + 128);
    LAS int* gbase = (LAS int*)(F.lds + 65536 + 8192 + 128 + 256);
    for (int tile = F.vcu; tile < T / 32; tile += F.G) {
        const int tok0 = tile * 32;
        if (tid < 64) lcnt[tid] = 0;
#pragma unroll 1
        for (int j = 0; j < 4; ++j) {
            const int tok = tok0 + 4 * w + j;
            float sq = lane < 32 ? PSQ[(size_t)tok * 32 + lane] : 0.f;
            sq = wave_sum(sq);
            const float rinv = rsqrtf(sq * (1.f / D) + RMS_EPS);
            if (lane == 0) rinvs[4 * w + j] = rinv;
            const f32x4* hr = (const f32x4*)(H1 + (size_t)tok * D) + lane;
            unsigned* o = (unsigned*)(V8 + (size_t)tok * D) + lane;
#pragma unroll
            for (int jj = 0; jj < 8; ++jj) { const f32x4 hv = hr[64 * jj]; const f32x4 gg = *((const f32x4*)g + lane + 64 * jj);
                o[64 * jj] = pk_fp8x4(hv.x * rinv * gg.x, hv.y * rinv * gg.y, hv.z * rinv * gg.z, hv.w * rinv * gg.w); }
        }
        {
            f32x16 acc0 = {}, acc1 = {};
            const int tk = lane & 31, half = lane >> 5;
            const float* hp = H1 + (size_t)(tok0 + tk) * D + 256 * w + 4 * half;
            const float* wp = WRG + (size_t)(256 * w + 4 * half) * NE + tk;
#pragma unroll 4
            for (int kk = 0; kk < 32; ++kk) {
                const f32x4 av = *(const f32x4*)(hp + 8 * kk);
#pragma unroll
                for (int s = 0; s < 4; ++s) {
                    const float b0 = wp[(size_t)(8 * kk + s) * NE], b1 = wp[(size_t)(8 * kk + s) * NE + 32];
                    acc0 = __builtin_amdgcn_mfma_f32_32x32x2f32(av[s], b0, acc0, 0, 0, 0);
                    acc1 = __builtin_amdgcn_mfma_f32_32x32x2f32(av[s], b1, acc1, 0, 0, 0);
                }
            }
#pragma unroll
            for (int r = 0; r < 16; ++r) { const int tr = crow(r, half); part[(w * 32 + tr) * 64 + tk] = acc0[r]; part[(w * 32 + tr) * 64 + 32 + tk] = acc1[r]; }
        }
        __syncthreads();
#pragma unroll
        for (int q = 0; q < 4; ++q) { const int idx = tid + 512 * q; float s = 0.f;
#pragma unroll
            for (int ww = 0; ww < 8; ++ww) s += part[ww * 2048 + idx];
            logit[idx] = s * rinvs[idx >> 6]; }
        __syncthreads();
        int sel_k[4], sel_ls[4]; float sel_w[4];
        const float bias = rbias[lane];
#pragma unroll
        for (int j = 0; j < 4; ++j) {
            const int tl = 4 * w + j;
            const float score = sigmoidf_(logit[tl * 64 + lane]);
            const float biased = score + bias;
            float m1 = biased; m1 = fmaxf(m1, __shfl_xor(m1, 1)); m1 = fmaxf(m1, __shfl_xor(m1, 2)); m1 = fmaxf(m1, __shfl_xor(m1, 4));
            const unsigned long long gm = 0xFFull << (lane & 56);
            const unsigned long long b1 = __ballot(biased == m1) & gm;
            const int i1 = __builtin_ctzll(b1);
            float v2 = (lane == i1) ? -INFINITY : biased;
            float m2 = v2; m2 = fmaxf(m2, __shfl_xor(m2, 1)); m2 = fmaxf(m2, __shfl_xor(m2, 2)); m2 = fmaxf(m2, __shfl_xor(m2, 4));
            const float gs = m1 + m2; const int gi = lane >> 3;
            int rank = 0;
#pragma unroll
            for (int gg = 0; gg < 8; ++gg) { const float o = __shfl(gs, 8 * gg); rank += (o > gs || (o == gs && gg < gi)) ? 1 : 0; }
            float mv = rank < 4 ? biased : -INFINITY;
            int myk = -1;
#pragma unroll
            for (int it = 0; it < 8; ++it) { const float mx = wave_max(mv); const unsigned long long bb = __ballot(mv == mx); const int sl = __builtin_ctzll(bb); if (lane == sl) { myk = it; mv = -INFINITY; } }
            const float ssum = wave_sum(myk >= 0 ? score : 0.f);
            sel_k[j] = myk; sel_w[j] = score / ssum * 2.5f;
            sel_ls[j] = 0;
            if (myk >= 0) sel_ls[j] = __hip_atomic_fetch_add((LAS int*)&lcnt[lane], 1, __ATOMIC_RELAXED, __HIP_MEMORY_SCOPE_WORKGROUP);
        }
        __syncthreads();
        if (tid < 64) gbase[tid] = (int)atomicAdd(CNT + tid, (unsigned)lcnt[tid]);
        __syncthreads();
#pragma unroll
        for (int j = 0; j < 4; ++j) if (sel_k[j] >= 0) { const int tok = tok0 + 4 * w + j; const int aid = tok * 8 + sel_k[j];
            const size_t li = (size_t)lane * T + gbase[lane] + sel_ls[j]; LIST[li] = aid; LISTW[li] = sel_w[j]; }
        __syncthreads();
    }
}

template <int MULT> __device__ __forceinline__ int moe_table(Frame& F, LAS int* tab) {
    if (F.tid < 64) {
        const int cnt = (int)__hip_atomic_load(F.ctl + CW_CNT + F.tid, __ATOMIC_RELAXED, __HIP_MEMORY_SCOPE_AGENT);
        int inc = ((cnt + 255) >> 8) * MULT;
#pragma unroll
        for (int o = 1; o < 64; o <<= 1) { const int n = __shfl_up(inc, o); if (F.lane >= o) inc += n; }
        tab[F.tid] = inc; tab[64 + F.tid] = cnt;
    }
    __syncthreads();
    return 32 * MULT + tab[63];
}

__device__ __forceinline__ void p8_final(Frame& F, const Args& a) {
    const float* H1 = (const float*)(F.ws + WS_H1); const unsigned char* YB8 = F.ws + WS_YB; const float* g = a.in[17];
    const int gw = F.vcu * NWAVES + F.wave, NGW = F.G * NWAVES;
    for (int tok = gw; tok < T; tok += NGW) {
        const f32x4* hr = (const f32x4*)(H1 + (size_t)tok * D) + F.lane;
        f32x4 v[8], y[8];
#pragma unroll
        for (int j = 0; j < 8; ++j) { v[j] = hr[64 * j]; y[j] = (f32x4){0.f, 0.f, 0.f, 0.f}; }
#pragma unroll 3
        for (int k = 0; k < 9; ++k) {
            const size_t row = k < 8 ? (size_t)tok * 8 + k : (size_t)NASSIGN + tok;
            const unsigned* yr = (const unsigned*)(YB8 + row * D) + F.lane;
#pragma unroll
            for (int j = 0; j < 8; ++j) { const unsigned w = yr[64 * j]; const f32x2 lo = __builtin_amdgcn_cvt_pk_f32_fp8((int)w, false), hi = __builtin_amdgcn_cvt_pk_f32_fp8((int)w, true);
                y[j].x += lo.x; y[j].y += lo.y; y[j].z += hi.x; y[j].w += hi.y; }
        }
#pragma unroll
        for (int j = 0; j < 8; ++j) v[j] = v[j] + y[j] * (1.f / YB_SCALE);
        float s = 0.f;
#pragma unroll
        for (int j = 0; j < 8; ++j) s += (v[j].x * v[j].x + v[j].y * v[j].y) + (v[j].z * v[j].z + v[j].w * v[j].w);
        const float rinv = rsqrtf(wave_sum(s) * (1.f / D) + RMS_EPS);
        f32x4* o = (f32x4*)(a.out + (size_t)tok * D) + F.lane;
#pragma unroll
        for (int j = 0; j < 8; ++j) { const f32x4 gg = *((const f32x4*)g + F.lane + 64 * j); o[64 * j] = (f32x4){v[j].x * rinv * gg.x, v[j].y * rinv * gg.y, v[j].z * rinv * gg.z, v[j].w * rinv * gg.w}; }
    }
}

constexpr int N_PHASES = 9;
__global__ void __launch_bounds__(NTHREADS, 2) fwd_kernel(Args args) {
    extern __shared__ __attribute__((aligned(16))) unsigned char lds_raw[];
    Frame F;
    F.lds = (LAS unsigned char*)lds_raw;
    F.MISC = (volatile LAS unsigned*)(F.lds + MISC_OFF);
    F.tid = threadIdx.x; F.lane = F.tid & 63; F.wave = __builtin_amdgcn_readfirstlane(F.tid >> 6);
    F.G = gridDim.x; { const int bx = blockIdx.x; F.vcu = (F.G % 8 == 0) ? (bx % 8) * (F.G / 8) + bx / 8 : bx; }
    F.ws = args.ws; F.ctl = (unsigned*)(args.ws + WS_CTL);
    for (int u = F.tid; u < (LDS_BYTES - MISC_OFF) / 4; u += NTHREADS) ((LAS unsigned*)(F.lds + MISC_OFF))[u] = 0u;
    __syncthreads();
    const int lo = args.ph_lo, hi = args.ph_hi;
    XcdBarrier bar; bar.bar = F.ctl + CW_BAR; bar.x = 0; bar.st = nullptr;
    if (hi - lo > 1) bar = xcd_barrier_post(F.ctl + CW_BAR, F.MISC + 8);
#define IN(k) (lo <= (k) && (k) < hi)
#define SEAM(k) do { if (IN(k) && IN((k) + 1)) xcd_barrier(bar); } while (0)
    unsigned char* ws = args.ws;
    LAS int* tab = (LAS int*)(F.lds + MISC_OFF + 256);

#define REPS(k) for (int rep_ = 0; rep_ < (PROBE_DUP == (k) ? 2 : 1); ++rep_)
#define REPBAR(k) do { if (PROBE_DUP == (k) && rep_ == 0) xcd_barrier(bar); } while (0)
    if (IN(0)) { p0_prologue(F, args); SEAM(0); }
    if (IN(1)) {
        DenseSched S{(const char*)(ws + WS_U), (const char*)(ws + WS_WINT), T / 256, NIN / 256, D, F.G, (int)blockIdx.x, PROBE_DUP == 1 ? 2 : 1, (T / 256) * (NIN / 256) % 256};
        EpiZ E{(bf16_t*)(ws + WS_Z), (float*)(ws + WS_FL), args.in[3]};
        pg8::gemm_phase<false>(F.lds, 2 * D, S, E);
        SEAM(1);
    }
    if (IN(2)) { REPS(2) { p2_attention(F, args); REPBAR(2); } SEAM(2); }
    if (IN(3)) {
        BranchSched S{(const char*)(ws + WS_YS), (const char*)(ws + WS_YF), (const char*)(ws + WS_WSWAT), (const char*)(ws + WS_WFOXT), T / 256, D / 256, 1024, F.G, (int)blockIdx.x, PROBE_DUP == 3 ? 2 : 1};
        EpiMix E{(const bf16_t*)(ws + WS_Z), (bf16_t*)(ws + WS_MIX)};
        pg8::gemm_phase<false>(F.lds, 2 * 1024, S, E);
        SEAM(3);
    }
    if (IN(4)) {
        DenseSched S{(const char*)(ws + WS_MIX), (const char*)(ws + WS_WOUTT), T / 256, D / 256, D, F.G, (int)blockIdx.x, PROBE_DUP == 4 ? 2 : 1, 0};
        EpiOut E{args.in[0], (float*)(ws + WS_H1), (float*)(ws + WS_PSQ)};
        pg8::gemm_phase<false>(F.lds, 2 * D, S, E);
        SEAM(4);
    }
    if (IN(5)) {
        if (PROBE_DUP == 5) { p5_router(F, args, F.ctl + 256, (float*)(ws + WS_T1), (int*)(ws + WS_T1 + 2 * MiB)); xcd_barrier(bar); }
        p5_router(F, args, F.ctl + CW_CNT, (float*)(ws + WS_LISTW), (int*)(ws + WS_LIST));
        if (PROBE_DUP == 9) { for (int q = 0; q < 16; ++q) xcd_barrier(bar); }
        SEAM(5); }
    if (IN(6)) {
        const int total = moe_table<4>(F, tab);
        MoeSched<0> S{tab, (const int*)(ws + WS_LIST), (const float*)(ws + WS_LISTW), (const char*)(ws + WS_V), (const char*)(ws + WS_WGU), (LAS int*)(F.lds + MISC_OFF + 1024), (LAS float*)(F.lds + MISC_OFF + 4096), total, F.G, F.vcu, PROBE_DUP == 6 ? 2 : 1};
        EpiSwiglu E{&S, (unsigned char*)(ws + WS_HB)};
        pg8::gemm_phase<true>(F.lds, 2048, S, E);
        SEAM(6);
    }
    if (IN(7)) {
        const int total = moe_table<8>(F, tab);
        MoeSched<1> S{tab, (const int*)(ws + WS_LIST), (const float*)(ws + WS_LISTW), (const char*)(ws + WS_HB), (const char*)(ws + WS_WD), (LAS int*)(F.lds + MISC_OFF + 1024), (LAS float*)(F.lds + MISC_OFF + 4096), total, F.G, F.vcu, PROBE_DUP == 7 ? 2 : 1};
        EpiDown E{&S, (unsigned char*)(ws + WS_YB)};
        pg8::gemm_phase<true>(F.lds, 512, S, E);
        SEAM(7);
    }
    if (IN(8)) { REPS(8) { p8_final(F, args); REPBAR(8); } }
#undef IN
#undef SEAM
}

extern "C" void kernel_launch(void* const* d_in, const int* in_sizes, int n_in, void* d_out, int out_size, void* d_ws, size_t ws_size, hipStream_t stream) {
    static int grid = 0;
    if (grid == 0) {
        if (n_in != 18 || out_size != T * D || ws_size < WS_END) { fprintf(stderr, "kernel_launch: unexpected shapes (n_in %d out %d ws %zu)\n", n_in, out_size, ws_size); grid = -1; return; }
        int dev = 0, cus = 0, per_cu = 0;
        if (hipGetDevice(&dev) != hipSuccess || hipDeviceGetAttribute(&cus, hipDeviceAttributeMultiprocessorCount, dev) != hipSuccess) { grid = -1; return; }
        if (hipFuncSetAttribute((const void*)fwd_kernel, hipFuncAttributeMaxDynamicSharedMemorySize, LDS_BYTES) != hipSuccess) { fprintf(stderr, "kernel_launch: hipFuncSetAttribute failed\n"); grid = -1; return; }
        if (hipOccupancyMaxActiveBlocksPerMultiprocessor(&per_cu, (const void*)fwd_kernel, NTHREADS, LDS_BYTES) != hipSuccess || per_cu < 1) { fprintf(stderr, "kernel_launch: occupancy query says %d blocks per CU\n", per_cu); (void)hipGetLastError(); grid = -1; return; }
        grid = cus;
        if (grid % 8 != 0 || grid > 256) grid = (grid / 8) * 8 > 256 ? 256 : (grid / 8) * 8;
    }
    if (grid <= 0) return;
    (void)hipMemsetAsync((char*)d_ws + WS_CTL, 0, CTL_ZERO_BYTES, stream);
    Args a{};
    for (int i = 0; i < 18; ++i) a.in[i] = (const float*)d_in[i];
    a.out = (float*)d_out; a.ws = (unsigned char*)d_ws;
#if MK_N_LAUNCHES == 1
    a.ph_lo = 0; a.ph_hi = N_PHASES;
    hipLaunchKernelGGL(fwd_kernel, dim3(grid), dim3(NTHREADS), LDS_BYTES, stream, a);
#else
    for (int p = 0; p < N_PHASES; ++p) { a.ph_lo = p; a.ph_hi = p + 1; hipLaunchKernelGGL(fwd_kernel, dim3(grid), dim3(NTHREADS), LDS_BYTES, stream, a); }
#endif
}
```

```cpp
#include <hip/hip_runtime.h>
#include <cstdio>
#include <cstdint>

#ifndef MK_N_LAUNCHES
#define MK_N_LAUNCHES 1
#endif
#define PROBE_DUP -1

#define LAS __attribute__((address_space(3)))
#define GAS __attribute__((address_space(1)))
typedef unsigned short bf16_t;
typedef short bf16x8 __attribute__((ext_vector_type(8)));
typedef short s16x4 __attribute__((ext_vector_type(4)));
typedef float f32x2 __attribute__((ext_vector_type(2)));
typedef float f32x4 __attribute__((ext_vector_type(4)));
typedef float f32x16 __attribute__((ext_vector_type(16)));
typedef unsigned u32x2 __attribute__((ext_vector_type(2)));
typedef unsigned u32x4 __attribute__((ext_vector_type(4)));
typedef __bf16 bf16x2_t __attribute__((ext_vector_type(2)));

constexpr int T = 8192, D = 2048, SEQ = 2048, NBATCH = 4;
constexpr int NE = 64, FF = 512, TOPK = 8;
constexpr int ZP = 8704;
constexpr int ZQ = 0, ZK = 1024, ZV = 1280, ZFQ = 1536, ZFK = 2560, ZFV = 3584, ZGS = 4608, ZGF = 6656;
constexpr int NIN = 8960;
constexpr float RMS_EPS = 1e-6f;
constexpr float LOG2E = 1.4426950408889634f;
constexpr float QSCALE = 0.125f * LOG2E;
constexpr int NASSIGN = T * TOPK;
constexpr int NROWS_H = NASSIGN + T;

constexpr size_t MiB = 1u << 20;
constexpr size_t WS_CTL = 0, CTL_ZERO_BYTES = 64 * 1024;
constexpr size_t WS_FL = 1 * MiB;
constexpr size_t WS_WTS = 1 * MiB + 512 * 1024;
constexpr size_t WS_LIST = 2 * MiB;
constexpr size_t WS_WSWAT = 4 * MiB, WS_WFOXT = 8 * MiB, WS_WOUTT = 12 * MiB;
constexpr size_t WS_WINT = 20 * MiB;
constexpr size_t WS_WRG = 55 * MiB;
constexpr size_t WS_PSQ = 55 * MiB + 512 * 1024;
constexpr size_t WS_U = 56 * MiB;
constexpr size_t WS_Z = 88 * MiB;
constexpr size_t WS_YS = 224 * MiB, WS_YF = 240 * MiB;
constexpr size_t WS_T1 = 256 * MiB;
constexpr size_t WS_MIX = 320 * MiB;
constexpr size_t WS_H1 = 352 * MiB;
constexpr size_t WS_V = 416 * MiB;
constexpr size_t WS_HB = 448 * MiB;
constexpr size_t WS_WGU = 520 * MiB;
constexpr size_t WS_WD = 780 * MiB;
constexpr size_t WS_YB = 56 * MiB;
constexpr size_t WS_LISTW = 910 * MiB;
constexpr size_t WS_END = 912 * MiB;
static_assert(WS_YB + (size_t)NROWS_H * D * 2 <= WS_MIX + 32 * MiB, "YB overlay");
constexpr int CW_CNT = 64;
constexpr int CW_BAR = 4096;

constexpr int RING_BYTES = 131072;
constexpr int MISC_OFF = 139264;
constexpr int LDS_BYTES = 147456;
constexpr int NWAVES = 8, NTHREADS = 512;

__device__ __forceinline__ unsigned cvtpk(float lo, float hi) { f32x2 v = {lo, hi}; bf16x2_t b = __builtin_convertvector(v, bf16x2_t); return __builtin_bit_cast(unsigned, b); }
__device__ __forceinline__ float bf2f(bf16_t h) { return __builtin_bit_cast(float, (unsigned)h << 16); }
__device__ __forceinline__ float bflo(unsigned w) { return __builtin_bit_cast(float, w << 16); }
__device__ __forceinline__ float bfhi(unsigned w) { return __builtin_bit_cast(float, w & 0xffff0000u); }
__device__ __forceinline__ float wave_sum(float v) {
#pragma unroll
    for (int o = 1; o < 64; o <<= 1) v += __shfl_xor(v, o);
    return v;
}
__device__ __forceinline__ float wave_max(float v) {
#pragma unroll
    for (int o = 1; o < 64; o <<= 1) v = fmaxf(v, __shfl_xor(v, o));
    return v;
}
__device__ __forceinline__ float sigmoidf_(float x) { return 1.0f / (1.0f + __expf(-x)); }
#define LDS_WAIT() asm volatile("s_waitcnt lgkmcnt(0)" ::: "memory")
#define VM_WAIT() asm volatile("s_waitcnt vmcnt(0)" ::: "memory")

#define XB_TMO      128
#define XB_XCNT(j)  (256  + 64 * (j))
#define XB_XSUB(j)  (1280 + 64 * (j))
#define XB_XGEN(j)  (2304 + 64 * (j))
#define XB_TOP      3328
#define XB_TOPGEN   3392
#define XCD_BAR_WORDS 3456
#define XB_SPIN_CAP (1u << 20)
__device__ __forceinline__ unsigned xb_ld(unsigned* p)              { return __hip_atomic_load(p, __ATOMIC_RELAXED, __HIP_MEMORY_SCOPE_AGENT); }
__device__ __forceinline__ unsigned xb_add(unsigned* p, unsigned v) { return __hip_atomic_fetch_add(p, v, __ATOMIC_RELAXED, __HIP_MEMORY_SCOPE_AGENT); }
__device__ __forceinline__ unsigned xb_xcc_id() { return (unsigned)__builtin_amdgcn_s_getreg((3 << 11) | 20) & 0xFu; }
#define XB_SPIN(cond, bar) do { unsigned _sp = 0; while (cond) { __builtin_amdgcn_s_sleep(1); \
    if ((++_sp & 255u) == 0u) { if (xb_ld(&(bar)[XB_TMO])) break; if (_sp > XB_SPIN_CAP) { atomicAdd(&(bar)[XB_TMO], 1u); break; } } } } while (0)
struct XcdBarrier { unsigned* bar; unsigned x; volatile LAS unsigned* st; };
__device__ __forceinline__ XcdBarrier xcd_barrier_post(unsigned* bar, volatile LAS unsigned* st) {
    XcdBarrier b; b.bar = bar; b.x = xb_xcc_id(); b.st = st;
    if (threadIdx.x == 0) (void)xb_add(&bar[XB_XCNT(b.x)], 1u);
    return b;
}
__device__ __forceinline__ void xcd_barrier_complete(unsigned* bar, unsigned x, unsigned& nloc, unsigned& nx) {
    const unsigned G = gridDim.x * gridDim.y * gridDim.z;
    unsigned sum, cnt, mine, sp = 0u;
    for (;;) {
        sum = 0u; cnt = 0u; mine = 0u;
#pragma unroll
        for (unsigned j = 0; j < 16; ++j) { const unsigned c = xb_ld(&bar[XB_XCNT(j)]); sum += c; cnt += (c > 0u) ? 1u : 0u; mine = (j == x) ? c : mine; }
        if (sum == G) break;
        __builtin_amdgcn_s_sleep(1);
        if ((++sp & 255u) == 0u) { if (xb_ld(&bar[XB_TMO])) break; if (sp > XB_SPIN_CAP) { atomicAdd(&bar[XB_TMO], 1u); break; } }
    }
    nloc = mine > 0u ? mine : 1u; nx = cnt > 0u ? cnt : 1u;
}
__device__ __forceinline__ void xcd_barrier(const XcdBarrier& b) {
    asm volatile("s_waitcnt vmcnt(0)" ::: "memory");
    __syncthreads();
    if (threadIdx.x == 0) {
        unsigned* bar = b.bar;
        __builtin_amdgcn_s_waitcnt(0);
        unsigned nloc = b.st[0], nx = b.st[1];
        if (nloc == 0u) { xcd_barrier_complete(bar, b.x, nloc, nx); b.st[0] = nloc; b.st[1] = nx; }
        const unsigned old = xb_add(&bar[XB_XSUB(b.x)], 1u);
        const unsigned gen = old / nloc;
        if (old + 1u == (gen + 1u) * nloc) {
            __builtin_amdgcn_fence(__ATOMIC_RELEASE, "agent");
            asm volatile("s_waitcnt vmcnt(0)" ::: "memory");
            const unsigned og = xb_add(&bar[XB_TOP], 1u);
            const unsigned tg = og / nx;
            if (og + 1u == (tg + 1u) * nx) xb_add(&bar[XB_TOPGEN], 1u);
            else XB_SPIN(xb_ld(&bar[XB_TOPGEN]) == tg, bar);
            __builtin_amdgcn_fence(__ATOMIC_ACQUIRE, "agent");
            xb_add(&bar[XB_XGEN(b.x)], 1u);
            asm volatile("s_waitcnt vmcnt(0)" ::: "memory");
        } else {
            XB_SPIN(xb_ld(&bar[XB_XGEN(b.x)]) == gen, bar);
            __builtin_amdgcn_fence(__ATOMIC_ACQUIRE, "agent");
            asm volatile("s_waitcnt vmcnt(0)" ::: "memory");
        }
    }
    __syncthreads();
}

namespace pg8 {
constexpr int BM = 256, BK = 64, HALF = 128, HTB = HALF * BK * 2, STAGE_BYTES = 8 * HTB, NXCD = 8, WGM = 8;
__host__ __device__ __forceinline__ int lds_byte(int r, int c) { const int st = (r >> 4) * 2 + (c >> 5), rr = r & 15, cc = c & 31, ob = rr * 64 + cc * 2; return st * 1024 + (ob ^ (((ob >> 9) & 1) << 5)); }
__host__ __device__ __forceinline__ void stage_rc(int b, int& R, int& C) { const int st = b / 1024, sb = b % 1024, swz = sb ^ (((sb >> 9) & 1) << 5); R = (st >> 1) * 16 + swz / 64; C = (st & 1) * 32 + (swz % 64) / 2; }
__host__ __device__ __forceinline__ int perm32(int rho) { const int n = rho >> 4, i = rho & 15; return 8 * (i >> 2) + 4 * n + (i & 3); }

struct Unit { const char* A; const char* B; int pm, pn, e, rt, hm; };

__device__ __forceinline__ void static_tile(int L, int nM, int nN, int& pm, int& pn) {
    const int nwg = nM * nN; int wgid = L;
    { const int q = nwg / NXCD, r = nwg % NXCD, xcd = wgid % NXCD, off = wgid / NXCD; wgid = (xcd < r ? xcd * (q + 1) : r * (q + 1) + (xcd - r) * q) + off; }
    const int nig = WGM * nN, gid = wgid / nig, fm = gid * WGM, gsz = (nM - fm) < WGM ? (nM - fm) : WGM;
    pm = fm + ((wgid % nig) % gsz); pn = (wgid % nig) / gsz;
}

typedef int v4i_t __attribute__((ext_vector_type(4)));
typedef int v8i_t __attribute__((ext_vector_type(8)));
template <bool FP8, class Epi, class Sched>
__device__ __forceinline__ void gemm_phase(LAS unsigned char* lds, const int Kb, const Sched& S, const Epi& E, const int stagger_ticks = 0) {
    if (stagger_ticks > 0) { const unsigned long long t0_ = __builtin_amdgcn_s_memrealtime(); while (__builtin_amdgcn_s_memrealtime() - t0_ < (unsigned long long)stagger_ticks) __builtin_amdgcn_s_sleep(8); }
    const int tid = threadIdx.x, wid = __builtin_amdgcn_readfirstlane(tid >> 6), lane = tid & 63, wr = wid >> 2, wc = wid & 3, fr = lane & 15, fq = lane >> 4;
    const int nt = Kb / 128;
    int Ri[2], Ci[2]; unsigned voffB[2];
#pragma unroll
    for (int i = 0; i < 2; ++i) { int R, C; stage_rc(tid * 16 + i * 8192, R, C); Ri[i] = R; Ci[i] = C; const int Rb = (R & ~31) + perm32(R & 31); voffB[i] = (unsigned)(Rb * Kb + C * 2); }
    const size_t kstep = (size_t)(BK * 2);
    const size_t hstep = (size_t)HALF * Kb;
    const unsigned ldsw = (unsigned)wid * 1024u;
    const int aoff = lds_byte(wr * 64 + fr, fq * 8), boff = lds_byte(wc * 32 + fr, fq * 8);
#define PG8_SA(b, h) (((b) * 2 + (h)) * HTB)
#define PG8_SB(b, h) ((4 + (b) * 2 + (h)) * HTB)
#define PG8_STAGE(bufoff, gbase, voff) do { _Pragma("unroll") for (int _i = 0; _i < 2; ++_i) \
        __builtin_amdgcn_global_load_lds((const unsigned*)((const char*)(gbase) + (voff)[_i]), (LAS unsigned*)(lds + (bufoff) + ldsw + _i * 8192), 16, 0, 0); } while (0)
#define PG8_LDA(dst, b, h) do { if constexpr (FP8) { _Pragma("unroll") for (int m = 0; m < 4; ++m) { dst##8[m].lo = *(const LAS v4i_t*)(lds + PG8_SA(b, h) + aoff + m * 2048); dst##8[m].hi = *(const LAS v4i_t*)(lds + PG8_SA(b, h) + aoff + m * 2048 + 1024); } } \
        else { _Pragma("unroll") for (int m = 0; m < 4; ++m) _Pragma("unroll") for (int k = 0; k < 2; ++k) dst[m][k] = *(const LAS bf16x8*)(lds + PG8_SA(b, h) + aoff + m * 2048 + k * 1024); } } while (0)
#define PG8_LDB(dst, b, h) do { if constexpr (FP8) { _Pragma("unroll") for (int n = 0; n < 2; ++n) { dst##8[n].lo = *(const LAS v4i_t*)(lds + PG8_SB(b, h) + boff + n * 2048); dst##8[n].hi = *(const LAS v4i_t*)(lds + PG8_SB(b, h) + boff + n * 2048 + 1024); } } \
        else { _Pragma("unroll") for (int n = 0; n < 2; ++n) _Pragma("unroll") for (int k = 0; k < 2; ++k) dst[n][k] = *(const LAS bf16x8*)(lds + PG8_SB(b, h) + boff + n * 2048 + k * 1024); } } while (0)
#define PG8_MMA(ai, bj, At, Bt) do { __builtin_amdgcn_s_setprio(1); \
        if constexpr (FP8) { _Pragma("unroll") for (int m = 0; m < 4; ++m) _Pragma("unroll") for (int n = 0; n < 2; ++n) \
            asm volatile("v_mfma_scale_f32_16x16x128_f8f6f4 %0, %1, %2, %0, %3, %3 op_sel_hi:[0,0,0]" : "+v"(acc[ai][bj][m][n]) : "v"(Bt##8[n]), "v"(At##8[m]), "v"(sc8)); } \
        else { _Pragma("unroll") for (int m = 0; m < 4; ++m) _Pragma("unroll") for (int n = 0; n < 2; ++n) _Pragma("unroll") for (int k = 0; k < 2; ++k) \
            acc[ai][bj][m][n] = __builtin_amdgcn_mfma_f32_16x16x32_bf16(Bt[n][k], At[m][k], acc[ai][bj][m][n], 0, 0, 0); } \
        __builtin_amdgcn_s_setprio(0); } while (0)
#define PG8_WAIT_V(n) asm volatile("s_waitcnt vmcnt(" #n ")" ::: "memory")
#define PG8_WAIT_L(n) asm volatile("s_waitcnt lgkmcnt(" #n ")" ::: "memory")
#define PG8_BAR __builtin_amdgcn_s_barrier()
#define PG8_SCHED __builtin_amdgcn_sched_barrier(0)
    Unit cur, nxt; int ui = 0;
    if (!S.next(0, cur)) return;
    unsigned vc[2][2], vn[2][2];
    int pfa = -1; float pfw = 0.f;
    S.pf_issue(cur, pfa, pfw); S.pf_commit(0, pfa, pfw);
    asm volatile("s_waitcnt vmcnt(0) lgkmcnt(0)" ::: "memory"); PG8_BAR; asm volatile("" ::: "memory");
    S.rowoffs(cur, 0, vc, Ri, Ci);
    f32x4 acc[2][2][4][2];
#pragma unroll
    for (int a = 0; a < 2; ++a)
#pragma unroll
        for (int b = 0; b < 2; ++b)
#pragma unroll
            for (int m = 0; m < 4; ++m)
#pragma unroll
                for (int n = 0; n < 2; ++n) acc[a][b][m][n] = (f32x4){0.f, 0.f, 0.f, 0.f};
    const int sc8 = 0x7f7f7f7f;
    bf16x8 At[4][2], B0[2][2], B1[2][2]; v8i_t At8[4], B08[2], B18[2];
    const char* cA = cur.A; const char* cB = cur.B;
    PG8_STAGE(PG8_SB(0, 0), cB, voffB); PG8_STAGE(PG8_SB(0, 1), cB + hstep, voffB); PG8_STAGE(PG8_SA(0, 0), cA, vc[0]); PG8_STAGE(PG8_SA(0, 1), cA, vc[1]);
    if (wr == 1) PG8_BAR;
    PG8_WAIT_V(2); PG8_BAR;
    PG8_STAGE(PG8_SB(1, 0), cB + kstep, voffB); PG8_STAGE(PG8_SA(1, 0), cA + kstep, vc[0]); PG8_STAGE(PG8_SB(1, 1), cB + hstep + kstep, voffB);
    PG8_WAIT_V(6); PG8_BAR;
    for (;;) {
        const bool has_next = S.next(ui + 1, nxt);
        const int scur = ui % 3, snxt = (ui + 1) % 3;
        const bool h0 = (cur.hm & 1) != 0, h1 = (cur.hm & 2) != 0;
        const char* nA = has_next ? nxt.A : cA; const char* nB = has_next ? nxt.B : cB;
        if (has_next) S.pf_issue(nxt, pfa, pfw);
        constexpr int NH = Epi::MIDK ? 2 : 1;
        for (int kh = 0; kh < NH; ++kh) {
        if constexpr (Epi::MIDK) { if (kh == 1) E.mid(acc, cur, wr, wc, fr, fq); }
        const int tend = (kh + 1) * nt / NH;
        for (int t = kh * nt / NH; t < tend; t += 2) {
            const bool last = (t == nt - 2);
            if (t == (nt >= 8 ? nt - 4 : 0) && has_next) S.pf_commit(snxt, pfa, pfw);
            const char* a1 = cA + (size_t)(t + 1) * kstep;
            const char* a2 = last ? nA : cA + (size_t)(t + 2) * kstep; const char* b2 = last ? nB : cB + (size_t)(t + 2) * kstep;
            const char* a3 = a2 + kstep; const char* b3 = b2 + kstep;
            if (last) {
                if (has_next) S.rowoffs(nxt, snxt, vn, Ri, Ci);
                else { vn[0][0] = vc[0][0]; vn[0][1] = vc[0][1]; vn[1][0] = vc[1][0]; vn[1][1] = vc[1][1]; }
            }
            unsigned v2[2][2];
            v2[0][0] = last ? vn[0][0] : vc[0][0]; v2[0][1] = last ? vn[0][1] : vc[0][1]; v2[1][0] = last ? vn[1][0] : vc[1][0]; v2[1][1] = last ? vn[1][1] : vc[1][1];
            PG8_LDB(B0, 0, 0); PG8_LDB(B1, 0, 1); PG8_SCHED; PG8_LDA(At, 0, 0); PG8_STAGE(PG8_SA(1, 1), a1, vc[1]);
            PG8_WAIT_V(8); PG8_WAIT_L(0); PG8_BAR; if (h0) { PG8_MMA(0, 0, At, B0); PG8_MMA(0, 1, At, B1); } PG8_BAR; PG8_SCHED;
            PG8_LDA(At, 0, 1); PG8_STAGE(PG8_SB(0, 0), b2, voffB); PG8_STAGE(PG8_SB(0, 1), b2 + hstep, voffB); PG8_STAGE(PG8_SA(0, 0), a2, v2[0]);
            PG8_WAIT_V(8); PG8_WAIT_L(0); PG8_BAR; if (h1) { PG8_MMA(1, 0, At, B0); PG8_MMA(1, 1, At, B1); } PG8_BAR; PG8_SCHED;
            PG8_LDB(B0, 1, 0); PG8_LDB(B1, 1, 1); PG8_SCHED; PG8_LDA(At, 1, 0); PG8_STAGE(PG8_SA(0, 1), a2, v2[1]);
            PG8_WAIT_V(8); PG8_WAIT_L(0); PG8_BAR; if (h0) { PG8_MMA(0, 0, At, B0); PG8_MMA(0, 1, At, B1); } PG8_BAR; PG8_SCHED;
            PG8_LDA(At, 1, 1); PG8_STAGE(PG8_SB(1, 0), b3, voffB); PG8_STAGE(PG8_SB(1, 1), b3 + hstep, voffB); PG8_STAGE(PG8_SA(1, 0), a3, v2[0]);
            PG8_WAIT_V(8); PG8_WAIT_L(0); PG8_BAR; if (h1) { PG8_MMA(1, 0, At, B0); PG8_MMA(1, 1, At, B1); } PG8_BAR; PG8_SCHED;
        }
        }
        if (wr == 0) PG8_BAR;
        if constexpr (FP8) {
            asm volatile("s_nop 15\n\ts_nop 15" ::: "memory");
#pragma unroll
            for (int a = 0; a < 2; ++a)
#pragma unroll
                for (int b = 0; b < 2; ++b)
#pragma unroll
                    for (int m = 0; m < 4; ++m)
#pragma unroll
                        for (int n = 0; n < 2; ++n) asm volatile("" : "+v"(acc[a][b][m][n]));
        }
        E(acc, cur, scur, wr, wc, fr, fq);
        if (!has_next) break;
#pragma unroll
        for (int a = 0; a < 2; ++a)
#pragma unroll
            for (int b = 0; b < 2; ++b)
#pragma unroll
                for (int m = 0; m < 4; ++m)
#pragma unroll
                    for (int n = 0; n < 2; ++n) acc[a][b][m][n] = (f32x4){0.f, 0.f, 0.f, 0.f};
        cur = nxt; cA = nA; cB = nB; ++ui;
        vc[0][0] = vn[0][0]; vc[0][1] = vn[0][1]; vc[1][0] = vn[1][0]; vc[1][1] = vn[1][1];
        if (wr == 1) PG8_BAR;
    }
    PG8_WAIT_V(0);
    PG8_BAR;
#undef PG8_SA
#undef PG8_SB
#undef PG8_STAGE
#undef PG8_LDA
#undef PG8_LDB
#undef PG8_MMA
#undef PG8_WAIT_V
#undef PG8_WAIT_L
#undef PG8_BAR
#undef PG8_SCHED
}
}
using pg8::Unit;

struct Args { const float* in[18]; float* out; unsigned char* ws; int ph_lo, ph_hi; };
struct Frame {
    LAS unsigned char* lds; volatile LAS unsigned* MISC; unsigned* ctl; unsigned char* ws;
    int tid, lane, wave, vcu, G;
};

struct DenseSched {
    const char* A; const char* Bt; int nM, nN, K, G, c, dup, nsplit;
    __device__ __forceinline__ bool next(int i, Unit& u) const {
        int L = i * G + c; int hm_ = 3;
        if (nsplit > 0) {
            const int nfull = nM * nN - nsplit, tot = nfull + 2 * nsplit;
            if (L >= tot * dup) return false; if (L >= tot) L -= tot;
            if (L >= nfull) { hm_ = 1 << ((L - nfull) & 1); L = nfull + ((L - nfull) >> 1); }
        } else { if (L >= nM * nN * dup) return false; if (L >= nM * nN) L -= nM * nN; }
        int pm, pn; pg8::static_tile(L, nM, nN, pm, pn);
        u.pm = pm; u.pn = pn; u.e = 0; u.rt = 0; u.hm = hm_; u.A = A + (size_t)pm * 256 * K * 2; u.B = Bt + (size_t)pn * 256 * K * 2; return true;
    }
    __device__ __forceinline__ void pf_issue(const Unit&, int&, float&) const {}
    __device__ __forceinline__ void pf_commit(int, int, float) const {}
    __device__ __forceinline__ void rowoffs(const Unit&, int, unsigned (&vo)[2][2], const int (&R)[2], const int (&C)[2]) const {
#pragma unroll
        for (int h = 0; h < 2; ++h)
#pragma unroll
            for (int i = 0; i < 2; ++i) vo[h][i] = (unsigned)((R[i] + 128 * h) * K + C[i]) * 2u;
    }
};
struct BranchSched {
    const char* A0; const char* A1; const char* B0; const char* B1; int nM, nN, K, G, c, dup;
    __device__ __forceinline__ bool next(int i, Unit& u) const {
        int L = (i >> 1) * G + c; if (L >= nM * nN * dup) return false; if (L >= nM * nN) L -= nM * nN;
        int pm, pn; pg8::static_tile(L, nM, nN, pm, pn);
        const int br = i & 1;
        u.pm = pm; u.pn = pn; u.e = br; u.rt = 0; u.hm = 3; u.A = (br ? A1 : A0) + (size_t)pm * 256 * K * 2; u.B = (br ? B1 : B0) + (size_t)pn * 256 * K * 2; return true;
    }
    __device__ __forceinline__ void pf_issue(const Unit&, int&, float&) const {}
    __device__ __forceinline__ void pf_commit(int, int, float) const {}
    __device__ __forceinline__ void rowoffs(const Unit&, int, unsigned (&vo)[2][2], const int (&R)[2], const int (&C)[2]) const {
#pragma unroll
        for (int h = 0; h < 2; ++h)
#pragma unroll
            for (int i = 0; i < 2; ++i) vo[h][i] = (unsigned)((R[i] + 128 * h) * K + C[i]) * 2u;
    }
};
template <int MODE> struct MoeSched {
    const LAS int* tab; const int* list; const float* listw; const char* A; const char* Bt; LAS int* rowA; LAS float* rowW; int total, G, vcu, dup;
    static constexpr int MULT = MODE == 0 ? 4 : 8, KB = MODE == 0 ? 2048 : 512  , NCOLS = MODE == 0 ? 1024 : 2048;
    __device__ __forceinline__ bool next(int i, Unit& u) const {
        int L = i * G + vcu; if (L >= total * dup) return false; if (L >= total) L -= total;
        int e, j, nrt, cnte = T;
        if (L < 32 * MULT) { e = 64; j = L; nrt = 32; }
        else {
            const int Lr = L - 32 * MULT; const int lane = threadIdx.x & 63;
            const int pin = tab[lane];
            const unsigned long long bal = __ballot(pin <= Lr);
            e = __builtin_popcountll(bal); e = e > 63 ? 63 : e;
            const int pex = e > 0 ? tab[e - 1] : 0; const int cnt = tab[64 + e];
            j = Lr - pex; nrt = (cnt + 255) >> 8; nrt = nrt < 1 ? 1 : nrt; cnte = cnt;
        }
        e = __builtin_amdgcn_readfirstlane(e); j = __builtin_amdgcn_readfirstlane(j); nrt = __builtin_amdgcn_readfirstlane(nrt);
        u.e = e; u.rt = j % nrt; u.pn = j / nrt; u.pm = 0;
        u.hm = (__builtin_amdgcn_readfirstlane(cnte) - u.rt * 256 > 128) ? 3 : 1;
        u.A = A; u.B = Bt + ((size_t)e * NCOLS + (size_t)u.pn * 256) * KB; return true;
    }
    __device__ __forceinline__ void pf_issue(const Unit& u, int& pa, float& pw) const {
        const int tid = threadIdx.x; pa = -1; pw = 0.f;
        if (tid < 256) { const int idx = u.rt * 256 + tid;
            if (u.e == 64) { pa = NASSIGN + idx; pw = 1.f; }
            else if (idx < tab[64 + u.e]) { pa = list[u.e * T + idx]; if (MODE == 1) pw = listw[u.e * T + idx]; } }
    }
    __device__ __forceinline__ void pf_commit(int s, int pa, float pw) const { const int tid = threadIdx.x; if (tid < 256) { rowA[s * 256 + tid] = pa; rowW[s * 256 + tid] = pw; } }
    __device__ __forceinline__ void rowoffs(const Unit& u, int s, unsigned (&vo)[2][2], const int (&R)[2], const int (&C)[2]) const {
#pragma unroll
        for (int h = 0; h < 2; ++h)
#pragma unroll
            for (int i = 0; i < 2; ++i) {
                int a = rowA[s * 256 + R[i] + 128 * h];
                unsigned row;
                if (MODE == 0) { a = a < 0 ? 0 : a; row = a < NASSIGN ? (unsigned)(a >> 3) : (unsigned)(a - NASSIGN); }
                else row = a < 0 ? 0u : (unsigned)a;
                vo[h][i] = row * (unsigned)KB + (unsigned)C[i] * 2u;
            }
    }
};

struct EpiZ {
    static constexpr bool MIDK = false;
    bf16_t* Z; float* FL; const float* fbias;
    __device__ __forceinline__ void operator()(const f32x4 (&acc)[2][2][4][2], const Unit& u, int slot, int wr, int wc, int fr, int fq) const {
        const int row0 = u.pm * 256 + wr * 64 + fr;
        if (u.pn == 34) {
            if (wc == 0 && fq < 2) {
                float fb[8];
#pragma unroll
                for (int j = 0; j < 8; ++j) fb[j] = fbias[8 * fq + j];
#pragma unroll
                for (int ai = 0; ai < 2; ++ai) if (u.hm & (1 << ai))
#pragma unroll
                    for (int m = 0; m < 4; ++m) {
                        float* o = FL + (size_t)(row0 + ai * 128 + m * 16) * 16 + 8 * fq;
#pragma unroll
                        for (int n = 0; n < 2; ++n) { f32x4 r;
#pragma unroll
                            for (int j = 0; j < 4; ++j) { const float x = acc[ai][0][m][n][j] + fb[4 * n + j]; const float ls = x >= 0.f ? -log1pf(expf(-x)) : x - log1pf(expf(x)); r[j] = ls * LOG2E; }
                            *(f32x4*)(o + 4 * n) = r; }
                    }
            }
            return;
        }
        const int mode = (u.pn < 4 || (u.pn >= 6 && u.pn < 10)) ? 1 : (u.pn >= 18 ? 2 : 0);
        const int col0 = u.pn * 256 + wc * 32 + 8 * fq;
#pragma unroll
        for (int ai = 0; ai < 2; ++ai) if (u.hm & (1 << ai))
#pragma unroll
            for (int m = 0; m < 4; ++m) { bf16_t* rowp = Z + (size_t)(row0 + ai * 128 + m * 16) * ZP + col0;
#pragma unroll
                for (int bj = 0; bj < 2; ++bj) { f32x4 v0 = acc[ai][bj][m][0], v1 = acc[ai][bj][m][1];
                    if (mode == 1) { v0 = v0 * QSCALE; v1 = v1 * QSCALE; }
                    else if (mode == 2) {
#pragma unroll
                        for (int j = 0; j < 4; ++j) { v0[j] = sigmoidf_(v0[j]); v1[j] = sigmoidf_(v1[j]); } }
                    u32x4 w; w.x = cvtpk(v0[0], v0[1]); w.y = cvtpk(v0[2], v0[3]); w.z = cvtpk(v1[0], v1[1]); w.w = cvtpk(v1[2], v1[3]);
                    *(u32x4*)(rowp + bj * 128) = w; } }
    }
};
struct EpiMix {
    static constexpr bool MIDK = true;
    const bf16_t* Z; bf16_t* MIX;
    __device__ __forceinline__ void mid(f32x4 (&acc)[2][2][4][2], const Unit& u, int wr, int wc, int fr, int fq) const {
        int opq = 0; asm volatile("" : "+v"(opq));
        const int row0 = u.pm * 256 + wr * 64 + fr + opq, col0 = u.pn * 256 + wc * 32 + 8 * fq;
#pragma unroll
        for (int ai = 0; ai < 2; ++ai)
#pragma unroll
            for (int m = 0; m < 4; ++m) { const size_t row = (size_t)(row0 + ai * 128 + m * 16);
#pragma unroll
                for (int bj = 0; bj < 2; ++bj) {
                    const u32x4 gs = *(const u32x4*)(Z + row * ZP + ZGS + col0 + bj * 128), gf = *(const u32x4*)(Z + row * ZP + ZGF + col0 + bj * 128);
                    f32x4& v0 = acc[ai][bj][m][0]; f32x4& v1 = acc[ai][bj][m][1];
                    v0[0] *= bflo(gs.x) * __builtin_amdgcn_rcpf(bflo(gf.x)); v0[1] *= bfhi(gs.x) * __builtin_amdgcn_rcpf(bfhi(gf.x)); v0[2] *= bflo(gs.y) * __builtin_amdgcn_rcpf(bflo(gf.y)); v0[3] *= bfhi(gs.y) * __builtin_amdgcn_rcpf(bfhi(gf.y));
                    v1[0] *= bflo(gs.z) * __builtin_amdgcn_rcpf(bflo(gf.z)); v1[1] *= bfhi(gs.z) * __builtin_amdgcn_rcpf(bfhi(gf.z)); v1[2] *= bflo(gs.w) * __builtin_amdgcn_rcpf(bflo(gf.w)); v1[3] *= bfhi(gs.w) * __builtin_amdgcn_rcpf(bfhi(gf.w)); }
                asm volatile("" ::: "memory"); }
    }
    __device__ __forceinline__ void operator()(const f32x4 (&acc)[2][2][4][2], const Unit& u, int slot, int wr, int wc, int fr, int fq) const {
        const int row0 = u.pm * 256 + wr * 64 + fr, col0 = u.pn * 256 + wc * 32 + 8 * fq;
#pragma unroll
        for (int ai = 0; ai < 2; ++ai)
#pragma unroll
            for (int m = 0; m < 4; ++m) { const size_t row = (size_t)(row0 + ai * 128 + m * 16);
#pragma unroll
                for (int bj = 0; bj < 2; ++bj) {
                    const u32x4 g = *(const u32x4*)(Z + row * ZP + ZGF + col0 + bj * 128);
                    f32x4 v0 = acc[ai][bj][m][0], v1 = acc[ai][bj][m][1];
                    v0[0] *= bflo(g.x); v0[1] *= bfhi(g.x); v0[2] *= bflo(g.y); v0[3] *= bfhi(g.y);
                    v1[0] *= bflo(g.z); v1[1] *= bfhi(g.z); v1[2] *= bflo(g.w); v1[3] *= bfhi(g.w);
                    u32x4 w; w.x = cvtpk(v0[0], v0[1]); w.y = cvtpk(v0[2], v0[3]); w.z = cvtpk(v1[0], v1[1]); w.w = cvtpk(v1[2], v1[3]);
                    *(u32x4*)(MIX + row * D + col0 + bj * 128) = w; } }
    }
};
struct EpiOut {
    static constexpr bool MIDK = false;
    const float* X; float* H1; float* PSQ;
    __device__ __forceinline__ void operator()(const f32x4 (&acc)[2][2][4][2], const Unit& u, int slot, int wr, int wc, int fr, int fq) const {
        const int row0 = u.pm * 256 + wr * 64 + fr, col0 = u.pn * 256 + wc * 32 + 8 * fq;
#pragma unroll
        for (int ai = 0; ai < 2; ++ai) if (u.hm & (1 << ai))
#pragma unroll
            for (int m = 0; m < 4; ++m) { const size_t row = (size_t)(row0 + ai * 128 + m * 16); float sq = 0.f;
#pragma unroll
                for (int bj = 0; bj < 2; ++bj) {
                    const float* xp = X + row * D + col0 + bj * 128; float* hp = H1 + row * D + col0 + bj * 128;
                    const f32x4 x0 = *(const f32x4*)xp, x1 = *(const f32x4*)(xp + 4);
                    const f32x4 h0 = acc[ai][bj][m][0] + x0, h1 = acc[ai][bj][m][1] + x1;
                    *(f32x4*)hp = h0; *(f32x4*)(hp + 4) = h1;
                    sq += (h0[0] * h0[0] + h0[1] * h0[1]) + (h0[2] * h0[2] + h0[3] * h0[3]) + (h1[0] * h1[0] + h1[1] * h1[1]) + (h1[2] * h1[2] + h1[3] * h1[3]); }
                sq += __shfl_xor(sq, 16); sq += __shfl_xor(sq, 32);
                if (fq == 0) PSQ[row * 32 + u.pn * 4 + wc] = sq; }
    }
};
__device__ __forceinline__ unsigned pk_fp8x4(float a, float b, float c, float d) {
    a = __builtin_amdgcn_fmed3f(a, -448.f, 448.f); b = __builtin_amdgcn_fmed3f(b, -448.f, 448.f); c = __builtin_amdgcn_fmed3f(c, -448.f, 448.f); d = __builtin_amdgcn_fmed3f(d, -448.f, 448.f);
    int r = __builtin_amdgcn_cvt_pk_fp8_f32(a, b, 0, false); r = __builtin_amdgcn_cvt_pk_fp8_f32(c, d, r, true); return (unsigned)r;
}
constexpr float WGU_SCALE = 32.f, WD_SCALE = 16.f;
struct EpiSwiglu {
    static constexpr bool MIDK = false;
    const MoeSched<0>* S; unsigned char* HB8;
    __device__ __forceinline__ void operator()(const f32x4 (&acc)[2][2][4][2], const Unit& u, int slot, int wr, int wc, int fr, int fq) const {
        const int ff0 = u.pn * 128 + wc * 32 + 8 * fq;
#pragma unroll
        for (int ai = 0; ai < 2; ++ai) if (u.hm & (1 << ai))
#pragma unroll
            for (int m = 0; m < 4; ++m) { const int a = S->rowA[slot * 256 + ai * 128 + wr * 64 + m * 16 + fr];
                if (a >= 0) { float h[8];
#pragma unroll
                    for (int n = 0; n < 2; ++n)
#pragma unroll
                        for (int j = 0; j < 4; ++j) { const float g = acc[ai][0][m][n][j] * (1.f / WGU_SCALE), up = acc[ai][1][m][n][j] * (1.f / WGU_SCALE); h[4 * n + j] = g * sigmoidf_(g) * up; }
                    u32x2 w; w.x = pk_fp8x4(h[0], h[1], h[2], h[3]); w.y = pk_fp8x4(h[4], h[5], h[6], h[7]);
                    *(u32x2*)(HB8 + (size_t)a * FF + ff0) = w; } }
    }
};
constexpr float YB_SCALE = 16.f;
struct EpiDown {
    static constexpr bool MIDK = false;
    const MoeSched<1>* S; unsigned char* YB8;
    __device__ __forceinline__ void operator()(const f32x4 (&acc)[2][2][4][2], const Unit& u, int slot, int wr, int wc, int fr, int fq) const {
        const int col0 = u.pn * 256 + wc * 32 + 8 * fq;
#pragma unroll
        for (int ai = 0; ai < 2; ++ai) if (u.hm & (1 << ai))
#pragma unroll
            for (int m = 0; m < 4; ++m) { const int ri = slot * 256 + ai * 128 + wr * 64 + m * 16 + fr; const int a = S->rowA[ri];
                if (a >= 0) { const float w8 = S->rowW[ri] * (YB_SCALE / WD_SCALE);
#pragma unroll
                    for (int bj = 0; bj < 2; ++bj) { const f32x4 v0 = acc[ai][bj][m][0] * w8, v1 = acc[ai][bj][m][1] * w8;
                        u32x2 w; w.x = pk_fp8x4(v0[0], v0[1], v0[2], v0[3]); w.y = pk_fp8x4(v1[0], v1[1], v1[2], v1[3]);
                        *(u32x2*)(YB8 + (size_t)a * D + col0 + bj * 128) = w; } } }
    }
};

struct P0Item { const float* src; unsigned char* dst; int ldw, nvalid, K, fp8; float scale; };
__device__ __forceinline__ void p0_map(int r, int NB, int& kp, int& nb) { kp = r / NB; nb = r % NB; }
__device__ __forceinline__ P0Item p0_decode(int pr, int half, const Args& a, unsigned char* ws) {
    constexpr int P_IN = 16 * 140, P_SW = 8 * 32, P_OUT = 16 * 32, P_GU = 16 * 8, P_DN = 4 * 32, P_EXP = 2 * P_GU + P_DN;
    P0Item q; q.fp8 = 0; q.scale = 1.f; int r = pr;
    if (r < P_IN) { int kp, nb; p0_map(r, 140, kp, nb); const int kb = 2 * kp + half, n0 = nb * 64;
        int c0, nv; if (n0 < 4608) { c0 = n0; nv = 64; } else if (n0 < 8704) { c0 = n0 + 16; nv = 64; } else if (n0 == 8704) { c0 = 4608; nv = 16; } else { c0 = 0; nv = 0; }
        q.src = a.in[2] + (size_t)kb * 64 * 8720 + c0; q.ldw = 8720; q.nvalid = nv; q.K = D; q.dst = ws + WS_WINT + ((size_t)n0 * D + kb * 64) * 2; return q; }
    r -= P_IN;
    if (r < P_SW) { int kp, nb; p0_map(r, 32, kp, nb); const int kb = 2 * kp + half; q.src = a.in[5] + (size_t)kb * 64 * D + nb * 64; q.ldw = D; q.nvalid = 64; q.K = D; q.dst = ws + WS_WSWAT + ((size_t)nb * 64 * D + kb * 64) * 2; return q; }
    r -= P_SW;
    if (r < P_SW) { int kp, nb; p0_map(r, 32, kp, nb); const int kb = 2 * kp + half; q.src = a.in[6] + (size_t)kb * 64 * D + nb * 64; q.ldw = D; q.nvalid = 64; q.K = D; q.dst = ws + WS_WSWAT + ((size_t)nb * 64 * D + 1024 + kb * 64) * 2; return q; }
    r -= P_SW;
    if (r < P_OUT) { int kp, nb; p0_map(r, 32, kp, nb); const int kb = 2 * kp + half; q.src = a.in[7] + (size_t)kb * 64 * D + nb * 64; q.ldw = D; q.nvalid = 64; q.K = D; q.dst = ws + WS_WOUTT + ((size_t)nb * 64 * D + kb * 64) * 2; return q; }
    r -= P_OUT;
    const int e = r / P_EXP; r -= e * P_EXP; q.fp8 = 1;
    if (r < 2 * P_GU) { const int up = r >= P_GU; r -= up * P_GU; int kp, nb; p0_map(r, 8, kp, nb); const int kb = 2 * kp + half, n0 = nb * 64;
        const float* src = e < 64 ? (up ? a.in[12] : a.in[11]) + (size_t)e * D * FF : (up ? a.in[15] : a.in[14]);
        const int drow = 256 * (n0 >> 7) + (n0 & 127) + 128 * up;
        q.src = src + (size_t)kb * 64 * FF + n0; q.ldw = FF; q.nvalid = 64; q.K = D; q.scale = WGU_SCALE; q.dst = ws + WS_WGU + ((size_t)e * 1024 + drow) * D + kb * 64; return q; }
    r -= 2 * P_GU;
    { int kp, nb; p0_map(r, 32, kp, nb); const int kb = 2 * kp + half;
        const float* src = e < 64 ? a.in[13] + (size_t)e * FF * D : a.in[16];
        q.src = src + (size_t)kb * 64 * D + nb * 64; q.ldw = D; q.nvalid = 64; q.K = FF; q.scale = WD_SCALE; q.dst = ws + WS_WD + ((size_t)e * D + nb * 64) * FF + kb * 64; return q; }
}
__device__ __forceinline__ void p0_load(const P0Item& q, f32x4 (&v)[16], int lane) {
    const int kr = lane >> 4, nc = (lane & 15) * 4; const bool ok = nc < q.nvalid;
    const float* p = q.src + (size_t)kr * q.ldw + nc;
#pragma unroll
    for (int i = 0; i < 16; ++i) v[i] = ok ? *(const f32x4*)(p + (size_t)(4 * i) * q.ldw) : (f32x4){0.f, 0.f, 0.f, 0.f};
}
__device__ __forceinline__ void p0_process(const P0Item& q, const f32x4 (&v)[16], LAS float* scr, int lane) {
    const int kr = lane >> 4, nc = (lane & 15) * 4;
#pragma unroll
    for (int i = 0; i < 16; ++i) { LAS float* w = scr + (4 * i + kr) * 65 + nc; w[0] = v[i][0]; w[1] = v[i][1]; w[2] = v[i][2]; w[3] = v[i][3]; }
    LDS_WAIT(); asm volatile("" ::: "memory");
    const int c = lane & 7;
#pragma unroll
    for (int j = 0; j < 8; ++j) { const int n = (lane >> 3) + 8 * j; const LAS float* s = scr + (8 * c) * 65 + n;
        u32x4 o; o.x = cvtpk(s[0 * 65], s[1 * 65]); o.y = cvtpk(s[2 * 65], s[3 * 65]); o.z = cvtpk(s[4 * 65], s[5 * 65]); o.w = cvtpk(s[6 * 65], s[7 * 65]);
        *(u32x4*)(q.dst + ((size_t)n * q.K + 8 * c) * 2) = o; }
    LDS_WAIT(); asm volatile("" ::: "memory");
}
__device__ __forceinline__ void p0_load8(const P0Item& q, f32x4 (&v)[16], int lane) {
    const int kq = lane >> 4, nc = (lane & 15) * 4;
    const float* p = q.src + (size_t)(16 * kq) * q.ldw + nc;
#pragma unroll
    for (int i = 0; i < 16; ++i) v[i] = __builtin_nontemporal_load((const f32x4*)(p + (size_t)i * q.ldw));
}
__device__ __forceinline__ void p0_pack8(const f32x4 (&v)[16], float sc, LAS unsigned char* tile, int chunk, int m) {
#pragma unroll
    for (int j = 0; j < 4; ++j) { const int n = 4 * m + j; u32x4 o;
        o.x = pk_fp8x4(v[0][j] * sc, v[1][j] * sc, v[2][j] * sc, v[3][j] * sc); o.y = pk_fp8x4(v[4][j] * sc, v[5][j] * sc, v[6][j] * sc, v[7][j] * sc);
        o.z = pk_fp8x4(v[8][j] * sc, v[9][j] * sc, v[10][j] * sc, v[11][j] * sc); o.w = pk_fp8x4(v[12][j] * sc, v[13][j] * sc, v[14][j] * sc, v[15][j] * sc);
        *(LAS u32x4*)(tile + n * 128 + ((chunk ^ ((n >> 2) & 7)) * 16)) = o; }
}
__device__ __forceinline__ void p0_prologue(Frame& F, const Args& a) {
    LAS float* scr = (LAS float*)(F.lds + F.wave * 16640);
    const int gw = F.vcu * NWAVES + F.wave, NGW = F.G * NWAVES;
    unsigned char* ws = F.ws;
    {
        const float* g = a.in[1];
        for (int m = gw; m < T; m += NGW) {
            const f32x4* xr = (const f32x4*)(a.in[0] + (size_t)m * D) + F.lane;
            f32x4 v[8]; float s = 0.f;
#pragma unroll
            for (int j = 0; j < 8; ++j) { v[j] = xr[64 * j]; s += (v[j].x * v[j].x + v[j].y * v[j].y) + (v[j].z * v[j].z + v[j].w * v[j].w); }
            const float rinv = rsqrtf(wave_sum(s) * (1.f / D) + RMS_EPS);
            u32x2* o = (u32x2*)((bf16_t*)(ws + WS_U) + (size_t)m * D) + F.lane;
#pragma unroll
            for (int j = 0; j < 8; ++j) { const f32x4 gg = *((const f32x4*)g + F.lane + 64 * j); u32x2 w; w.x = cvtpk(v[j].x * rinv * gg.x, v[j].y * rinv * gg.y); w.y = cvtpk(v[j].z * rinv * gg.z, v[j].w * rinv * gg.w); o[64 * j] = w; }
        }
    }
    {
        const float* wr = a.in[9]; const float* g = a.in[8]; float* o = (float*)(ws + WS_WRG);
        for (int i = gw * 64 + F.lane; i < D * NE; i += NGW * 64) o[i] = wr[i] * g[i >> 6];
    }
    constexpr int NB16 = 16 * 140 + 2 * 8 * 32 + 16 * 32, NPAIRS = NB16 + 65 * (2 * 16 * 8 + 4 * 32);
    constexpr int REP = (PROBE_DUP == 0 || PROBE_DUP == 11) ? 2 : (PROBE_DUP == 10 ? 3 : 1);
    f32x4 va[16], vb[16]; P0Item qa, qb;
    {
        const int nj = (NB16 + NGW - 1) / NGW;
        int pr = gw;
        if (pr < NB16) { qa = p0_decode(pr, 0, a, ws); p0_load(qa, va, F.lane); }
        for (int j = 0; j < nj; ++j) {
            const bool act = pr < NB16;
            if (act) { qb = p0_decode(pr, 1, a, ws); p0_load(qb, vb, F.lane); }
            if (act) p0_process(qa, va, scr, F.lane);
            __builtin_amdgcn_s_barrier();
            const int pn = pr + NGW;
            if (pn < NB16) { qa = p0_decode(pn, 0, a, ws); p0_load(qa, va, F.lane); }
            if (act) p0_process(qb, vb, scr, F.lane);
            __builtin_amdgcn_s_barrier();
            pr = pn;
        }
    }
    {
        constexpr int NF = (NPAIRS - NB16) * REP;
        const int nj = (NF + NGW - 1) / NGW;
        LAS unsigned char* tile = (LAS unsigned char*)scr;
        const int kq = F.lane >> 4, m = F.lane & 15;
        int pr = gw;
        if (pr < NF) { qa = p0_decode(NB16 + pr % (NPAIRS - NB16), 0, a, ws); p0_load8(qa, va, F.lane); }
        for (int j = 0; j < nj; ++j) {
            const bool act = pr < NF;
            if (act) { qb = p0_decode(NB16 + pr % (NPAIRS - NB16), 1, a, ws); p0_load8(qb, vb, F.lane); }
            if (act) p0_pack8(va, qa.scale, tile, kq, m);
            __builtin_amdgcn_s_barrier();
            const int pn = pr + NGW;
            const P0Item qc = qa;
            if (pn < NF) { qa = p0_decode(NB16 + pn % (NPAIRS - NB16), 0, a, ws); p0_load8(qa, va, F.lane); }
            if (act) {
                p0_pack8(vb, qb.scale, tile, 4 + kq, m);
                LDS_WAIT(); asm volatile("" ::: "memory");
                const bool st = !(PROBE_DUP == 11 && pr >= NPAIRS - NB16);
                const int c = F.lane & 7;
#pragma unroll
                for (int jj = 0; jj < 8; ++jj) { const int n = (F.lane >> 3) + 8 * jj;
                    const u32x4 o = *(const LAS u32x4*)(tile + n * 128 + ((c ^ ((n >> 2) & 7)) * 16));
                    if (st) *(u32x4*)(qc.dst + (size_t)n * qc.K + 16 * c) = o; else asm volatile("" :: "v"(o)); }
                LDS_WAIT(); asm volatile("" ::: "memory");
            }
            __builtin_amdgcn_s_barrier();
            pr = pn;
        }
    }
}

__device__ __forceinline__ int crow(int r, int hi) { return (r & 3) + 8 * (r >> 2) + 4 * hi; }
__device__ __forceinline__ s16x4 vtr(LAS const char* p) { typedef short v4i16_t __attribute__((ext_vector_type(4))); return __builtin_bit_cast(s16x4, __builtin_amdgcn_ds_read_tr16_b64_v4i16((LAS v4i16_t*)p)); }

__device__ __forceinline__ void attn_qk(f32x16 (&p)[2], const bf16x8 (&qf)[4], LAS const char* Kt, int r32, int hi) {
#pragma unroll
    for (int kb = 0; kb < 2; ++kb) { const int kv = 32 * kb + r32; const int sw = (kv >> 1) & 7; LAS const char* rowp = Kt + kv * 128;
        f32x16 c = {};
#pragma unroll
        for (int s = 0; s < 4; ++s) { const bf16x8 a = *(const LAS bf16x8*)(rowp + (((2 * s + hi) ^ sw) * 16)); c = __builtin_amdgcn_mfma_f32_32x32x16_bf16(a, qf[s], c, 0, 0, 0); }
        p[kb] = c; }
}
__device__ __forceinline__ void attn_softmax_pv(f32x16 (&p)[2], f32x16 (&o)[2], float& m, float& l, LAS const char* Vt, int lane) {
    float mx = p[0][0];
#pragma unroll
    for (int kb = 0; kb < 2; ++kb)
#pragma unroll
        for (int r = 0; r < 16; ++r) mx = fmaxf(mx, p[kb][r]);
    mx = fmaxf(mx, __shfl_xor(mx, 32));
    const float mn = fmaxf(m, mx);
    const float alpha = __builtin_amdgcn_exp2f(m - mn);
    float rs = 0.f;
#pragma unroll
    for (int kb = 0; kb < 2; ++kb)
#pragma unroll
        for (int r = 0; r < 16; ++r) { const float e = __builtin_amdgcn_exp2f(p[kb][r] - mn); p[kb][r] = e; rs += e; }
    rs += __shfl_xor(rs, 32);
    l = l * alpha + rs; m = mn;
#pragma unroll
    for (int db = 0; db < 2; ++db)
#pragma unroll
        for (int r = 0; r < 16; ++r) o[db][r] *= alpha;
    const int g = lane >> 4, i = lane & 15;
    LAS const char* vb = Vt + (4 * (g >> 1) + (i >> 2)) * 64 + (g & 1) * 32 + (i & 3) * 8;
#pragma unroll
    for (int kb = 0; kb < 2; ++kb)
#pragma unroll
        for (int ks = 0; ks < 2; ++ks) {
            u32x4 pw; pw.x = cvtpk(p[kb][8 * ks + 0], p[kb][8 * ks + 1]); pw.y = cvtpk(p[kb][8 * ks + 2], p[kb][8 * ks + 3]); pw.z = cvtpk(p[kb][8 * ks + 4], p[kb][8 * ks + 5]); pw.w = cvtpk(p[kb][8 * ks + 6], p[kb][8 * ks + 7]);
            const bf16x8 pb = __builtin_bit_cast(bf16x8, pw);
#pragma unroll
            for (int db = 0; db < 2; ++db) {
                const s16x4 lo = vtr(vb + db * 4096 + (32 * kb + 16 * ks) * 64), hi4 = vtr(vb + db * 4096 + (32 * kb + 16 * ks + 8) * 64);
                const bf16x8 va = (bf16x8){lo[0], lo[1], lo[2], lo[3], hi4[0], hi4[1], hi4[2], hi4[3]};
                o[db] = __builtin_amdgcn_mfma_f32_32x32x16_bf16(va, pb, o[db], 0, 0, 0); } }
}
__device__ __forceinline__ void attn_store_kv(LAS char* Kt, LAS char* Vt, const u32x4& kr, const u32x4& vr, int tid) {
    const int kv = tid >> 3, c = tid & 7;
    *(LAS u32x4*)(Kt + kv * 128 + ((c ^ ((kv >> 1) & 7)) * 16)) = kr;
    *(LAS u32x4*)(Vt + (c >> 2) * 4096 + kv * 64 + (c & 3) * 16) = vr;
}
__device__ __forceinline__ void attn_store_o(const f32x16 (&o)[2], float l, bf16_t* orow, int hi) {
    const float rl = 1.0f / l;
#pragma unroll
    for (int db = 0; db < 2; ++db)
#pragma unroll
        for (int rq = 0; rq < 4; ++rq) { u32x2 w; w.x = cvtpk(o[db][4 * rq] * rl, o[db][4 * rq + 1] * rl); w.y = cvtpk(o[db][4 * rq + 2] * rl, o[db][4 * rq + 3] * rl);
            *(u32x2*)(orow + 32 * db + 8 * rq + 4 * hi) = w; }
}

__device__ __forceinline__ void swa_unit(Frame& F, int unit, const float* sinks) {
    const bf16_t* Z = (const bf16_t*)(F.ws + WS_Z); bf16_t* YS = (bf16_t*)(F.ws + WS_YS);
    const int b = unit >> 6, kvh = (unit >> 4) & 3, nb = unit & 15;
    const int tid = F.tid, lane = F.lane, r32 = lane & 31, hi = lane >> 5, w = F.wave;
    LAS char* Kl = (LAS char*)F.lds; LAS char* Vl = (LAS char*)F.lds + 32768;
    const int t0 = nb * 128;
    {
        const int kv = tid >> 3, c = tid & 7;
#pragma unroll
        for (int tl = 0; tl < 4; ++tl) {
            if (nb > 0 || tl >= 2) {
                const size_t row = (size_t)(b * SEQ + t0 - 128 + tl * 64 + kv);
                const u32x4 kr = *(const u32x4*)(Z + row * ZP + ZK + kvh * 64 + c * 8);
                const u32x4 vr = *(const u32x4*)(Z + row * ZP + ZV + kvh * 64 + c * 8);
                attn_store_kv(Kl + tl * 8192, Vl + tl * 8192, kr, vr, tid);
            }
        }
    }
    __syncthreads();
    const int qh = kvh * 4 + (w >> 1);
    const float slope2 = exp2f(-0.5f * (float)(qh + 1)) * LOG2E;
    const float sink2 = sinks[qh] * LOG2E;
#pragma unroll 1
    for (int sb = 0; sb < 2; ++sb) {
        const int r0 = 64 * (w & 1) + 32 * sb;
        const int qrel = r0 + r32;
        const size_t qrow = (size_t)(b * SEQ + t0 + qrel);
        bf16x8 qf[4];
#pragma unroll
        for (int s = 0; s < 4; ++s) qf[s] = *(const bf16x8*)(Z + qrow * ZP + ZQ + qh * 64 + 16 * s + 8 * hi);
        f32x16 o[2]; o[0] = f32x16{}; o[1] = f32x16{};
        float m = sink2, l = 1.0f;
        const int tl0 = (r0 + 1) >> 6;
#pragma unroll 1
        for (int tt = 0; tt < 3; ++tt) {
            const int tl = tl0 + tt;
            if (nb == 0 && tl < 2) continue;
            f32x16 p[2];
            attn_qk(p, qf, Kl + tl * 8192, r32, hi);
#pragma unroll
            for (int kb = 0; kb < 2; ++kb)
#pragma unroll
                for (int r = 0; r < 16; ++r) {
                    const int krel = tl * 64 + 32 * kb + crow(r, hi) - 128;
                    const int dist = qrel - krel;
                    const float s = p[kb][r] - slope2 * (float)dist;
                    p[kb][r] = (dist >= 0 && dist < 128) ? s : -INFINITY;
                }
            attn_softmax_pv(p, o, m, l, Vl + tl * 8192, lane);
        }
        attn_store_o(o, l, YS + qrow * 2048 + qh * 64, hi);
    }
    __syncthreads();
}

__device__ __forceinline__ void fox_unit(Frame& F, int bh, int qb, LAS const float* c2) {
    const bf16_t* Z = (const bf16_t*)(F.ws + WS_Z); bf16_t* YF = (bf16_t*)(F.ws + WS_YS);
    const int b = bh >> 4, h = bh & 15;
    const int tid = F.tid, lane = F.lane, r32 = lane & 31, hi = lane >> 5, w = F.wave;
    LAS char* Kl = (LAS char*)F.lds; LAS char* Vl = (LAS char*)F.lds + 16384;
    const int q0 = qb * 256, qw = q0 + 32 * w, qabs = qw + r32;
    const size_t qrow = (size_t)(b * SEQ + qabs);
    const int NT = 4 * (qb + 1);
    const int kvr = tid >> 3, kc = tid & 7;
    const bf16_t* kbase = Z + (size_t)(b * SEQ + kvr) * ZP + ZFK + h * 64 + kc * 8;
    const bf16_t* vbase = Z + (size_t)(b * SEQ + kvr) * ZP + ZFV + h * 64 + kc * 8;
    u32x4 kr = *(const u32x4*)kbase, vr = *(const u32x4*)vbase;
    bf16x8 qf[4];
#pragma unroll
    for (int s = 0; s < 4; ++s) qf[s] = *(const bf16x8*)(Z + qrow * ZP + ZFQ + h * 64 + 16 * s + 8 * hi);
    attn_store_kv(Kl, Vl, kr, vr, tid);
    __syncthreads();
    f32x16 o[2]; o[0] = f32x16{}; o[1] = f32x16{};
    float m = -1e30f, l = 0.f;
#pragma unroll 1
    for (int t = 0; t < NT; ++t) {
        const int buf = t & 1;
        if (t + 1 < NT) { kr = *(const u32x4*)(kbase + (size_t)(t + 1) * 64 * ZP); vr = *(const u32x4*)(vbase + (size_t)(t + 1) * 64 * ZP); }
        const int k0 = t * 64;
        if (k0 <= qw + 31) {
            f32x16 p[2];
            attn_qk(p, qf, Kl + buf * 8192, r32, hi);
            const bool diag = (k0 + 63 > qw);
#pragma unroll
            for (int kb = 0; kb < 2; ++kb)
#pragma unroll
                for (int rq = 0; rq < 4; ++rq) {
                    const int kk = k0 + 32 * kb + 8 * rq + 4 * hi;
                    const f32x4 cc = *(const LAS f32x4*)(c2 + kk);
#pragma unroll
                    for (int j = 0; j < 4; ++j) { float s = p[kb][4 * rq + j] - cc[j]; if (diag && (kk + j > qabs)) s = -INFINITY; p[kb][4 * rq + j] = s; }
                }
            attn_softmax_pv(p, o, m, l, Vl + buf * 8192, lane);
        }
        if (t + 1 < NT) attn_store_kv(Kl + (buf ^ 1) * 8192, Vl + (buf ^ 1) * 8192, kr, vr, tid);
        __syncthreads();
    }
    attn_store_o(o, l, YF + qrow * 2048 + 1024 + h * 64, hi);
}
__device__ __forceinline__ void p2_attention(Frame& F, const Args& a) {
    for (int u = F.vcu; u < 256; u += F.G) swa_unit(F, u, a.in[4]);
    LAS float* c2 = (LAS float*)(F.lds + 32768);
    LAS float* wtot = (LAS float*)(F.lds + 32768 + 8192);
    const float* FL = (const float*)(F.ws + WS_FL);
    for (int it = F.vcu; it < 256; it += F.G) {
        const int bh = it >> 2, s = it & 3, b = bh >> 4, h = bh & 15;
        {
            float v[4]; float run = 0.f;
#pragma unroll
            for (int j = 0; j < 4; ++j) { run += FL[(size_t)(b * SEQ + 4 * F.tid + j) * 16 + h]; v[j] = run; }
            float inc = run;
#pragma unroll
            for (int o = 1; o < 64; o <<= 1) { const float n = __shfl_up(inc, o); if (F.lane >= o) inc += n; }
            if (F.lane == 63) wtot[F.wave] = inc;
            __syncthreads();
            float base = inc - run;
            for (int ww = 0; ww < F.wave; ++ww) base += wtot[ww];
#pragma unroll
            for (int j = 0; j < 4; ++j) c2[4 * F.tid + j] = base + v[j];
            __syncthreads();
        }
        fox_unit(F, bh, s, c2);
        fox_unit(F, bh, 7 - s, c2);
        __syncthreads();
    }
}

__device__ __forceinline__ void p5_router(Frame& F, const Args& a, unsigned* CNT, float* LISTW, int* LIST) {
    const float* H1 = (const float*)(F.ws + WS_H1); const float* PSQ = (const float*)(F.ws + WS_PSQ); const float* WRG = (const float*)(F.ws + WS_WRG);
    unsigned char* V8 = F.ws + WS_V;
    const float* g = a.in[8]; const float* rbias = a.in[10];
    const int lane = F.lane, w = F.wave, tid = F.tid;
    LAS float* part = (LAS float*)F.lds;
    LAS float* logit = (LAS float*)(F.lds + 65536);
    LAS float* rinvs = (LAS float*)(F.lds + 65536 + 8192);
    LAS int* lcnt = (LAS int*)(F.lds + 65536 + 8192 + 128);
    LAS int* gbase = (LAS int*)(F.lds + 65536 + 8192 + 128 + 256);
    for (int tile = F.vcu; tile < T / 32; tile += F.G) {
        const int tok0 = tile * 32;
        if (tid < 64) lcnt[tid] = 0;
#pragma unroll 1
        for (int j = 0; j < 4; ++j) {
            const int tok = tok0 + 4 * w + j;
            float sq = lane < 32 ? PSQ[(size_t)tok * 32 + lane] : 0.f;
            sq = wave_sum(sq);
            const float rinv = rsqrtf(sq * (1.f / D) + RMS_EPS);
            if (lane == 0) rinvs[4 * w + j] = rinv;
            const f32x4* hr = (const f32x4*)(H1 + (size_t)tok * D) + lane;
            unsigned* o = (unsigned*)(V8 + (size_t)tok * D) + lane;
#pragma unroll
            for (int jj = 0; jj < 8; ++jj) { const f32x4 hv = hr[64 * jj]; const f32x4 gg = *((const f32x4*)g + lane + 64 * jj);
                o[64 * jj] = pk_fp8x4(hv.x * rinv * gg.x, hv.y * rinv * gg.y, hv.z * rinv * gg.z, hv.w * rinv * gg.w); }
        }
        {
            f32x16 acc0 = {}, acc1 = {};
            const int tk = lane & 31, half = lane >> 5;
            const float* hp = H1 + (size_t)(tok0 + tk) * D + 256 * w + 4 * half;
            const float* wp = WRG + (size_t)(256 * w + 4 * half) * NE + tk;
#pragma unroll 4
            for (int kk = 0; kk < 32; ++kk) {
                const f32x4 av = *(const f32x4*)(hp + 8 * kk);
#pragma unroll
                for (int s = 0; s < 4; ++s) {
                    const float b0 = wp[(size_t)(8 * kk + s) * NE], b1 = wp[(size_t)(8 * kk + s) * NE + 32];
                    acc0 = __builtin_amdgcn_mfma_f32_32x32x2f32(av[s], b0, acc0, 0, 0, 0);
                    acc1 = __builtin_amdgcn_mfma_f32_32x32x2f32(av[s], b1, acc1, 0, 0, 0);
                }
            }
#pragma unroll
            for (int r = 0; r < 16; ++r) { const int tr = crow(r, half); part[(w * 32 + tr) * 64 + tk] = acc0[r]; part[(w * 32 + tr) * 64 + 32 + tk] = acc1[r]; }
        }
        __syncthreads();
#pragma unroll
        for (int q = 0; q < 4; ++q) { const int idx = tid + 512 * q; float s = 0.f;
#pragma unroll
            for (int ww = 0; ww < 8; ++ww) s += part[ww * 2048 + idx];
            logit[idx] = s * rinvs[idx >> 6]; }
        __syncthreads();
        int sel_k[4], sel_ls[4]; float sel_w[4];
        const float bias = rbias[lane];
#pragma unroll
        for (int j = 0; j < 4; ++j) {
            const int tl = 4 * w + j;
            const float score = sigmoidf_(logit[tl * 64 + lane]);
            const float biased = score + bias;
            float m1 = biased; m1 = fmaxf(m1, __shfl_xor(m1, 1)); m1 = fmaxf(m1, __shfl_xor(m1, 2)); m1 = fmaxf(m1, __shfl_xor(m1, 4));
            const unsigned long long gm = 0xFFull << (lane & 56);
            const unsigned long long b1 = __ballot(biased == m1) & gm;
            const int i1 = __builtin_ctzll(b1);
            float v2 = (lane == i1) ? -INFINITY : biased;
            float m2 = v2; m2 = fmaxf(m2, __shfl_xor(m2, 1)); m2 = fmaxf(m2, __shfl_xor(m2, 2)); m2 = fmaxf(m2, __shfl_xor(m2, 4));
            const float gs = m1 + m2; const int gi = lane >> 3;
            int rank = 0;
#pragma unroll
            for (int gg = 0; gg < 8; ++gg) { const float o = __shfl(gs, 8 * gg); rank += (o > gs || (o == gs && gg < gi)) ? 1 : 0; }
            float mv = rank < 4 ? biased : -INFINITY;
            int myk = -1;
#pragma unroll
            for (int it = 0; it < 8; ++it) { const float mx = wave_max(mv); const unsigned long long bb = __ballot(mv == mx); const int sl = __builtin_ctzll(bb); if (lane == sl) { myk = it; mv = -INFINITY; } }
            const float ssum = wave_sum(myk >= 0 ? score : 0.f);
            sel_k[j] = myk; sel_w[j] = score / ssum * 2.5f;
            sel_ls[j] = 0;
            if (myk >= 0) sel_ls[j] = __hip_atomic_fetch_add((LAS int*)&lcnt[lane], 1, __ATOMIC_RELAXED, __HIP_MEMORY_SCOPE_WORKGROUP);
        }
        __syncthreads();
        if (tid < 64) gbase[tid] = (int)atomicAdd(CNT + tid, (unsigned)lcnt[tid]);
        __syncthreads();
#pragma unroll
        for (int j = 0; j < 4; ++j) if (sel_k[j] >= 0) { const int tok = tok0 + 4 * w + j; const int aid = tok * 8 + sel_k[j];
            const size_t li = (size_t)lane * T + gbase[lane] + sel_ls[j]; LIST[li] = aid; LISTW[li] = sel_w[j]; }
        __syncthreads();
    }
}

template <int MULT> __device__ __forceinline__ int moe_table(Frame& F, LAS int* tab) {
    if (F.tid < 64) {
        const int cnt = (int)__hip_atomic_load(F.ctl + CW_CNT + F.tid, __ATOMIC_RELAXED, __HIP_MEMORY_SCOPE_AGENT);
        int inc = ((cnt + 255) >> 8) * MULT;
#pragma unroll
        for (int o = 1; o < 64; o <<= 1) { const int n = __shfl_up(inc, o); if (F.lane >= o) inc += n; }
        tab[F.tid] = inc; tab[64 + F.tid] = cnt;
    }
    __syncthreads();
    return 32 * MULT + tab[63];
}

__device__ __forceinline__ void p8_final(Frame& F, const Args& a) {
    const float* H1 = (const float*)(F.ws + WS_H1); const unsigned char* YB8 = F.ws + WS_YB; const float* g = a.in[17];
    const int gw = F.vcu * NWAVES + F.wave, NGW = F.G * NWAVES;
    for (int tok = gw; tok < T; tok += NGW) {
        const f32x4* hr = (const f32x4*)(H1 + (size_t)tok * D) + F.lane;
        f32x4 v[8], y[8];
#pragma unroll
        for (int j = 0; j < 8; ++j) { v[j] = hr[64 * j]; y[j] = (f32x4){0.f, 0.f, 0.f, 0.f}; }
#pragma unroll 3
        for (int k = 0; k < 9; ++k) {
            const size_t row = k < 8 ? (size_t)tok * 8 + k : (size_t)NASSIGN + tok;
            const unsigned* yr = (const unsigned*)(YB8 + row * D) + F.lane;
#pragma unroll
            for (int j = 0; j < 8; ++j) { const unsigned w = yr[64 * j]; const f32x2 lo = __builtin_amdgcn_cvt_pk_f32_fp8((int)w, false), hi = __builtin_amdgcn_cvt_pk_f32_fp8((int)w, true);
                y[j].x += lo.x; y[j].y += lo.y; y[j].z += hi.x; y[j].w += hi.y; }
        }
#pragma unroll
        for (int j = 0; j < 8; ++j) v[j] = v[j] + y[j] * (1.f / YB_SCALE);
        float s = 0.f;
#pragma unroll
        for (int j = 0; j < 8; ++j) s += (v[j].x * v[j].x + v[j].y * v[j].y) + (v[j].z * v[j].z + v[j].w * v[j].w);
        const float rinv = rsqrtf(wave_sum(s) * (1.f / D) + RMS_EPS);
        f32x4* o = (f32x4*)(a.out + (size_t)tok * D) + F.lane;
#pragma unroll
        for (int j = 0; j < 8; ++j) { const f32x4 gg = *((const f32x4*)g + F.lane + 64 * j); o[64 * j] = (f32x4){v[j].x * rinv * gg.x, v[j].y * rinv * gg.y, v[j].z * rinv * gg.z, v[j].w * rinv * gg.w}; }
    }
}

constexpr int N_PHASES = 9;
__global__ void __launch_bounds__(NTHREADS, 2) fwd_kernel(Args args) {
    extern __shared__ __attribute__((aligned(16))) unsigned char lds_raw[];
    Frame F;
    F.lds = (LAS unsigned char*)lds_raw;
    F.MISC = (volatile LAS unsigned*)(F.lds + MISC_OFF);
    F.tid = threadIdx.x; F.lane = F.tid & 63; F.wave = __builtin_amdgcn_readfirstlane(F.tid >> 6);
    F.G = gridDim.x; { const int bx = blockIdx.x; F.vcu = (F.G % 8 == 0) ? (bx % 8) * (F.G / 8) + bx / 8 : bx; }
    F.ws = args.ws; F.ctl = (unsigned*)(args.ws + WS_CTL);
    for (int u = F.tid; u < (LDS_BYTES - MISC_OFF) / 4; u += NTHREADS) ((LAS unsigned*)(F.lds + MISC_OFF))[u] = 0u;
    __syncthreads();
    const int lo = args.ph_lo, hi = args.ph_hi;
    XcdBarrier bar; bar.bar = F.ctl + CW_BAR; bar.x = 0; bar.st = nullptr;
    if (hi - lo > 1) bar = xcd_barrier_post(F.ctl + CW_BAR, F.MISC + 8);
#define IN(k) (lo <= (k) && (k) < hi)
#define SEAM(k) do { if (IN(k) && IN((k) + 1)) xcd_barrier(bar); } while (0)
    unsigned char* ws = args.ws;
    LAS int* tab = (LAS int*)(F.lds + MISC_OFF + 256);

#define REPS(k) for (int rep_ = 0; rep_ < (PROBE_DUP == (k) ? 2 : 1); ++rep_)
#define REPBAR(k) do { if (PROBE_DUP == (k) && rep_ == 0) xcd_barrier(bar); } while (0)
    if (IN(0)) { p0_prologue(F, args); SEAM(0); }
    if (IN(1)) {
        DenseSched S{(const char*)(ws + WS_U), (const char*)(ws + WS_WINT), T / 256, NIN / 256, D, F.G, (int)blockIdx.x, PROBE_DUP == 1 ? 2 : 1, (T / 256) * (NIN / 256) % 256};
        EpiZ E{(bf16_t*)(ws + WS_Z), (float*)(ws + WS_FL), args.in[3]};
        pg8::gemm_phase<false>(F.lds, 2 * D, S, E);
        SEAM(1);
    }
    if (IN(2)) { REPS(2) { p2_attention(F, args); REPBAR(2); } SEAM(2); }
    if (IN(3)) {
DenseSched S{(const char*)(ws + WS_YS), (const char*)(ws + WS_WSWAT), T / 256, D / 256, D, F.G, (int)blockIdx.x, PROBE_DUP == 3 ? 2 : 1, 0};
        EpiMix E{(const bf16_t*)(ws + WS_Z), (bf16_t*)(ws + WS_MIX)};
        pg8::gemm_phase<false>(F.lds, 2 * D, S, E);
        SEAM(3);
    }
    if (IN(4)) {
        DenseSched S{(const char*)(ws + WS_MIX), (const char*)(ws + WS_WOUTT), T / 256, D / 256, D, F.G, (int)blockIdx.x, PROBE_DUP == 4 ? 2 : 1, 0};
        EpiOut E{args.in[0], (float*)(ws + WS_H1), (float*)(ws + WS_PSQ)};
        pg8::gemm_phase<false>(F.lds, 2 * D, S, E);
        SEAM(4);
    }
    if (IN(5)) {
        if (PROBE_DUP == 5) { p5_router(F, args, F.ctl + 256, (float*)(ws + WS_T1), (int*)(ws + WS_T1 + 2 * MiB)); xcd_barrier(bar); }
        p5_router(F, args, F.ctl + CW_CNT, (float*)(ws + WS_LISTW), (int*)(ws + WS_LIST));
        if (PROBE_DUP == 9) { for (int q = 0; q < 16; ++q) xcd_barrier(bar); }
        SEAM(5); }
    if (IN(6)) {
        const int total = moe_table<4>(F, tab);
        MoeSched<0> S{tab, (const int*)(ws + WS_LIST), (const float*)(ws + WS_LISTW), (const char*)(ws + WS_V), (const char*)(ws + WS_WGU), (LAS int*)(F.lds + MISC_OFF + 1024), (LAS float*)(F.lds + MISC_OFF + 4096), total, F.G, F.vcu, PROBE_DUP == 6 ? 2 : 1};
        EpiSwiglu E{&S, (unsigned char*)(ws + WS_HB)};
        pg8::gemm_phase<true>(F.lds, 2048, S, E);
        SEAM(6);
    }
    if (IN(7)) {
        const int total = moe_table<8>(F, tab);
        MoeSched<1> S{tab, (const int*)(ws + WS_LIST), (const float*)(ws + WS_LISTW), (const char*)(ws + WS_HB), (const char*)(ws + WS_WD), (LAS int*)(F.lds + MISC_OFF + 1024), (LAS float*)(F.lds + MISC_OFF + 4096), total, F.G, F.vcu, PROBE_DUP == 7 ? 2 : 1};
        EpiDown E{&S, (unsigned char*)(ws + WS_YB)};
        pg8::gemm_phase<true>(F.lds, 512, S, E);
        SEAM(7);
    }
    if (IN(8)) { REPS(8) { p8_final(F, args); REPBAR(8); } }
#undef IN
#undef SEAM
}

extern "C" void kernel_launch(void* const* d_in, const int* in_sizes, int n_in, void* d_out, int out_size, void* d_ws, size_t ws_size, hipStream_t stream) {
    static int grid = 0;
    if (grid == 0) {
        if (n_in != 18 || out_size != T * D || ws_size < WS_END) { fprintf(stderr, "kernel_launch: unexpected shapes (n_in %d out %d ws %zu)\n", n_in, out_size, ws_size); grid = -1; return; }
        int dev = 0, cus = 0, per_cu = 0;
        if (hipGetDevice(&dev) != hipSuccess || hipDeviceGetAttribute(&cus, hipDeviceAttributeMultiprocessorCount, dev) != hipSuccess) { grid = -1; return; }
        if (hipFuncSetAttribute((const void*)fwd_kernel, hipFuncAttributeMaxDynamicSharedMemorySize, LDS_BYTES) != hipSuccess) { fprintf(stderr, "kernel_launch: hipFuncSetAttribute failed\n"); grid = -1; return; }
        if (hipOccupancyMaxActiveBlocksPerMultiprocessor(&per_cu, (const void*)fwd_kernel, NTHREADS, LDS_BYTES) != hipSuccess || per_cu < 1) { fprintf(stderr, "kernel_launch: occupancy query says %d blocks per CU\n", per_cu); (void)hipGetLastError(); grid = -1; return; }
        grid = cus;
        if (grid % 8 != 0 || grid > 256) grid = (grid / 8) * 8 > 256 ? 256 : (grid / 8) * 8;
    }
    if (grid <= 0) return;
    (void)hipMemsetAsync((char*)d_ws + WS_CTL, 0, CTL_ZERO_BYTES, stream);
    Args a{};
    for (int i = 0; i < 18; ++i) a.in[i] = (const float*)d_in[i];
    a.out = (float*)d_out; a.ws = (unsigned char*)d_ws;
#if MK_N_LAUNCHES == 1
    a.ph_lo = 0; a.ph_hi = N_PHASES;
    hipLaunchKernelGGL(fwd_kernel, dim3(grid), dim3(NTHREADS), LDS_BYTES, stream, a);
#else
    for (int p = 0; p < N_PHASES; ++p) { a.ph_lo = p; a.ph_hi = p + 1; hipLaunchKernelGGL(fwd_kernel, dim3(grid), dim3(NTHREADS), LDS_BYTES, stream, a); }
#endif
}
```

```cpp
#include <hip/hip_runtime.h>
#include <cstdio>
#include <cstdint>

#ifndef MK_N_LAUNCHES
#define MK_N_LAUNCHES 1
#endif
#define PROBE_DUP -1

#define LAS __attribute__((address_space(3)))
#define GAS __attribute__((address_space(1)))
typedef unsigned short bf16_t;
typedef short bf16x8 __attribute__((ext_vector_type(8)));
typedef short s16x4 __attribute__((ext_vector_type(4)));
typedef float f32x2 __attribute__((ext_vector_type(2)));
typedef float f32x4 __attribute__((ext_vector_type(4)));
typedef float f32x16 __attribute__((ext_vector_type(16)));
typedef unsigned u32x2 __attribute__((ext_vector_type(2)));
typedef unsigned u32x4 __attribute__((ext_vector_type(4)));
typedef __bf16 bf16x2_t __attribute__((ext_vector_type(2)));

constexpr int T = 8192, D = 2048, SEQ = 2048, NBATCH = 4;
constexpr int NE = 64, FF = 512, TOPK = 8;
constexpr int ZP = 8704;
constexpr int ZQ = 0, ZK = 1024, ZV = 1280, ZFQ = 1536, ZFK = 2560, ZFV = 3584, ZGS = 4608, ZGF = 6656;
constexpr int NIN = 8960;
constexpr float RMS_EPS = 1e-6f;
constexpr float LOG2E = 1.4426950408889634f;
constexpr float QSCALE = 0.125f * LOG2E;
constexpr int NASSIGN = T * TOPK;
constexpr int NROWS_H = NASSIGN + T;

constexpr size_t MiB = 1u << 20;
constexpr size_t WS_CTL = 0, CTL_ZERO_BYTES = 64 * 1024;
constexpr size_t WS_FL = 1 * MiB;
constexpr size_t WS_WTS = 1 * MiB + 512 * 1024;
constexpr size_t WS_LIST = 2 * MiB;
constexpr size_t WS_WSWAT = 4 * MiB, WS_WFOXT = 8 * MiB, WS_WOUTT = 12 * MiB;
constexpr size_t WS_WINT = 20 * MiB;
constexpr size_t WS_WRG = 55 * MiB;
constexpr size_t WS_PSQ = 55 * MiB + 512 * 1024;
constexpr size_t WS_U = 56 * MiB;
constexpr size_t WS_Z = 88 * MiB;
constexpr size_t WS_YS = 224 * MiB, WS_YF = 240 * MiB;
constexpr size_t WS_T1 = 256 * MiB;
constexpr size_t WS_MIX = 320 * MiB;
constexpr size_t WS_H1 = 352 * MiB;
constexpr size_t WS_V = 416 * MiB;
constexpr size_t WS_HB = 448 * MiB;
constexpr size_t WS_WGU = 520 * MiB;
constexpr size_t WS_WD = 780 * MiB;
constexpr size_t WS_YB = 56 * MiB;
constexpr size_t WS_LISTW = 910 * MiB;
constexpr size_t WS_END = 912 * MiB;
static_assert(WS_YB + (size_t)NROWS_H * D * 2 <= WS_MIX + 32 * MiB, "YB overlay");
constexpr int CW_CNT = 64;
constexpr int CW_BAR = 4096;

constexpr int RING_BYTES = 131072;
constexpr int MISC_OFF = 139264;
constexpr int LDS_BYTES = 147456;
constexpr int NWAVES = 8, NTHREADS = 512;

__device__ __forceinline__ unsigned cvtpk(float lo, float hi) { f32x2 v = {lo, hi}; bf16x2_t b = __builtin_convertvector(v, bf16x2_t); return __builtin_bit_cast(unsigned, b); }
__device__ __forceinline__ float bf2f(bf16_t h) { return __builtin_bit_cast(float, (unsigned)h << 16); }
__device__ __forceinline__ float bflo(unsigned w) { return __builtin_bit_cast(float, w << 16); }
__device__ __forceinline__ float bfhi(unsigned w) { return __builtin_bit_cast(float, w & 0xffff0000u); }
__device__ __forceinline__ float wave_sum(float v) {
#pragma unroll
    for (int o = 1; o < 64; o <<= 1) v += __shfl_xor(v, o);
    return v;
}
__device__ __forceinline__ float wave_max(float v) {
#pragma unroll
    for (int o = 1; o < 64; o <<= 1) v = fmaxf(v, __shfl_xor(v, o));
    return v;
}
__device__ __forceinline__ float sigmoidf_(float x) { return 1.0f / (1.0f + __expf(-x)); }
#define LDS_WAIT() asm volatile("s_waitcnt lgkmcnt(0)" ::: "memory")
#define VM_WAIT() asm volatile("s_waitcnt vmcnt(0)" ::: "memory")

#define XB_TMO      128
#define XB_XCNT(j)  (256  + 64 * (j))
#define XB_XSUB(j)  (1280 + 64 * (j))
#define XB_XGEN(j)  (2304 + 64 * (j))
#define XB_TOP      3328
#define XB_TOPGEN   3392
#define XCD_BAR_WORDS 3456
#define XB_SPIN_CAP (1u << 20)
__device__ __forceinline__ unsigned xb_ld(unsigned* p)              { return __hip_atomic_load(p, __ATOMIC_RELAXED, __HIP_MEMORY_SCOPE_AGENT); }
__device__ __forceinline__ unsigned xb_add(unsigned* p, unsigned v) { return __hip_atomic_fetch_add(p, v, __ATOMIC_RELAXED, __HIP_MEMORY_SCOPE_AGENT); }
__device__ __forceinline__ unsigned xb_xcc_id() { return (unsigned)__builtin_amdgcn_s_getreg((3 << 11) | 20) & 0xFu; }
#define XB_SPIN(cond, bar) do { unsigned _sp = 0; while (cond) { __builtin_amdgcn_s_sleep(1); \
    if ((++_sp & 255u) == 0u) { if (xb_ld(&(bar)[XB_TMO])) break; if (_sp > XB_SPIN_CAP) { atomicAdd(&(bar)[XB_TMO], 1u); break; } } } } while (0)
struct XcdBarrier { unsigned* bar; unsigned x; volatile LAS unsigned* st; };
__device__ __forceinline__ XcdBarrier xcd_barrier_post(unsigned* bar, volatile LAS unsigned* st) {
    XcdBarrier b; b.bar = bar; b.x = xb_xcc_id(); b.st = st;
    if (threadIdx.x == 0) (void)xb_add(&bar[XB_XCNT(b.x)], 1u);
    return b;
}
__device__ __forceinline__ void xcd_barrier_complete(unsigned* bar, unsigned x, unsigned& nloc, unsigned& nx) {
    const unsigned G = gridDim.x * gridDim.y * gridDim.z;
    unsigned sum, cnt, mine, sp = 0u;
    for (;;) {
        sum = 0u; cnt = 0u; mine = 0u;
#pragma unroll
        for (unsigned j = 0; j < 16; ++j) { const unsigned c = xb_ld(&bar[XB_XCNT(j)]); sum += c; cnt += (c > 0u) ? 1u : 0u; mine = (j == x) ? c : mine; }
        if (sum == G) break;
        __builtin_amdgcn_s_sleep(1);
        if ((++sp & 255u) == 0u) { if (xb_ld(&bar[XB_TMO])) break; if (sp > XB_SPIN_CAP) { atomicAdd(&bar[XB_TMO], 1u); break; } }
    }
    nloc = mine > 0u ? mine : 1u; nx = cnt > 0u ? cnt : 1u;
}
__device__ __forceinline__ void xcd_barrier(const XcdBarrier& b) {
    asm volatile("s_waitcnt vmcnt(0)" ::: "memory");
    __syncthreads();
    if (threadIdx.x == 0) {
        unsigned* bar = b.bar;
        __builtin_amdgcn_s_waitcnt(0);
        unsigned nloc = b.st[0], nx = b.st[1];
        if (nloc == 0u) { xcd_barrier_complete(bar, b.x, nloc, nx); b.st[0] = nloc; b.st[1] = nx; }
        const unsigned old = xb_add(&bar[XB_XSUB(b.x)], 1u);
        const unsigned gen = old / nloc;
        if (old + 1u == (gen + 1u) * nloc) {
            __builtin_amdgcn_fence(__ATOMIC_RELEASE, "agent");
            asm volatile("s_waitcnt vmcnt(0)" ::: "memory");
            const unsigned og = xb_add(&bar[XB_TOP], 1u);
            const unsigned tg = og / nx;
            if (og + 1u == (tg + 1u) * nx) xb_add(&bar[XB_TOPGEN], 1u);
            else XB_SPIN(xb_ld(&bar[XB_TOPGEN]) == tg, bar);
            __builtin_amdgcn_fence(__ATOMIC_ACQUIRE, "agent");
            xb_add(&bar[XB_XGEN(b.x)], 1u);
            asm volatile("s_waitcnt vmcnt(0)" ::: "memory");
        } else {
            XB_SPIN(xb_ld(&bar[XB_XGEN(b.x)]) == gen, bar);
            __builtin_amdgcn_fence(__ATOMIC_ACQUIRE, "agent");
            asm volatile("s_waitcnt vmcnt(0)" ::: "memory");
        }
    }
    __syncthreads();
}

namespace pg8 {
constexpr int BM = 256, BK = 64, HALF = 128, HTB = HALF * BK * 2, STAGE_BYTES = 8 * HTB, NXCD = 8, WGM = 8;
__host__ __device__ __forceinline__ int lds_byte(int r, int c) { const int st = (r >> 4) * 2 + (c >> 5), rr = r & 15, cc = c & 31, ob = rr * 64 + cc * 2; return st * 1024 + (ob ^ (((ob >> 9) & 1) << 5)); }
__host__ __device__ __forceinline__ void stage_rc(int b, int& R, int& C) { const int st = b / 1024, sb = b % 1024, swz = sb ^ (((sb >> 9) & 1) << 5); R = (st >> 1) * 16 + swz / 64; C = (st & 1) * 32 + (swz % 64) / 2; }
__host__ __device__ __forceinline__ int perm32(int rho) { const int n = rho >> 4, i = rho & 15; return 8 * (i >> 2) + 4 * n + (i & 3); }

struct Unit { const char* A; const char* B; int pm, pn, e, rt, hm; };

__device__ __forceinline__ void static_tile(int L, int nM, int nN, int& pm, int& pn) {
    const int nwg = nM * nN; int wgid = L;
    { const int q = nwg / NXCD, r = nwg % NXCD, xcd = wgid % NXCD, off = wgid / NXCD; wgid = (xcd < r ? xcd * (q + 1) : r * (q + 1) + (xcd - r) * q) + off; }
    const int nig = WGM * nN, gid = wgid / nig, fm = gid * WGM, gsz = (nM - fm) < WGM ? (nM - fm) : WGM;
    pm = fm + ((wgid % nig) % gsz); pn = (wgid % nig) / gsz;
}

typedef int v4i_t __attribute__((ext_vector_type(4)));
typedef int v8i_t __attribute__((ext_vector_type(8)));
template <bool FP8, class Epi, class Sched>
__device__ __forceinline__ void gemm_phase(LAS unsigned char* lds, const int Kb, const Sched& S, const Epi& E, const int stagger_ticks = 0) {
    if (stagger_ticks > 0) { const unsigned long long t0_ = __builtin_amdgcn_s_memrealtime(); while (__builtin_amdgcn_s_memrealtime() - t0_ < (unsigned long long)stagger_ticks) __builtin_amdgcn_s_sleep(8); }
    const int tid = threadIdx.x, wid = __builtin_amdgcn_readfirstlane(tid >> 6), lane = tid & 63, wr = wid >> 2, wc = wid & 3, fr = lane & 15, fq = lane >> 4;
    const int nt = Kb / 128;
    int Ri[2], Ci[2]; unsigned voffB[2];
#pragma unroll
    for (int i = 0; i < 2; ++i) { int R, C; stage_rc(tid * 16 + i * 8192, R, C); Ri[i] = R; Ci[i] = C; const int Rb = (R & ~31) + perm32(R & 31); voffB[i] = (unsigned)(Rb * Kb + C * 2); }
    const size_t kstep = (size_t)(BK * 2);
    const size_t hstep = (size_t)HALF * Kb;
    const unsigned ldsw = (unsigned)wid * 1024u;
    const int aoff = lds_byte(wr * 64 + fr, fq * 8), boff = lds_byte(wc * 32 + fr, fq * 8);
#define PG8_SA(b, h) (((b) * 2 + (h)) * HTB)
#define PG8_SB(b, h) ((4 + (b) * 2 + (h)) * HTB)
#define PG8_STAGE(bufoff, gbase, voff) do { _Pragma("unroll") for (int _i = 0; _i < 2; ++_i) \
        __builtin_amdgcn_global_load_lds((const unsigned*)((const char*)(gbase) + (voff)[_i]), (LAS unsigned*)(lds + (bufoff) + ldsw + _i * 8192), 16, 0, 0); } while (0)
#define PG8_LDA(dst, b, h) do { if constexpr (FP8) { _Pragma("unroll") for (int m = 0; m < 4; ++m) { dst##8[m].lo = *(const LAS v4i_t*)(lds + PG8_SA(b, h) + aoff + m * 2048); dst##8[m].hi = *(const LAS v4i_t*)(lds + PG8_SA(b, h) + aoff + m * 2048 + 1024); } } \
        else { _Pragma("unroll") for (int m = 0; m < 4; ++m) _Pragma("unroll") for (int k = 0; k < 2; ++k) dst[m][k] = *(const LAS bf16x8*)(lds + PG8_SA(b, h) + aoff + m * 2048 + k * 1024); } } while (0)
#define PG8_LDB(dst, b, h) do { if constexpr (FP8) { _Pragma("unroll") for (int n = 0; n < 2; ++n) { dst##8[n].lo = *(const LAS v4i_t*)(lds + PG8_SB(b, h) + boff + n * 2048); dst##8[n].hi = *(const LAS v4i_t*)(lds + PG8_SB(b, h) + boff + n * 2048 + 1024); } } \
        else { _Pragma("unroll") for (int n = 0; n < 2; ++n) _Pragma("unroll") for (int k = 0; k < 2; ++k) dst[n][k] = *(const LAS bf16x8*)(lds + PG8_SB(b, h) + boff + n * 2048 + k * 1024); } } while (0)
#define PG8_MMA(ai, bj, At, Bt) do { __builtin_amdgcn_s_setprio(1); \
        if constexpr (FP8) { _Pragma("unroll") for (int m = 0; m < 4; ++m) _Pragma("unroll") for (int n = 0; n < 2; ++n) \
            asm volatile("v_mfma_scale_f32_16x16x128_f8f6f4 %0, %1, %2, %0, %3, %3 op_sel_hi:[0,0,0]" : "+v"(acc[ai][bj][m][n]) : "v"(Bt##8[n]), "v"(At##8[m]), "v"(sc8)); } \
        else { _Pragma("unroll") for (int m = 0; m < 4; ++m) _Pragma("unroll") for (int n = 0; n < 2; ++n) _Pragma("unroll") for (int k = 0; k < 2; ++k) \
            acc[ai][bj][m][n] = __builtin_amdgcn_mfma_f32_16x16x32_bf16(Bt[n][k], At[m][k], acc[ai][bj][m][n], 0, 0, 0); } \
        __builtin_amdgcn_s_setprio(0); } while (0)
#define PG8_WAIT_V(n) asm volatile("s_waitcnt vmcnt(" #n ")" ::: "memory")
#define PG8_WAIT_L(n) asm volatile("s_waitcnt lgkmcnt(" #n ")" ::: "memory")
#define PG8_BAR __builtin_amdgcn_s_barrier()
#define PG8_SCHED __builtin_amdgcn_sched_barrier(0)
    Unit cur, nxt; int ui = 0;
    if (!S.next(0, cur)) return;
    unsigned vc[2][2], vn[2][2];
    int pfa = -1; float pfw = 0.f;
    S.pf_issue(cur, pfa, pfw); S.pf_commit(0, pfa, pfw);
    asm volatile("s_waitcnt vmcnt(0) lgkmcnt(0)" ::: "memory"); PG8_BAR; asm volatile("" ::: "memory");
    S.rowoffs(cur, 0, vc, Ri, Ci);
    f32x4 acc[2][2][4][2];
#pragma unroll
    for (int a = 0; a < 2; ++a)
#pragma unroll
        for (int b = 0; b < 2; ++b)
#pragma unroll
            for (int m = 0; m < 4; ++m)
#pragma unroll
                for (int n = 0; n < 2; ++n) acc[a][b][m][n] = (f32x4){0.f, 0.f, 0.f, 0.f};
    const int sc8 = 0x7f7f7f7f;
    bf16x8 At[4][2], B0[2][2], B1[2][2]; v8i_t At8[4], B08[2], B18[2];
    const char* cA = cur.A; const char* cB = cur.B;
    PG8_STAGE(PG8_SB(0, 0), cB, voffB); PG8_STAGE(PG8_SB(0, 1), cB + hstep, voffB); PG8_STAGE(PG8_SA(0, 0), cA, vc[0]); PG8_STAGE(PG8_SA(0, 1), cA, vc[1]);
    if (wr == 1) PG8_BAR;
    PG8_WAIT_V(2); PG8_BAR;
    PG8_STAGE(PG8_SB(1, 0), cB + kstep, voffB); PG8_STAGE(PG8_SA(1, 0), cA + kstep, vc[0]); PG8_STAGE(PG8_SB(1, 1), cB + hstep + kstep, voffB);
    PG8_WAIT_V(6); PG8_BAR;
    for (;;) {
        const bool has_next = S.next(ui + 1, nxt);
        const int scur = ui % 3, snxt = (ui + 1) % 3;
        const bool h0 = (cur.hm & 1) != 0, h1 = (cur.hm & 2) != 0;
        const char* nA = has_next ? nxt.A : cA; const char* nB = has_next ? nxt.B : cB;
        if (has_next) S.pf_issue(nxt, pfa, pfw);
        constexpr int NH = Epi::MIDK ? 2 : 1;
        for (int kh = 0; kh < NH; ++kh) {
        if constexpr (Epi::MIDK) { if (kh == 1) E.mid(acc, cur, wr, wc, fr, fq); }
        const int tend = (kh + 1) * nt / NH;
        for (int t = kh * nt / NH; t < tend; t += 2) {
            const bool last = (t == nt - 2);
            if (t == (nt >= 8 ? nt - 4 : 0) && has_next) S.pf_commit(snxt, pfa, pfw);
            const char* a1 = cA + (size_t)(t + 1) * kstep;
            const char* a2 = last ? nA : cA + (size_t)(t + 2) * kstep; const char* b2 = last ? nB : cB + (size_t)(t + 2) * kstep;
            const char* a3 = a2 + kstep; const char* b3 = b2 + kstep;
            if (last) {
                if (has_next) S.rowoffs(nxt, snxt, vn, Ri, Ci);
                else { vn[0][0] = vc[0][0]; vn[0][1] = vc[0][1]; vn[1][0] = vc[1][0]; vn[1][1] = vc[1][1]; }
            }
            unsigned v2[2][2];
            v2[0][0] = last ? vn[0][0] : vc[0][0]; v2[0][1] = last ? vn[0][1] : vc[0][1]; v2[1][0] = last ? vn[1][0] : vc[1][0]; v2[1][1] = last ? vn[1][1] : vc[1][1];
            PG8_LDB(B0, 0, 0); PG8_LDB(B1, 0, 1); PG8_SCHED; PG8_LDA(At, 0, 0); PG8_STAGE(PG8_SA(1, 1), a1, vc[1]);
            PG8_WAIT_V(8); PG8_WAIT_L(0); PG8_BAR; if (h0) { PG8_MMA(0, 0, At, B0); PG8_MMA(0, 1, At, B1); } PG8_BAR; PG8_SCHED;
            PG8_LDA(At, 0, 1); PG8_STAGE(PG8_SB(0, 0), b2, voffB); PG8_STAGE(PG8_SB(0, 1), b2 + hstep, voffB); PG8_STAGE(PG8_SA(0, 0), a2, v2[0]);
            PG8_WAIT_V(8); PG8_WAIT_L(0); PG8_BAR; if (h1) { PG8_MMA(1, 0, At, B0); PG8_MMA(1, 1, At, B1); } PG8_BAR; PG8_SCHED;
            PG8_LDB(B0, 1, 0); PG8_LDB(B1, 1, 1); PG8_SCHED; PG8_LDA(At, 1, 0); PG8_STAGE(PG8_SA(0, 1), a2, v2[1]);
            PG8_WAIT_V(8); PG8_WAIT_L(0); PG8_BAR; if (h0) { PG8_MMA(0, 0, At, B0); PG8_MMA(0, 1, At, B1); } PG8_BAR; PG8_SCHED;
            PG8_LDA(At, 1, 1); PG8_STAGE(PG8_SB(1, 0), b3, voffB); PG8_STAGE(PG8_SB(1, 1), b3 + hstep, voffB); PG8_STAGE(PG8_SA(1, 0), a3, v2[0]);
            PG8_WAIT_V(8); PG8_WAIT_L(0); PG8_BAR; if (h1) { PG8_MMA(1, 0, At, B0); PG8_MMA(1, 1, At, B1); } PG8_BAR; PG8_SCHED;
        }
        }
        if (wr == 0) PG8_BAR;
        if constexpr (FP8) {
            asm volatile("s_nop 15\n\ts_nop 15" ::: "memory");
#pragma unroll
            for (int a = 0; a < 2; ++a)
#pragma unroll
                for (int b = 0; b < 2; ++b)
#pragma unroll
                    for (int m = 0; m < 4; ++m)
#pragma unroll
                        for (int n = 0; n < 2; ++n) asm volatile("" : "+v"(acc[a][b][m][n]));
        }
        E(acc, cur, scur, wr, wc, fr, fq);
        if (!has_next) break;
#pragma unroll
        for (int a = 0; a < 2; ++a)
#pragma unroll
            for (int b = 0; b < 2; ++b)
#pragma unroll
                for (int m = 0; m < 4; ++m)
#pragma unroll
                    for (int n = 0; n < 2; ++n) acc[a][b][m][n] = (f32x4){0.f, 0.f, 0.f, 0.f};
        cur = nxt; cA = nA; cB = nB; ++ui;
        vc[0][0] = vn[0][0]; vc[0][1] = vn[0][1]; vc[1][0] = vn[1][0]; vc[1][1] = vn[1][1];
        if (wr == 1) PG8_BAR;
    }
    PG8_WAIT_V(0);
    PG8_BAR;
#undef PG8_SA
#undef PG8_SB
#undef PG8_STAGE
#undef PG8_LDA
#undef PG8_LDB
#undef PG8_MMA
#undef PG8_WAIT_V
#undef PG8_WAIT_L
#undef PG8_BAR
#undef PG8_SCHED
}
}
using pg8::Unit;

struct Args { const float* in[18]; float* out; unsigned char* ws; int ph_lo, ph_hi; };
struct Frame {
    LAS unsigned char* lds; volatile LAS unsigned* MISC; unsigned* ctl; unsigned char* ws;
    int tid, lane, wave, vcu, G;
};

struct DenseSched {
    const char* A; const char* Bt; int nM, nN, K, G, c, dup, nsplit;
    __device__ __forceinline__ bool next(int i, Unit& u) const {
        int L = i * G + c; int hm_ = 3;
        if (nsplit > 0) {
            const int nfull = nM * nN - nsplit, tot = nfull + 2 * nsplit;
            if (L >= tot * dup) return false; if (L >= tot) L -= tot;
            if (L >= nfull) { hm_ = 1 << ((L - nfull) & 1); L = nfull + ((L - nfull) >> 1); }
        } else { if (L >= nM * nN * dup) return false; if (L >= nM * nN) L -= nM * nN; }
        int pm, pn; pg8::static_tile(L, nM, nN, pm, pn);
        u.pm = pm; u.pn = pn; u.e = 0; u.rt = 0; u.hm = hm_; u.A = A + (size_t)pm * 256 * K * 2; u.B = Bt + (size_t)pn * 256 * K * 2; return true;
    }
    __device__ __forceinline__ void pf_issue(const Unit&, int&, float&) const {}
    __device__ __forceinline__ void pf_commit(int, int, float) const {}
    __device__ __forceinline__ void rowoffs(const Unit&, int, unsigned (&vo)[2][2], const int (&R)[2], const int (&C)[2]) const {
#pragma unroll
        for (int h = 0; h < 2; ++h)
#pragma unroll
            for (int i = 0; i < 2; ++i) vo[h][i] = (unsigned)((R[i] + 128 * h) * K + C[i]) * 2u;
    }
};
struct BranchSched {
    const char* A0; const char* A1; const char* B0; const char* B1; int nM, nN, K, G, c, dup;
    __device__ __forceinline__ bool next(int i, Unit& u) const {
        int L = (i >> 1) * G + c; if (L >= nM * nN * dup) return false; if (L >= nM * nN) L -= nM * nN;
        int pm, pn; pg8::static_tile(L, nM, nN, pm, pn);
        const int br = i & 1;
        u.pm = pm; u.pn = pn; u.e = br; u.rt = 0; u.hm = 3; u.A = (br ? A1 : A0) + (size_t)pm * 256 * K * 2; u.B = (br ? B1 : B0) + (size_t)pn * 256 * K * 2; return true;
    }
    __device__ __forceinline__ void pf_issue(const Unit&, int&, float&) const {}
    __device__ __forceinline__ void pf_commit(int, int, float) const {}
    __device__ __forceinline__ void rowoffs(const Unit&, int, unsigned (&vo)[2][2], const int (&R)[2], const int (&C)[2]) const {
#pragma unroll
        for (int h = 0; h < 2; ++h)
#pragma unroll
            for (int i = 0; i < 2; ++i) vo[h][i] = (unsigned)((R[i] + 128 * h) * K + C[i]) * 2u;
    }
};
template <int MODE> struct MoeSched {
    const LAS int* tab; const int* list; const float* listw; const char* A; const char* Bt; LAS int* rowA; LAS float* rowW; int total, G, vcu, dup;
    static constexpr int MULT = MODE == 0 ? 4 : 8, KB = MODE == 0 ? 2048 : 512  , NCOLS = MODE == 0 ? 1024 : 2048;
    __device__ __forceinline__ bool next(int i, Unit& u) const {
        int L = i * G + vcu; if (L >= total * dup) return false; if (L >= total) L -= total;
        int e, j, nrt, cnte = T;
        if (L < 32 * MULT) { e = 64; j = L; nrt = 32; }
        else {
            const int Lr = L - 32 * MULT; const int lane = threadIdx.x & 63;
            const int pin = tab[lane];
            const unsigned long long bal = __ballot(pin <= Lr);
            e = __builtin_popcountll(bal); e = e > 63 ? 63 : e;
            const int pex = e > 0 ? tab[e - 1] : 0; const int cnt = tab[64 + e];
            j = Lr - pex; nrt = (cnt + 255) >> 8; nrt = nrt < 1 ? 1 : nrt; cnte = cnt;
        }
        e = __builtin_amdgcn_readfirstlane(e); j = __builtin_amdgcn_readfirstlane(j); nrt = __builtin_amdgcn_readfirstlane(nrt);
        u.e = e; u.rt = j % nrt; u.pn = j / nrt; u.pm = 0;
        u.hm = (__builtin_amdgcn_readfirstlane(cnte) - u.rt * 256 > 128) ? 3 : 1;
        u.A = A; u.B = Bt + ((size_t)e * NCOLS + (size_t)u.pn * 256) * KB; return true;
    }
    __device__ __forceinline__ void pf_issue(const Unit& u, int& pa, float& pw) const {
        const int tid = threadIdx.x; pa = -1; pw = 0.f;
        if (tid < 256) { const int idx = u.rt * 256 + tid;
            if (u.e == 64) { pa = NASSIGN + idx; pw = 1.f; }
            else if (idx < tab[64 + u.e]) { pa = list[u.e * T + idx]; if (MODE == 1) pw = listw[u.e * T + idx]; } }
    }
    __device__ __forceinline__ void pf_commit(int s, int pa, float pw) const { const int tid = threadIdx.x; if (tid < 256) { rowA[s * 256 + tid] = pa; rowW[s * 256 + tid] = pw; } }
    __device__ __forceinline__ void rowoffs(const Unit& u, int s, unsigned (&vo)[2][2], const int (&R)[2], const int (&C)[2]) const {
#pragma unroll
        for (int h = 0; h < 2; ++h)
#pragma unroll
            for (int i = 0; i < 2; ++i) {
                int a = rowA[s * 256 + R[i] + 128 * h];
                unsigned row;
                if (MODE == 0) { a = a < 0 ? 0 : a; row = a < NASSIGN ? (unsigned)(a >> 3) : (unsigned)(a - NASSIGN); }
                else row = a < 0 ? 0u : (unsigned)a;
                vo[h][i] = row * (unsigned)KB + (unsigned)C[i] * 2u;
            }
    }
};

struct EpiZ {
    static constexpr bool MIDK = false;
    bf16_t* Z; float* FL; const float* fbias;
    __device__ __forceinline__ void operator()(const f32x4 (&acc)[2][2][4][2], const Unit& u, int slot, int wr, int wc, int fr, int fq) const {
        const int row0 = u.pm * 256 + wr * 64 + fr;
        if (u.pn == 34) {
            if (wc == 0 && fq < 2) {
                float fb[8];
#pragma unroll
                for (int j = 0; j < 8; ++j) fb[j] = fbias[8 * fq + j];
#pragma unroll
                for (int ai = 0; ai < 2; ++ai) if (u.hm & (1 << ai))
#pragma unroll
                    for (int m = 0; m < 4; ++m) {
                        float* o = FL + (size_t)(row0 + ai * 128 + m * 16) * 16 + 8 * fq;
#pragma unroll
                        for (int n = 0; n < 2; ++n) { f32x4 r;
#pragma unroll
                            for (int j = 0; j < 4; ++j) { const float x = acc[ai][0][m][n][j] + fb[4 * n + j]; const float ls = x >= 0.f ? -log1pf(expf(-x)) : x - log1pf(expf(x)); r[j] = ls * LOG2E; }
                            *(f32x4*)(o + 4 * n) = r; }
                    }
            }
            return;
        }
        const int mode = (u.pn < 4 || (u.pn >= 6 && u.pn < 10)) ? 1 : (u.pn >= 18 ? 2 : 0);
        const int col0 = u.pn * 256 + wc * 32 + 8 * fq;
#pragma unroll
        for (int ai = 0; ai < 2; ++ai) if (u.hm & (1 << ai))
#pragma unroll
            for (int m = 0; m < 4; ++m) { bf16_t* rowp = Z + (size_t)(row0 + ai * 128 + m * 16) * ZP + col0;
#pragma unroll
                for (int bj = 0; bj < 2; ++bj) { f32x4 v0 = acc[ai][bj][m][0], v1 = acc[ai][bj][m][1];
                    if (mode == 1) { v0 = v0 * QSCALE; v1 = v1 * QSCALE; }
                    else if (mode == 2) {
#pragma unroll
                        for (int j = 0; j < 4; ++j) { v0[j] = sigmoidf_(v0[j]); v1[j] = sigmoidf_(v1[j]); } }
                    u32x4 w; w.x = cvtpk(v0[0], v0[1]); w.y = cvtpk(v0[2], v0[3]); w.z = cvtpk(v1[0], v1[1]); w.w = cvtpk(v1[2], v1[3]);
                    *(u32x4*)(rowp + bj * 128) = w; } }
    }
};
struct EpiMix {
    static constexpr bool MIDK = true;
    const bf16_t* Z; bf16_t* MIX;
    __device__ __forceinline__ void mid(f32x4 (&acc)[2][2][4][2], const Unit& u, int wr, int wc, int fr, int fq) const {
        int opq = 0; asm volatile("" : "+v"(opq));
        const int row0 = u.pm * 256 + wr * 64 + fr + opq, col0 = u.pn * 256 + wc * 32 + 8 * fq;
#pragma unroll
        for (int ai = 0; ai < 2; ++ai)
#pragma unroll
            for (int m = 0; m < 4; ++m) { const size_t row = (size_t)(row0 + ai * 128 + m * 16);
#pragma unroll
                for (int bj = 0; bj < 2; ++bj) {
                    const u32x4 gs = *(const u32x4*)(Z + row * ZP + ZGS + col0 + bj * 128), gf = *(const u32x4*)(Z + row * ZP + ZGF + col0 + bj * 128);
                    f32x4& v0 = acc[ai][bj][m][0]; f32x4& v1 = acc[ai][bj][m][1];
                    v0[0] *= bflo(gs.x) * __builtin_amdgcn_rcpf(bflo(gf.x)); v0[1] *= bfhi(gs.x) * __builtin_amdgcn_rcpf(bfhi(gf.x)); v0[2] *= bflo(gs.y) * __builtin_amdgcn_rcpf(bflo(gf.y)); v0[3] *= bfhi(gs.y) * __builtin_amdgcn_rcpf(bfhi(gf.y));
                    v1[0] *= bflo(gs.z) * __builtin_amdgcn_rcpf(bflo(gf.z)); v1[1] *= bfhi(gs.z) * __builtin_amdgcn_rcpf(bfhi(gf.z)); v1[2] *= bflo(gs.w) * __builtin_amdgcn_rcpf(bflo(gf.w)); v1[3] *= bfhi(gs.w) * __builtin_amdgcn_rcpf(bfhi(gf.w)); }
                asm volatile("" ::: "memory"); }
    }
    __device__ __forceinline__ void operator()(const f32x4 (&acc)[2][2][4][2], const Unit& u, int slot, int wr, int wc, int fr, int fq) const {
        const int row0 = u.pm * 256 + wr * 64 + fr, col0 = u.pn * 256 + wc * 32 + 8 * fq;
#pragma unroll
        for (int ai = 0; ai < 2; ++ai)
#pragma unroll
            for (int m = 0; m < 4; ++m) { const size_t row = (size_t)(row0 + ai * 128 + m * 16);
#pragma unroll
                for (int bj = 0; bj < 2; ++bj) {
                    const u32x4 g = *(const u32x4*)(Z + row * ZP + ZGF + col0 + bj * 128);
                    f32x4 v0 = acc[ai][bj][m][0], v1 = acc[ai][bj][m][1];
                    v0[0] *= bflo(g.x); v0[1] *= bfhi(g.x); v0[2] *= bflo(g.y); v0[3] *= bfhi(g.y);
                    v1[0] *= bflo(g.z); v1[1] *= bfhi(g.z); v1[2] *= bflo(g.w); v1[3] *= bfhi(g.w);
                    u32x4 w; w.x = cvtpk(v0[0], v0[1]); w.y = cvtpk(v0[2], v0[3]); w.z = cvtpk(v1[0], v1[1]); w.w = cvtpk(v1[2], v1[3]);
                    *(u32x4*)(MIX + row * D + col0 + bj * 128) = w; } }
    }
};
struct EpiOut {
    static constexpr bool MIDK = false;
    const float* X; float* H1; float* PSQ;
    __device__ __forceinline__ void operator()(const f32x4 (&acc)[2][2][4][2], const Unit& u, int slot, int wr, int wc, int fr, int fq) const {
        const int row0 = u.pm * 256 + wr * 64 + fr, col0 = u.pn * 256 + wc * 32 + 8 * fq;
#pragma unroll
        for (int ai = 0; ai < 2; ++ai) if (u.hm & (1 << ai))
#pragma unroll
            for (int m = 0; m < 4; ++m) { const size_t row = (size_t)(row0 + ai * 128 + m * 16); float sq = 0.f;
#pragma unroll
                for (int bj = 0; bj < 2; ++bj) {
                    const float* xp = X + row * D + col0 + bj * 128; float* hp = H1 + row * D + col0 + bj * 128;
                    const f32x4 x0 = *(const f32x4*)xp, x1 = *(const f32x4*)(xp + 4);
                    const f32x4 h0 = acc[ai][bj][m][0] + x0, h1 = acc[ai][bj][m][1] + x1;
                    *(f32x4*)hp = h0; *(f32x4*)(hp + 4) = h1;
                    sq += (h0[0] * h0[0] + h0[1] * h0[1]) + (h0[2] * h0[2] + h0[3] * h0[3]) + (h1[0] * h1[0] + h1[1] * h1[1]) + (h1[2] * h1[2] + h1[3] * h1[3]); }
                sq += __shfl_xor(sq, 16); sq += __shfl_xor(sq, 32);
                if (fq == 0) PSQ[row * 32 + u.pn * 4 + wc] = sq; }
    }
};
__device__ __forceinline__ unsigned pk_fp8x4(float a, float b, float c, float d) {
    a = __builtin_amdgcn_fmed3f(a, -448.f, 448.f); b = __builtin_amdgcn_fmed3f(b, -448.f, 448.f); c = __builtin_amdgcn_fmed3f(c, -448.f, 448.f); d = __builtin_amdgcn_fmed3f(d, -448.f, 448.f);
    int r = __builtin_amdgcn_cvt_pk_fp8_f32(a, b, 0, false); r = __builtin_amdgcn_cvt_pk_fp8_f32(c, d, r, true); return (unsigned)r;
}
constexpr float WGU_SCALE = 32.f, WD_SCALE = 16.f;
struct EpiSwiglu {
    static constexpr bool MIDK = false;
    const MoeSched<0>* S; unsigned char* HB8;
    __device__ __forceinline__ void operator()(const f32x4 (&acc)[2][2][4][2], const Unit& u, int slot, int wr, int wc, int fr, int fq) const {
        const int ff0 = u.pn * 128 + wc * 32 + 8 * fq;
#pragma unroll
        for (int ai = 0; ai < 2; ++ai) if (u.hm & (1 << ai))
#pragma unroll
            for (int m = 0; m < 4; ++m) { const int a = S->rowA[slot * 256 + ai * 128 + wr * 64 + m * 16 + fr];
                if (a >= 0) { float h[8];
#pragma unroll
                    for (int n = 0; n < 2; ++n)
#pragma unroll
                        for (int j = 0; j < 4; ++j) { const float g = acc[ai][0][m][n][j] * (1.f / WGU_SCALE), up = acc[ai][1][m][n][j] * (1.f / WGU_SCALE); h[4 * n + j] = g * sigmoidf_(g) * up; }
                    u32x2 w; w.x = pk_fp8x4(h[0], h[1], h[2], h[3]); w.y = pk_fp8x4(h[4], h[5], h[6], h[7]);
                    *(u32x2*)(HB8 + (size_t)a * FF + ff0) = w; } }
    }
};
constexpr float YB_SCALE = 16.f;
struct EpiDown {
    static constexpr bool MIDK = false;
    const MoeSched<1>* S; unsigned char* YB8;
    __device__ __forceinline__ void operator()(const f32x4 (&acc)[2][2][4][2], const Unit& u, int slot, int wr, int wc, int fr, int fq) const {
        const int col0 = u.pn * 256 + wc * 32 + 8 * fq;
#pragma unroll
        for (int ai = 0; ai < 2; ++ai) if (u.hm & (1 << ai))
#pragma unroll
            for (int m = 0; m < 4; ++m) { const int ri = slot * 256 + ai * 128 + wr * 64 + m * 16 + fr; const int a = S->rowA[ri];
                if (a >= 0) { const float w8 = S->rowW[ri] * (YB_SCALE / WD_SCALE);
#pragma unroll
                    for (int bj = 0; bj < 2; ++bj) { const f32x4 v0 = acc[ai][bj][m][0] * w8, v1 = acc[ai][bj][m][1] * w8;
                        u32x2 w; w.x = pk_fp8x4(v0[0], v0[1], v0[2], v0[3]); w.y = pk_fp8x4(v1[0], v1[1], v1[2], v1[3]);
                        *(u32x2*)(YB8 + (size_t)a * D + col0 + bj * 128) = w; } } }
    }
};

struct P0Item { const float* src; unsigned char* dst; int ldw, nvalid, K, fp8; float scale; };
__device__ __forceinline__ void p0_map(int r, int NB, int& kp, int& nb) { kp = r / NB; nb = r % NB; }
__device__ __forceinline__ P0Item p0_decode(int pr, int half, const Args& a, unsigned char* ws) {
    constexpr int P_IN = 16 * 140, P_SW = 8 * 32, P_OUT = 16 * 32, P_GU = 16 * 8, P_DN = 4 * 32, P_EXP = 2 * P_GU + P_DN;
    P0Item q; q.fp8 = 0; q.scale = 1.f; int r = pr;
    if (r < P_IN) { int kp, nb; p0_map(r, 140, kp, nb); const int kb = 2 * kp + half, n0 = nb * 64;
        int c0, nv; if (n0 < 4608) { c0 = n0; nv = 64; } else if (n0 < 8704) { c0 = n0 + 16; nv = 64; } else if (n0 == 8704) { c0 = 4608; nv = 16; } else { c0 = 0; nv = 0; }
        q.src = a.in[2] + (size_t)kb * 64 * 8720 + c0; q.ldw = 8720; q.nvalid = nv; q.K = D; q.dst = ws + WS_WINT + ((size_t)n0 * D + kb * 64) * 2; return q; }
    r -= P_IN;
    if (r < P_SW) { int kp, nb; p0_map(r, 32, kp, nb); const int kb = 2 * kp + half; q.src = a.in[5] + (size_t)kb * 64 * D + nb * 64; q.ldw = D; q.nvalid = 64; q.K = D; q.dst = ws + WS_WSWAT + ((size_t)nb * 64 * D + kb * 64) * 2; return q; }
    r -= P_SW;
    if (r < P_SW) { int kp, nb; p0_map(r, 32, kp, nb); const int kb = 2 * kp + half; q.src = a.in[6] + (size_t)kb * 64 * D + nb * 64; q.ldw = D; q.nvalid = 64; q.K = D; q.dst = ws + WS_WSWAT + ((size_t)nb * 64 * D + 1024 + kb * 64) * 2; return q; }
    r -= P_SW;
    if (r < P_OUT) { int kp, nb; p0_map(r, 32, kp, nb); const int kb = 2 * kp + half; q.src = a.in[7] + (size_t)kb * 64 * D + nb * 64; q.ldw = D; q.nvalid = 64; q.K = D; q.dst = ws + WS_WOUTT + ((size_t)nb * 64 * D + kb * 64) * 2; return q; }
    r -= P_OUT;
    const int e = r / P_EXP; r -= e * P_EXP; q.fp8 = 1;
    if (r < 2 * P_GU) { const int up = r >= P_GU; r -= up * P_GU; int kp, nb; p0_map(r, 8, kp, nb); const int kb = 2 * kp + half, n0 = nb * 64;
        const float* src = e < 64 ? (up ? a.in[12] : a.in[11]) + (size_t)e * D * FF : (up ? a.in[15] : a.in[14]);
        const int drow = 256 * (n0 >> 7) + (n0 & 127) + 128 * up;
        q.src = src + (size_t)kb * 64 * FF + n0; q.ldw = FF; q.nvalid = 64; q.K = D; q.scale = WGU_SCALE; q.dst = ws + WS_WGU + ((size_t)e * 1024 + drow) * D + kb * 64; return q; }
    r -= 2 * P_GU;
    { int kp, nb; p0_map(r, 32, kp, nb); const int kb = 2 * kp + half;
        const float* src = e < 64 ? a.in[13] + (size_t)e * FF * D : a.in[16];
        q.src = src + (size_t)kb * 64 * D + nb * 64; q.ldw = D; q.nvalid = 64; q.K = FF; q.scale = WD_SCALE; q.dst = ws + WS_WD + ((size_t)e * D + nb * 64) * FF + kb * 64; return q; }
}
__device__ __forceinline__ void p0_load(const P0Item& q, f32x4 (&v)[16], int lane) {
    const int kr = lane >> 4, nc = (lane & 15) * 4; const bool ok = nc < q.nvalid;
    const float* p = q.src + (size_t)kr * q.ldw + nc;
#pragma unroll
    for (int i = 0; i < 16; ++i) v[i] = ok ? *(const f32x4*)(p + (size_t)(4 * i) * q.ldw) : (f32x4){0.f, 0.f, 0.f, 0.f};
}
__device__ __forceinline__ void p0_process(const P0Item& q, const f32x4 (&v)[16], LAS float* scr, int lane) {
    const int kr = lane >> 4, nc = (lane & 15) * 4;
#pragma unroll
    for (int i = 0; i < 16; ++i) { LAS float* w = scr + (4 * i + kr) * 65 + nc; w[0] = v[i][0]; w[1] = v[i][1]; w[2] = v[i][2]; w[3] = v[i][3]; }
    LDS_WAIT(); asm volatile("" ::: "memory");
    const int c = lane & 7;
#pragma unroll
    for (int j = 0; j < 8; ++j) { const int n = (lane >> 3) + 8 * j; const LAS float* s = scr + (8 * c) * 65 + n;
        u32x4 o; o.x = cvtpk(s[0 * 65], s[1 * 65]); o.y = cvtpk(s[2 * 65], s[3 * 65]); o.z = cvtpk(s[4 * 65], s[5 * 65]); o.w = cvtpk(s[6 * 65], s[7 * 65]);
        *(u32x4*)(q.dst + ((size_t)n * q.K + 8 * c) * 2) = o; }
    LDS_WAIT(); asm volatile("" ::: "memory");
}
__device__ __forceinline__ void p0_load8(const P0Item& q, f32x4 (&v)[16], int lane) {
    const int kq = lane >> 4, nc = (lane & 15) * 4;
    const float* p = q.src + (size_t)(16 * kq) * q.ldw + nc;
#pragma unroll
    for (int i = 0; i < 16; ++i) v[i] = __builtin_nontemporal_load((const f32x4*)(p + (size_t)i * q.ldw));
}
__device__ __forceinline__ void p0_pack8(const f32x4 (&v)[16], float sc, LAS unsigned char* tile, int chunk, int m) {
#pragma unroll
    for (int j = 0; j < 4; ++j) { const int n = 4 * m + j; u32x4 o;
        o.x = pk_fp8x4(v[0][j] * sc, v[1][j] * sc, v[2][j] * sc, v[3][j] * sc); o.y = pk_fp8x4(v[4][j] * sc, v[5][j] * sc, v[6][j] * sc, v[7][j] * sc);
        o.z = pk_fp8x4(v[8][j] * sc, v[9][j] * sc, v[10][j] * sc, v[11][j] * sc); o.w = pk_fp8x4(v[12][j] * sc, v[13][j] * sc, v[14][j] * sc, v[15][j] * sc);
        *(LAS u32x4*)(tile + n * 128 + ((chunk ^ ((n >> 2) & 7)) * 16)) = o; }
}
__device__ __forceinline__ void p0_prologue(Frame& F, const Args& a) {
    LAS float* scr = (LAS float*)(F.lds + F.wave * 16640);
    const int gw = F.vcu * NWAVES + F.wave, NGW = F.G * NWAVES;
    unsigned char* ws = F.ws;
    {
        const float* g = a.in[1];
        for (int m = gw; m < T; m += NGW) {
            const f32x4* xr = (const f32x4*)(a.in[0] + (size_t)m * D) + F.lane;
            f32x4 v[8]; float s = 0.f;
#pragma unroll
            for (int j = 0; j < 8; ++j) { v[j] = xr[64 * j]; s += (v[j].x * v[j].x + v[j].y * v[j].y) + (v[j].z * v[j].z + v[j].w * v[j].w); }
            const float rinv = rsqrtf(wave_sum(s) * (1.f / D) + RMS_EPS);
            u32x2* o = (u32x2*)((bf16_t*)(ws + WS_U) + (size_t)m * D) + F.lane;
#pragma unroll
            for (int j = 0; j < 8; ++j) { const f32x4 gg = *((const f32x4*)g + F.lane + 64 * j); u32x2 w; w.x = cvtpk(v[j].x * rinv * gg.x, v[j].y * rinv * gg.y); w.y = cvtpk(v[j].z * rinv * gg.z, v[j].w * rinv * gg.w); o[64 * j] = w; }
        }
    }
    {
        const float* wr = a.in[9]; const float* g = a.in[8]; u32x4* o = (u32x4*)(ws + WS_WRG);
        for (int i = gw * 64 + F.lane; i < 256 * NE; i += NGW * 64) { const int kb8 = i >> 6, e = i & 63; float x[8]; u32x4 h, l;
#pragma unroll
            for (int j = 0; j < 8; ++j) x[j] = wr[(size_t)(8 * kb8 + j) * NE + e] * g[8 * kb8 + j];
            h.x = cvtpk(x[0], x[1]); h.y = cvtpk(x[2], x[3]); h.z = cvtpk(x[4], x[5]); h.w = cvtpk(x[6], x[7]);
            l.x = cvtpk(x[0] - bflo(h.x), x[1] - bfhi(h.x)); l.y = cvtpk(x[2] - bflo(h.y), x[3] - bfhi(h.y)); l.z = cvtpk(x[4] - bflo(h.z), x[5] - bfhi(h.z)); l.w = cvtpk(x[6] - bflo(h.w), x[7] - bfhi(h.w));
            o[i] = h; o[16384 + i] = l; }
    }
    constexpr int NB16 = 16 * 140 + 2 * 8 * 32 + 16 * 32, NPAIRS = NB16 + 65 * (2 * 16 * 8 + 4 * 32);
    constexpr int REP = (PROBE_DUP == 0 || PROBE_DUP == 11) ? 2 : (PROBE_DUP == 10 ? 3 : 1);
    f32x4 va[16], vb[16]; P0Item qa, qb;
    {
        const int nj = (NB16 + NGW - 1) / NGW;
        int pr = gw;
        if (pr < NB16) { qa = p0_decode(pr, 0, a, ws); p0_load(qa, va, F.lane); }
        for (int j = 0; j < nj; ++j) {
            const bool act = pr < NB16;
            if (act) { qb = p0_decode(pr, 1, a, ws); p0_load(qb, vb, F.lane); }
            if (act) p0_process(qa, va, scr, F.lane);
            __builtin_amdgcn_s_barrier();
            const int pn = pr + NGW;
            if (pn < NB16) { qa = p0_decode(pn, 0, a, ws); p0_load(qa, va, F.lane); }
            if (act) p0_process(qb, vb, scr, F.lane);
            __builtin_amdgcn_s_barrier();
            pr = pn;
        }
    }
    {
        constexpr int NF = (NPAIRS - NB16) * REP;
        const int nj = (NF + NGW - 1) / NGW;
        LAS unsigned char* tile = (LAS unsigned char*)scr;
        const int kq = F.lane >> 4, m = F.lane & 15;
        int pr = gw;
        if (pr < NF) { qa = p0_decode(NB16 + pr % (NPAIRS - NB16), 0, a, ws); p0_load8(qa, va, F.lane); }
        for (int j = 0; j < nj; ++j) {
            const bool act = pr < NF;
            if (act) { qb = p0_decode(NB16 + pr % (NPAIRS - NB16), 1, a, ws); p0_load8(qb, vb, F.lane); }
            if (act) p0_pack8(va, qa.scale, tile, kq, m);
            __builtin_amdgcn_s_barrier();
            const int pn = pr + NGW;
            const P0Item qc = qa;
            if (pn < NF) { qa = p0_decode(NB16 + pn % (NPAIRS - NB16), 0, a, ws); p0_load8(qa, va, F.lane); }
            if (act) {
                p0_pack8(vb, qb.scale, tile, 4 + kq, m);
                LDS_WAIT(); asm volatile("" ::: "memory");
                const bool st = !(PROBE_DUP == 11 && pr >= NPAIRS - NB16);
                const int c = F.lane & 7;
#pragma unroll
                for (int jj = 0; jj < 8; ++jj) { const int n = (F.lane >> 3) + 8 * jj;
                    const u32x4 o = *(const LAS u32x4*)(tile + n * 128 + ((c ^ ((n >> 2) & 7)) * 16));
                    if (st) *(u32x4*)(qc.dst + (size_t)n * qc.K + 16 * c) = o; else asm volatile("" :: "v"(o)); }
                LDS_WAIT(); asm volatile("" ::: "memory");
            }
            __builtin_amdgcn_s_barrier();
            pr = pn;
        }
    }
}

__device__ __forceinline__ int crow(int r, int hi) { return (r & 3) + 8 * (r >> 2) + 4 * hi; }
__device__ __forceinline__ s16x4 vtr(LAS const char* p) { typedef short v4i16_t __attribute__((ext_vector_type(4))); return __builtin_bit_cast(s16x4, __builtin_amdgcn_ds_read_tr16_b64_v4i16((LAS v4i16_t*)p)); }

__device__ __forceinline__ void attn_qk(f32x16 (&p)[2], const bf16x8 (&qf)[4], LAS const char* Kt, int r32, int hi) {
#pragma unroll
    for (int kb = 0; kb < 2; ++kb) { const int kv = 32 * kb + r32; const int sw = (kv >> 1) & 7; LAS const char* rowp = Kt + kv * 128;
        f32x16 c = p[kb];
#pragma unroll
        for (int s = 0; s < 4; ++s) { const bf16x8 a = *(const LAS bf16x8*)(rowp + (((2 * s + hi) ^ sw) * 16)); c = __builtin_amdgcn_mfma_f32_32x32x16_bf16(a, qf[s], c, 0, 0, 0); }
        p[kb] = c; }
}
constexpr float ATT_THR = 8.0f;
__device__ __forceinline__ void attn_softmax_pv(f32x16 (&p)[2], f32x16 (&o)[2], float& m, float& l, LAS const char* Vt, int lane) {
    float mx = fmaxf(p[0][0], p[1][0]);
#pragma unroll
    for (int r = 1; r < 16; ++r) mx = fmaxf(mx, fmaxf(p[0][r], p[1][r]));
    mx = fmaxf(mx, __shfl_xor(mx, 32));
    if (__any(mx > ATT_THR)) {
        const float d = fmaxf(mx, 0.f), alpha = __builtin_amdgcn_exp2f(-d);
        m += d; l *= alpha;
#pragma unroll
        for (int kb = 0; kb < 2; ++kb)
#pragma unroll
            for (int r = 0; r < 16; ++r) p[kb][r] -= d;
#pragma unroll
        for (int db = 0; db < 2; ++db)
#pragma unroll
            for (int r = 0; r < 16; ++r) o[db][r] *= alpha;
    }
    float rs = 0.f;
#pragma unroll
    for (int kb = 0; kb < 2; ++kb)
#pragma unroll
        for (int r = 0; r < 16; ++r) { const float e = __builtin_amdgcn_exp2f(p[kb][r]); p[kb][r] = e; rs += e; }
    rs += __shfl_xor(rs, 32);
    l += rs;
    const int g = lane >> 4, i = lane & 15;
    LAS const char* vb = Vt + (4 * (g >> 1) + (i >> 2)) * 64 + (g & 1) * 32 + (i & 3) * 8;
#pragma unroll
    for (int kb = 0; kb < 2; ++kb)
#pragma unroll
        for (int ks = 0; ks < 2; ++ks) {
            u32x4 pw; pw.x = cvtpk(p[kb][8 * ks + 0], p[kb][8 * ks + 1]); pw.y = cvtpk(p[kb][8 * ks + 2], p[kb][8 * ks + 3]); pw.z = cvtpk(p[kb][8 * ks + 4], p[kb][8 * ks + 5]); pw.w = cvtpk(p[kb][8 * ks + 6], p[kb][8 * ks + 7]);
            const bf16x8 pb = __builtin_bit_cast(bf16x8, pw);
#pragma unroll
            for (int db = 0; db < 2; ++db) {
                const s16x4 lo = vtr(vb + db * 4096 + (32 * kb + 16 * ks) * 64), hi4 = vtr(vb + db * 4096 + (32 * kb + 16 * ks + 8) * 64);
                const bf16x8 va = (bf16x8){lo[0], lo[1], lo[2], lo[3], hi4[0], hi4[1], hi4[2], hi4[3]};
                o[db] = __builtin_amdgcn_mfma_f32_32x32x16_bf16(va, pb, o[db], 0, 0, 0); } }
}
__device__ __forceinline__ void attn_store_kv(LAS char* Kt, LAS char* Vt, const u32x4& kr, const u32x4& vr, int tid) {
    const int kv = tid >> 3, c = tid & 7;
    *(LAS u32x4*)(Kt + kv * 128 + ((c ^ ((kv >> 1) & 7)) * 16)) = kr;
    *(LAS u32x4*)(Vt + (c >> 2) * 4096 + kv * 64 + (c & 3) * 16) = vr;
}
__device__ __forceinline__ void attn_store_o(const f32x16 (&o)[2], float l, bf16_t* orow, int hi) {
    const float rl = 1.0f / l;
#pragma unroll
    for (int db = 0; db < 2; ++db)
#pragma unroll
        for (int rq = 0; rq < 4; ++rq) { u32x2 w; w.x = cvtpk(o[db][4 * rq] * rl, o[db][4 * rq + 1] * rl); w.y = cvtpk(o[db][4 * rq + 2] * rl, o[db][4 * rq + 3] * rl);
            *(u32x2*)(orow + 32 * db + 8 * rq + 4 * hi) = w; }
}

__device__ __forceinline__ void swa_unit(Frame& F, int unit, const float* sinks) {
    const bf16_t* Z = (const bf16_t*)(F.ws + WS_Z); bf16_t* YS = (bf16_t*)(F.ws + WS_YS);
    const int b = unit >> 6, kvh = (unit >> 4) & 3, nb = unit & 15;
    const int tid = F.tid, lane = F.lane, r32 = lane & 31, hi = lane >> 5, w = F.wave;
    LAS char* Kl = (LAS char*)F.lds; LAS char* Vl = (LAS char*)F.lds + 32768;
    const int t0 = nb * 128;
    {
        const int kv = tid >> 3, c = tid & 7;
#pragma unroll
        for (int tl = 0; tl < 4; ++tl) {
            if (nb > 0 || tl >= 2) {
                const size_t row = (size_t)(b * SEQ + t0 - 128 + tl * 64 + kv);
                const u32x4 kr = *(const u32x4*)(Z + row * ZP + ZK + kvh * 64 + c * 8);
                const u32x4 vr = *(const u32x4*)(Z + row * ZP + ZV + kvh * 64 + c * 8);
                attn_store_kv(Kl + tl * 8192, Vl + tl * 8192, kr, vr, tid);
            }
        }
    }
    __syncthreads();
    const int qh = kvh * 4 + (w >> 1);
    const float slope2 = exp2f(-0.5f * (float)(qh + 1)) * LOG2E;
    const float sink2 = sinks[qh] * LOG2E;
#pragma unroll 1
    for (int sb = 0; sb < 2; ++sb) {
        const int r0 = 64 * (w & 1) + 32 * sb;
        const int qrel = r0 + r32;
        const size_t qrow = (size_t)(b * SEQ + t0 + qrel);
        bf16x8 qf[4];
#pragma unroll
        for (int s = 0; s < 4; ++s) qf[s] = *(const bf16x8*)(Z + qrow * ZP + ZQ + qh * 64 + 16 * s + 8 * hi);
        f32x16 o[2]; o[0] = f32x16{}; o[1] = f32x16{};
        float m = sink2, l = 1.0f;
        const int tl0 = (r0 + 1) >> 6;
#pragma unroll 1
        for (int tt = 0; tt < 3; ++tt) {
            const int tl = tl0 + tt;
            if (nb == 0 && tl < 2) continue;
            f32x16 p[2];
            const float qterm = -slope2 * (float)qrel - m;
#pragma unroll
            for (int kb = 0; kb < 2; ++kb)
#pragma unroll
                for (int r = 0; r < 16; ++r) p[kb][r] = fmaf(slope2, (float)(tl * 64 + 32 * kb + crow(r, hi) - 128), qterm);
            attn_qk(p, qf, Kl + tl * 8192, r32, hi);
#pragma unroll
            for (int kb = 0; kb < 2; ++kb)
#pragma unroll
                for (int r = 0; r < 16; ++r) {
                    const int dist = qrel - (tl * 64 + 32 * kb + crow(r, hi) - 128);
                    if (!(dist >= 0 && dist < 128)) p[kb][r] = -INFINITY;
                }
            attn_softmax_pv(p, o, m, l, Vl + tl * 8192, lane);
        }
        attn_store_o(o, l, YS + qrow * 2048 + qh * 64, hi);
    }
    __syncthreads();
}

__device__ __forceinline__ void fox_unit(Frame& F, int bh, int qb, LAS const float* c2) {
    const bf16_t* Z = (const bf16_t*)(F.ws + WS_Z); bf16_t* YF = (bf16_t*)(F.ws + WS_YS);
    const int b = bh >> 4, h = bh & 15;
    const int tid = F.tid, lane = F.lane, r32 = lane & 31, hi = lane >> 5, w = F.wave;
    LAS char* Kl = (LAS char*)F.lds; LAS char* Vl = (LAS char*)F.lds + 16384;
    const int q0 = qb * 256, qw = q0 + 32 * w, qabs = qw + r32;
    const size_t qrow = (size_t)(b * SEQ + qabs);
    const int NT = 4 * (qb + 1);
    const int kvr = tid >> 3, kc = tid & 7;
    const bf16_t* kbase = Z + (size_t)(b * SEQ + kvr) * ZP + ZFK + h * 64 + kc * 8;
    const bf16_t* vbase = Z + (size_t)(b * SEQ + kvr) * ZP + ZFV + h * 64 + kc * 8;
    u32x4 kra = *(const u32x4*)kbase, vra = *(const u32x4*)vbase;
    u32x4 krb = *(const u32x4*)(kbase + (size_t)64 * ZP), vrb = *(const u32x4*)(vbase + (size_t)64 * ZP);
    bf16x8 qf[4];
#pragma unroll
    for (int s = 0; s < 4; ++s) qf[s] = *(const bf16x8*)(Z + qrow * ZP + ZFQ + h * 64 + 16 * s + 8 * hi);
    attn_store_kv(Kl, Vl, kra, vra, tid);
    __syncthreads();
    f32x16 o[2]; o[0] = f32x16{}; o[1] = f32x16{};
    float m = -c2[qabs], l = 0.f;
#define FOX_STEP(t, KRN, VRN, KRC, VRC) do { \
        const int buf = (t) & 1; \
        if ((t) + 2 < NT) { KRN = *(const u32x4*)(kbase + (size_t)((t) + 2) * 64 * ZP); VRN = *(const u32x4*)(vbase + (size_t)((t) + 2) * 64 * ZP); } \
        const int k0 = (t) * 64; \
        if (k0 <= qw + 31) { \
            f32x16 p[2]; const float negm = -m; \
            _Pragma("unroll") for (int kb = 0; kb < 2; ++kb) _Pragma("unroll") for (int rq = 0; rq < 4; ++rq) { const f32x4 cc = *(const LAS f32x4*)(c2 + k0 + 32 * kb + 8 * rq + 4 * hi); \
                _Pragma("unroll") for (int j = 0; j < 4; ++j) p[kb][4 * rq + j] = negm - cc[j]; } \
            attn_qk(p, qf, Kl + buf * 8192, r32, hi); \
            if (k0 + 63 > qw) { _Pragma("unroll") for (int kb = 0; kb < 2; ++kb) _Pragma("unroll") for (int r = 0; r < 16; ++r) if (k0 + 32 * kb + crow(r, hi) > qabs) p[kb][r] = -INFINITY; } \
            attn_softmax_pv(p, o, m, l, Vl + buf * 8192, lane); \
        } \
        if ((t) + 1 < NT) attn_store_kv(Kl + (buf ^ 1) * 8192, Vl + (buf ^ 1) * 8192, KRC, VRC, tid); \
        __syncthreads(); } while (0)
#pragma unroll 1
    for (int t = 0; t < NT; t += 2) {
        FOX_STEP(t, kra, vra, krb, vrb);
        FOX_STEP(t + 1, krb, vrb, kra, vra);
    }
#undef FOX_STEP
    attn_store_o(o, l, YF + qrow * 2048 + 1024 + h * 64, hi);
}
__device__ __forceinline__ void p2_attention(Frame& F, const Args& a) {
    for (int u = F.vcu; u < 256; u += F.G) swa_unit(F, u, a.in[4]);
    LAS float* c2 = (LAS float*)(F.lds + 32768);
    LAS float* wtot = (LAS float*)(F.lds + 32768 + 8192);
    const float* FL = (const float*)(F.ws + WS_FL);
    for (int it = F.vcu; it < 256; it += F.G) {
        const int bh = it >> 2, s = it & 3, b = bh >> 4, h = bh & 15;
        {
            float v[4]; float run = 0.f;
#pragma unroll
            for (int j = 0; j < 4; ++j) { run += FL[(size_t)(b * SEQ + 4 * F.tid + j) * 16 + h]; v[j] = run; }
            float inc = run;
#pragma unroll
            for (int o = 1; o < 64; o <<= 1) { const float n = __shfl_up(inc, o); if (F.lane >= o) inc += n; }
            if (F.lane == 63) wtot[F.wave] = inc;
            __syncthreads();
            float base = inc - run;
            for (int ww = 0; ww < F.wave; ++ww) base += wtot[ww];
#pragma unroll
            for (int j = 0; j < 4; ++j) c2[4 * F.tid + j] = base + v[j];
            __syncthreads();
        }
        fox_unit(F, bh, s, c2);
        fox_unit(F, bh, 7 - s, c2);
        __syncthreads();
    }
}

__device__ __forceinline__ void p5_router(Frame& F, const Args& a, unsigned* CNT, float* LISTW, int* LIST) {
    const float* H1 = (const float*)(F.ws + WS_H1); const float* PSQ = (const float*)(F.ws + WS_PSQ);
    unsigned char* V8 = F.ws + WS_V;
    const float* g = a.in[8]; const float* rbias = a.in[10];
    const int lane = F.lane, w = F.wave, tid = F.tid;
    LAS float* part = (LAS float*)F.lds;
    LAS float* logit = (LAS float*)(F.lds + 65536);
    LAS float* rinvs = (LAS float*)(F.lds + 65536 + 8192);
    LAS int* lcnt = (LAS int*)(F.lds + 65536 + 8192 + 128);
    LAS int* gbase = (LAS int*)(F.lds + 65536 + 8192 + 128 + 256);
    for (int tile = F.vcu; tile < T / 32; tile += F.G) {
        const int tok0 = tile * 32;
        if (tid < 64) lcnt[tid] = 0;
#pragma unroll
        for (int j = 0; j < 4; ++j) {
            const int tok = tok0 + 4 * w + j;
            float sq = lane < 32 ? PSQ[(size_t)tok * 32 + lane] : 0.f;
            sq = wave_sum(sq);
            const float rinv = rsqrtf(sq * (1.f / D) + RMS_EPS);
            if (lane == 0) rinvs[4 * w + j] = rinv;
            const f32x4* hr = (const f32x4*)(H1 + (size_t)tok * D) + lane;
            unsigned* o = (unsigned*)(V8 + (size_t)tok * D) + lane;
#pragma unroll
            for (int jj = 0; jj < 8; ++jj) { const f32x4 hv = hr[64 * jj]; const f32x4 gg = *((const f32x4*)g + lane + 64 * jj);
                o[64 * jj] = pk_fp8x4(hv.x * rinv * gg.x, hv.y * rinv * gg.y, hv.z * rinv * gg.z, hv.w * rinv * gg.w); }
        }
        {
            f32x16 acc0 = {}, acc1 = {};
            const int tk = lane & 31, half = lane >> 5;
            const float* hp = H1 + (size_t)(tok0 + tk) * D + 256 * w + 8 * half;
            const u32x4* wh = (const u32x4*)(F.ws + WS_WRG) + (size_t)(32 * w + half) * 64 + tk;
            const u32x4* wl = wh + 16384;
#pragma unroll 4
            for (int s16 = 0; s16 < 16; ++s16) {
                const f32x4 x0 = *(const f32x4*)(hp + 16 * s16), x1 = *(const f32x4*)(hp + 16 * s16 + 4);
                const u32x4 bh0 = wh[(size_t)(2 * s16) * 64], bh1 = wh[(size_t)(2 * s16) * 64 + 32], bl0 = wl[(size_t)(2 * s16) * 64], bl1 = wl[(size_t)(2 * s16) * 64 + 32];
                u32x4 ah, al;
                ah.x = cvtpk(x0[0], x0[1]); ah.y = cvtpk(x0[2], x0[3]); ah.z = cvtpk(x1[0], x1[1]); ah.w = cvtpk(x1[2], x1[3]);
                al.x = cvtpk(x0[0] - bflo(ah.x), x0[1] - bfhi(ah.x)); al.y = cvtpk(x0[2] - bflo(ah.y), x0[3] - bfhi(ah.y)); al.z = cvtpk(x1[0] - bflo(ah.z), x1[1] - bfhi(ah.z)); al.w = cvtpk(x1[2] - bflo(ah.w), x1[3] - bfhi(ah.w));
                const bf16x8 AH = __builtin_bit_cast(bf16x8, ah), AL = __builtin_bit_cast(bf16x8, al);
                acc0 = __builtin_amdgcn_mfma_f32_32x32x16_bf16(AH, __builtin_bit_cast(bf16x8, bh0), acc0, 0, 0, 0);
                acc1 = __builtin_amdgcn_mfma_f32_32x32x16_bf16(AH, __builtin_bit_cast(bf16x8, bh1), acc1, 0, 0, 0);
                acc0 = __builtin_amdgcn_mfma_f32_32x32x16_bf16(AH, __builtin_bit_cast(bf16x8, bl0), acc0, 0, 0, 0);
                acc1 = __builtin_amdgcn_mfma_f32_32x32x16_bf16(AH, __builtin_bit_cast(bf16x8, bl1), acc1, 0, 0, 0);
                acc0 = __builtin_amdgcn_mfma_f32_32x32x16_bf16(AL, __builtin_bit_cast(bf16x8, bh0), acc0, 0, 0, 0);
                acc1 = __builtin_amdgcn_mfma_f32_32x32x16_bf16(AL, __builtin_bit_cast(bf16x8, bh1), acc1, 0, 0, 0);
            }
#pragma unroll
            for (int r = 0; r < 16; ++r) { const int tr = crow(r, half); part[(w * 32 + tr) * 64 + tk] = acc0[r]; part[(w * 32 + tr) * 64 + 32 + tk] = acc1[r]; }
        }
        __syncthreads();
#pragma unroll
        for (int q = 0; q < 4; ++q) { const int idx = tid + 512 * q; float s = 0.f;
#pragma unroll
            for (int ww = 0; ww < 8; ++ww) s += part[ww * 2048 + idx];
            logit[idx] = s * rinvs[idx >> 6]; }
        __syncthreads();
        int sel_k[4], sel_ls[4]; float sel_w[4];
        const float bias = rbias[lane];
#pragma unroll
        for (int j = 0; j < 4; ++j) {
            const int tl = 4 * w + j;
            const float score = sigmoidf_(logit[tl * 64 + lane]);
            const float biased = score + bias;
            float m1 = biased; m1 = fmaxf(m1, __shfl_xor(m1, 1)); m1 = fmaxf(m1, __shfl_xor(m1, 2)); m1 = fmaxf(m1, __shfl_xor(m1, 4));
            const unsigned long long gm = 0xFFull << (lane & 56);
            const unsigned long long b1 = __ballot(biased == m1) & gm;
            const int i1 = __builtin_ctzll(b1);
            float v2 = (lane == i1) ? -INFINITY : biased;
            float m2 = v2; m2 = fmaxf(m2, __shfl_xor(m2, 1)); m2 = fmaxf(m2, __shfl_xor(m2, 2)); m2 = fmaxf(m2, __shfl_xor(m2, 4));
            const float gs = m1 + m2; const int gi = lane >> 3;
            int rank = 0;
#pragma unroll
            for (int gg = 0; gg < 8; ++gg) { const float o = __shfl(gs, 8 * gg); rank += (o > gs || (o == gs && gg < gi)) ? 1 : 0; }
            float mv = rank < 4 ? biased : -INFINITY;
            int myk = -1;
#pragma unroll
            for (int it = 0; it < 8; ++it) { const float mx = wave_max(mv); const unsigned long long bb = __ballot(mv == mx); const int sl = __builtin_ctzll(bb); if (lane == sl) { myk = it; mv = -INFINITY; } }
            const float ssum = wave_sum(myk >= 0 ? score : 0.f);
            sel_k[j] = myk; sel_w[j] = score / ssum * 2.5f;
            sel_ls[j] = 0;
            if (myk >= 0) sel_ls[j] = __hip_atomic_fetch_add((LAS int*)&lcnt[lane], 1, __ATOMIC_RELAXED, __HIP_MEMORY_SCOPE_WORKGROUP);
        }
        __syncthreads();
        if (tid < 64) gbase[tid] = (int)atomicAdd(CNT + tid, (unsigned)lcnt[tid]);
        __syncthreads();
#pragma unroll
        for (int j = 0; j < 4; ++j) if (sel_k[j] >= 0) { const int tok = tok0 + 4 * w + j; const int aid = tok * 8 + sel_k[j];
            const size_t li = (size_t)lane * T + gbase[lane] + sel_ls[j]; LIST[li] = aid; LISTW[li] = sel_w[j]; }
        __syncthreads();
    }
}

template <int MULT> __device__ __forceinline__ int moe_table(Frame& F, LAS int* tab) {
    if (F.tid < 64) {
        const int cnt = (int)__hip_atomic_load(F.ctl + CW_CNT + F.tid, __ATOMIC_RELAXED, __HIP_MEMORY_SCOPE_AGENT);
        int inc = ((cnt + 255) >> 8) * MULT;
#pragma unroll
        for (int o = 1; o < 64; o <<= 1) { const int n = __shfl_up(inc, o); if (F.lane >= o) inc += n; }
        tab[F.tid] = inc; tab[64 + F.tid] = cnt;
    }
    __syncthreads();
    return 32 * MULT + tab[63];
}

__device__ __forceinline__ void p8_final(Frame& F, const Args& a) {
    const float* H1 = (const float*)(F.ws + WS_H1); const unsigned char* YB8 = F.ws + WS_YB; const float* g = a.in[17];
    const int gw = F.vcu * NWAVES + F.wave, NGW = F.G * NWAVES;
    for (int tok = gw; tok < T; tok += NGW) {
        const f32x4* hr = (const f32x4*)(H1 + (size_t)tok * D) + F.lane;
        f32x4 v[8], y[8];
#pragma unroll
        for (int j = 0; j < 8; ++j) { v[j] = hr[64 * j]; y[j] = (f32x4){0.f, 0.f, 0.f, 0.f}; }
#pragma unroll 3
        for (int k = 0; k < 9; ++k) {
            const size_t row = k < 8 ? (size_t)tok * 8 + k : (size_t)NASSIGN + tok;
            const unsigned* yr = (const unsigned*)(YB8 + row * D) + F.lane;
#pragma unroll
            for (int j = 0; j < 8; ++j) { const unsigned w = yr[64 * j]; const f32x2 lo = __builtin_amdgcn_cvt_pk_f32_fp8((int)w, false), hi = __builtin_amdgcn_cvt_pk_f32_fp8((int)w, true);
                y[j].x += lo.x; y[j].y += lo.y; y[j].z += hi.x; y[j].w += hi.y; }
        }
#pragma unroll
        for (int j = 0; j < 8; ++j) v[j] = v[j] + y[j] * (1.f / YB_SCALE);
        float s = 0.f;
#pragma unroll
        for (int j = 0; j < 8; ++j) s += (v[j].x * v[j].x + v[j].y * v[j].y) + (v[j].z * v[j].z + v[j].w * v[j].w);
        const float rinv = rsqrtf(wave_sum(s) * (1.f / D) + RMS_EPS);
        f32x4* o = (f32x4*)(a.out + (size_t)tok * D) + F.lane;
#pragma unroll
        for (int j = 0; j < 8; ++j) { const f32x4 gg = *((const f32x4*)g + F.lane + 64 * j); o[64 * j] = (f32x4){v[j].x * rinv * gg.x, v[j].y * rinv * gg.y, v[j].z * rinv * gg.z, v[j].w * rinv * gg.w}; }
    }
}

constexpr int N_PHASES = 9;
__global__ void __launch_bounds__(NTHREADS, 2) fwd_kernel(Args args) {
    extern __shared__ __attribute__((aligned(16))) unsigned char lds_raw[];
    Frame F;
    F.lds = (LAS unsigned char*)lds_raw;
    F.MISC = (volatile LAS unsigned*)(F.lds + MISC_OFF);
    F.tid = threadIdx.x; F.lane = F.tid & 63; F.wave = __builtin_amdgcn_readfirstlane(F.tid >> 6);
    F.G = gridDim.x; { const int bx = blockIdx.x; F.vcu = (F.G % 8 == 0) ? (bx % 8) * (F.G / 8) + bx / 8 : bx; }
    F.ws = args.ws; F.ctl = (unsigned*)(args.ws + WS_CTL);
    for (int u = F.tid; u < (LDS_BYTES - MISC_OFF) / 4; u += NTHREADS) ((LAS unsigned*)(F.lds + MISC_OFF))[u] = 0u;
    __syncthreads();
    const int lo = args.ph_lo, hi = args.ph_hi;
    XcdBarrier bar; bar.bar = F.ctl + CW_BAR; bar.x = 0; bar.st = nullptr;
    if (hi - lo > 1) bar = xcd_barrier_post(F.ctl + CW_BAR, F.MISC + 8);
#define IN(k) (lo <= (k) && (k) < hi)
#define SEAM(k) do { if (IN(k) && IN((k) + 1)) xcd_barrier(bar); } while (0)
    unsigned char* ws = args.ws;
    LAS int* tab = (LAS int*)(F.lds + MISC_OFF + 256);

#define REPS(k) for (int rep_ = 0; rep_ < (PROBE_DUP == (k) ? 2 : 1); ++rep_)
#define REPBAR(k) do { if (PROBE_DUP == (k) && rep_ == 0) xcd_barrier(bar); } while (0)
    if (IN(0)) { p0_prologue(F, args); SEAM(0); }
    if (IN(1)) {
        DenseSched S{(const char*)(ws + WS_U), (const char*)(ws + WS_WINT), T / 256, NIN / 256, D, F.G, (int)blockIdx.x, PROBE_DUP == 1 ? 2 : 1, (T / 256) * (NIN / 256) % 256};
        EpiZ E{(bf16_t*)(ws + WS_Z), (float*)(ws + WS_FL), args.in[3]};
        pg8::gemm_phase<false>(F.lds, 2 * D, S, E);
        SEAM(1);
    }
    if (IN(2)) { REPS(2) { p2_attention(F, args); REPBAR(2); } SEAM(2); }
    if (IN(3)) {
DenseSched S{(const char*)(ws + WS_YS), (const char*)(ws + WS_WSWAT), T / 256, D / 256, D, F.G, (int)blockIdx.x, PROBE_DUP == 3 ? 2 : 1, 0};
        EpiMix E{(const bf16_t*)(ws + WS_Z), (bf16_t*)(ws + WS_MIX)};
        pg8::gemm_phase<false>(F.lds, 2 * D, S, E);
        SEAM(3);
    }
    if (IN(4)) {
        DenseSched S{(const char*)(ws + WS_MIX), (const char*)(ws + WS_WOUTT), T / 256, D / 256, D, F.G, (int)blockIdx.x, PROBE_DUP == 4 ? 2 : 1, 0};
        EpiOut E{args.in[0], (float*)(ws + WS_H1), (float*)(ws + WS_PSQ)};
        pg8::gemm_phase<false>(F.lds, 2 * D, S, E);
        SEAM(4);
    }
    if (IN(5)) {
        if (PROBE_DUP == 5) { p5_router(F, args, F.ctl + 256, (float*)(ws + WS_T1), (int*)(ws + WS_T1 + 2 * MiB)); xcd_barrier(bar); }
        p5_router(F, args, F.ctl + CW_CNT, (float*)(ws + WS_LISTW), (int*)(ws + WS_LIST));
        if (PROBE_DUP == 9) { for (int q = 0; q < 16; ++q) xcd_barrier(bar); }
        SEAM(5); }
    if (IN(6)) {
        const int total = moe_table<4>(F, tab);
        MoeSched<0> S{tab, (const int*)(ws + WS_LIST), (const float*)(ws + WS_LISTW), (const char*)(ws + WS_V), (const char*)(ws + WS_WGU), (LAS int*)(F.lds + MISC_OFF + 1024), (LAS float*)(F.lds + MISC_OFF + 4096), total, F.G, F.vcu, PROBE_DUP == 6 ? 2 : 1};
        EpiSwiglu E{&S, (unsigned char*)(ws + WS_HB)};
        pg8::gemm_phase<true>(F.lds, 2048, S, E);
        SEAM(6);
    }
    if (IN(7)) {
        const int total = moe_table<8>(F, tab);
        MoeSched<1> S{tab, (const int*)(ws + WS_LIST), (const float*)(ws + WS_LISTW), (const char*)(ws + WS_HB), (const char*)(ws + WS_WD), (LAS int*)(F.lds + MISC_OFF + 1024), (LAS float*)(F.lds + MISC_OFF + 4096), total, F.G, F.vcu, PROBE_DUP == 7 ? 2 : 1};
        EpiDown E{&S, (unsigned char*)(ws + WS_YB)};
        pg8::gemm_phase<true>(F.lds, 512, S, E);
        SEAM(7);
    }
    if (IN(8)) { REPS(8) { p8_final(F, args); REPBAR(8); } }
#undef IN
#undef SEAM
}

extern "C" void kernel_launch(void* const* d_in, const int* in_sizes, int n_in, void* d_out, int out_size, void* d_ws, size_t ws_size, hipStream_t stream) {
    static int grid = 0;
    if (grid == 0) {
        if (n_in != 18 || out_size != T * D || ws_size < WS_END) { fprintf(stderr, "kernel_launch: unexpected shapes (n_in %d out %d ws %zu)\n", n_in, out_size, ws_size); grid = -1; return; }
        int dev = 0, cus = 0, per_cu = 0;
        if (hipGetDevice(&dev) != hipSuccess || hipDeviceGetAttribute(&cus, hipDeviceAttributeMultiprocessorCount, dev) != hipSuccess) { grid = -1; return; }
        if (hipFuncSetAttribute((const void*)fwd_kernel, hipFuncAttributeMaxDynamicSharedMemorySize, LDS_BYTES) != hipSuccess) { fprintf(stderr, "kernel_launch: hipFuncSetAttribute failed\n"); grid = -1; return; }
        if (hipOccupancyMaxActiveBlocksPerMultiprocessor(&per_cu, (const void*)fwd_kernel, NTHREADS, LDS_BYTES) != hipSuccess || per_cu < 1) { fprintf(stderr, "kernel_launch: occupancy query says %d blocks per CU\n", per_cu); (void)hipGetLastError(); grid = -1; return; }
        grid = cus;
        if (grid % 8 != 0 || grid > 256) grid = (grid / 8) * 8 > 256 ? 256 : (grid / 8) * 8;
    }
    if (grid <= 0) return;
    (void)hipMemsetAsync((char*)d_ws + WS_CTL, 0, CTL_ZERO_BYTES, stream);
    Args a{};
    for (int i = 0; i < 18; ++i) a.in[i] = (const float*)d_in[i];
    a.out = (float*)d_out; a.ws = (unsigned char*)d_ws;
#if MK_N_LAUNCHES == 1
    a.ph_lo = 0; a.ph_hi = N_PHASES;
    hipLaunchKernelGGL(fwd_kernel, dim3(grid), dim3(NTHREADS), LDS_BYTES, stream, a);
#else
    for (int p = 0; p < N_PHASES; ++p) { a.ph_lo = p; a.ph_hi = p + 1; hipLaunchKernelGGL(fwd_kernel, dim3(grid), dim3(NTHREADS), LDS_BYTES, stream, a); }
#endif
}
```

```cpp
#include <hip/hip_runtime.h>
#include <cstdio>
#include <cstdint>

#ifndef MK_N_LAUNCHES
#define MK_N_LAUNCHES 1
#endif
#define PROBE_DUP -1

#define LAS __attribute__((address_space(3)))
#define GAS __attribute__((address_space(1)))
typedef unsigned short bf16_t;
typedef short bf16x8 __attribute__((ext_vector_type(8)));
typedef short s16x4 __attribute__((ext_vector_type(4)));
typedef float f32x2 __attribute__((ext_vector_type(2)));
typedef float f32x4 __attribute__((ext_vector_type(4)));
typedef float f32x16 __attribute__((ext_vector_type(16)));
typedef unsigned u32x2 __attribute__((ext_vector_type(2)));
typedef unsigned u32x4 __attribute__((ext_vector_type(4)));
typedef __bf16 bf16x2_t __attribute__((ext_vector_type(2)));

constexpr int T = 8192, D = 2048, SEQ = 2048, NBATCH = 4;
constexpr int NE = 64, FF = 512, TOPK = 8;
constexpr int ZP = 8704;
constexpr int ZQ = 0, ZK = 1024, ZV = 1280, ZFQ = 1536, ZFK = 2560, ZFV = 3584, ZGS = 4608, ZGF = 6656;
constexpr int NIN = 8960;
constexpr float RMS_EPS = 1e-6f;
constexpr float LOG2E = 1.4426950408889634f;
constexpr float QSCALE = 0.125f * LOG2E;
constexpr int NASSIGN = T * TOPK;
constexpr int NROWS_H = NASSIGN + T;

constexpr size_t MiB = 1u << 20;
constexpr size_t WS_CTL = 0, CTL_ZERO_BYTES = 64 * 1024;
constexpr size_t WS_FL = 1 * MiB;
constexpr size_t WS_WTS = 1 * MiB + 512 * 1024;
constexpr size_t WS_LIST = 2 * MiB;
constexpr size_t WS_WSWAT = 4 * MiB, WS_WFOXT = 8 * MiB, WS_WOUTT = 12 * MiB;
constexpr size_t WS_WINT = 20 * MiB;
constexpr size_t WS_WRG = 55 * MiB;
constexpr size_t WS_PSQ = 55 * MiB + 512 * 1024;
constexpr size_t WS_U = 56 * MiB;
constexpr size_t WS_Z = 88 * MiB;
constexpr size_t WS_YS = 224 * MiB, WS_YF = 240 * MiB;
constexpr size_t WS_T1 = 256 * MiB;
constexpr size_t WS_U8 = 288 * MiB;
constexpr size_t WS_WINT8 = 304 * MiB;
constexpr size_t WS_MIX = 320 * MiB;
constexpr size_t WS_H1 = 352 * MiB;
constexpr size_t WS_V = 416 * MiB;
constexpr size_t WS_HB = 448 * MiB;
constexpr size_t WS_WGU = 520 * MiB;
constexpr size_t WS_WD = 780 * MiB;
constexpr size_t WS_YB = 56 * MiB;
constexpr size_t WS_LISTW = 910 * MiB;
constexpr size_t WS_END = 912 * MiB;
static_assert(WS_YB + (size_t)NROWS_H * D * 2 <= WS_MIX + 32 * MiB, "YB overlay");
constexpr int CW_CNT = 64;
constexpr int CW_BAR = 4096;

constexpr int RING_BYTES = 131072;
constexpr int MISC_OFF = 139264;
constexpr int LDS_BYTES = 147456;
constexpr int NWAVES = 8, NTHREADS = 512;

__device__ __forceinline__ unsigned cvtpk(float lo, float hi) { f32x2 v = {lo, hi}; bf16x2_t b = __builtin_convertvector(v, bf16x2_t); return __builtin_bit_cast(unsigned, b); }
__device__ __forceinline__ float bf2f(bf16_t h) { return __builtin_bit_cast(float, (unsigned)h << 16); }
__device__ __forceinline__ float bflo(unsigned w) { return __builtin_bit_cast(float, w << 16); }
__device__ __forceinline__ float bfhi(unsigned w) { return __builtin_bit_cast(float, w & 0xffff0000u); }
__device__ __forceinline__ float wave_sum(float v) {
#pragma unroll
    for (int o = 1; o < 64; o <<= 1) v += __shfl_xor(v, o);
    return v;
}
__device__ __forceinline__ float wave_max(float v) {
#pragma unroll
    for (int o = 1; o < 64; o <<= 1) v = fmaxf(v, __shfl_xor(v, o));
    return v;
}
__device__ __forceinline__ float sigmoidf_(float x) { return 1.0f / (1.0f + __expf(-x)); }
#define LDS_WAIT() asm volatile("s_waitcnt lgkmcnt(0)" ::: "memory")
#define VM_WAIT() asm volatile("s_waitcnt vmcnt(0)" ::: "memory")

#define XB_TMO      128
#define XB_XCNT(j)  (256  + 64 * (j))
#define XB_XSUB(j)  (1280 + 64 * (j))
#define XB_XGEN(j)  (2304 + 64 * (j))
#define XB_TOP      3328
#define XB_TOPGEN   3392
#define XCD_BAR_WORDS 3456
#define XB_SPIN_CAP (1u << 20)
__device__ __forceinline__ unsigned xb_ld(unsigned* p)              { return __hip_atomic_load(p, __ATOMIC_RELAXED, __HIP_MEMORY_SCOPE_AGENT); }
__device__ __forceinline__ unsigned xb_add(unsigned* p, unsigned v) { return __hip_atomic_fetch_add(p, v, __ATOMIC_RELAXED, __HIP_MEMORY_SCOPE_AGENT); }
__device__ __forceinline__ unsigned xb_xcc_id() { return (unsigned)__builtin_amdgcn_s_getreg((3 << 11) | 20) & 0xFu; }
#define XB_SPIN(cond, bar) do { unsigned _sp = 0; while (cond) { __builtin_amdgcn_s_sleep(1); \
    if ((++_sp & 255u) == 0u) { if (xb_ld(&(bar)[XB_TMO])) break; if (_sp > XB_SPIN_CAP) { atomicAdd(&(bar)[XB_TMO], 1u); break; } } } } while (0)
struct XcdBarrier { unsigned* bar; unsigned x; volatile LAS unsigned* st; };
__device__ __forceinline__ XcdBarrier xcd_barrier_post(unsigned* bar, volatile LAS unsigned* st) {
    XcdBarrier b; b.bar = bar; b.x = xb_xcc_id(); b.st = st;
    if (threadIdx.x == 0) (void)xb_add(&bar[XB_XCNT(b.x)], 1u);
    return b;
}
__device__ __forceinline__ void xcd_barrier_complete(unsigned* bar, unsigned x, unsigned& nloc, unsigned& nx) {
    const unsigned G = gridDim.x * gridDim.y * gridDim.z;
    unsigned sum, cnt, mine, sp = 0u;
    for (;;) {
        sum = 0u; cnt = 0u; mine = 0u;
#pragma unroll
        for (unsigned j = 0; j < 16; ++j) { const unsigned c = xb_ld(&bar[XB_XCNT(j)]); sum += c; cnt += (c > 0u) ? 1u : 0u; mine = (j == x) ? c : mine; }
        if (sum == G) break;
        __builtin_amdgcn_s_sleep(1);
        if ((++sp & 255u) == 0u) { if (xb_ld(&bar[XB_TMO])) break; if (sp > XB_SPIN_CAP) { atomicAdd(&bar[XB_TMO], 1u); break; } }
    }
    nloc = mine > 0u ? mine : 1u; nx = cnt > 0u ? cnt : 1u;
}
__device__ __forceinline__ void xcd_barrier(const XcdBarrier& b) {
    asm volatile("s_waitcnt vmcnt(0)" ::: "memory");
    __syncthreads();
    if (threadIdx.x == 0) {
        unsigned* bar = b.bar;
        __builtin_amdgcn_s_waitcnt(0);
        unsigned nloc = b.st[0], nx = b.st[1];
        if (nloc == 0u) { xcd_barrier_complete(bar, b.x, nloc, nx); b.st[0] = nloc; b.st[1] = nx; }
        const unsigned old = xb_add(&bar[XB_XSUB(b.x)], 1u);
        const unsigned gen = old / nloc;
        if (old + 1u == (gen + 1u) * nloc) {
            __builtin_amdgcn_fence(__ATOMIC_RELEASE, "agent");
            asm volatile("s_waitcnt vmcnt(0)" ::: "memory");
            const unsigned og = xb_add(&bar[XB_TOP], 1u);
            const unsigned tg = og / nx;
            if (og + 1u == (tg + 1u) * nx) xb_add(&bar[XB_TOPGEN], 1u);
            else XB_SPIN(xb_ld(&bar[XB_TOPGEN]) == tg, bar);
            __builtin_amdgcn_fence(__ATOMIC_ACQUIRE, "agent");
            xb_add(&bar[XB_XGEN(b.x)], 1u);
            asm volatile("s_waitcnt vmcnt(0)" ::: "memory");
        } else {
            XB_SPIN(xb_ld(&bar[XB_XGEN(b.x)]) == gen, bar);
            __builtin_amdgcn_fence(__ATOMIC_ACQUIRE, "agent");
            asm volatile("s_waitcnt vmcnt(0)" ::: "memory");
        }
    }
    __syncthreads();
}

namespace pg8 {
constexpr int BM = 256, BK = 64, HALF = 128, HTB = HALF * BK * 2, STAGE_BYTES = 8 * HTB, NXCD = 8, WGM = 8;
__host__ __device__ __forceinline__ int lds_byte(int r, int c) { const int st = (r >> 4) * 2 + (c >> 5), rr = r & 15, cc = c & 31, ob = rr * 64 + cc * 2; return st * 1024 + (ob ^ (((ob >> 9) & 1) << 5)); }
__host__ __device__ __forceinline__ void stage_rc(int b, int& R, int& C) { const int st = b / 1024, sb = b % 1024, swz = sb ^ (((sb >> 9) & 1) << 5); R = (st >> 1) * 16 + swz / 64; C = (st & 1) * 32 + (swz % 64) / 2; }
__host__ __device__ __forceinline__ int perm32(int rho) { const int n = rho >> 4, i = rho & 15; return 8 * (i >> 2) + 4 * n + (i & 3); }

struct Unit { const char* A; const char* B; int pm, pn, e, rt, hm; };

__device__ __forceinline__ void static_tile(int L, int nM, int nN, int& pm, int& pn) {
    const int nwg = nM * nN; int wgid = L;
    { const int q = nwg / NXCD, r = nwg % NXCD, xcd = wgid % NXCD, off = wgid / NXCD; wgid = (xcd < r ? xcd * (q + 1) : r * (q + 1) + (xcd - r) * q) + off; }
    const int nig = WGM * nN, gid = wgid / nig, fm = gid * WGM, gsz = (nM - fm) < WGM ? (nM - fm) : WGM;
    pm = fm + ((wgid % nig) % gsz); pn = (wgid % nig) / gsz;
}

typedef int v4i_t __attribute__((ext_vector_type(4)));
typedef int v8i_t __attribute__((ext_vector_type(8)));
template <bool FP8, class Epi, class Sched>
__device__ __forceinline__ void gemm_phase(LAS unsigned char* lds, const int Kb, const Sched& S, const Epi& E, const int stagger_ticks = 0) {
    if (stagger_ticks > 0) { const unsigned long long t0_ = __builtin_amdgcn_s_memrealtime(); while (__builtin_amdgcn_s_memrealtime() - t0_ < (unsigned long long)stagger_ticks) __builtin_amdgcn_s_sleep(8); }
    const int tid = threadIdx.x, wid = __builtin_amdgcn_readfirstlane(tid >> 6), lane = tid & 63, wr = wid >> 2, wc = wid & 3, fr = lane & 15, fq = lane >> 4;
    const int nt = Kb / 128;
    int Ri[2], Ci[2]; unsigned voffB[2];
#pragma unroll
    for (int i = 0; i < 2; ++i) { int R, C; stage_rc(tid * 16 + i * 8192, R, C); Ri[i] = R; Ci[i] = C; const int Rb = (R & ~31) + perm32(R & 31); voffB[i] = (unsigned)(Rb * Kb + C * 2); }
    const size_t kstep = (size_t)(BK * 2);
    const size_t hstep = (size_t)HALF * Kb;
    const unsigned ldsw = (unsigned)wid * 1024u;
    const int aoff = lds_byte(wr * 64 + fr, fq * 8), boff = lds_byte(wc * 32 + fr, fq * 8);
#define PG8_SA(b, h) (((b) * 2 + (h)) * HTB)
#define PG8_SB(b, h) ((4 + (b) * 2 + (h)) * HTB)
#define PG8_STAGE(bufoff, gbase, voff) do { _Pragma("unroll") for (int _i = 0; _i < 2; ++_i) \
        __builtin_amdgcn_global_load_lds((const unsigned*)((const char*)(gbase) + (voff)[_i]), (LAS unsigned*)(lds + (bufoff) + ldsw + _i * 8192), 16, 0, 0); } while (0)
#define PG8_LDA(dst, b, h) do { if constexpr (FP8) { _Pragma("unroll") for (int m = 0; m < 4; ++m) { dst##8[m].lo = *(const LAS v4i_t*)(lds + PG8_SA(b, h) + aoff + m * 2048); dst##8[m].hi = *(const LAS v4i_t*)(lds + PG8_SA(b, h) + aoff + m * 2048 + 1024); } } \
        else { _Pragma("unroll") for (int m = 0; m < 4; ++m) _Pragma("unroll") for (int k = 0; k < 2; ++k) dst[m][k] = *(const LAS bf16x8*)(lds + PG8_SA(b, h) + aoff + m * 2048 + k * 1024); } } while (0)
#define PG8_LDB(dst, b, h) do { if constexpr (FP8) { _Pragma("unroll") for (int n = 0; n < 2; ++n) { dst##8[n].lo = *(const LAS v4i_t*)(lds + PG8_SB(b, h) + boff + n * 2048); dst##8[n].hi = *(const LAS v4i_t*)(lds + PG8_SB(b, h) + boff + n * 2048 + 1024); } } \
        else { _Pragma("unroll") for (int n = 0; n < 2; ++n) _Pragma("unroll") for (int k = 0; k < 2; ++k) dst[n][k] = *(const LAS bf16x8*)(lds + PG8_SB(b, h) + boff + n * 2048 + k * 1024); } } while (0)
#define PG8_MMA(ai, bj, At, Bt) do { __builtin_amdgcn_s_setprio(1); \
        if constexpr (FP8) { _Pragma("unroll") for (int m = 0; m < 4; ++m) _Pragma("unroll") for (int n = 0; n < 2; ++n) \
            asm volatile("v_mfma_scale_f32_16x16x128_f8f6f4 %0, %1, %2, %0, %3, %3 op_sel_hi:[0,0,0]" : "+v"(acc[ai][bj][m][n]) : "v"(Bt##8[n]), "v"(At##8[m]), "v"(sc8)); } \
        else { _Pragma("unroll") for (int m = 0; m < 4; ++m) _Pragma("unroll") for (int n = 0; n < 2; ++n) _Pragma("unroll") for (int k = 0; k < 2; ++k) \
            acc[ai][bj][m][n] = __builtin_amdgcn_mfma_f32_16x16x32_bf16(Bt[n][k], At[m][k], acc[ai][bj][m][n], 0, 0, 0); } \
        __builtin_amdgcn_s_setprio(0); } while (0)
#define PG8_WAIT_V(n) asm volatile("s_waitcnt vmcnt(" #n ")" ::: "memory")
#define PG8_WAIT_L(n) asm volatile("s_waitcnt lgkmcnt(" #n ")" ::: "memory")
#define PG8_BAR __builtin_amdgcn_s_barrier()
#define PG8_SCHED __builtin_amdgcn_sched_barrier(0)
    Unit cur, nxt; int ui = 0;
    if (!S.next(0, cur)) return;
    unsigned vc[2][2], vn[2][2];
    int pfa = -1; float pfw = 0.f;
    S.pf_issue(cur, pfa, pfw); S.pf_commit(0, pfa, pfw);
    asm volatile("s_waitcnt vmcnt(0) lgkmcnt(0)" ::: "memory"); PG8_BAR; asm volatile("" ::: "memory");
    S.rowoffs(cur, 0, vc, Ri, Ci);
    f32x4 acc[2][2][4][2];
#pragma unroll
    for (int a = 0; a < 2; ++a)
#pragma unroll
        for (int b = 0; b < 2; ++b)
#pragma unroll
            for (int m = 0; m < 4; ++m)
#pragma unroll
                for (int n = 0; n < 2; ++n) acc[a][b][m][n] = (f32x4){0.f, 0.f, 0.f, 0.f};
    const int sc8 = 0x7f7f7f7f;
    bf16x8 At[4][2], B0[2][2], B1[2][2]; v8i_t At8[4], B08[2], B18[2];
    const char* cA = cur.A; const char* cB = cur.B;
    PG8_STAGE(PG8_SB(0, 0), cB, voffB); PG8_STAGE(PG8_SB(0, 1), cB + hstep, voffB); PG8_STAGE(PG8_SA(0, 0), cA, vc[0]); PG8_STAGE(PG8_SA(0, 1), cA, vc[1]);
    if (wr == 1) PG8_BAR;
    PG8_WAIT_V(2); PG8_BAR;
    PG8_STAGE(PG8_SB(1, 0), cB + kstep, voffB); PG8_STAGE(PG8_SA(1, 0), cA + kstep, vc[0]); PG8_STAGE(PG8_SB(1, 1), cB + hstep + kstep, voffB);
    PG8_WAIT_V(6); PG8_BAR;
    for (;;) {
        const bool has_next = S.next(ui + 1, nxt);
        const int scur = ui % 3, snxt = (ui + 1) % 3;
        const bool h0 = (cur.hm & 1) != 0, h1 = (cur.hm & 2) != 0;
        const char* nA = has_next ? nxt.A : cA; const char* nB = has_next ? nxt.B : cB;
        if (has_next) S.pf_issue(nxt, pfa, pfw);
        constexpr int NH = Epi::MIDK ? 2 : 1;
        for (int kh = 0; kh < NH; ++kh) {
        if constexpr (Epi::MIDK) { if (kh == 1) E.mid(acc, cur, wr, wc, fr, fq); }
        const int tend = (kh + 1) * nt / NH;
        for (int t = kh * nt / NH; t < tend; t += 2) {
            const bool last = (t == nt - 2);
            if (t == (nt >= 8 ? nt - 4 : 0) && has_next) S.pf_commit(snxt, pfa, pfw);
            const char* a1 = cA + (size_t)(t + 1) * kstep;
            const char* a2 = last ? nA : cA + (size_t)(t + 2) * kstep; const char* b2 = last ? nB : cB + (size_t)(t + 2) * kstep;
            const char* a3 = a2 + kstep; const char* b3 = b2 + kstep;
            if (last) {
                if (has_next) S.rowoffs(nxt, snxt, vn, Ri, Ci);
                else { vn[0][0] = vc[0][0]; vn[0][1] = vc[0][1]; vn[1][0] = vc[1][0]; vn[1][1] = vc[1][1]; }
            }
            unsigned v2[2][2];
            v2[0][0] = last ? vn[0][0] : vc[0][0]; v2[0][1] = last ? vn[0][1] : vc[0][1]; v2[1][0] = last ? vn[1][0] : vc[1][0]; v2[1][1] = last ? vn[1][1] : vc[1][1];
            PG8_LDB(B0, 0, 0); PG8_LDB(B1, 0, 1); PG8_SCHED; PG8_LDA(At, 0, 0); PG8_STAGE(PG8_SA(1, 1), a1, vc[1]);
            PG8_WAIT_V(8); PG8_WAIT_L(0); PG8_BAR; if (h0) { PG8_MMA(0, 0, At, B0); PG8_MMA(0, 1, At, B1); } PG8_BAR; PG8_SCHED;
            PG8_LDA(At, 0, 1); PG8_STAGE(PG8_SB(0, 0), b2, voffB); PG8_STAGE(PG8_SB(0, 1), b2 + hstep, voffB); PG8_STAGE(PG8_SA(0, 0), a2, v2[0]);
            PG8_WAIT_V(8); PG8_WAIT_L(0); PG8_BAR; if (h1) { PG8_MMA(1, 0, At, B0); PG8_MMA(1, 1, At, B1); } PG8_BAR; PG8_SCHED;
            PG8_LDB(B0, 1, 0); PG8_LDB(B1, 1, 1); PG8_SCHED; PG8_LDA(At, 1, 0); PG8_STAGE(PG8_SA(0, 1), a2, v2[1]);
            PG8_WAIT_V(8); PG8_WAIT_L(0); PG8_BAR; if (h0) { PG8_MMA(0, 0, At, B0); PG8_MMA(0, 1, At, B1); } PG8_BAR; PG8_SCHED;
            PG8_LDA(At, 1, 1); PG8_STAGE(PG8_SB(1, 0), b3, voffB); PG8_STAGE(PG8_SB(1, 1), b3 + hstep, voffB); PG8_STAGE(PG8_SA(1, 0), a3, v2[0]);
            PG8_WAIT_V(8); PG8_WAIT_L(0); PG8_BAR; if (h1) { PG8_MMA(1, 0, At, B0); PG8_MMA(1, 1, At, B1); } PG8_BAR; PG8_SCHED;
        }
        }
        if (wr == 0) PG8_BAR;
        if constexpr (FP8) {
            asm volatile("s_nop 15\n\ts_nop 15" ::: "memory");
#pragma unroll
            for (int a = 0; a < 2; ++a)
#pragma unroll
                for (int b = 0; b < 2; ++b)
#pragma unroll
                    for (int m = 0; m < 4; ++m)
#pragma unroll
                        for (int n = 0; n < 2; ++n) asm volatile("" : "+v"(acc[a][b][m][n]));
        }
        E(acc, cur, scur, wr, wc, fr, fq);
        if (!has_next) break;
#pragma unroll
        for (int a = 0; a < 2; ++a)
#pragma unroll
            for (int b = 0; b < 2; ++b)
#pragma unroll
                for (int m = 0; m < 4; ++m)
#pragma unroll
                    for (int n = 0; n < 2; ++n) acc[a][b][m][n] = (f32x4){0.f, 0.f, 0.f, 0.f};
        cur = nxt; cA = nA; cB = nB; ++ui;
        vc[0][0] = vn[0][0]; vc[0][1] = vn[0][1]; vc[1][0] = vn[1][0]; vc[1][1] = vn[1][1];
        if (wr == 1) PG8_BAR;
    }
    PG8_WAIT_V(0);
    PG8_BAR;
#undef PG8_SA
#undef PG8_SB
#undef PG8_STAGE
#undef PG8_LDA
#undef PG8_LDB
#undef PG8_MMA
#undef PG8_WAIT_V
#undef PG8_WAIT_L
#undef PG8_BAR
#undef PG8_SCHED
}
}
using pg8::Unit;

struct Args { const float* in[18]; float* out; unsigned char* ws; int ph_lo, ph_hi; };
struct Frame {
    LAS unsigned char* lds; volatile LAS unsigned* MISC; unsigned* ctl; unsigned char* ws;
    int tid, lane, wave, vcu, G;
};

struct DenseSched {
    const char* A; const char* Bt; int nM, nN, Kb  , G, c, dup, nsplit, pn0  , pn_last  ;
    __device__ __forceinline__ bool next(int i, Unit& u) const {
        int L = i * G + c; int hm_ = 3;
        if (nsplit > 0) {
            const int nfull = nM * nN - nsplit, tot = nfull + 2 * nsplit;
            if (L >= tot * dup) return false; if (L >= tot) L -= tot;
            if (L >= nfull) { hm_ = 1 << ((L - nfull) & 1); L = nfull + ((L - nfull) >> 1); }
        } else { if (L >= nM * nN * dup) return false; if (L >= nM * nN) L -= nM * nN; }
        int pm, pn; pg8::static_tile(L, nM, nN, pm, pn);
        if (pn_last >= 0 && pn == nN - 1) pn = pn_last;
        u.pm = pm; u.pn = pn + pn0; u.e = 0; u.rt = 0; u.hm = hm_; u.A = A + (size_t)pm * 256 * Kb; u.B = Bt + (size_t)pn * 256 * Kb; return true;
    }
    __device__ __forceinline__ void pf_issue(const Unit&, int&, float&) const {}
    __device__ __forceinline__ void pf_commit(int, int, float) const {}
    __device__ __forceinline__ void rowoffs(const Unit&, int, unsigned (&vo)[2][2], const int (&R)[2], const int (&C)[2]) const {
#pragma unroll
        for (int h = 0; h < 2; ++h)
#pragma unroll
            for (int i = 0; i < 2; ++i) vo[h][i] = (unsigned)((R[i] + 128 * h) * Kb + C[i] * 2);
    }
};
struct BranchSched {
    const char* A0; const char* A1; const char* B0; const char* B1; int nM, nN, K, G, c, dup;
    __device__ __forceinline__ bool next(int i, Unit& u) const {
        int L = (i >> 1) * G + c; if (L >= nM * nN * dup) return false; if (L >= nM * nN) L -= nM * nN;
        int pm, pn; pg8::static_tile(L, nM, nN, pm, pn);
        const int br = i & 1;
        u.pm = pm; u.pn = pn; u.e = br; u.rt = 0; u.hm = 3; u.A = (br ? A1 : A0) + (size_t)pm * 256 * K * 2; u.B = (br ? B1 : B0) + (size_t)pn * 256 * K * 2; return true;
    }
    __device__ __forceinline__ void pf_issue(const Unit&, int&, float&) const {}
    __device__ __forceinline__ void pf_commit(int, int, float) const {}
    __device__ __forceinline__ void rowoffs(const Unit&, int, unsigned (&vo)[2][2], const int (&R)[2], const int (&C)[2]) const {
#pragma unroll
        for (int h = 0; h < 2; ++h)
#pragma unroll
            for (int i = 0; i < 2; ++i) vo[h][i] = (unsigned)((R[i] + 128 * h) * K + C[i]) * 2u;
    }
};
template <int MODE> struct MoeSched {
    const LAS int* tab; const int* list; const float* listw; const char* A; const char* Bt; LAS int* rowA; LAS float* rowW; int total, G, vcu, dup;
    static constexpr int MULT = MODE == 0 ? 4 : 8, KB = MODE == 0 ? 2048 : 512  , NCOLS = MODE == 0 ? 1024 : 2048;
    __device__ __forceinline__ bool next(int i, Unit& u) const {
        int L = i * G + vcu; if (L >= total * dup) return false; if (L >= total) L -= total;
        int e, j, nrt, cnte = T;
        if (L < 32 * MULT) { e = 64; j = L; nrt = 32; }
        else {
            const int Lr = L - 32 * MULT; const int lane = threadIdx.x & 63;
            const int pin = tab[lane];
            const unsigned long long bal = __ballot(pin <= Lr);
            e = __builtin_popcountll(bal); e = e > 63 ? 63 : e;
            const int pex = e > 0 ? tab[e - 1] : 0; const int cnt = tab[64 + e];
            j = Lr - pex; nrt = (cnt + 255) >> 8; nrt = nrt < 1 ? 1 : nrt; cnte = cnt;
        }
        e = __builtin_amdgcn_readfirstlane(e); j = __builtin_amdgcn_readfirstlane(j); nrt = __builtin_amdgcn_readfirstlane(nrt);
        u.e = e; u.rt = j % nrt; u.pn = j / nrt; u.pm = 0;
        u.hm = (__builtin_amdgcn_readfirstlane(cnte) - u.rt * 256 > 128) ? 3 : 1;
        u.A = A; u.B = Bt + ((size_t)e * NCOLS + (size_t)u.pn * 256) * KB; return true;
    }
    __device__ __forceinline__ void pf_issue(const Unit& u, int& pa, float& pw) const {
        const int tid = threadIdx.x; pa = -1; pw = 0.f;
        if (tid < 256) { const int idx = u.rt * 256 + tid;
            if (u.e == 64) { pa = NASSIGN + idx; pw = 1.f; }
            else if (idx < tab[64 + u.e]) { pa = list[u.e * T + idx]; if (MODE == 1) pw = listw[u.e * T + idx]; } }
    }
    __device__ __forceinline__ void pf_commit(int s, int pa, float pw) const { const int tid = threadIdx.x; if (tid < 256) { rowA[s * 256 + tid] = pa; rowW[s * 256 + tid] = pw; } }
    __device__ __forceinline__ void rowoffs(const Unit& u, int s, unsigned (&vo)[2][2], const int (&R)[2], const int (&C)[2]) const {
#pragma unroll
        for (int h = 0; h < 2; ++h)
#pragma unroll
            for (int i = 0; i < 2; ++i) {
                int a = rowA[s * 256 + R[i] + 128 * h];
                unsigned row;
                if (MODE == 0) { a = a < 0 ? 0 : a; row = a < NASSIGN ? (unsigned)(a >> 3) : (unsigned)(a - NASSIGN); }
                else row = a < 0 ? 0u : (unsigned)a;
                vo[h][i] = row * (unsigned)KB + (unsigned)C[i] * 2u;
            }
    }
};

struct EpiZ {
    static constexpr bool MIDK = false;
    bf16_t* Z; float* FL; const float* fbias; float gscale;
    __device__ __forceinline__ void operator()(const f32x4 (&acc)[2][2][4][2], const Unit& u, int slot, int wr, int wc, int fr, int fq) const {
        const int row0 = u.pm * 256 + wr * 64 + fr;
        if (u.pn == 34) {
            if (wc == 0 && fq < 2) {
                float fb[8];
#pragma unroll
                for (int j = 0; j < 8; ++j) fb[j] = fbias[8 * fq + j];
#pragma unroll
                for (int ai = 0; ai < 2; ++ai) if (u.hm & (1 << ai))
#pragma unroll
                    for (int m = 0; m < 4; ++m) {
                        float* o = FL + (size_t)(row0 + ai * 128 + m * 16) * 16 + 8 * fq;
#pragma unroll
                        for (int n = 0; n < 2; ++n) { f32x4 r;
#pragma unroll
                            for (int j = 0; j < 4; ++j) { const float x = acc[ai][0][m][n][j] + fb[4 * n + j]; const float ls = x >= 0.f ? -log1pf(expf(-x)) : x - log1pf(expf(x)); r[j] = ls * LOG2E; }
                            *(f32x4*)(o + 4 * n) = r; }
                    }
            }
            return;
        }
        const int mode = (u.pn < 4 || (u.pn >= 6 && u.pn < 10)) ? 1 : (u.pn >= 18 ? 2 : 0);
        const int col0 = u.pn * 256 + wc * 32 + 8 * fq;
#pragma unroll
        for (int ai = 0; ai < 2; ++ai) if (u.hm & (1 << ai))
#pragma unroll
            for (int m = 0; m < 4; ++m) { bf16_t* rowp = Z + (size_t)(row0 + ai * 128 + m * 16) * ZP + col0;
#pragma unroll
                for (int bj = 0; bj < 2; ++bj) { f32x4 v0 = acc[ai][bj][m][0], v1 = acc[ai][bj][m][1];
                    if (mode == 1) { v0 = v0 * QSCALE; v1 = v1 * QSCALE; }
                    else if (mode == 2) {
#pragma unroll
                        for (int j = 0; j < 4; ++j) { v0[j] = sigmoidf_(v0[j] * gscale); v1[j] = sigmoidf_(v1[j] * gscale); } }
                    u32x4 w; w.x = cvtpk(v0[0], v0[1]); w.y = cvtpk(v0[2], v0[3]); w.z = cvtpk(v1[0], v1[1]); w.w = cvtpk(v1[2], v1[3]);
                    *(u32x4*)(rowp + bj * 128) = w; } }
    }
};
struct EpiMix {
    static constexpr bool MIDK = true;
    const bf16_t* Z; bf16_t* MIX;
    __device__ __forceinline__ void mid(f32x4 (&acc)[2][2][4][2], const Unit& u, int wr, int wc, int fr, int fq) const {
        int opq = 0; asm volatile("" : "+v"(opq));
        const int row0 = u.pm * 256 + wr * 64 + fr + opq, col0 = u.pn * 256 + wc * 32 + 8 * fq;
#pragma unroll
        for (int ai = 0; ai < 2; ++ai)
#pragma unroll
            for (int m = 0; m < 4; ++m) { const size_t row = (size_t)(row0 + ai * 128 + m * 16);
#pragma unroll
                for (int bj = 0; bj < 2; ++bj) {
                    const u32x4 gs = *(const u32x4*)(Z + row * ZP + ZGS + col0 + bj * 128), gf = *(const u32x4*)(Z + row * ZP + ZGF + col0 + bj * 128);
                    f32x4& v0 = acc[ai][bj][m][0]; f32x4& v1 = acc[ai][bj][m][1];
                    v0[0] *= bflo(gs.x) * __builtin_amdgcn_rcpf(bflo(gf.x)); v0[1] *= bfhi(gs.x) * __builtin_amdgcn_rcpf(bfhi(gf.x)); v0[2] *= bflo(gs.y) * __builtin_amdgcn_rcpf(bflo(gf.y)); v0[3] *= bfhi(gs.y) * __builtin_amdgcn_rcpf(bfhi(gf.y));
                    v1[0] *= bflo(gs.z) * __builtin_amdgcn_rcpf(bflo(gf.z)); v1[1] *= bfhi(gs.z) * __builtin_amdgcn_rcpf(bfhi(gf.z)); v1[2] *= bflo(gs.w) * __builtin_amdgcn_rcpf(bflo(gf.w)); v1[3] *= bfhi(gs.w) * __builtin_amdgcn_rcpf(bfhi(gf.w)); }
                asm volatile("" ::: "memory"); }
    }
    __device__ __forceinline__ void operator()(const f32x4 (&acc)[2][2][4][2], const Unit& u, int slot, int wr, int wc, int fr, int fq) const {
        const int row0 = u.pm * 256 + wr * 64 + fr, col0 = u.pn * 256 + wc * 32 + 8 * fq;
#pragma unroll
        for (int ai = 0; ai < 2; ++ai)
#pragma unroll
            for (int m = 0; m < 4; ++m) { const size_t row = (size_t)(row0 + ai * 128 + m * 16);
#pragma unroll
                for (int bj = 0; bj < 2; ++bj) {
                    const u32x4 g = *(const u32x4*)(Z + row * ZP + ZGF + col0 + bj * 128);
                    f32x4 v0 = acc[ai][bj][m][0], v1 = acc[ai][bj][m][1];
                    v0[0] *= bflo(g.x); v0[1] *= bfhi(g.x); v0[2] *= bflo(g.y); v0[3] *= bfhi(g.y);
                    v1[0] *= bflo(g.z); v1[1] *= bfhi(g.z); v1[2] *= bflo(g.w); v1[3] *= bfhi(g.w);
                    u32x4 w; w.x = cvtpk(v0[0], v0[1]); w.y = cvtpk(v0[2], v0[3]); w.z = cvtpk(v1[0], v1[1]); w.w = cvtpk(v1[2], v1[3]);
                    *(u32x4*)(MIX + row * D + col0 + bj * 128) = w; } }
    }
};
struct EpiOut {
    static constexpr bool MIDK = false;
    const float* X; float* H1; float* PSQ;
    __device__ __forceinline__ void operator()(const f32x4 (&acc)[2][2][4][2], const Unit& u, int slot, int wr, int wc, int fr, int fq) const {
        const int row0 = u.pm * 256 + wr * 64 + fr, col0 = u.pn * 256 + wc * 32 + 8 * fq;
#pragma unroll
        for (int ai = 0; ai < 2; ++ai) if (u.hm & (1 << ai))
#pragma unroll
            for (int m = 0; m < 4; ++m) { const size_t row = (size_t)(row0 + ai * 128 + m * 16); float sq = 0.f;
#pragma unroll
                for (int bj = 0; bj < 2; ++bj) {
                    const float* xp = X + row * D + col0 + bj * 128; float* hp = H1 + row * D + col0 + bj * 128;
                    const f32x4 x0 = *(const f32x4*)xp, x1 = *(const f32x4*)(xp + 4);
                    const f32x4 h0 = acc[ai][bj][m][0] + x0, h1 = acc[ai][bj][m][1] + x1;
                    *(f32x4*)hp = h0; *(f32x4*)(hp + 4) = h1;
                    sq += (h0[0] * h0[0] + h0[1] * h0[1]) + (h0[2] * h0[2] + h0[3] * h0[3]) + (h1[0] * h1[0] + h1[1] * h1[1]) + (h1[2] * h1[2] + h1[3] * h1[3]); }
                sq += __shfl_xor(sq, 16); sq += __shfl_xor(sq, 32);
                if (fq == 0) PSQ[row * 32 + u.pn * 4 + wc] = sq; }
    }
};
__device__ __forceinline__ unsigned pk_fp8x4(float a, float b, float c, float d) {
    a = __builtin_amdgcn_fmed3f(a, -448.f, 448.f); b = __builtin_amdgcn_fmed3f(b, -448.f, 448.f); c = __builtin_amdgcn_fmed3f(c, -448.f, 448.f); d = __builtin_amdgcn_fmed3f(d, -448.f, 448.f);
    int r = __builtin_amdgcn_cvt_pk_fp8_f32(a, b, 0, false); r = __builtin_amdgcn_cvt_pk_fp8_f32(c, d, r, true); return (unsigned)r;
}
constexpr float WGU_SCALE = 32.f, WD_SCALE = 16.f, WIN_SCALE = 32.f;
struct EpiSwiglu {
    static constexpr bool MIDK = false;
    const MoeSched<0>* S; unsigned char* HB8;
    __device__ __forceinline__ void operator()(const f32x4 (&acc)[2][2][4][2], const Unit& u, int slot, int wr, int wc, int fr, int fq) const {
        const int ff0 = u.pn * 128 + wc * 32 + 8 * fq;
#pragma unroll
        for (int ai = 0; ai < 2; ++ai) if (u.hm & (1 << ai))
#pragma unroll
            for (int m = 0; m < 4; ++m) { const int a = S->rowA[slot * 256 + ai * 128 + wr * 64 + m * 16 + fr];
                if (a >= 0) { float h[8];
#pragma unroll
                    for (int n = 0; n < 2; ++n)
#pragma unroll
                        for (int j = 0; j < 4; ++j) { const float g = acc[ai][0][m][n][j] * (1.f / WGU_SCALE), up = acc[ai][1][m][n][j] * (1.f / WGU_SCALE); h[4 * n + j] = g * sigmoidf_(g) * up; }
                    u32x2 w; w.x = pk_fp8x4(h[0], h[1], h[2], h[3]); w.y = pk_fp8x4(h[4], h[5], h[6], h[7]);
                    *(u32x2*)(HB8 + (size_t)a * FF + ff0) = w; } }
    }
};
constexpr float YB_SCALE = 16.f;
struct EpiDown {
    static constexpr bool MIDK = false;
    const MoeSched<1>* S; unsigned char* YB8;
    __device__ __forceinline__ void operator()(const f32x4 (&acc)[2][2][4][2], const Unit& u, int slot, int wr, int wc, int fr, int fq) const {
        const int col0 = u.pn * 256 + wc * 32 + 8 * fq;
#pragma unroll
        for (int ai = 0; ai < 2; ++ai) if (u.hm & (1 << ai))
#pragma unroll
            for (int m = 0; m < 4; ++m) { const int ri = slot * 256 + ai * 128 + wr * 64 + m * 16 + fr; const int a = S->rowA[ri];
                if (a >= 0) { const float w8 = S->rowW[ri] * (YB_SCALE / WD_SCALE);
#pragma unroll
                    for (int bj = 0; bj < 2; ++bj) { const f32x4 v0 = acc[ai][bj][m][0] * w8, v1 = acc[ai][bj][m][1] * w8;
                        u32x2 w; w.x = pk_fp8x4(v0[0], v0[1], v0[2], v0[3]); w.y = pk_fp8x4(v1[0], v1[1], v1[2], v1[3]);
                        *(u32x2*)(YB8 + (size_t)a * D + col0 + bj * 128) = w; } } }
    }
};

struct P0Item { const float* src; unsigned char* dst; int ldw, nvalid, K, fp8; float scale; };
__device__ __forceinline__ void p0_map(int r, int NB, int& kp, int& nb) { kp = r / NB; nb = r % NB; }
__device__ __forceinline__ P0Item p0_decode(int pr, int half, const Args& a, unsigned char* ws) {
    constexpr int P_IN = 16 * 76, P_SW = 8 * 32, P_OUT = 16 * 32, P_G = 16 * 64, P_GU = 16 * 8, P_DN = 4 * 32, P_EXP = 2 * P_GU + P_DN;
    P0Item q; q.fp8 = 0; q.scale = 1.f; int r = pr;
    if (r < P_IN) { int kp, nbx; p0_map(r, 76, kp, nbx); const int nb = nbx < 72 ? nbx : nbx + 64; const int kb = 2 * kp + half, n0 = nb * 64;
        int c0, nv; if (n0 < 4608) { c0 = n0; nv = 64; } else if (n0 == 8704) { c0 = 4608; nv = 16; } else { c0 = 0; nv = 0; }
        q.src = a.in[2] + (size_t)kb * 64 * 8720 + c0; q.ldw = 8720; q.nvalid = nv; q.K = D; q.dst = ws + WS_WINT + ((size_t)n0 * D + kb * 64) * 2; return q; }
    r -= P_IN;
    if (r < P_SW) { int kp, nb; p0_map(r, 32, kp, nb); const int kb = 2 * kp + half; q.src = a.in[5] + (size_t)kb * 64 * D + nb * 64; q.ldw = D; q.nvalid = 64; q.K = D; q.dst = ws + WS_WSWAT + ((size_t)nb * 64 * D + kb * 64) * 2; return q; }
    r -= P_SW;
    if (r < P_SW) { int kp, nb; p0_map(r, 32, kp, nb); const int kb = 2 * kp + half; q.src = a.in[6] + (size_t)kb * 64 * D + nb * 64; q.ldw = D; q.nvalid = 64; q.K = D; q.dst = ws + WS_WSWAT + ((size_t)nb * 64 * D + 1024 + kb * 64) * 2; return q; }
    r -= P_SW;
    if (r < P_OUT) { int kp, nb; p0_map(r, 32, kp, nb); const int kb = 2 * kp + half; q.src = a.in[7] + (size_t)kb * 64 * D + nb * 64; q.ldw = D; q.nvalid = 64; q.K = D; q.dst = ws + WS_WOUTT + ((size_t)nb * 64 * D + kb * 64) * 2; return q; }
    r -= P_OUT;
    q.fp8 = 1;
    if (r < P_G) { int kp, nb; p0_map(r, 64, kp, nb); const int kb = 2 * kp + half;
        q.src = a.in[2] + (size_t)kb * 64 * 8720 + 4624 + nb * 64; q.ldw = 8720; q.nvalid = 64; q.K = D; q.scale = WIN_SCALE; q.dst = ws + WS_WINT8 + (size_t)nb * 64 * D + kb * 64; return q; }
    r -= P_G;
    const int e = r / P_EXP; r -= e * P_EXP;
    if (r < 2 * P_GU) { const int up = r >= P_GU; r -= up * P_GU; int kp, nb; p0_map(r, 8, kp, nb); const int kb = 2 * kp + half, n0 = nb * 64;
        const float* src = e < 64 ? (up ? a.in[12] : a.in[11]) + (size_t)e * D * FF : (up ? a.in[15] : a.in[14]);
        const int drow = 256 * (n0 >> 7) + (n0 & 127) + 128 * up;
        q.src = src + (size_t)kb * 64 * FF + n0; q.ldw = FF; q.nvalid = 64; q.K = D; q.scale = WGU_SCALE; q.dst = ws + WS_WGU + ((size_t)e * 1024 + drow) * D + kb * 64; return q; }
    r -= 2 * P_GU;
    { int kp, nb; p0_map(r, 32, kp, nb); const int kb = 2 * kp + half;
        const float* src = e < 64 ? a.in[13] + (size_t)e * FF * D : a.in[16];
        q.src = src + (size_t)kb * 64 * D + nb * 64; q.ldw = D; q.nvalid = 64; q.K = FF; q.scale = WD_SCALE; q.dst = ws + WS_WD + ((size_t)e * D + nb * 64) * FF + kb * 64; return q; }
}
__device__ __forceinline__ void p0_load(const P0Item& q, f32x4 (&v)[16], int lane) {
    const int kr = lane >> 4, nc = (lane & 15) * 4; const bool ok = nc < q.nvalid;
    const float* p = q.src + (size_t)kr * q.ldw + nc;
#pragma unroll
    for (int i = 0; i < 16; ++i) v[i] = ok ? *(const f32x4*)(p + (size_t)(4 * i) * q.ldw) : (f32x4){0.f, 0.f, 0.f, 0.f};
}
__device__ __forceinline__ void p0_process(const P0Item& q, const f32x4 (&v)[16], LAS float* scr, int lane) {
    const int kr = lane >> 4, nc = (lane & 15) * 4;
#pragma unroll
    for (int i = 0; i < 16; ++i) { LAS float* w = scr + (4 * i + kr) * 65 + nc; w[0] = v[i][0]; w[1] = v[i][1]; w[2] = v[i][2]; w[3] = v[i][3]; }
    LDS_WAIT(); asm volatile("" ::: "memory");
    const int c = lane & 7;
#pragma unroll
    for (int j = 0; j < 8; ++j) { const int n = (lane >> 3) + 8 * j; const LAS float* s = scr + (8 * c) * 65 + n;
        u32x4 o; o.x = cvtpk(s[0 * 65], s[1 * 65]); o.y = cvtpk(s[2 * 65], s[3 * 65]); o.z = cvtpk(s[4 * 65], s[5 * 65]); o.w = cvtpk(s[6 * 65], s[7 * 65]);
        *(u32x4*)(q.dst + ((size_t)n * q.K + 8 * c) * 2) = o; }
    LDS_WAIT(); asm volatile("" ::: "memory");
}
__device__ __forceinline__ void p0_load8(const P0Item& q, f32x4 (&v)[16], int lane) {
    const int kq = lane >> 4, nc = (lane & 15) * 4;
    const float* p = q.src + (size_t)(16 * kq) * q.ldw + nc;
#pragma unroll
    for (int i = 0; i < 16; ++i) v[i] = __builtin_nontemporal_load((const f32x4*)(p + (size_t)i * q.ldw));
}
__device__ __forceinline__ void p0_pack8(const f32x4 (&v)[16], float sc, LAS unsigned char* tile, int chunk, int m) {
#pragma unroll
    for (int j = 0; j < 4; ++j) { const int n = 4 * m + j; u32x4 o;
        o.x = pk_fp8x4(v[0][j] * sc, v[1][j] * sc, v[2][j] * sc, v[3][j] * sc); o.y = pk_fp8x4(v[4][j] * sc, v[5][j] * sc, v[6][j] * sc, v[7][j] * sc);
        o.z = pk_fp8x4(v[8][j] * sc, v[9][j] * sc, v[10][j] * sc, v[11][j] * sc); o.w = pk_fp8x4(v[12][j] * sc, v[13][j] * sc, v[14][j] * sc, v[15][j] * sc);
        *(LAS u32x4*)(tile + n * 128 + ((chunk ^ ((n >> 2) & 7)) * 16)) = o; }
}
__device__ __forceinline__ void p0_prologue(Frame& F, const Args& a) {
    LAS float* scr = (LAS float*)(F.lds + F.wave * 16640);
    const int gw = F.vcu * NWAVES + F.wave, NGW = F.G * NWAVES;
    unsigned char* ws = F.ws;
    {
        const float* g = a.in[1];
        for (int m = gw; m < T; m += NGW) {
            const f32x4* xr = (const f32x4*)(a.in[0] + (size_t)m * D) + F.lane;
            f32x4 v[8]; float s = 0.f;
#pragma unroll
            for (int j = 0; j < 8; ++j) { v[j] = xr[64 * j]; s += (v[j].x * v[j].x + v[j].y * v[j].y) + (v[j].z * v[j].z + v[j].w * v[j].w); }
            const float rinv = rsqrtf(wave_sum(s) * (1.f / D) + RMS_EPS);
            u32x2* o = (u32x2*)((bf16_t*)(ws + WS_U) + (size_t)m * D) + F.lane; unsigned* o8 = (unsigned*)(ws + WS_U8 + (size_t)m * D) + F.lane;
#pragma unroll
            for (int j = 0; j < 8; ++j) { const f32x4 gg = *((const f32x4*)g + F.lane + 64 * j); const float u0 = v[j].x * rinv * gg.x, u1 = v[j].y * rinv * gg.y, u2 = v[j].z * rinv * gg.z, u3 = v[j].w * rinv * gg.w;
                u32x2 w; w.x = cvtpk(u0, u1); w.y = cvtpk(u2, u3); o[64 * j] = w; o8[64 * j] = pk_fp8x4(u0, u1, u2, u3); }
        }
    }
    {
        const float* wr = a.in[9]; const float* g = a.in[8]; u32x4* o = (u32x4*)(ws + WS_WRG);
        for (int i = gw * 64 + F.lane; i < 256 * NE; i += NGW * 64) { const int kb8 = i >> 6, e = i & 63; float x[8]; u32x4 h, l;
#pragma unroll
            for (int j = 0; j < 8; ++j) x[j] = wr[(size_t)(8 * kb8 + j) * NE + e] * g[8 * kb8 + j];
            h.x = cvtpk(x[0], x[1]); h.y = cvtpk(x[2], x[3]); h.z = cvtpk(x[4], x[5]); h.w = cvtpk(x[6], x[7]);
            l.x = cvtpk(x[0] - bflo(h.x), x[1] - bfhi(h.x)); l.y = cvtpk(x[2] - bflo(h.y), x[3] - bfhi(h.y)); l.z = cvtpk(x[4] - bflo(h.z), x[5] - bfhi(h.z)); l.w = cvtpk(x[6] - bflo(h.w), x[7] - bfhi(h.w));
            o[i] = h; o[16384 + i] = l; }
    }
    constexpr int NB16 = 16 * 76 + 2 * 8 * 32 + 16 * 32, NPAIRS = NB16 + 16 * 64 + 65 * (2 * 16 * 8 + 4 * 32);
    constexpr int REP = (PROBE_DUP == 0 || PROBE_DUP == 11) ? 2 : (PROBE_DUP == 10 ? 3 : 1);
    f32x4 va[16], vb[16]; P0Item qa, qb;
    {
        const int nj = (NB16 + NGW - 1) / NGW;
        int pr = gw;
        if (pr < NB16) { qa = p0_decode(pr, 0, a, ws); p0_load(qa, va, F.lane); }
        for (int j = 0; j < nj; ++j) {
            const bool act = pr < NB16;
            if (act) { qb = p0_decode(pr, 1, a, ws); p0_load(qb, vb, F.lane); }
            if (act) p0_process(qa, va, scr, F.lane);
            __builtin_amdgcn_s_barrier();
            const int pn = pr + NGW;
            if (pn < NB16) { qa = p0_decode(pn, 0, a, ws); p0_load(qa, va, F.lane); }
            if (act) p0_process(qb, vb, scr, F.lane);
            __builtin_amdgcn_s_barrier();
            pr = pn;
        }
    }
    {
        constexpr int NF = (NPAIRS - NB16) * REP;
        const int nj = (NF + NGW - 1) / NGW;
        LAS unsigned char* tile = (LAS unsigned char*)scr;
        const int kq = F.lane >> 4, m = F.lane & 15;
        int pr = gw;
        if (pr < NF) { qa = p0_decode(NB16 + pr % (NPAIRS - NB16), 0, a, ws); p0_load8(qa, va, F.lane); }
        for (int j = 0; j < nj; ++j) {
            const bool act = pr < NF;
            if (act) { qb = p0_decode(NB16 + pr % (NPAIRS - NB16), 1, a, ws); p0_load8(qb, vb, F.lane); }
            if (act) p0_pack8(va, qa.scale, tile, kq, m);
            __builtin_amdgcn_s_barrier();
            const int pn = pr + NGW;
            const P0Item qc = qa;
            if (pn < NF) { qa = p0_decode(NB16 + pn % (NPAIRS - NB16), 0, a, ws); p0_load8(qa, va, F.lane); }
            if (act) {
                p0_pack8(vb, qb.scale, tile, 4 + kq, m);
                LDS_WAIT(); asm volatile("" ::: "memory");
                const bool st = !(PROBE_DUP == 11 && pr >= NPAIRS - NB16);
                const int c = F.lane & 7;
#pragma unroll
                for (int jj = 0; jj < 8; ++jj) { const int n = (F.lane >> 3) + 8 * jj;
                    const u32x4 o = *(const LAS u32x4*)(tile + n * 128 + ((c ^ ((n >> 2) & 7)) * 16));
                    if (st) *(u32x4*)(qc.dst + (size_t)n * qc.K + 16 * c) = o; else asm volatile("" :: "v"(o)); }
                LDS_WAIT(); asm volatile("" ::: "memory");
            }
            __builtin_amdgcn_s_barrier();
            pr = pn;
        }
    }
}

__device__ __forceinline__ int crow(int r, int hi) { return (r & 3) + 8 * (r >> 2) + 4 * hi; }
__device__ __forceinline__ s16x4 vtr(LAS const char* p) { typedef short v4i16_t __attribute__((ext_vector_type(4))); return __builtin_bit_cast(s16x4, __builtin_amdgcn_ds_read_tr16_b64_v4i16((LAS v4i16_t*)p)); }

__device__ __forceinline__ void attn_qk(f32x16 (&p)[2], const bf16x8 (&qf)[4], LAS const char* Kt, int r32, int hi) {
#pragma unroll
    for (int kb = 0; kb < 2; ++kb) { const int kv = 32 * kb + r32; const int sw = (kv >> 1) & 7; LAS const char* rowp = Kt + kv * 128;
        f32x16 c = p[kb];
#pragma unroll
        for (int s = 0; s < 4; ++s) { const bf16x8 a = *(const LAS bf16x8*)(rowp + (((2 * s + hi) ^ sw) * 16)); c = __builtin_amdgcn_mfma_f32_32x32x16_bf16(a, qf[s], c, 0, 0, 0); }
        p[kb] = c; }
}
constexpr float ATT_THR = 8.0f;
__device__ __forceinline__ void attn_softmax_pv(f32x16 (&p)[2], f32x16 (&o)[2], float& m, float& l, LAS const char* Vt, int lane) {
    float mx = fmaxf(p[0][0], p[1][0]);
#pragma unroll
    for (int r = 1; r < 16; ++r) mx = fmaxf(mx, fmaxf(p[0][r], p[1][r]));
    mx = fmaxf(mx, __shfl_xor(mx, 32));
    if (__any(mx > ATT_THR)) {
        const float d = fmaxf(mx, 0.f), alpha = __builtin_amdgcn_exp2f(-d);
        m += d; l *= alpha;
#pragma unroll
        for (int kb = 0; kb < 2; ++kb)
#pragma unroll
            for (int r = 0; r < 16; ++r) p[kb][r] -= d;
#pragma unroll
        for (int db = 0; db < 2; ++db)
#pragma unroll
            for (int r = 0; r < 16; ++r) o[db][r] *= alpha;
    }
    float rs = 0.f;
#pragma unroll
    for (int kb = 0; kb < 2; ++kb)
#pragma unroll
        for (int r = 0; r < 16; ++r) { const float e = __builtin_amdgcn_exp2f(p[kb][r]); p[kb][r] = e; rs += e; }
    rs += __shfl_xor(rs, 32);
    l += rs;
    const int g = lane >> 4, i = lane & 15;
    LAS const char* vb = Vt + (4 * (g >> 1) + (i >> 2)) * 64 + (g & 1) * 32 + (i & 3) * 8;
#pragma unroll
    for (int kb = 0; kb < 2; ++kb)
#pragma unroll
        for (int ks = 0; ks < 2; ++ks) {
            u32x4 pw; pw.x = cvtpk(p[kb][8 * ks + 0], p[kb][8 * ks + 1]); pw.y = cvtpk(p[kb][8 * ks + 2], p[kb][8 * ks + 3]); pw.z = cvtpk(p[kb][8 * ks + 4], p[kb][8 * ks + 5]); pw.w = cvtpk(p[kb][8 * ks + 6], p[kb][8 * ks + 7]);
            const bf16x8 pb = __builtin_bit_cast(bf16x8, pw);
#pragma unroll
            for (int db = 0; db < 2; ++db) {
                const s16x4 lo = vtr(vb + db * 4096 + (32 * kb + 16 * ks) * 64), hi4 = vtr(vb + db * 4096 + (32 * kb + 16 * ks + 8) * 64);
                const bf16x8 va = (bf16x8){lo[0], lo[1], lo[2], lo[3], hi4[0], hi4[1], hi4[2], hi4[3]};
                o[db] = __builtin_amdgcn_mfma_f32_32x32x16_bf16(va, pb, o[db], 0, 0, 0); } }
}
__device__ __forceinline__ void attn_store_kv(LAS char* Kt, LAS char* Vt, const u32x4& kr, const u32x4& vr, int tid) {
    const int kv = tid >> 3, c = tid & 7;
    *(LAS u32x4*)(Kt + kv * 128 + ((c ^ ((kv >> 1) & 7)) * 16)) = kr;
    *(LAS u32x4*)(Vt + (c >> 2) * 4096 + kv * 64 + (c & 3) * 16) = vr;
}
__device__ __forceinline__ void attn_store_o(const f32x16 (&o)[2], float l, bf16_t* orow, int hi) {
    const float rl = 1.0f / l;
#pragma unroll
    for (int db = 0; db < 2; ++db)
#pragma unroll
        for (int rq = 0; rq < 4; ++rq) { u32x2 w; w.x = cvtpk(o[db][4 * rq] * rl, o[db][4 * rq + 1] * rl); w.y = cvtpk(o[db][4 * rq + 2] * rl, o[db][4 * rq + 3] * rl);
            *(u32x2*)(orow + 32 * db + 8 * rq + 4 * hi) = w; }
}

__device__ __forceinline__ void swa_unit(Frame& F, int unit, const float* sinks) {
    const bf16_t* Z = (const bf16_t*)(F.ws + WS_Z); bf16_t* YS = (bf16_t*)(F.ws + WS_YS);
    const int b = unit >> 6, kvh = (unit >> 4) & 3, nb = unit & 15;
    const int tid = F.tid, lane = F.lane, r32 = lane & 31, hi = lane >> 5, w = F.wave;
    LAS char* Kl = (LAS char*)F.lds; LAS char* Vl = (LAS char*)F.lds + 32768;
    const int t0 = nb * 128;
    {
        const int kv = tid >> 3, c = tid & 7;
#pragma unroll
        for (int tl = 0; tl < 4; ++tl) {
            if (nb > 0 || tl >= 2) {
                const size_t row = (size_t)(b * SEQ + t0 - 128 + tl * 64 + kv);
                const u32x4 kr = *(const u32x4*)(Z + row * ZP + ZK + kvh * 64 + c * 8);
                const u32x4 vr = *(const u32x4*)(Z + row * ZP + ZV + kvh * 64 + c * 8);
                attn_store_kv(Kl + tl * 8192, Vl + tl * 8192, kr, vr, tid);
            }
        }
    }
    __syncthreads();
    const int qh = kvh * 4 + (w >> 1);
    const float slope2 = exp2f(-0.5f * (float)(qh + 1)) * LOG2E;
    const float sink2 = sinks[qh] * LOG2E;
#pragma unroll 1
    for (int sb = 0; sb < 2; ++sb) {
        const int r0 = 64 * (w & 1) + 32 * sb;
        const int qrel = r0 + r32;
        const size_t qrow = (size_t)(b * SEQ + t0 + qrel);
        bf16x8 qf[4];
#pragma unroll
        for (int s = 0; s < 4; ++s) qf[s] = *(const bf16x8*)(Z + qrow * ZP + ZQ + qh * 64 + 16 * s + 8 * hi);
        f32x16 o[2]; o[0] = f32x16{}; o[1] = f32x16{};
        float m = sink2, l = 1.0f;
        const int tl0 = (r0 + 1) >> 6;
#pragma unroll 1
        for (int tt = 0; tt < 3; ++tt) {
            const int tl = tl0 + tt;
            if (nb == 0 && tl < 2) continue;
            f32x16 p[2];
            const float qterm = -slope2 * (float)qrel - m;
#pragma unroll
            for (int kb = 0; kb < 2; ++kb)
#pragma unroll
                for (int r = 0; r < 16; ++r) p[kb][r] = fmaf(slope2, (float)(tl * 64 + 32 * kb + crow(r, hi) - 128), qterm);
            attn_qk(p, qf, Kl + tl * 8192, r32, hi);
#pragma unroll
            for (int kb = 0; kb < 2; ++kb)
#pragma unroll
                for (int r = 0; r < 16; ++r) {
                    const int dist = qrel - (tl * 64 + 32 * kb + crow(r, hi) - 128);
                    if (!(dist >= 0 && dist < 128)) p[kb][r] = -INFINITY;
                }
            attn_softmax_pv(p, o, m, l, Vl + tl * 8192, lane);
        }
        attn_store_o(o, l, YS + qrow * 2048 + qh * 64, hi);
    }
    __syncthreads();
}

__device__ __forceinline__ void fox_unit(Frame& F, int bh, int qb, LAS const float* c2) {
    const bf16_t* Z = (const bf16_t*)(F.ws + WS_Z); bf16_t* YF = (bf16_t*)(F.ws + WS_YS);
    const int b = bh >> 4, h = bh & 15;
    const int tid = F.tid, lane = F.lane, r32 = lane & 31, hi = lane >> 5, w = F.wave;
    LAS char* Kl = (LAS char*)F.lds; LAS char* Vl = (LAS char*)F.lds + 16384;
    const int q0 = qb * 256, qw = q0 + 32 * w, qabs = qw + r32;
    const size_t qrow = (size_t)(b * SEQ + qabs);
    const int NT = 4 * (qb + 1);
    const int kvr = tid >> 3, kc = tid & 7;
    const bf16_t* kbase = Z + (size_t)(b * SEQ + kvr) * ZP + ZFK + h * 64 + kc * 8;
    const bf16_t* vbase = Z + (size_t)(b * SEQ + kvr) * ZP + ZFV + h * 64 + kc * 8;
    u32x4 kra = *(const u32x4*)kbase, vra = *(const u32x4*)vbase;
    u32x4 krb = *(const u32x4*)(kbase + (size_t)64 * ZP), vrb = *(const u32x4*)(vbase + (size_t)64 * ZP);
    bf16x8 qf[4];
#pragma unroll
    for (int s = 0; s < 4; ++s) qf[s] = *(const bf16x8*)(Z + qrow * ZP + ZFQ + h * 64 + 16 * s + 8 * hi);
    attn_store_kv(Kl, Vl, kra, vra, tid);
    __syncthreads();
    f32x16 o[2]; o[0] = f32x16{}; o[1] = f32x16{};
    float m = -c2[qabs], l = 0.f;
#define FOX_STEP(t, KRN, VRN, KRC, VRC) do { \
        const int buf = (t) & 1; \
        if ((t) + 2 < NT) { KRN = *(const u32x4*)(kbase + (size_t)((t) + 2) * 64 * ZP); VRN = *(const u32x4*)(vbase + (size_t)((t) + 2) * 64 * ZP); } \
        const int k0 = (t) * 64; \
        if (k0 <= qw + 31) { \
            f32x16 p[2]; const float negm = -m; \
            _Pragma("unroll") for (int kb = 0; kb < 2; ++kb) _Pragma("unroll") for (int rq = 0; rq < 4; ++rq) { const f32x4 cc = *(const LAS f32x4*)(c2 + k0 + 32 * kb + 8 * rq + 4 * hi); \
                _Pragma("unroll") for (int j = 0; j < 4; ++j) p[kb][4 * rq + j] = negm - cc[j]; } \
            attn_qk(p, qf, Kl + buf * 8192, r32, hi); \
            if (k0 + 63 > qw) { _Pragma("unroll") for (int kb = 0; kb < 2; ++kb) _Pragma("unroll") for (int r = 0; r < 16; ++r) if (k0 + 32 * kb + crow(r, hi) > qabs) p[kb][r] = -INFINITY; } \
            attn_softmax_pv(p, o, m, l, Vl + buf * 8192, lane); \
        } \
        if ((t) + 1 < NT) attn_store_kv(Kl + (buf ^ 1) * 8192, Vl + (buf ^ 1) * 8192, KRC, VRC, tid); \
        __syncthreads(); } while (0)
#pragma unroll 1
    for (int t = 0; t < NT; t += 2) {
        FOX_STEP(t, kra, vra, krb, vrb);
        FOX_STEP(t + 1, krb, vrb, kra, vra);
    }
#undef FOX_STEP
    attn_store_o(o, l, YF + qrow * 2048 + 1024 + h * 64, hi);
}
__device__ __forceinline__ void p2_attention(Frame& F, const Args& a) {
    for (int u = F.vcu; u < 256; u += F.G) swa_unit(F, u, a.in[4]);
    LAS float* c2 = (LAS float*)(F.lds + 32768);
    LAS float* wtot = (LAS float*)(F.lds + 32768 + 8192);
    const float* FL = (const float*)(F.ws + WS_FL);
    for (int it = F.vcu; it < 256; it += F.G) {
        const int bh = it >> 2, s = it & 3, b = bh >> 4, h = bh & 15;
        {
            float v[4]; float run = 0.f;
#pragma unroll
            for (int j = 0; j < 4; ++j) { run += FL[(size_t)(b * SEQ + 4 * F.tid + j) * 16 + h]; v[j] = run; }
            float inc = run;
#pragma unroll
            for (int o = 1; o < 64; o <<= 1) { const float n = __shfl_up(inc, o); if (F.lane >= o) inc += n; }
            if (F.lane == 63) wtot[F.wave] = inc;
            __syncthreads();
            float base = inc - run;
            for (int ww = 0; ww < F.wave; ++ww) base += wtot[ww];
#pragma unroll
            for (int j = 0; j < 4; ++j) c2[4 * F.tid + j] = base + v[j];
            __syncthreads();
        }
        fox_unit(F, bh, s, c2);
        fox_unit(F, bh, 7 - s, c2);
        __syncthreads();
    }
}

__device__ __forceinline__ void p5_router(Frame& F, const Args& a, unsigned* CNT, float* LISTW, int* LIST) {
    const float* H1 = (const float*)(F.ws + WS_H1); const float* PSQ = (const float*)(F.ws + WS_PSQ);
    unsigned char* V8 = F.ws + WS_V;
    const float* g = a.in[8]; const float* rbias = a.in[10];
    const int lane = F.lane, w = F.wave, tid = F.tid;
    LAS float* part = (LAS float*)F.lds;
    LAS float* logit = (LAS float*)(F.lds + 65536);
    LAS float* rinvs = (LAS float*)(F.lds + 65536 + 8192);
    LAS int* lcnt = (LAS int*)(F.lds + 65536 + 8192 + 128);
    LAS int* gbase = (LAS int*)(F.lds + 65536 + 8192 + 128 + 256);
    for (int tile = F.vcu; tile < T / 32; tile += F.G) {
        const int tok0 = tile * 32;
        if (tid < 64) lcnt[tid] = 0;
#pragma unroll
        for (int j = 0; j < 4; ++j) {
            const int tok = tok0 + 4 * w + j;
            float sq = lane < 32 ? PSQ[(size_t)tok * 32 + lane] : 0.f;
            sq = wave_sum(sq);
            const float rinv = rsqrtf(sq * (1.f / D) + RMS_EPS);
            if (lane == 0) rinvs[4 * w + j] = rinv;
            const f32x4* hr = (const f32x4*)(H1 + (size_t)tok * D) + lane;
            unsigned* o = (unsigned*)(V8 + (size_t)tok * D) + lane;
#pragma unroll
            for (int jj = 0; jj < 8; ++jj) { const f32x4 hv = hr[64 * jj]; const f32x4 gg = *((const f32x4*)g + lane + 64 * jj);
                o[64 * jj] = pk_fp8x4(hv.x * rinv * gg.x, hv.y * rinv * gg.y, hv.z * rinv * gg.z, hv.w * rinv * gg.w); }
        }
        {
            f32x16 acc0 = {}, acc1 = {};
            const int tk = lane & 31, half = lane >> 5;
            const float* hp = H1 + (size_t)(tok0 + tk) * D + 256 * w + 8 * half;
            const u32x4* wh = (const u32x4*)(F.ws + WS_WRG) + (size_t)(32 * w + half) * 64 + tk;
            const u32x4* wl = wh + 16384;
#pragma unroll 4
            for (int s16 = 0; s16 < 16; ++s16) {
                const f32x4 x0 = *(const f32x4*)(hp + 16 * s16), x1 = *(const f32x4*)(hp + 16 * s16 + 4);
                const u32x4 bh0 = wh[(size_t)(2 * s16) * 64], bh1 = wh[(size_t)(2 * s16) * 64 + 32], bl0 = wl[(size_t)(2 * s16) * 64], bl1 = wl[(size_t)(2 * s16) * 64 + 32];
                u32x4 ah, al;
                ah.x = cvtpk(x0[0], x0[1]); ah.y = cvtpk(x0[2], x0[3]); ah.z = cvtpk(x1[0], x1[1]); ah.w = cvtpk(x1[2], x1[3]);
                al.x = cvtpk(x0[0] - bflo(ah.x), x0[1] - bfhi(ah.x)); al.y = cvtpk(x0[2] - bflo(ah.y), x0[3] - bfhi(ah.y)); al.z = cvtpk(x1[0] - bflo(ah.z), x1[1] - bfhi(ah.z)); al.w = cvtpk(x1[2] - bflo(ah.w), x1[3] - bfhi(ah.w));
                const bf16x8 AH = __builtin_bit_cast(bf16x8, ah), AL = __builtin_bit_cast(bf16x8, al);
                acc0 = __builtin_amdgcn_mfma_f32_32x32x16_bf16(AH, __builtin_bit_cast(bf16x8, bh0), acc0, 0, 0, 0);
                acc1 = __builtin_amdgcn_mfma_f32_32x32x16_bf16(AH, __builtin_bit_cast(bf16x8, bh1), acc1, 0, 0, 0);
                acc0 = __builtin_amdgcn_mfma_f32_32x32x16_bf16(AH, __builtin_bit_cast(bf16x8, bl0), acc0, 0, 0, 0);
                acc1 = __builtin_amdgcn_mfma_f32_32x32x16_bf16(AH, __builtin_bit_cast(bf16x8, bl1), acc1, 0, 0, 0);
                acc0 = __builtin_amdgcn_mfma_f32_32x32x16_bf16(AL, __builtin_bit_cast(bf16x8, bh0), acc0, 0, 0, 0);
                acc1 = __builtin_amdgcn_mfma_f32_32x32x16_bf16(AL, __builtin_bit_cast(bf16x8, bh1), acc1, 0, 0, 0);
            }
#pragma unroll
            for (int r = 0; r < 16; ++r) { const int tr = crow(r, half); part[(w * 32 + tr) * 64 + tk] = acc0[r]; part[(w * 32 + tr) * 64 + 32 + tk] = acc1[r]; }
        }
        __syncthreads();
#pragma unroll
        for (int q = 0; q < 4; ++q) { const int idx = tid + 512 * q; float s = 0.f;
#pragma unroll
            for (int ww = 0; ww < 8; ++ww) s += part[ww * 2048 + idx];
            logit[idx] = s * rinvs[idx >> 6]; }
        __syncthreads();
        int sel_k[4], sel_ls[4]; float sel_w[4];
        const float bias = rbias[lane];
#pragma unroll
        for (int j = 0; j < 4; ++j) {
            const int tl = 4 * w + j;
            const float score = sigmoidf_(logit[tl * 64 + lane]);
            const float biased = score + bias;
            float m1 = biased; m1 = fmaxf(m1, __shfl_xor(m1, 1)); m1 = fmaxf(m1, __shfl_xor(m1, 2)); m1 = fmaxf(m1, __shfl_xor(m1, 4));
            const unsigned long long gm = 0xFFull << (lane & 56);
            const unsigned long long b1 = __ballot(biased == m1) & gm;
            const int i1 = __builtin_ctzll(b1);
            float v2 = (lane == i1) ? -INFINITY : biased;
            float m2 = v2; m2 = fmaxf(m2, __shfl_xor(m2, 1)); m2 = fmaxf(m2, __shfl_xor(m2, 2)); m2 = fmaxf(m2, __shfl_xor(m2, 4));
            const float gs = m1 + m2; const int gi = lane >> 3;
            int rank = 0;
#pragma unroll
            for (int gg = 0; gg < 8; ++gg) { const float o = __shfl(gs, 8 * gg); rank += (o > gs || (o == gs && gg < gi)) ? 1 : 0; }
            float mv = rank < 4 ? biased : -INFINITY;
            int myk = -1;
#pragma unroll
            for (int it = 0; it < 8; ++it) { const float mx = wave_max(mv); const unsigned long long bb = __ballot(mv == mx); const int sl = __builtin_ctzll(bb); if (lane == sl) { myk = it; mv = -INFINITY; } }
            const float ssum = wave_sum(myk >= 0 ? score : 0.f);
            sel_k[j] = myk; sel_w[j] = score / ssum * 2.5f;
            sel_ls[j] = 0;
            if (myk >= 0) sel_ls[j] = __hip_atomic_fetch_add((LAS int*)&lcnt[lane], 1, __ATOMIC_RELAXED, __HIP_MEMORY_SCOPE_WORKGROUP);
        }
        __syncthreads();
        if (tid < 64) gbase[tid] = (int)atomicAdd(CNT + tid, (unsigned)lcnt[tid]);
        __syncthreads();
#pragma unroll
        for (int j = 0; j < 4; ++j) if (sel_k[j] >= 0) { const int tok = tok0 + 4 * w + j; const int aid = tok * 8 + sel_k[j];
            const size_t li = (size_t)lane * T + gbase[lane] + sel_ls[j]; LIST[li] = aid; LISTW[li] = sel_w[j]; }
        __syncthreads();
    }
}

template <int MULT> __device__ __forceinline__ int moe_table(Frame& F, LAS int* tab) {
    if (F.tid < 64) {
        const int cnt = (int)__hip_atomic_load(F.ctl + CW_CNT + F.tid, __ATOMIC_RELAXED, __HIP_MEMORY_SCOPE_AGENT);
        int inc = ((cnt + 255) >> 8) * MULT;
#pragma unroll
        for (int o = 1; o < 64; o <<= 1) { const int n = __shfl_up(inc, o); if (F.lane >= o) inc += n; }
        tab[F.tid] = inc; tab[64 + F.tid] = cnt;
    }
    __syncthreads();
    return 32 * MULT + tab[63];
}

__device__ __forceinline__ void p8_final(Frame& F, const Args& a) {
    const float* H1 = (const float*)(F.ws + WS_H1); const unsigned char* YB8 = F.ws + WS_YB; const float* g = a.in[17];
    const int gw = F.vcu * NWAVES + F.wave, NGW = F.G * NWAVES;
    for (int tok = gw; tok < T; tok += NGW) {
        const f32x4* hr = (const f32x4*)(H1 + (size_t)tok * D) + F.lane;
        f32x4 v[8], y[8];
#pragma unroll
        for (int j = 0; j < 8; ++j) { v[j] = hr[64 * j]; y[j] = (f32x4){0.f, 0.f, 0.f, 0.f}; }
#pragma unroll 3
        for (int k = 0; k < 9; ++k) {
            const size_t row = k < 8 ? (size_t)tok * 8 + k : (size_t)NASSIGN + tok;
            const unsigned* yr = (const unsigned*)(YB8 + row * D) + F.lane;
#pragma unroll
            for (int j = 0; j < 8; ++j) { const unsigned w = yr[64 * j]; const f32x2 lo = __builtin_amdgcn_cvt_pk_f32_fp8((int)w, false), hi = __builtin_amdgcn_cvt_pk_f32_fp8((int)w, true);
                y[j].x += lo.x; y[j].y += lo.y; y[j].z += hi.x; y[j].w += hi.y; }
        }
#pragma unroll
        for (int j = 0; j < 8; ++j) v[j] = v[j] + y[j] * (1.f / YB_SCALE);
        float s = 0.f;
#pragma unroll
        for (int j = 0; j < 8; ++j) s += (v[j].x * v[j].x + v[j].y * v[j].y) + (v[j].z * v[j].z + v[j].w * v[j].w);
        const float rinv = rsqrtf(wave_sum(s) * (1.f / D) + RMS_EPS);
        f32x4* o = (f32x4*)(a.out + (size_t)tok * D) + F.lane;
#pragma unroll
        for (int j = 0; j < 8; ++j) { const f32x4 gg = *((const f32x4*)g + F.lane + 64 * j); o[64 * j] = (f32x4){v[j].x * rinv * gg.x, v[j].y * rinv * gg.y, v[j].z * rinv * gg.z, v[j].w * rinv * gg.w}; }
    }
}

constexpr int N_PHASES = 9;
__global__ void __launch_bounds__(NTHREADS, 2) fwd_kernel(Args args) {
    extern __shared__ __attribute__((aligned(16))) unsigned char lds_raw[];
    Frame F;
    F.lds = (LAS unsigned char*)lds_raw;
    F.MISC = (volatile LAS unsigned*)(F.lds + MISC_OFF);
    F.tid = threadIdx.x; F.lane = F.tid & 63; F.wave = __builtin_amdgcn_readfirstlane(F.tid >> 6);
    F.G = gridDim.x; { const int bx = blockIdx.x; F.vcu = (F.G % 8 == 0) ? (bx % 8) * (F.G / 8) + bx / 8 : bx; }
    F.ws = args.ws; F.ctl = (unsigned*)(args.ws + WS_CTL);
    for (int u = F.tid; u < (LDS_BYTES - MISC_OFF) / 4; u += NTHREADS) ((LAS unsigned*)(F.lds + MISC_OFF))[u] = 0u;
    __syncthreads();
    const int lo = args.ph_lo, hi = args.ph_hi;
    XcdBarrier bar; bar.bar = F.ctl + CW_BAR; bar.x = 0; bar.st = nullptr;
    if (hi - lo > 1) bar = xcd_barrier_post(F.ctl + CW_BAR, F.MISC + 8);
#define IN(k) (lo <= (k) && (k) < hi)
#define SEAM(k) do { if (IN(k) && IN((k) + 1)) xcd_barrier(bar); } while (0)
    unsigned char* ws = args.ws;
    LAS int* tab = (LAS int*)(F.lds + MISC_OFF + 256);

#define REPS(k) for (int rep_ = 0; rep_ < (PROBE_DUP == (k) ? 2 : 1); ++rep_)
#define REPBAR(k) do { if (PROBE_DUP == (k) && rep_ == 0) xcd_barrier(bar); } while (0)
    if (IN(0)) { p0_prologue(F, args); SEAM(0); }
    if (IN(1)) {
        {
            DenseSched S{(const char*)(ws + WS_U), (const char*)(ws + WS_WINT), T / 256, 19, 2 * D, F.G, (int)blockIdx.x, PROBE_DUP == 1 ? 2 : 1, (T / 256) * 19 % 256, 0, 34};
            EpiZ E{(bf16_t*)(ws + WS_Z), (float*)(ws + WS_FL), args.in[3], 1.f};
            pg8::gemm_phase<false>(F.lds, 2 * D, S, E);
        }
        {
            DenseSched S{(const char*)(ws + WS_U8), (const char*)(ws + WS_WINT8), T / 256, 16, D, F.G, (int)blockIdx.x, PROBE_DUP == 1 ? 2 : 1, 0, 18, -1};
            EpiZ E{(bf16_t*)(ws + WS_Z), (float*)(ws + WS_FL), args.in[3], 1.f / WIN_SCALE};
            pg8::gemm_phase<true>(F.lds, D, S, E);
        }
        SEAM(1);
    }
    if (IN(2)) { REPS(2) { p2_attention(F, args); REPBAR(2); } SEAM(2); }
    if (IN(3)) {
DenseSched S{(const char*)(ws + WS_YS), (const char*)(ws + WS_WSWAT), T / 256, D / 256, 2 * D, F.G, (int)blockIdx.x, PROBE_DUP == 3 ? 2 : 1, 0, 0, -1};
        EpiMix E{(const bf16_t*)(ws + WS_Z), (bf16_t*)(ws + WS_MIX)};
        pg8::gemm_phase<false>(F.lds, 2 * D, S, E);
        SEAM(3);
    }
    if (IN(4)) {
        DenseSched S{(const char*)(ws + WS_MIX), (const char*)(ws + WS_WOUTT), T / 256, D / 256, 2 * D, F.G, (int)blockIdx.x, PROBE_DUP == 4 ? 2 : 1, 0, 0, -1};
        EpiOut E{args.in[0], (float*)(ws + WS_H1), (float*)(ws + WS_PSQ)};
        pg8::gemm_phase<false>(F.lds, 2 * D, S, E);
        SEAM(4);
    }
    if (IN(5)) {
        if (PROBE_DUP == 5) { p5_router(F, args, F.ctl + 256, (float*)(ws + WS_T1), (int*)(ws + WS_T1 + 2 * MiB)); xcd_barrier(bar); }
        p5_router(F, args, F.ctl + CW_CNT, (float*)(ws + WS_LISTW), (int*)(ws + WS_LIST));
        if (PROBE_DUP == 9) { for (int q = 0; q < 16; ++q) xcd_barrier(bar); }
        SEAM(5); }
    if (IN(6)) {
        const int total = moe_table<4>(F, tab);
        MoeSched<0> S{tab, (const int*)(ws + WS_LIST), (const float*)(ws + WS_LISTW), (const char*)(ws + WS_V), (const char*)(ws + WS_WGU), (LAS int*)(F.lds + MISC_OFF + 1024), (LAS float*)(F.lds + MISC_OFF + 4096), total, F.G, F.vcu, PROBE_DUP == 6 ? 2 : 1};
        EpiSwiglu E{&S, (unsigned char*)(ws + WS_HB)};
        pg8::gemm_phase<true>(F.lds, 2048, S, E);
        SEAM(6);
    }
    if (IN(7)) {
        const int total = moe_table<8>(F, tab);
        MoeSched<1> S{tab, (const int*)(ws + WS_LIST), (const float*)(ws + WS_LISTW), (const char*)(ws + WS_HB), (const char*)(ws + WS_WD), (LAS int*)(F.lds + MISC_OFF + 1024), (LAS float*)(F.lds + MISC_OFF + 4096), total, F.G, F.vcu, PROBE_DUP == 7 ? 2 : 1};
        EpiDown E{&S, (unsigned char*)(ws + WS_YB)};
        pg8::gemm_phase<true>(F.lds, 512, S, E);
        SEAM(7);
    }
    if (IN(8)) { REPS(8) { p8_final(F, args); REPBAR(8); } }
#undef IN
#undef SEAM
}

extern "C" void kernel_launch(void* const* d_in, const int* in_sizes, int n_in, void* d_out, int out_size, void* d_ws, size_t ws_size, hipStream_t stream) {
    static int grid = 0;
    if (grid == 0) {
        if (n_in != 18 || out_size != T * D || ws_size < WS_END) { fprintf(stderr, "kernel_launch: unexpected shapes (n_in %d out %d ws %zu)\n", n_in, out_size, ws_size); grid = -1; return; }
        int dev = 0, cus = 0, per_cu = 0;
        if (hipGetDevice(&dev) != hipSuccess || hipDeviceGetAttribute(&cus, hipDeviceAttributeMultiprocessorCount, dev) != hipSuccess) { grid = -1; return; }
        if (hipFuncSetAttribute((const void*)fwd_kernel, hipFuncAttributeMaxDynamicSharedMemorySize, LDS_BYTES) != hipSuccess) { fprintf(stderr, "kernel_launch: hipFuncSetAttribute failed\n"); grid = -1; return; }
        if (hipOccupancyMaxActiveBlocksPerMultiprocessor(&per_cu, (const void*)fwd_kernel, NTHREADS, LDS_BYTES) != hipSuccess || per_cu < 1) { fprintf(stderr, "kernel_launch: occupancy query says %d blocks per CU\n", per_cu); (void)hipGetLastError(); grid = -1; return; }
        grid = cus;
        if (grid % 8 != 0 || grid > 256) grid = (grid / 8) * 8 > 256 ? 256 : (grid / 8) * 8;
    }
    if (grid <= 0) return;
    (void)hipMemsetAsync((char*)d_ws + WS_CTL, 0, CTL_ZERO_BYTES, stream);
    Args a{};
    for (int i = 0; i < 18; ++i) a.in[i] = (const float*)d_in[i];
    a.out = (float*)d_out; a.ws = (unsigned char*)d_ws;
#if MK_N_LAUNCHES == 1
    a.ph_lo = 0; a.ph_hi = N_PHASES;
    hipLaunchKernelGGL(fwd_kernel, dim3(grid), dim3(NTHREADS), LDS_BYTES, stream, a);
#else
    for (int p = 0; p < N_PHASES; ++p) { a.ph_lo = p; a.ph_hi = p + 1; hipLaunchKernelGGL(fwd_kernel, dim3(grid), dim3(NTHREADS), LDS_BYTES, stream, a); }
#endif
}
```
